# Optimizing an MI355X kernel written in HIP

```python
import math
import jax, jax.numpy as jnp
from jax import lax
import numpy as np

D_MODEL = 1024
BATCH = 8
SEQ = 4096
DEPTH = 2

GRID_W = 64
CTX_LEN = 256
N_MIXERS = 2
D_INNER = 2 * D_MODEL
HEADDIM = 64
N_SSD_HEADS = D_INNER // HEADDIM
N_GROUPS = 8
HPG = N_SSD_HEADS // N_GROUPS
D_STATE = 128
SSD_CONV = 5
CHUNK = 128
CONV_DIM = D_INNER + 2 * N_GROUPS * D_STATE
D_IN_PROJ = 2 * D_INNER + 2 * N_GROUPS * D_STATE + 2 * N_SSD_HEADS
SC_WIDTH = D_MODEL
SC_K = 3
D_FF = 2816
N_EXPERTS = 8
TOP_K = 2
D_FF_EXPERT = 3584
EPS = 1e-6
N_EVEN = (DEPTH + 1) // 2
N_ODD = DEPTH // 2

kernel_name = "hybrid_ssd_shortconv_moe_dit"


def rmsnorm(x, g):
    xf = x.astype(jnp.float32)
    xf = xf * lax.rsqrt(jnp.mean(xf * xf, axis=-1, keepdims=True) + EPS)
    return (xf * g.astype(jnp.float32)).astype(x.dtype)


def dwconv_centred(u, w):
    k = w.shape[0]
    pad = k // 2
    n = u.shape[-2]
    up = jnp.pad(u, [(0, 0)] * (u.ndim - 2) + [(pad, pad), (0, 0)])
    return sum(up[..., t:t + n, :] * w[t] for t in range(k))


def conv_rows(u, w, rows):
    b, n, ch = u.shape
    return dwconv_centred(u.reshape(b, rows, GRID_W, ch), w).reshape(b, n, ch)


def ssd_chunked(xh, dt, A, Bm, Cm, h0, want_y=True):
    b, n, g, j, p = xh.shape
    ns = Bm.shape[-1]
    nc = n // CHUNK
    xdt = (xh * dt[..., None]).reshape(b, nc, CHUNK, g, j, p)
    Bc = Bm.reshape(b, nc, CHUNK, g, ns)
    Cc = Cm.reshape(b, nc, CHUNK, g, ns)
    dA = (dt * A).reshape(b, nc, CHUNK, g, j).transpose(0, 1, 3, 4, 2)
    acum = jnp.cumsum(dA, axis=-1)
    decay_in = jnp.exp(acum[..., -1:] - acum)
    states = jnp.einsum("bcsgn,bcgjs,bcsgjp->bcgjpn", Bc, decay_in, xdt).astype(jnp.float32)
    chunk_decay = jnp.exp(acum[..., -1])

    def step(h, inp):
        st, dec = inp
        return dec[..., None, None] * h + st, h

    h_final, h_in = lax.scan(step, h0.astype(jnp.float32),
                             (jnp.moveaxis(states, 1, 0), jnp.moveaxis(chunk_decay, 1, 0)))
    if not want_y:
        return None, h_final
    h_in = jnp.moveaxis(h_in, 0, 1)
    mask = jnp.tril(jnp.ones((CHUNK, CHUNK), dtype=bool))
    seg = acum[..., :, None] - acum[..., None, :]
    lmat = jnp.exp(jnp.where(mask, seg, -jnp.inf))
    cb = jnp.einsum("bclgn,bcsgn->bcgls", Cc, Bc)
    y_diag = jnp.einsum("bcgls,bcgjls,bcsgjp->bclgjp", cb, lmat, xdt)
    y_off = jnp.einsum("bclgn,bcgjpn,bcgjl->bclgjp", Cc, h_in, jnp.exp(acum))
    return (y_diag + y_off).reshape(b, n, g, j, p), h_final


def ssd_mixer(h_lat, h_ctx, rows, w_in, conv_w, conv_b, a_log, dt_bias, d_skip, norm_w, w_out, ctx_out):
    A = -jnp.exp(a_log.astype(jnp.float32)).reshape(2, N_GROUPS, HPG)

    def prep(h, conv_fn):
        b, n = h.shape[:2]
        z, xbc, dt_raw = jnp.split(h @ w_in, [D_INNER, D_INNER + CONV_DIM], axis=-1)
        xbc = jax.nn.silu(conv_fn(xbc) + conv_b)
        xs, bm, cm = jnp.split(xbc, [D_INNER, D_INNER + N_GROUPS * D_STATE], axis=-1)
        xs = xs.reshape(b, n, N_GROUPS, HPG, HEADDIM)
        bm = bm.reshape(b, n, N_GROUPS, D_STATE)
        cm = cm.reshape(b, n, N_GROUPS, D_STATE)
        dt = jax.nn.softplus((dt_raw + dt_bias.reshape(-1)).astype(jnp.float32))
        return z, xs, bm, cm, dt.reshape(b, n, 2, N_GROUPS, HPG)

    def finish(z, xs, y):
        b, n = z.shape[:2]
        y = y + d_skip.reshape(N_GROUPS, HPG, 1) * xs
        y = y.reshape(b, n, D_INNER).astype(z.dtype) * jax.nn.silu(z)
        y = rmsnorm(y.reshape(b, n, N_GROUPS, D_INNER // N_GROUPS),
                    norm_w.reshape(N_GROUPS, D_INNER // N_GROUPS)).reshape(b, n, D_INNER)
        return y @ w_out

    zc, xc, bc, cc, dtc = prep(h_ctx, lambda u: dwconv_centred(u, conv_w))
    zl, xl, bl, cl, dtl = prep(h_lat, lambda u: conv_rows(u, conv_w, rows))
    b = h_lat.shape[0]
    y_lat = jnp.zeros(xl.shape, jnp.float32)
    y_ctx = jnp.zeros(xc.shape, jnp.float32) if ctx_out else None
    for d in range(2):
        o = (lambda t: t) if d == 0 else (lambda t: jnp.flip(t, axis=1))
        h0 = jnp.zeros((b, N_GROUPS, HPG, HEADDIM, D_STATE), jnp.float32)
        yc, hc = ssd_chunked(o(xc), o(dtc[:, :, d]), A[d], o(bc), o(cc), h0, want_y=ctx_out)
        yl, _ = ssd_chunked(o(xl), o(dtl[:, :, d]), A[d], o(bl), o(cl), hc)
        y_lat = y_lat + o(yl)
        if ctx_out:
            y_ctx = y_ctx + o(yc)
    out_lat = finish(zl, xl, y_lat)
    out_ctx = finish(zc, xc, y_ctx) if ctx_out else None
    return out_lat, out_ctx


def shortconv_mixer(h_lat, h_ctx, rows, w_in, conv_w, w_out):
    def one(h, conv_fn):
        gb, gc, v = jnp.split(h @ w_in, 3, axis=-1)
        return (gb * conv_fn(gc * v)) @ w_out

    out_lat = one(h_lat, lambda u: conv_rows(u, conv_w, rows))
    out_ctx = one(h_ctx, lambda u: dwconv_centred(u, conv_w)) if h_ctx is not None else None
    return out_lat, out_ctx


def swiglu(h, w_gu, w_down):
    g, u = jnp.split(h @ w_gu, 2, axis=-1)
    return (jax.nn.silu(g) * u) @ w_down


def moe_ffn(h, router, w_gu, w_down):
    logits = (h @ router).astype(jnp.float32)
    top_val, top_idx = lax.top_k(logits, TOP_K)
    gates = jax.nn.softmax(top_val, axis=-1)
    out = jnp.zeros_like(h)
    for e in range(N_EXPERTS):
        w_e = jnp.sum(jnp.where(top_idx == e, gates, 0.0), axis=-1, keepdims=True).astype(h.dtype)
        out = out + w_e * swiglu(h, w_gu[e], w_down[e])
    return out


def setup_inputs(seed: int = 0) -> dict:
    key = jax.random.key(seed)
    ks = jax.random.split(key, 24)
    f32 = jnp.float32

    def nrm(k, shape, scale):
        return jax.random.normal(k, shape, f32) * scale

    dt0 = jnp.exp(jax.random.uniform(ks[12], (N_EVEN, 2, N_SSD_HEADS), f32, math.log(1e-3), math.log(1e-1)))
    return {
        "x": nrm(ks[0], (BATCH, SEQ, D_MODEL), 1.0),
        "c": nrm(ks[1], (BATCH, D_MODEL), 1.0),
        "ctx": nrm(ks[2], (BATCH, CTX_LEN, D_MODEL), 1.0),
        "c_ctx": nrm(ks[3], (D_MODEL,), 1.0),
        "ada_w": nrm(ks[4], (DEPTH, D_MODEL, 6 * D_MODEL), 0.5 * D_MODEL ** -0.5),
        "ada_b": nrm(ks[5], (DEPTH, 6 * D_MODEL), 0.02),
        "norm_pre": 1.0 + nrm(ks[6], (DEPTH, 2, D_MODEL), 0.1),
        "norm_post": 1.0 + nrm(ks[7], (DEPTH, 2, D_MODEL), 0.1),
        "ssd_w_in": nrm(ks[8], (N_EVEN, D_MODEL, D_IN_PROJ), D_MODEL ** -0.5),
        "ssd_conv_w": nrm(ks[9], (N_EVEN, SSD_CONV, CONV_DIM), SSD_CONV ** -0.5),
        "ssd_conv_b": nrm(ks[10], (N_EVEN, CONV_DIM), 0.02),
        "ssd_a_log": jnp.log(jax.random.uniform(ks[11], (N_EVEN, 2, N_SSD_HEADS), f32, 1.0, 16.0)),
        "ssd_dt_bias": dt0 + jnp.log(-jnp.expm1(-dt0)),
        "ssd_d": 1.0 + nrm(ks[13], (N_EVEN, N_SSD_HEADS), 0.1),
        "ssd_norm": 1.0 + nrm(ks[14], (N_EVEN, D_INNER), 0.1),
        "ssd_w_out": nrm(ks[15], (N_EVEN, D_INNER, D_MODEL), D_INNER ** -0.5),
        "sc_w_in": nrm(ks[16], (N_ODD, D_MODEL, 3 * SC_WIDTH), D_MODEL ** -0.5),
        "sc_conv_w": nrm(ks[17], (N_ODD, SC_K, SC_WIDTH), SC_K ** -0.5),
        "sc_w_out": nrm(ks[18], (N_ODD, SC_WIDTH, D_MODEL), SC_WIDTH ** -0.5),
        "ffn_w_gu": nrm(ks[19], (N_EVEN, D_MODEL, 2 * D_FF), D_MODEL ** -0.5),
        "ffn_w_down": nrm(ks[20], (N_EVEN, D_FF, D_MODEL), D_FF ** -0.5),
        "moe_router": nrm(ks[21], (N_ODD, D_MODEL, N_EXPERTS), D_MODEL ** -0.5),
        "moe_w_gu": nrm(ks[22], (N_ODD, N_EXPERTS, D_MODEL, 2 * D_FF_EXPERT), D_MODEL ** -0.5),
        "moe_w_down": nrm(ks[23], (N_ODD, N_EXPERTS, D_FF_EXPERT, D_MODEL), D_FF_EXPERT ** -0.5),
    }


def reference(x, c, ctx, c_ctx, ada_w, ada_b, norm_pre, norm_post, ssd_w_in, ssd_conv_w, ssd_conv_b,
              ssd_a_log, ssd_dt_bias, ssd_d, ssd_norm, ssd_w_out, sc_w_in, sc_conv_w, sc_w_out,
              ffn_w_gu, ffn_w_down, moe_router, moe_w_gu, moe_w_down):
    rows = x.shape[1] // GRID_W
    x_lat, x_ctx = x, ctx
    s_c = jax.nn.silu(c)
    s_cc = jax.nn.silu(c_ctx)
    for i in range(DEPTH):
        j = i // N_MIXERS
        is_ssd = i % N_MIXERS == 0
        ctx_next = any(k % N_MIXERS == 0 for k in range(i + 1, DEPTH))
        need_ctx_in = is_ssd or ctx_next
        sh1, sc1, g1, sh2, sc2, g2 = jnp.split((s_c @ ada_w[i] + ada_b[i])[:, None, :], 6, axis=-1)
        csh1, csc1, cg1, csh2, csc2, cg2 = jnp.split((s_cc @ ada_w[i] + ada_b[i])[None, None, :], 6, axis=-1)

        h_lat = rmsnorm(x_lat, norm_pre[i, 0]) * (1.0 + sc1) + sh1
        h_ctx = rmsnorm(x_ctx, norm_pre[i, 0]) * (1.0 + csc1) + csh1 if need_ctx_in else None
        if is_ssd:
            y_lat, y_ctx = ssd_mixer(h_lat, h_ctx, rows, ssd_w_in[j], ssd_conv_w[j], ssd_conv_b[j], ssd_a_log[j],
                                     ssd_dt_bias[j], ssd_d[j], ssd_norm[j], ssd_w_out[j], ctx_next)
        else:
            y_lat, y_ctx = shortconv_mixer(h_lat, h_ctx, rows, sc_w_in[j], sc_conv_w[j], sc_w_out[j])
        x_lat = x_lat + g1 * rmsnorm(y_lat, norm_post[i, 0])
        if ctx_next:
            x_ctx = x_ctx + cg1 * rmsnorm(y_ctx, norm_post[i, 0])

        if is_ssd:
            ffn = lambda h: swiglu(h, ffn_w_gu[j], ffn_w_down[j])
        else:
            ffn = lambda h: moe_ffn(h, moe_router[j], moe_w_gu[j], moe_w_down[j])
        x_lat = x_lat + g2 * rmsnorm(ffn(rmsnorm(x_lat, norm_pre[i, 1]) * (1.0 + sc2) + sh2), norm_post[i, 1])
        if ctx_next:
            x_ctx = x_ctx + cg2 * rmsnorm(ffn(rmsnorm(x_ctx, norm_pre[i, 1]) * (1.0 + csc2) + csh2), norm_post[i, 1])
    return x_lat
```

```cpp
#include <hip/hip_runtime.h>
#include <cstdio>
#include <cstdint>
#define MK_PER_PHASE 0
#define MK_LAST_PHASE 18
#define MK_DUMP 0
namespace pg8 {
#define PG8_LAS __attribute__((address_space(3)))
typedef unsigned short bf16_t;
typedef short bf16x8 __attribute__((ext_vector_type(8)));
typedef float f32x4 __attribute__((ext_vector_type(4)));
typedef unsigned u32x4 __attribute__((ext_vector_type(4)));
constexpr int BM = 256, BK = 64, HALF = 128, HTB = HALF * BK * 2  , STAGE_BYTES = 8 * HTB, NXCD = 8, WGM = 8;

__host__ __device__ __forceinline__ int lds_byte(int r, int c) { const int st = (r >> 4) * 2 + (c >> 5), rr = r & 15, cc = c & 31, ob = rr * 64 + cc * 2; return st * 1024 + (ob ^ (((ob >> 9) & 1) << 5)); }
__host__ __device__ __forceinline__ void stage_rc(int b, int& R, int& C) { const int st = b / 1024, sb = b % 1024, swz = sb ^ (((sb >> 9) & 1) << 5); R = (st >> 1) * 16 + swz / 64; C = (st & 1) * 32 + (swz % 64) / 2; }
__host__ __device__ __forceinline__ int perm32(int rho) { const int n = rho >> 4, i = rho & 15; return 8 * (i >> 2) + 4 * n + (i & 3); }

struct Unit { int pm, pn; };
struct Gemm { const bf16_t* A; const bf16_t* Bt; int M, N, K; };

struct StaticOrder {
    int nM, nN, nwg, G, c;
    __host__ __device__ void init(int M, int N, int G_, int c_) { nM = M / BM; nN = N / BM; nwg = nM * nN; G = G_; c = c_; }
    __host__ __device__ bool next(int i, Unit& u) const {
        const long L = (long)i * G + c; if (L >= nwg) return false;
        int wgid = (int)L; { const int q = nwg / NXCD, r = nwg % NXCD, xcd = wgid % NXCD, off = wgid / NXCD; wgid = (xcd < r ? xcd * (q + 1) : r * (q + 1) + (xcd - r) * q) + off; }
        const int nig = WGM * nN, gid = wgid / nig, fm = gid * WGM, gsz = (nM - fm) < WGM ? (nM - fm) : WGM;
        u.pm = fm + ((wgid % nig) % gsz); u.pn = (wgid % nig) / gsz; return true;
    }
    __device__ __forceinline__ void a_ready(const Unit&) const {}
    __device__ __forceinline__ void done(const Unit&) const {}
    __device__ __forceinline__ size_t boff(const Unit&) const { return 0; }
};

typedef float f32x2c __attribute__((ext_vector_type(2)));
typedef __bf16 bf16x2c __attribute__((ext_vector_type(2)));
__device__ __forceinline__ unsigned cvt_pk_bf16(float lo, float hi) { const f32x2c v = {lo, hi}; return __builtin_bit_cast(unsigned, __builtin_convertvector(v, bf16x2c)); }
typedef float f32x2 __attribute__((ext_vector_type(2)));
__device__ __forceinline__ f32x2 gelu_pk(f32x2 v) {
    const f32x2 av = __builtin_elementwise_abs(v), d = av * 0.2316418882f + 1.0f;
    f32x2 t; t.x = __builtin_amdgcn_rcpf(d.x); t.y = __builtin_amdgcn_rcpf(d.y);
    f32x2 q = t * 0.5307027145f + (-0.7265760135f); q = q * t + 0.7107068705f; q = q * t + (-0.142248368f); q = q * t + 0.127414796f; q = q * t;
    const f32x2 s = (v * v) * (-0.72134752044f);
    f32x2 e; e.x = __builtin_amdgcn_exp2f(s.x); e.y = __builtin_amdgcn_exp2f(s.y);
    const f32x2 m = v * (q * e), r = v - m;
    f32x2 o; o.x = v.x < 0.f ? m.x : r.x; o.y = v.y < 0.f ? m.y : r.y; return o;
}

template <int ACT  > struct EpiBf16 {
    static constexpr bool PERM = true, AFTER_DRAIN = false; static_assert(ACT == 0 || ACT == 1, "EpiBf16: ACT is 0 (none) or 1 (gelu_pk)");
    bf16_t* O; int ldc; const float* bias; int split_cols; size_t split_stride; float scale0;
    __device__ __forceinline__ void operator()(const f32x4 (&acc)[2][2][4][2], const Unit& u, int wr, int wc, int fr, int fq) const {
        const int row0 = u.pm * BM + wr * 64 + fr; int colt = u.pn * BM; bf16_t* base = O;
        float sc = 1.f; if (split_cols) { const int t = colt / split_cols; base += (size_t)t * split_stride; colt -= t * split_cols; if (t == 0) sc = scale0; }
        const int col0 = colt + wc * 32 + 8 * fq, bcol0 = u.pn * BM + wc * 32 + 8 * fq;
        f32x4 bv[2][2];
#pragma unroll
        for (int bj = 0; bj < 2; ++bj)
#pragma unroll
            for (int n = 0; n < 2; ++n) bv[bj][n] = bias ? *(const f32x4*)(bias + bcol0 + bj * HALF + 4 * n) : (f32x4){0.f, 0.f, 0.f, 0.f};
#pragma unroll
        for (int ai = 0; ai < 2; ++ai)
#pragma unroll
            for (int m = 0; m < 4; ++m) { bf16_t* rowp = base + (size_t)(row0 + ai * HALF + m * 16) * ldc + col0;
#pragma unroll
                for (int bj = 0; bj < 2; ++bj) { f32x4 v0 = acc[ai][bj][m][0] + bv[bj][0], v1 = acc[ai][bj][m][1] + bv[bj][1];
                    if (ACT == 1) { f32x2 a = gelu_pk((f32x2){v0[0], v0[1]}), b = gelu_pk((f32x2){v0[2], v0[3]}), c = gelu_pk((f32x2){v1[0], v1[1]}), d = gelu_pk((f32x2){v1[2], v1[3]});
                        v0 = (f32x4){a.x, a.y, b.x, b.y}; v1 = (f32x4){c.x, c.y, d.x, d.y}; }
                    v0 = v0 * sc; v1 = v1 * sc; u32x4 w; w.x = cvt_pk_bf16(v0[0], v0[1]); w.y = cvt_pk_bf16(v0[2], v0[3]); w.z = cvt_pk_bf16(v1[0], v1[1]); w.w = cvt_pk_bf16(v1[2], v1[3]);
                    *(u32x4*)(rowp + bj * HALF) = w; } }
    }
};

template <class Epi, class Sched, bool ALIGN_EPI = false, bool SP2 = false>
__device__ __forceinline__ void gemm_phase(PG8_LAS unsigned char* lds, const Gemm g, const Sched& S, const Epi& E) {
    const int tid = threadIdx.x, wid = __builtin_amdgcn_readfirstlane(tid >> 6), lane = tid & 63, wr = wid >> 2, wc = wid & 3, fr = lane & 15, fq = lane >> 4;
    const int K = g.K, nt = K / BK;
    unsigned voffA[2], voffB[2];
#pragma unroll
    for (int i = 0; i < 2; ++i) { int R, C; stage_rc(tid * 16 + i * 8192, R, C); const int Rb = Epi::PERM ? ((R & ~31) + perm32(R & 31)) : R;
        voffA[i] = (unsigned)(R * K + C) * 2u; voffB[i] = (unsigned)(Rb * K + C) * 2u; }
    const size_t kstep = (size_t)(BK * 2);
    const size_t hstep = (size_t)HALF * K * 2;
    const size_t tstep = 2 * hstep;
    const unsigned ldsw = (unsigned)wid * 1024u;
    const int aoff = lds_byte(wr * 64 + fr, fq * 8), boff = lds_byte(wc * 32 + fr, fq * 8);
#define PG8_SA(b, h) (((b) * 2 + (h)) * HTB)
#define PG8_SB(b, h) ((4 + (b) * 2 + (h)) * HTB)
#define PG8_STAGE(bufoff, gbase, voff) do { _Pragma("unroll") for (int _i = 0; _i < 2; ++_i) \
        __builtin_amdgcn_global_load_lds((const unsigned*)((const char*)(gbase) + (voff)[_i]), (PG8_LAS unsigned*)(lds + (bufoff) + ldsw + _i * 8192), 16, 0, 0); } while (0)
#define PG8_LDA(dst, b, h) do { _Pragma("unroll") for (int m = 0; m < 4; ++m) _Pragma("unroll") for (int k = 0; k < 2; ++k) dst[m][k] = *(const PG8_LAS bf16x8*)(lds + PG8_SA(b, h) + aoff + m * 2048 + k * 1024); } while (0)
#define PG8_LDB(dst, b, h) do { _Pragma("unroll") for (int n = 0; n < 2; ++n) _Pragma("unroll") for (int k = 0; k < 2; ++k) dst[n][k] = *(const PG8_LAS bf16x8*)(lds + PG8_SB(b, h) + boff + n * 2048 + k * 1024); } while (0)
#define PG8_MMA(ai, bj, At, Bt) do { __builtin_amdgcn_s_setprio(1); _Pragma("unroll") for (int m = 0; m < 4; ++m) _Pragma("unroll") for (int n = 0; n < 2; ++n) _Pragma("unroll") for (int k = 0; k < 2; ++k) \
        acc[ai][bj][m][n] = __builtin_amdgcn_mfma_f32_16x16x32_bf16(Bt[n][k], At[m][k], acc[ai][bj][m][n], 0, 0, 0); __builtin_amdgcn_s_setprio(0); } while (0)
#define PG8_WAIT_V(n) asm volatile("s_waitcnt vmcnt(" #n ")" ::: "memory")
#define PG8_WAIT_L(n) asm volatile("s_waitcnt lgkmcnt(" #n ")" ::: "memory")
#define PG8_BAR __builtin_amdgcn_s_barrier()
#define PG8_SCHED __builtin_amdgcn_sched_barrier(0)
    Unit cur, nxt; int ui = 0;
    if (!S.next(0, cur)) return;
    f32x4 acc[2][2][4][2];
#pragma unroll
    for (int a = 0; a < 2; ++a)
#pragma unroll
        for (int b = 0; b < 2; ++b)
#pragma unroll
            for (int m = 0; m < 4; ++m)
#pragma unroll
                for (int n = 0; n < 2; ++n) acc[a][b][m][n] = (f32x4){0.f, 0.f, 0.f, 0.f};
    bf16x8 At[4][2], B0[2][2], B1[2][2];
    const char* cA = (const char*)g.A + (size_t)cur.pm * tstep; const char* cB = (const char*)g.Bt + S.boff(cur) + (size_t)cur.pn * tstep;
    S.a_ready(cur);
    if constexpr (SP2) {
        PG8_STAGE(PG8_SB(0, 0), cB, voffB); PG8_STAGE(PG8_SB(0, 1), cB + hstep, voffB); PG8_STAGE(PG8_SA(0, 0), cA, voffA); PG8_STAGE(PG8_SA(0, 1), cA + hstep, voffA);
        if (wr == 1) PG8_BAR;
        PG8_WAIT_V(2); PG8_BAR;
        PG8_STAGE(PG8_SB(1, 0), cB + kstep, voffB); PG8_STAGE(PG8_SA(1, 0), cA + kstep, voffA); PG8_STAGE(PG8_SB(1, 1), cB + hstep + kstep, voffB);
        PG8_WAIT_V(6); PG8_BAR;
    } else {
        PG8_STAGE(PG8_SB(0, 0), cB, voffB); PG8_STAGE(PG8_SA(0, 0), cA, voffA); PG8_STAGE(PG8_SB(0, 1), cB + hstep, voffB); PG8_STAGE(PG8_SA(0, 1), cA + hstep, voffA);
        if (wr == 1) PG8_BAR;
        PG8_WAIT_V(4); PG8_BAR;
        PG8_STAGE(PG8_SB(1, 0), cB + kstep, voffB); PG8_STAGE(PG8_SA(1, 0), cA + kstep, voffA); PG8_STAGE(PG8_SB(1, 1), cB + hstep + kstep, voffB);
        PG8_WAIT_V(6); PG8_BAR;
    }
    for (;;) {
        const bool has_next = S.next(ui + 1, nxt);
        const char* nA = has_next ? (const char*)g.A + (size_t)nxt.pm * tstep : cA; const char* nB = has_next ? (const char*)g.Bt + S.boff(nxt) + (size_t)nxt.pn * tstep : cB;
        for (int t = 0; t < nt; t += 2) {
            const bool last = (t == nt - 2);
            const char* a1 = cA + (size_t)(t + 1) * kstep;
            const char* a2 = last ? nA : cA + (size_t)(t + 2) * kstep; const char* b2 = last ? nB : cB + (size_t)(t + 2) * kstep;
            const char* a3 = a2 + kstep; const char* b3 = b2 + kstep;
            if (last && has_next) S.a_ready(nxt);
            if constexpr (SP2) {
            PG8_LDB(B0, 0, 0); PG8_LDB(B1, 0, 1); PG8_SCHED; PG8_LDA(At, 0, 0); PG8_STAGE(PG8_SA(1, 1), a1 + hstep, voffA);
            PG8_WAIT_V(8); PG8_WAIT_L(0); PG8_BAR; PG8_MMA(0, 0, At, B0); PG8_MMA(0, 1, At, B1); PG8_BAR; PG8_SCHED;
            PG8_LDA(At, 0, 1); PG8_STAGE(PG8_SB(0, 0), b2, voffB); PG8_STAGE(PG8_SB(0, 1), b2 + hstep, voffB); PG8_STAGE(PG8_SA(0, 0), a2, voffA);
            PG8_WAIT_V(8); PG8_WAIT_L(0); PG8_BAR; PG8_MMA(1, 0, At, B0); PG8_MMA(1, 1, At, B1); PG8_BAR; PG8_SCHED;
            PG8_LDB(B0, 1, 0); PG8_LDB(B1, 1, 1); PG8_SCHED; PG8_LDA(At, 1, 0); PG8_STAGE(PG8_SA(0, 1), a2 + hstep, voffA);
            PG8_WAIT_V(8); PG8_WAIT_L(0); PG8_BAR; PG8_MMA(0, 0, At, B0); PG8_MMA(0, 1, At, B1); PG8_BAR; PG8_SCHED;
            PG8_LDA(At, 1, 1); PG8_STAGE(PG8_SB(1, 0), b3, voffB); PG8_STAGE(PG8_SB(1, 1), b3 + hstep, voffB); PG8_STAGE(PG8_SA(1, 0), a3, voffA);
            PG8_WAIT_V(8); PG8_WAIT_L(0); PG8_BAR; PG8_MMA(1, 0, At, B0); PG8_MMA(1, 1, At, B1); PG8_BAR; PG8_SCHED;
            } else {
            PG8_LDB(B0, 0, 0); PG8_SCHED; PG8_LDA(At, 0, 0); PG8_STAGE(PG8_SA(1, 1), a1 + hstep, voffA);
            PG8_WAIT_L(8); PG8_BAR; PG8_WAIT_L(0); PG8_MMA(0, 0, At, B0); PG8_BAR; PG8_SCHED;
            PG8_LDB(B1, 0, 1); PG8_STAGE(PG8_SB(0, 0), b2, voffB);
            PG8_BAR; PG8_WAIT_L(0); PG8_MMA(0, 1, At, B1); PG8_BAR;
            PG8_LDA(At, 0, 1); PG8_STAGE(PG8_SA(0, 0), a2, voffA);
            PG8_BAR; PG8_WAIT_L(0); PG8_MMA(1, 0, At, B0); PG8_BAR; PG8_SCHED;
            PG8_STAGE(PG8_SB(0, 1), b2 + hstep, voffB);
            PG8_WAIT_V(6); PG8_BAR; PG8_MMA(1, 1, At, B1); PG8_BAR;
            PG8_LDB(B0, 1, 0); PG8_SCHED; PG8_LDA(At, 1, 0); PG8_STAGE(PG8_SA(0, 1), a2 + hstep, voffA);
            PG8_WAIT_L(8); PG8_BAR; PG8_WAIT_L(0); PG8_MMA(0, 0, At, B0); PG8_BAR; PG8_SCHED;
            PG8_LDB(B1, 1, 1); PG8_STAGE(PG8_SB(1, 0), b3, voffB);
            PG8_BAR; PG8_WAIT_L(0); PG8_MMA(0, 1, At, B1); PG8_BAR;
            PG8_LDA(At, 1, 1); PG8_STAGE(PG8_SA(1, 0), a3, voffA);
            PG8_BAR; PG8_WAIT_L(0); PG8_MMA(1, 0, At, B0); PG8_BAR; PG8_SCHED;
            PG8_STAGE(PG8_SB(1, 1), b3 + hstep, voffB);
            PG8_WAIT_V(6); PG8_BAR; PG8_MMA(1, 1, At, B1); PG8_BAR;
            }
        }
        if constexpr (ALIGN_EPI) { if (wr == 0) PG8_BAR; }
        if constexpr (!Epi::AFTER_DRAIN) { E(acc, cur, wr, wc, fr, fq); S.done(cur); }
        if (!has_next) break;
#pragma unroll
        for (int a = 0; a < 2; ++a)
#pragma unroll
            for (int b = 0; b < 2; ++b)
#pragma unroll
                for (int m = 0; m < 4; ++m)
#pragma unroll
                    for (int n = 0; n < 2; ++n) acc[a][b][m][n] = (f32x4){0.f, 0.f, 0.f, 0.f};
        cur = nxt; cA = nA; cB = nB; ++ui;
        if constexpr (ALIGN_EPI) { if (wr == 1) PG8_BAR; }
    }
    PG8_WAIT_V(0);
    if constexpr (!ALIGN_EPI) { if (wr == 0) PG8_BAR; }
    PG8_BAR;
    if constexpr (Epi::AFTER_DRAIN) { E.fused(acc, cur, wr, wc, fr, fq, lds, wid, lane); S.done(cur); }
#undef PG8_SA
#undef PG8_SB
#undef PG8_STAGE
#undef PG8_LDA
#undef PG8_LDB
#undef PG8_MMA
#undef PG8_WAIT_V
#undef PG8_WAIT_L
#undef PG8_BAR
#undef PG8_SCHED
}
}

constexpr int NWAVES = 8;
constexpr int DM = 1024, NB = 8, SEQ = 4096, CTXL = 256;
constexpr int MLAT = NB * SEQ, MCTX = NB * CTXL, MALL = MLAT + MCTX;
constexpr int DIN = 2048, CONVD = 4096, DINP = 6208, DINP_PAD = 6400;
constexpr int DFF = 2816, NE = 8, DFFE = 3584;
constexpr int NUNIT_LAT = NB * 32 * 8, NUNIT = NUNIT_LAT + NB * 2 * 8;
constexpr int MOE_ROWS = 67584;
constexpr float EPS = 1e-6f;
#ifndef MK_PER_PHASE
#define MK_PER_PHASE 0
#endif
#ifndef MK_LAST_PHASE
#define MK_LAST_PHASE 18
#endif
constexpr int N_PHASES = 19;

constexpr size_t MiB = 1u << 20;
constexpr size_t WS_CTL = 0, CTL_ZERO_BYTES = 1 * MiB;
constexpr size_t WS_MOD = 1 * MiB;
constexpr size_t WS_ROUTE = 2 * MiB;
constexpr size_t WS_CD = 4 * MiB;
constexpr size_t WS_WIN = 8 * MiB, WS_WOUT = 21 * MiB, WS_WGU = 25 * MiB, WS_WDN = 36 * MiB, WS_WSCI = 42 * MiB, WS_WSCO = 48 * MiB;
constexpr size_t WS_H = 56 * MiB;
constexpr size_t WS_Y = 124 * MiB;
constexpr size_t WS_Z = 188 * MiB;
constexpr size_t WS_XBC = 324 * MiB;
constexpr size_t WS_DT = 596 * MiB;
constexpr size_t WS_S = 606 * MiB;
constexpr size_t WS_ACT0 = 324 * MiB;
constexpr size_t WS_SCP = 324 * MiB;
constexpr size_t WS_HPERM = 124 * MiB;
constexpr size_t WS_WMGU = 256 * MiB, WS_WMDN = 368 * MiB;
constexpr size_t WS_ACT = 424 * MiB;
constexpr size_t WS_END = 886 * MiB;
static_assert(WS_S + (size_t)NUNIT * 8 * 8192 * 2 <= 878 * MiB && WS_ACT + (size_t)MOE_ROWS * DFFE * 2 <= WS_END, "d_ws map");
constexpr size_t RT_SELR = 0, RT_GATE = 256 * 1024, RT_POS = 512 * 1024, RT_CNT = 768 * 1024, RT_TEXP = 800 * 1024;
constexpr int CW_TMO = 0, CW_CODE = 1, CW_BAR = 4096;

constexpr int PXB = 528, PBB = 272, PMB = 272;
constexpr int XI_BYTES = 128 * PXB, BI_BYTES = 128 * PBB, MW_BYTES = 8 * 16 * PMB;
constexpr int SCAL_OFF = XI_BYTES + BI_BYTES + MW_BYTES;
constexpr int MISC_OFF = SCAL_OFF + 3 * 4096;
constexpr int LDS_BYTES = MISC_OFF + 512;
static_assert(LDS_BYTES <= 160 * 1024 && pg8::STAGE_BYTES <= MISC_OFF, "LDS map");

#define GAS __attribute__((address_space(1)))
#define LAS __attribute__((address_space(3)))
typedef unsigned short bf16;
typedef unsigned v4u __attribute__((ext_vector_type(4)));
typedef unsigned v2u __attribute__((ext_vector_type(2)));
typedef float f32x4 __attribute__((ext_vector_type(4)));
typedef short bf16x8 __attribute__((ext_vector_type(8)));
typedef short s16x4 __attribute__((ext_vector_type(4)));
typedef GAS unsigned gu32;
#define RLX_AGENT __ATOMIC_RELAXED, __HIP_MEMORY_SCOPE_AGENT
#define LDS_WAIT() asm volatile("s_waitcnt lgkmcnt(0)" ::: "memory")
#define VM_WAIT() asm volatile("s_waitcnt vmcnt(0)" ::: "memory")
typedef float f32x2n __attribute__((ext_vector_type(2)));
typedef __bf16 bf16x2n __attribute__((ext_vector_type(2)));
__device__ __forceinline__ unsigned pk2(float lo, float hi) { const f32x2n v = {lo, hi}; return __builtin_bit_cast(unsigned, __builtin_convertvector(v, bf16x2n)); }
__device__ __forceinline__ float bflo(unsigned u) { return __uint_as_float(u << 16); }
__device__ __forceinline__ float bfhi(unsigned u) { return __uint_as_float(u & 0xffff0000u); }
__device__ __forceinline__ float bf1(bf16 b) { return __uint_as_float(((unsigned)b) << 16); }
__device__ __forceinline__ f32x4 unpack4(v2u u) { return (f32x4){bflo(u.x), bfhi(u.x), bflo(u.y), bfhi(u.y)}; }
__device__ __forceinline__ v2u pack4(f32x4 v) { v2u r; r.x = pk2(v[0], v[1]); r.y = pk2(v[2], v[3]); return r; }
__device__ __forceinline__ float silu_f(float v) { return v / (1.0f + __expf(-v)); }
__device__ __forceinline__ float wave_sum(float v) {
#pragma unroll
    for (int o = 1; o < 64; o <<= 1) v += __shfl_xor(v, o);
    return v;
}
__device__ __forceinline__ unsigned lds_addr(LAS unsigned char* p) { return (unsigned)(size_t)p; }
__device__ __forceinline__ bf16x8 tr_pair(unsigned a0, unsigned a1) {
    s16x4 x, y;
    asm volatile("ds_read_b64_tr_b16 %0, %2\n\tds_read_b64_tr_b16 %1, %3\n\ts_waitcnt lgkmcnt(0)" : "=&v"(x), "=&v"(y) : "v"(a0), "v"(a1) : "memory");
    return (bf16x8){x[0], x[1], x[2], x[3], y[0], y[1], y[2], y[3]};
}
#define MFMA16(a, b, c) __builtin_amdgcn_mfma_f32_16x16x32_bf16((a), (b), (c), 0, 0, 0)

namespace pg8 {
struct EpiInProj {
    static constexpr bool PERM = true, AFTER_DRAIN = false;
    bf16_t* Z; bf16_t* XBC; float* DT;
    __device__ __forceinline__ void operator()(const f32x4 (&acc)[2][2][4][2], const Unit& u, int wr, int wc, int fr, int fq) const {
        const int row0 = u.pm * BM + wr * 64 + fr;
        if (u.pn < 24) {
            bf16_t* base; int ldc, colt;
            if (u.pn < 8) { base = Z; ldc = 2048; colt = u.pn * BM; } else { base = XBC; ldc = 4096; colt = (u.pn - 8) * BM; }
            const int col0 = colt + wc * 32 + 8 * fq;
#pragma unroll
            for (int ai = 0; ai < 2; ++ai)
#pragma unroll
                for (int m = 0; m < 4; ++m) { bf16_t* rowp = base + (size_t)(row0 + ai * HALF + m * 16) * ldc + col0;
#pragma unroll
                    for (int bj = 0; bj < 2; ++bj) { const f32x4 v0 = acc[ai][bj][m][0], v1 = acc[ai][bj][m][1];
                        u32x4 w; w.x = cvt_pk_bf16(v0[0], v0[1]); w.y = cvt_pk_bf16(v0[2], v0[3]); w.z = cvt_pk_bf16(v1[0], v1[1]); w.w = cvt_pk_bf16(v1[2], v1[3]);
                        *(u32x4*)(rowp + bj * HALF) = w; } }
        } else if (wc < 2) {
            const int col0 = wc * 32 + 8 * fq;
#pragma unroll
            for (int ai = 0; ai < 2; ++ai)
#pragma unroll
                for (int m = 0; m < 4; ++m) { float* rowp = DT + (size_t)(row0 + ai * HALF + m * 16) * 64 + col0;
                    *(f32x4*)(rowp) = acc[ai][0][m][0]; *(f32x4*)(rowp + 4) = acc[ai][0][m][1]; }
        }
    }
};
struct EpiSwiGLU {
    static constexpr bool PERM = true, AFTER_DRAIN = false;
    bf16_t* O; int ldc;
    __device__ __forceinline__ void operator()(const f32x4 (&acc)[2][2][4][2], const Unit& u, int wr, int wc, int fr, int fq) const {
        const int row0 = u.pm * BM + wr * 64 + fr, col0 = u.pn * HALF + wc * 32 + 8 * fq;
#pragma unroll
        for (int ai = 0; ai < 2; ++ai)
#pragma unroll
            for (int m = 0; m < 4; ++m) { bf16_t* rowp = O + (size_t)(row0 + ai * HALF + m * 16) * ldc + col0;
                float o[8];
#pragma unroll
                for (int n = 0; n < 2; ++n)
#pragma unroll
                    for (int j = 0; j < 4; ++j) { const float gt = acc[ai][0][m][n][j], up = acc[ai][1][m][n][j]; o[4 * n + j] = gt * __builtin_amdgcn_rcpf(1.0f + __expf(-gt)) * up; }
                u32x4 w; w.x = cvt_pk_bf16(o[0], o[1]); w.y = cvt_pk_bf16(o[2], o[3]); w.z = cvt_pk_bf16(o[4], o[5]); w.w = cvt_pk_bf16(o[6], o[7]);
                *(u32x4*)(rowp) = w; }
    }
};
struct GroupedOrder : StaticOrder {
    const int* texp; size_t estride;
    __device__ __forceinline__ size_t boff(const Unit& u) const { return (size_t)texp[u.pm] * estride; }
};
}

struct Frame {
    LAS unsigned char* lds;
    volatile LAS unsigned* MISC;
    gu32* ctl;
    int tid, lane, wave, G;
    const float* in[24]; float* out; unsigned char* ws;
};
enum { I_X = 0, I_C, I_CTX, I_CCTX, I_ADAW, I_ADAB, I_NPRE, I_NPOST, I_SWIN, I_SCONVW, I_SCONVB, I_SALOG, I_SDTB, I_SD, I_SNORM, I_SWOUT, I_SCWIN, I_SCCONV, I_SCWOUT, I_FGU, I_FDN, I_ROUTER, I_MGU, I_MDN };

__device__ __forceinline__ void cvt_item(const float* W, int K, int N, bf16* WT, LAS float* scr, int item, int lane, int mode, int dffx) {
    const int nblk = N / 32, kb = item / nblk, nb = item % nblk, k0 = 64 * kb, n0 = 32 * nb;
#pragma unroll 8
    for (int i = 0; i < 32; ++i) { const int kk = 2 * i + (lane >> 5); scr[kk * 33 + (lane & 31)] = W[(size_t)(k0 + kk) * N + n0 + (lane & 31)]; }
    LDS_WAIT(); asm volatile("" ::: "memory");
    const int c = lane & 7;
#pragma unroll
    for (int j = 0; j < 4; ++j) { const int n = (lane >> 3) + 8 * j; const LAS float* s = scr + (8 * c) * 33 + n;
        v4u o; o.x = pk2(s[0 * 33], s[1 * 33]); o.y = pk2(s[2 * 33], s[3 * 33]); o.z = pk2(s[4 * 33], s[5 * 33]); o.w = pk2(s[6 * 33], s[7 * 33]);
        int nd = n0 + n; if (mode) { const int half = nd >= dffx ? 1 : 0, i2 = nd - half * dffx; nd = 256 * (i2 >> 7) + 128 * half + (i2 & 127); }
        *(v4u*)(WT + (size_t)nd * K + k0 + 8 * c) = o; }
    LDS_WAIT(); asm volatile("" ::: "memory");
}
__device__ __forceinline__ void load_row_f32(const float* p, int lane, f32x4 (&v)[4]) {
#pragma unroll
    for (int j = 0; j < 4; ++j) v[j] = *(const f32x4*)(p + 4 * lane + 256 * j);
}
__device__ __forceinline__ void load_row_bf16(const bf16* p, int lane, f32x4 (&v)[4]) {
#pragma unroll
    for (int j = 0; j < 4; ++j) v[j] = unpack4(*(const v2u*)(p + 4 * lane + 256 * j));
}
__device__ __forceinline__ float row_ss(const f32x4 (&v)[4]) {
    float s = 0.f;
#pragma unroll
    for (int j = 0; j < 4; ++j) s += (v[j][0] * v[j][0] + v[j][1] * v[j][1]) + (v[j][2] * v[j][2] + v[j][3] * v[j][3]);
    return wave_sum(s);
}
__device__ __forceinline__ void prenorm_mod(f32x4 (&v)[4], const float* npre, const float* sc, const float* sh, int lane) {
    const float rr = rsqrtf(row_ss(v) * (1.0f / DM) + EPS);
#pragma unroll
    for (int j = 0; j < 4; ++j) { const int col = 4 * lane + 256 * j; const f32x4 w4 = *(const f32x4*)(npre + col), s4 = *(const f32x4*)(sc + col), h4 = *(const f32x4*)(sh + col);
        v[j] = (v[j] * rr * w4) * (s4 + 1.0f) + h4; }
}
__device__ __forceinline__ void store_row_bf16(bf16* p, int lane, const f32x4 (&v)[4]) {
#pragma unroll
    for (int j = 0; j < 4; ++j) *(v2u*)(p + 4 * lane + 256 * j) = pack4(v[j]);
}
__device__ __forceinline__ const float* mod_vec(Frame& F, int layer, int row, int chunk) { return (const float*)(F.ws + WS_MOD) + ((size_t)(layer * 9 + row) * 6144 + chunk * 1024); }

__device__ __forceinline__ void p0_prologue(Frame& F) {
    LAS float* scr = (LAS float*)(F.lds + F.wave * 8448);
    LAS float* SIL = (LAS float*)(F.lds + 69632);
    LAS float* RED = (LAS float*)(F.lds + 69632 + 36864);
    if ((int)blockIdx.x < 192) {
        for (int idx = F.tid; idx < 9 * 1024; idx += NWAVES * 64) { const int r = idx >> 10, k = idx & 1023; const float cv = r < 8 ? F.in[I_C][r * 1024 + k] : F.in[I_CCTX][k]; SIL[idx] = silu_f(cv); }
        __syncthreads();
        for (int t = blockIdx.x; t < 192; t += F.G) {
            const int i = t / 96, col0 = 64 * (t % 96);
            const float* wp = F.in[I_ADAW] + ((size_t)i * 1024 + F.wave * 128) * 6144 + col0 + F.lane;
            float acc[9];
#pragma unroll
            for (int r = 0; r < 9; ++r) acc[r] = 0.f;
            for (int k8 = 0; k8 < 128; k8 += 8) {
                float wv[8];
#pragma unroll
                for (int q = 0; q < 8; ++q) wv[q] = wp[(size_t)(k8 + q) * 6144];
#pragma unroll
                for (int q = 0; q < 8; ++q)
#pragma unroll
                    for (int r = 0; r < 9; ++r) acc[r] += SIL[r * 1024 + F.wave * 128 + k8 + q] * wv[q];
            }
#pragma unroll
            for (int r = 0; r < 9; ++r) RED[(F.wave * 9 + r) * 64 + F.lane] = acc[r];
            __syncthreads();
            for (int idx = F.tid; idx < 576; idx += NWAVES * 64) { const int r = idx >> 6, ln = idx & 63; float s = 0.f;
#pragma unroll
                for (int w = 0; w < 8; ++w) s += RED[(w * 9 + r) * 64 + ln];
                ((float*)(F.ws + WS_MOD))[(size_t)(i * 9 + r) * 6144 + col0 + ln] = s + F.in[I_ADAB][i * 6144 + col0 + ln]; }
            __syncthreads();
        }
    }
    const int gw = blockIdx.x * NWAVES + F.wave, NGW = F.G * NWAVES;
    constexpr int I0 = 16 * 194, I1 = 32 * 32, I2 = 16 * 176, I3 = 44 * 32, I4 = 16 * 96, I5 = 16 * 32;
    for (int it = gw; it < I0 + I1 + I2 + I3 + I4 + I5; it += NGW) {
        int r = it;
        if (r < I0) { cvt_item(F.in[I_SWIN], 1024, DINP, (bf16*)(F.ws + WS_WIN), scr, r, F.lane, 0, 0); continue; } r -= I0;
        if (r < I1) { cvt_item(F.in[I_SWOUT], 2048, 1024, (bf16*)(F.ws + WS_WOUT), scr, r, F.lane, 0, 0); continue; } r -= I1;
        if (r < I2) { cvt_item(F.in[I_FGU], 1024, 2 * DFF, (bf16*)(F.ws + WS_WGU), scr, r, F.lane, 1, DFF); continue; } r -= I2;
        if (r < I3) { cvt_item(F.in[I_FDN], DFF, 1024, (bf16*)(F.ws + WS_WDN), scr, r, F.lane, 0, 0); continue; } r -= I3;
        if (r < I4) { cvt_item(F.in[I_SCWIN], 1024, 3072, (bf16*)(F.ws + WS_WSCI), scr, r, F.lane, 0, 0); continue; } r -= I4;
        cvt_item(F.in[I_SCWOUT], 1024, 1024, (bf16*)(F.ws + WS_WSCO), scr, r, F.lane, 0, 0);
    }
    { v4u* zp = (v4u*)((bf16*)(F.ws + WS_WIN) + (size_t)DINP * 1024); const int n16 = (DINP_PAD - DINP) * 1024 / 8;
      for (int i = blockIdx.x * (NWAVES * 64) + F.tid; i < n16; i += F.G * NWAVES * 64) zp[i] = (v4u){0u, 0u, 0u, 0u}; }
}
__device__ __forceinline__ void p1_prenorm(Frame& F) {
    const int gw = blockIdx.x * NWAVES + F.wave, NGW = F.G * NWAVES;
    bf16* H = (bf16*)(F.ws + WS_H);
    for (int r = gw; r < MALL; r += NGW) {
        const float* src = r < MLAT ? F.in[I_X] + (size_t)r * DM : F.in[I_CTX] + (size_t)(r - MLAT) * DM; const int mr = r < MLAT ? (r >> 12) : 8;
        f32x4 v[4]; load_row_f32(src, F.lane, v);
        prenorm_mod(v, F.in[I_NPRE], mod_vec(F, 0, mr, 1), mod_vec(F, 0, mr, 0), F.lane);
        store_row_bf16(H + (size_t)r * DM, F.lane, v);
    }
}
template <bool NEXT>
__device__ __forceinline__ void resnorm_phase(Frame& F, const float* xin, int layer, int gchunk, const float* npost, const float* npre, int nlayer, int scchunk, int shchunk) {
    const int gw = blockIdx.x * NWAVES + F.wave, NGW = F.G * NWAVES;
    const bf16* Y = (const bf16*)(F.ws + WS_Y); bf16* H = (bf16*)(F.ws + WS_H);
    for (int r = gw; r < MLAT; r += NGW) {
        const int b = r >> 12;
        f32x4 y[4], x[4]; load_row_bf16(Y + (size_t)r * DM, F.lane, y); load_row_f32(xin + (size_t)r * DM, F.lane, x);
        const float rr = rsqrtf(row_ss(y) * (1.0f / DM) + EPS); const float* gt = mod_vec(F, layer, b, gchunk);
#pragma unroll
        for (int j = 0; j < 4; ++j) { const int col = 4 * F.lane + 256 * j; x[j] = x[j] + *(const f32x4*)(gt + col) * ((y[j] * rr) * *(const f32x4*)(npost + col)); *(f32x4*)(F.out + (size_t)r * DM + col) = x[j]; }
        if (NEXT) { prenorm_mod(x, npre, mod_vec(F, nlayer, b, scchunk), mod_vec(F, nlayer, b, shchunk), F.lane); store_row_bf16(H + (size_t)r * DM, F.lane, x); }
    }
}

__device__ __forceinline__ int ssd_sidx(int b, int cs, int g) { return (b * 34 + cs) * 8 + g; }
__device__ __forceinline__ void dt_scan(const float* DTR, int r0, int dcol, float bias, float A, int lane, float (&dt)[2], float (&dA)[2], float (&inc)[2], float& total) {
#pragma unroll
    for (int h = 0; h < 2; ++h) { const float x = DTR[(size_t)(r0 + lane + 64 * h) * 64 + dcol] + bias; dt[h] = x > 20.f ? x : log1pf(__expf(x)); dA[h] = dt[h] * A; }
    float s0 = dA[0], s1 = dA[1];
#pragma unroll
    for (int o = 1; o < 64; o <<= 1) { const float t0 = __shfl_up(s0, o), t1 = __shfl_up(s1, o); if (lane >= o) { s0 += t0; s1 += t1; } }
    const float tot0 = __shfl(s0, 63); s1 += tot0; inc[0] = s0; inc[1] = s1; total = __shfl(s1, 63);
}
__device__ __forceinline__ void ssd_phase_a(Frame& F) {
    LAS unsigned char* XI = F.lds; LAS unsigned char* BI = F.lds + XI_BYTES; LAS float* WS = (LAS float*)(F.lds + SCAL_OFF);
    const int lane = F.lane, w = F.wave, gq = lane >> 4, q4 = (lane & 15) >> 2, p4 = lane & 3, l15 = lane & 15;
    const unsigned trX = lds_addr(XI) + (8 * gq + q4) * PXB + 8 * p4, trB = lds_addr(BI) + (8 * gq + q4) * PBB + 8 * p4;
    bf16* XBC = (bf16*)(F.ws + WS_XBC); const float* DTR = (const float*)(F.ws + WS_DT); bf16* S = (bf16*)(F.ws + WS_S); float* CD = (float*)(F.ws + WS_CD);
    for (int u = blockIdx.x; u < NUNIT; u += F.G) {
        int b, cs, g; bool isctx;
        if (u < NUNIT_LAT) { b = u >> 8; cs = (u >> 3) & 31; g = u & 7; isctx = false; } else { const int v = u - NUNIT_LAT; b = v >> 4; cs = 32 + ((v >> 3) & 1); g = v & 7; isctx = true; }
        const int r0 = isctx ? MLAT + b * CTXL + (cs - 32) * 128 : b * SEQ + cs * 128, sidx = ssd_sidx(b, cs, g);
        const int col = lane < 32 ? g * 256 + 8 * lane : (lane < 48 ? 2048 + g * 128 + 8 * (lane - 32) : 3072 + g * 128 + 8 * (lane - 48));
        const int l0 = 16 * w; int lo, hi; if (isctx) { lo = -(cs - 32) * 128; hi = lo + 255; } else { lo = l0 & ~63; hi = lo + 63; }
        v4u raw[20];
#pragma unroll
        for (int i = 0; i < 20; ++i) { const int lp = l0 - 2 + i; raw[i] = (lp >= lo && lp <= hi) ? *(const v4u*)(XBC + (long)(r0 + lp) * CONVD + col) : (v4u){0u, 0u, 0u, 0u}; }
        float wt[5][8], bs[8];
#pragma unroll
        for (int t = 0; t < 5; ++t) { const f32x4 a = *(const f32x4*)(F.in[I_SCONVW] + t * CONVD + col), c4 = *(const f32x4*)(F.in[I_SCONVW] + t * CONVD + col + 4);
#pragma unroll
            for (int e = 0; e < 4; ++e) { wt[t][e] = a[e]; wt[t][4 + e] = c4[e]; } }
        { const f32x4 a = *(const f32x4*)(F.in[I_SCONVB] + col), c4 = *(const f32x4*)(F.in[I_SCONVB] + col + 4);
#pragma unroll
          for (int e = 0; e < 4; ++e) { bs[e] = a[e]; bs[4 + e] = c4[e]; } }
        VM_WAIT(); __syncthreads();
        float f[5][8];
#pragma unroll
        for (int i = 0; i < 4; ++i) { f[i][0] = bflo(raw[i].x); f[i][1] = bfhi(raw[i].x); f[i][2] = bflo(raw[i].y); f[i][3] = bfhi(raw[i].y); f[i][4] = bflo(raw[i].z); f[i][5] = bfhi(raw[i].z); f[i][6] = bflo(raw[i].w); f[i][7] = bfhi(raw[i].w); }
#pragma unroll
        for (int i = 0; i < 16; ++i) {
            { const int sl = (i + 4) % 5; const v4u rw = raw[i + 4]; f[sl][0] = bflo(rw.x); f[sl][1] = bfhi(rw.x); f[sl][2] = bflo(rw.y); f[sl][3] = bfhi(rw.y); f[sl][4] = bflo(rw.z); f[sl][5] = bfhi(rw.z); f[sl][6] = bflo(rw.w); f[sl][7] = bfhi(rw.w); }
            float o[8];
#pragma unroll
            for (int e = 0; e < 8; ++e) { float a = bs[e];
#pragma unroll
                for (int t = 0; t < 5; ++t) a += wt[t][e] * f[(i + t) % 5][e];
                o[e] = silu_f(a); }
            v4u ov; ov.x = pk2(o[0], o[1]); ov.y = pk2(o[2], o[3]); ov.z = pk2(o[4], o[5]); ov.w = pk2(o[6], o[7]);
            const int l = l0 + i;
            if (lane < 32) *(LAS v4u*)(XI + l * PXB + 16 * lane) = ov; else if (lane < 48) *(LAS v4u*)(BI + l * PBB + 16 * (lane - 32)) = ov;
            if (!isctx) *(v4u*)(XBC + (size_t)(r0 + l) * CONVD + col) = ov;
        }
        { const int d = w >> 2, hh = g * 4 + (w & 3); float dt[2], dA[2], inc[2], total;
          dt_scan(DTR, r0, d * 32 + hh, F.in[I_SDTB][d * 32 + hh], -__expf(F.in[I_SALOG][d * 32 + hh]), lane, dt, dA, inc, total);
#pragma unroll
          for (int h = 0; h < 2; ++h) WS[w * 128 + lane + 64 * h] = dt[h] * (d == 0 ? __expf(total - inc[h]) : __expf(inc[h] - dA[h]));
          if (lane == 0) CD[sidx * 8 + w] = __expf(total); }
        __syncthreads();
        bf16x8 bt[4];
#pragma unroll
        for (int ks = 0; ks < 4; ++ks) bt[ks] = tr_pair(trB + (32 * ks) * PBB + 32 * w, trB + (32 * ks + 4) * PBB + 32 * w);
#pragma unroll 1
        for (int j = 0; j < 4; ++j) {
            bf16x8 as_[2][4];
#pragma unroll
            for (int d = 0; d < 2; ++d) {
                const int combo = d * 4 + j;
#pragma unroll
                for (int ks = 0; ks < 4; ++ks) { const f32x4 w0 = *(const LAS f32x4*)(WS + combo * 128 + 32 * ks + 8 * gq), w1 = *(const LAS f32x4*)(WS + combo * 128 + 32 * ks + 8 * gq + 4);
                    const bf16x8 r8 = bt[ks]; bf16x8 o8;
                    const unsigned u0 = pk2(bf1((bf16)r8[0]) * w0[0], bf1((bf16)r8[1]) * w0[1]), u1 = pk2(bf1((bf16)r8[2]) * w0[2], bf1((bf16)r8[3]) * w0[3]);
                    const unsigned u2 = pk2(bf1((bf16)r8[4]) * w1[0], bf1((bf16)r8[5]) * w1[1]), u3 = pk2(bf1((bf16)r8[6]) * w1[2], bf1((bf16)r8[7]) * w1[3]);
                    o8[0] = (short)(u0 & 0xffff); o8[1] = (short)(u0 >> 16); o8[2] = (short)(u1 & 0xffff); o8[3] = (short)(u1 >> 16); o8[4] = (short)(u2 & 0xffff); o8[5] = (short)(u2 >> 16); o8[6] = (short)(u3 & 0xffff); o8[7] = (short)(u3 >> 16);
                    as_[d][ks] = o8; }
            }
#pragma unroll
            for (int pt = 0; pt < 4; ++pt) {
                bf16x8 xf[4];
#pragma unroll
                for (int ks = 0; ks < 4; ++ks) xf[ks] = tr_pair(trX + (32 * ks) * PXB + (j * 64 + pt * 16) * 2, trX + (32 * ks + 4) * PXB + (j * 64 + pt * 16) * 2);
#pragma unroll
                for (int d = 0; d < 2; ++d) { const int combo = d * 4 + j; f32x4 acc = {0.f, 0.f, 0.f, 0.f};
#pragma unroll
                    for (int ks = 0; ks < 4; ++ks) acc = MFMA16(as_[d][ks], xf[ks], acc);
                    *(v2u*)(S + ((size_t)(sidx * 8 + combo) * 64 + pt * 16 + l15) * 128 + 16 * w + 4 * gq) = pack4(acc); }
            }
        }
        __syncthreads();
    }
}
__device__ __forceinline__ void ssd_phase_b(Frame& F) {
    bf16* S = (bf16*)(F.ws + WS_S); const float* CD = (const float*)(F.ws + WS_CD);
    const int NT = F.G * NWAVES * 64;
    for (int q = blockIdx.x * (NWAVES * 64) + F.tid; q < 512 * 1024; q += NT) {
        const int e8 = q & 1023, seq = q >> 10, combo = seq & 7, g = (seq >> 3) & 7, b = seq >> 6, d = combo >> 2;
        float h[8];
#pragma unroll
        for (int e = 0; e < 8; ++e) h[e] = 0.f;
#pragma unroll
        for (int k = 0; k < 2; ++k) { const int cs = d == 0 ? 32 + k : 33 - k, si = ssd_sidx(b, cs, g) * 8 + combo; const float dec = CD[si]; const v4u t = *(const v4u*)(S + (size_t)si * 8192 + e8 * 8);
            h[0] = dec * h[0] + bflo(t.x); h[1] = dec * h[1] + bfhi(t.x); h[2] = dec * h[2] + bflo(t.y); h[3] = dec * h[3] + bfhi(t.y); h[4] = dec * h[4] + bflo(t.z); h[5] = dec * h[5] + bfhi(t.z); h[6] = dec * h[6] + bflo(t.w); h[7] = dec * h[7] + bfhi(t.w); }
        for (int c0 = 0; c0 < 32; c0 += 8) {
            v4u t[8]; float dc[8];
#pragma unroll
            for (int k = 0; k < 8; ++k) { const int cs = d == 0 ? c0 + k : 31 - (c0 + k), si = ssd_sidx(b, cs, g) * 8 + combo; dc[k] = CD[si]; t[k] = *(const v4u*)(S + (size_t)si * 8192 + e8 * 8); }
#pragma unroll
            for (int k = 0; k < 8; ++k) { const int cs = d == 0 ? c0 + k : 31 - (c0 + k), si = ssd_sidx(b, cs, g) * 8 + combo;
                v4u o; o.x = pk2(h[0], h[1]); o.y = pk2(h[2], h[3]); o.z = pk2(h[4], h[5]); o.w = pk2(h[6], h[7]);
                *(v4u*)(S + (size_t)si * 8192 + e8 * 8) = o;
                const float dec = dc[k]; const v4u tt = t[k];
                h[0] = dec * h[0] + bflo(tt.x); h[1] = dec * h[1] + bfhi(tt.x); h[2] = dec * h[2] + bflo(tt.y); h[3] = dec * h[3] + bfhi(tt.y); h[4] = dec * h[4] + bflo(tt.z); h[5] = dec * h[5] + bfhi(tt.z); h[6] = dec * h[6] + bflo(tt.w); h[7] = dec * h[7] + bfhi(tt.w); }
        }
    }
}
__device__ __forceinline__ void ssd_phase_c(Frame& F) {
    LAS unsigned char* XI = F.lds; LAS unsigned char* BI = F.lds + XI_BYTES; LAS unsigned char* MWw = F.lds + XI_BYTES + BI_BYTES + F.wave * (16 * PMB);
    LAS float* DTS = (LAS float*)(F.lds + SCAL_OFF); LAS float* INC = DTS + 1024; LAS float* DAA = DTS + 2048;
    const int tid = F.tid, lane = F.lane, w = F.wave, gq = lane >> 4, q4 = (lane & 15) >> 2, p4 = lane & 3, l15 = lane & 15, lme = 16 * w + l15;
    const unsigned trX = lds_addr(XI) + (8 * gq + q4) * PXB + 8 * p4;
    const bf16* XBC = (const bf16*)(F.ws + WS_XBC); const float* DTR = (const float*)(F.ws + WS_DT); const bf16* HIN = (const bf16*)(F.ws + WS_S); bf16* Z = (bf16*)(F.ws + WS_Z);
    for (int u = blockIdx.x; u < NUNIT_LAT; u += F.G) {
        const int b = u >> 8, c = (u >> 3) & 31, g = u & 7, r0 = b * SEQ + c * 128, sidx = ssd_sidx(b, c, g);
#pragma unroll
        for (int k = 0; k < 8; ++k) { const int id = tid + 512 * k, row = id >> 5, ch = id & 31; *(LAS v4u*)(XI + row * PXB + 16 * ch) = *(const v4u*)(XBC + (size_t)(r0 + row) * CONVD + g * 256 + 8 * ch); }
#pragma unroll
        for (int k = 0; k < 4; ++k) { const int id = tid + 512 * k, row = id >> 4, ch = id & 15; *(LAS v4u*)(BI + row * PBB + 16 * ch) = *(const v4u*)(XBC + (size_t)(r0 + row) * CONVD + 2048 + g * 128 + 8 * ch); }
        bf16x8 cf[4];
#pragma unroll
        for (int ks = 0; ks < 4; ++ks) cf[ks] = *(const bf16x8*)(XBC + (size_t)(r0 + lme) * CONVD + 3072 + g * 128 + 32 * ks + 8 * gq);
        v4u hp[2];
        const bf16* hbase = HIN + (size_t)sidx * 8 * 8192;
#pragma unroll
        for (int k = 0; k < 2; ++k) { const int id = tid + 512 * k; hp[k] = *(const v4u*)(hbase + (size_t)(id >> 4) * 128 + 8 * (id & 15)); }
        { const int d = w >> 2, hh = g * 4 + (w & 3); float dt[2], dA[2], inc[2], total;
          dt_scan(DTR, r0, d * 32 + hh, F.in[I_SDTB][d * 32 + hh], -__expf(F.in[I_SALOG][d * 32 + hh]), lane, dt, dA, inc, total);
#pragma unroll
          for (int h = 0; h < 2; ++h) { DTS[w * 128 + lane + 64 * h] = dt[h]; INC[w * 128 + lane + 64 * h] = inc[h]; DAA[w * 128 + lane + 64 * h] = dA[h]; } }
        __syncthreads();
        f32x4 Gt[8];
#pragma unroll
        for (int st = 0; st < 8; ++st) { f32x4 a = {0.f, 0.f, 0.f, 0.f};
#pragma unroll
            for (int ks = 0; ks < 4; ++ks) a = MFMA16(*(const LAS bf16x8*)(BI + (16 * st + l15) * PBB + (32 * ks + 8 * gq) * 2), cf[ks], a);
            Gt[st] = a; }
        __syncthreads();
        LAS unsigned char* HB0 = BI; LAS unsigned char* HB1 = BI + 64 * PBB;
#pragma unroll
        for (int k = 0; k < 2; ++k) { const int id = tid + 512 * k; *(LAS v4u*)(HB0 + (id >> 4) * PBB + 16 * (id & 15)) = hp[k]; }
#pragma unroll
        for (int k = 0; k < 2; ++k) { const int id = tid + 512 * k; hp[k] = *(const v4u*)(hbase + 4 * 8192 + (size_t)(id >> 4) * 128 + 8 * (id & 15)); }
        __syncthreads();
        float ssq = 0.f;
#pragma unroll 1
        for (int j = 0; j < 4; ++j) {
            f32x4 Y[4];
#pragma unroll
            for (int pt = 0; pt < 4; ++pt) Y[pt] = (f32x4){0.f, 0.f, 0.f, 0.f};
#pragma unroll 1
            for (int d = 0; d < 2; ++d) {
                const int combo = d * 4 + j, ci = 2 * j + d;
                LAS unsigned char* HBc = (ci & 1) ? HB1 : HB0; LAS unsigned char* HBn = (ci & 1) ? HB0 : HB1;
                if (ci < 7) {
#pragma unroll
                    for (int k = 0; k < 2; ++k) { const int id = tid + 512 * k; *(LAS v4u*)(HBn + (id >> 4) * PBB + 16 * (id & 15)) = hp[k]; }
                    if (ci < 6) { const int cn = ci + 2, combn = (cn & 1) * 4 + (cn >> 1);
#pragma unroll
                        for (int k = 0; k < 2; ++k) { const int id = tid + 512 * k; hp[k] = *(const v4u*)(hbase + (size_t)combn * 8192 + (size_t)(id >> 4) * 128 + 8 * (id & 15)); } }
                }
                const float inc_l = INC[combo * 128 + lme], exc_l = inc_l - DAA[combo * 128 + lme], tot = INC[combo * 128 + 127];
                const int kslo = d ? (w >> 1) : 0, kshi = d ? 3 : (w >> 1);
#pragma unroll
                for (int st = 0; st < 8; ++st) if (st >= 2 * kslo && st <= 2 * kshi + 1) {
                    const int s0 = 16 * st + 4 * gq;
                    const f32x4 inc_s = *(const LAS f32x4*)(INC + combo * 128 + s0), da_s = *(const LAS f32x4*)(DAA + combo * 128 + s0), dt_s = *(const LAS f32x4*)(DTS + combo * 128 + s0);
                    f32x4 val;
#pragma unroll
                    for (int e = 0; e < 4; ++e) { const int s = s0 + e; const bool valid = d ? (s >= lme) : (s <= lme); const float arg = d ? ((inc_s[e] - da_s[e]) - exc_l) : (inc_l - inc_s[e]);
                        val[e] = valid ? Gt[st][e] * __expf(arg) * dt_s[e] : 0.f; }
                    *(LAS v2u*)(MWw + l15 * PMB + (16 * st + 4 * gq) * 2) = pack4(val);
                }
                LDS_WAIT();
#pragma unroll
                for (int ks = 0; ks < 4; ++ks) if (ks >= kslo && ks <= kshi) {
                    const bf16x8 mb = *(const LAS bf16x8*)(MWw + l15 * PMB + (32 * ks + 8 * gq) * 2);
#pragma unroll
                    for (int pt = 0; pt < 4; ++pt) { const bf16x8 xa = tr_pair(trX + (32 * ks) * PXB + (j * 64 + pt * 16) * 2, trX + (32 * ks + 4) * PXB + (j * 64 + pt * 16) * 2);
                        Y[pt] = MFMA16(xa, mb, Y[pt]); }
                }
                f32x4 T[4];
#pragma unroll
                for (int pt = 0; pt < 4; ++pt) { f32x4 a = {0.f, 0.f, 0.f, 0.f};
#pragma unroll
                    for (int ks = 0; ks < 4; ++ks) a = MFMA16(*(const LAS bf16x8*)(HBc + (16 * pt + l15) * PBB + (32 * ks + 8 * gq) * 2), cf[ks], a);
                    T[pt] = a; }
                const float eo = d ? __expf(tot - exc_l) : __expf(inc_l);
#pragma unroll
                for (int pt = 0; pt < 4; ++pt) Y[pt] = Y[pt] + T[pt] * eo;
                __syncthreads();
            }
            const float dsk = F.in[I_SD][g * 4 + j];
#pragma unroll
            for (int pt = 0; pt < 4; ++pt) { const int ch = j * 64 + pt * 16 + 4 * gq;
                const f32x4 xv = unpack4(*(const LAS v2u*)(XI + lme * PXB + ch * 2)), zv = unpack4(*(const v2u*)(Z + (size_t)(r0 + lme) * DIN + g * 256 + ch));
                f32x4 y = Y[pt] + xv * dsk;
#pragma unroll
                for (int e = 0; e < 4; ++e) { y[e] = y[e] * silu_f(zv[e]); ssq += y[e] * y[e]; }
                *(LAS v2u*)(XI + lme * PXB + ch * 2) = pack4(y); }
        }
        ssq += __shfl_xor(ssq, 16); ssq += __shfl_xor(ssq, 32);
        const float rr = rsqrtf(ssq * (1.0f / 256.0f) + EPS);
#pragma unroll
        for (int j = 0; j < 4; ++j)
#pragma unroll
            for (int pt = 0; pt < 4; ++pt) { const int cl = j * 64 + pt * 16 + 4 * gq, ch = g * 256 + cl; const f32x4 nw = *(const f32x4*)(F.in[I_SNORM] + ch);
                *(v2u*)(Z + (size_t)(r0 + lme) * DIN + ch) = pack4(unpack4(*(const LAS v2u*)(XI + lme * PXB + cl * 2)) * rr * nw); }
        __syncthreads();
    }
}

__device__ __forceinline__ void p12_shortconv(Frame& F) {
    const bf16* P = (const bf16*)(F.ws + WS_SCP); bf16* U = (bf16*)(F.ws + WS_H); const float* cw = F.in[I_SCCONV];
    const int NT = F.G * NWAVES * 64;
    for (int id = blockIdx.x * (NWAVES * 64) + F.tid; id < MLAT * 128; id += NT) {
        const int r = id >> 7, col = 8 * (id & 127), xpos = r & 63;
        float acc[8];
#pragma unroll
        for (int e = 0; e < 8; ++e) acc[e] = 0.f;
#pragma unroll
        for (int t = 0; t < 3; ++t) { const int xp = xpos + t - 1; if (xp >= 0 && xp < 64) {
            const v4u gc = *(const v4u*)(P + (size_t)(r + t - 1) * 3072 + 1024 + col), vv = *(const v4u*)(P + (size_t)(r + t - 1) * 3072 + 2048 + col);
            const f32x4 w0 = *(const f32x4*)(cw + t * 1024 + col), w1 = *(const f32x4*)(cw + t * 1024 + col + 4);
            acc[0] += w0[0] * (bflo(gc.x) * bflo(vv.x)); acc[1] += w0[1] * (bfhi(gc.x) * bfhi(vv.x)); acc[2] += w0[2] * (bflo(gc.y) * bflo(vv.y)); acc[3] += w0[3] * (bfhi(gc.y) * bfhi(vv.y));
            acc[4] += w1[0] * (bflo(gc.z) * bflo(vv.z)); acc[5] += w1[1] * (bfhi(gc.z) * bfhi(vv.z)); acc[6] += w1[2] * (bflo(gc.w) * bflo(vv.w)); acc[7] += w1[3] * (bfhi(gc.w) * bfhi(vv.w)); } }
        const v4u gb = *(const v4u*)(P + (size_t)r * 3072 + col);
        v4u o; o.x = pk2(bflo(gb.x) * acc[0], bfhi(gb.x) * acc[1]); o.y = pk2(bflo(gb.y) * acc[2], bfhi(gb.y) * acc[3]); o.z = pk2(bflo(gb.z) * acc[4], bfhi(gb.z) * acc[5]); o.w = pk2(bflo(gb.w) * acc[6], bfhi(gb.w) * acc[7]);
        *(v4u*)(U + (size_t)r * DM + col) = o;
    }
}

__device__ __forceinline__ void p14_resnorm_route(Frame& F) {
    LAS float* RW = (LAS float*)F.lds;
    LAS int* SEL = (LAS int*)(F.lds + 32768);
    const bf16* Y = (const bf16*)(F.ws + WS_Y); bf16* H = (bf16*)(F.ws + WS_H);
    int* SELR = (int*)(F.ws + WS_ROUTE + RT_SELR); float* GATE = (float*)(F.ws + WS_ROUTE + RT_GATE); int* CNT = (int*)(F.ws + WS_ROUTE + RT_CNT);
    for (int i = F.tid; i < 8192; i += NWAVES * 64) RW[i] = F.in[I_ROUTER][i];
    __syncthreads();
    const float* npost = F.in[I_NPOST] + 2 * 1024; const float* npre = F.in[I_NPRE] + 3 * 1024;
    for (int vb = blockIdx.x; vb < 256; vb += F.G) {
        for (int i = 0; i < 16; ++i) {
            const int tl = 16 * F.wave + i, r = 128 * vb + tl, b = r >> 12;
            f32x4 y[4], x[4]; load_row_bf16(Y + (size_t)r * DM, F.lane, y); load_row_f32(F.out + (size_t)r * DM, F.lane, x);
            const float rr = rsqrtf(row_ss(y) * (1.0f / DM) + EPS); const float* gt = mod_vec(F, 1, b, 2);
#pragma unroll
            for (int j = 0; j < 4; ++j) { const int col = 4 * F.lane + 256 * j; x[j] = x[j] + *(const f32x4*)(gt + col) * ((y[j] * rr) * *(const f32x4*)(npost + col)); *(f32x4*)(F.out + (size_t)r * DM + col) = x[j]; }
            prenorm_mod(x, npre, mod_vec(F, 1, b, 4), mod_vec(F, 1, b, 3), F.lane);
            store_row_bf16(H + (size_t)r * DM, F.lane, x);
            float lg[8];
#pragma unroll
            for (int e = 0; e < 8; ++e) lg[e] = 0.f;
#pragma unroll
            for (int j = 0; j < 4; ++j)
#pragma unroll
                for (int q = 0; q < 4; ++q) { const int col = 4 * F.lane + 256 * j + q; const f32x4 r0 = *(const LAS f32x4*)(RW + col * 8), r1 = *(const LAS f32x4*)(RW + col * 8 + 4); const float hv = x[j][q];
                    lg[0] += hv * r0[0]; lg[1] += hv * r0[1]; lg[2] += hv * r0[2]; lg[3] += hv * r0[3]; lg[4] += hv * r1[0]; lg[5] += hv * r1[1]; lg[6] += hv * r1[2]; lg[7] += hv * r1[3]; }
#pragma unroll
            for (int e = 0; e < 8; ++e) lg[e] = wave_sum(lg[e]);
            int e0 = 0; float v0 = lg[0];
#pragma unroll
            for (int e = 1; e < 8; ++e) if (lg[e] > v0) { v0 = lg[e]; e0 = e; }
            int e1 = -1; float v1 = 0.f;
#pragma unroll
            for (int e = 0; e < 8; ++e) if (e != e0 && (e1 < 0 || lg[e] > v1)) { v1 = lg[e]; e1 = e; }
            if (F.lane == 0) { const float g0 = 1.0f / (1.0f + __expf(v1 - v0)); GATE[2 * r] = g0; GATE[2 * r + 1] = 1.0f - g0; SEL[2 * tl] = e0; SEL[2 * tl + 1] = e1; }
        }
        __syncthreads();
        if (F.tid < 8) { int cnt = 0;
            for (int t = 0; t < 256; ++t) if (SEL[t] == F.tid) { SELR[256 * vb + t] = F.tid | (cnt << 8); ++cnt; }
            CNT[vb * 8 + F.tid] = cnt; }
        __syncthreads();
    }
}
__device__ __forceinline__ void p15_permute(Frame& F) {
    LAS int* CNTL = (LAS int*)(F.lds + 69632);
    LAS int* PRE = CNTL + 2048;
    LAS int* TOT = PRE + 2048;
    LAS int* SEG = TOT + 8;
    const int* CNT = (const int*)(F.ws + WS_ROUTE + RT_CNT); const int* SELR = (const int*)(F.ws + WS_ROUTE + RT_SELR);
    int* POS = (int*)(F.ws + WS_ROUTE + RT_POS); int* TEXP = (int*)(F.ws + WS_ROUTE + RT_TEXP);
    const bf16* H = (const bf16*)(F.ws + WS_H); bf16* HP = (bf16*)(F.ws + WS_HPERM);
    for (int i = F.tid; i < 2048; i += NWAVES * 64) CNTL[i] = CNT[i];
    __syncthreads();
    if (F.tid < 8) { int run = 0; for (int v = 0; v < 256; ++v) { PRE[v * 8 + F.tid] = run; run += CNTL[v * 8 + F.tid]; } TOT[F.tid] = run; }
    __syncthreads();
    if (F.tid == 0) { int ss = 0; for (int e = 0; e < 8; ++e) { SEG[e] = ss; ss += (TOT[e] + 255) & ~255; } SEG[8] = ss;
        if (blockIdx.x == 0) { for (int e = 0; e < 8; ++e) for (int t = SEG[e] >> 8; t < (SEG[e + 1] >> 8); ++t) TEXP[t] = e; TEXP[300] = ss >> 8; } }
    __syncthreads();
    for (int vb = blockIdx.x; vb < 256; vb += F.G) {
        for (int i = 0; i < 16; ++i) { const int tl = 16 * F.wave + i, r = 128 * vb + tl;
            const v4u a = *(const v4u*)(H + (size_t)r * DM + 8 * F.lane), c = *(const v4u*)(H + (size_t)r * DM + 512 + 8 * F.lane);
#pragma unroll
            for (int k = 0; k < 2; ++k) { const int sr = SELR[2 * r + k], e = sr & 255, pos = SEG[e] + PRE[vb * 8 + e] + (sr >> 8);
                *(v4u*)(HP + (size_t)pos * DM + 8 * F.lane) = a; *(v4u*)(HP + (size_t)pos * DM + 512 + 8 * F.lane) = c;
                if (F.lane == 0) POS[2 * r + k] = pos; } }
    }
    if ((int)blockIdx.x < 8) { const int e = blockIdx.x;
        for (int row = SEG[e] + TOT[e] + F.wave; row < SEG[e + 1]; row += NWAVES) { *(v4u*)(HP + (size_t)row * DM + 8 * F.lane) = (v4u){0u, 0u, 0u, 0u}; *(v4u*)(HP + (size_t)row * DM + 512 + 8 * F.lane) = (v4u){0u, 0u, 0u, 0u}; } }
    LAS float* scr = (LAS float*)(F.lds + F.wave * 8448);
    const int gw = blockIdx.x * NWAVES + F.wave, NGW = F.G * NWAVES;
    constexpr int IG = 16 * 224, ID = 56 * 32;
    for (int it = gw; it < 8 * (IG + ID); it += NGW) {
        const int e = it / (IG + ID), r = it % (IG + ID);
        if (r < IG) cvt_item(F.in[I_MGU] + (size_t)e * 1024 * 2 * DFFE, 1024, 2 * DFFE, (bf16*)(F.ws + WS_WMGU) + (size_t)e * 2 * DFFE * 1024, scr, r, F.lane, 1, DFFE);
        else cvt_item(F.in[I_MDN] + (size_t)e * DFFE * 1024, DFFE, 1024, (bf16*)(F.ws + WS_WMDN) + (size_t)e * 1024 * DFFE, scr, r - IG, F.lane, 0, 0);
    }
}
__device__ __forceinline__ void p18_final(Frame& F) {
    const int gw = blockIdx.x * NWAVES + F.wave, NGW = F.G * NWAVES;
    const bf16* YP = (const bf16*)(F.ws + WS_HPERM); const int* POS = (const int*)(F.ws + WS_ROUTE + RT_POS); const float* GATE = (const float*)(F.ws + WS_ROUTE + RT_GATE);
    const float* npost = F.in[I_NPOST] + 3 * 1024;
    for (int r = gw; r < MLAT; r += NGW) {
        const int b = r >> 12, p0 = POS[2 * r], p1 = POS[2 * r + 1]; const float g0 = GATE[2 * r], g1 = GATE[2 * r + 1];
        f32x4 a[4], c[4], x[4]; load_row_bf16(YP + (size_t)p0 * DM, F.lane, a); load_row_bf16(YP + (size_t)p1 * DM, F.lane, c); load_row_f32(F.out + (size_t)r * DM, F.lane, x);
#pragma unroll
        for (int j = 0; j < 4; ++j) a[j] = a[j] * g0 + c[j] * g1;
        const float rr = rsqrtf(row_ss(a) * (1.0f / DM) + EPS); const float* gt = mod_vec(F, 1, b, 5);
#pragma unroll
        for (int j = 0; j < 4; ++j) { const int col = 4 * F.lane + 256 * j; *(f32x4*)(F.out + (size_t)r * DM + col) = x[j] + *(const f32x4*)(gt + col) * ((a[j] * rr) * *(const f32x4*)(npost + col)); }
    }
}

#define XB_TMO      128
#define XB_XCNT(j)  (256  + 64 * (j))
#define XB_XSUB(j)  (1280 + 64 * (j))
#define XB_XGEN(j)  (2304 + 64 * (j))
#define XB_TOP      3328
#define XB_TOPGEN   3392
#define XCD_BAR_WORDS 3456
#define XB_SPIN_CAP (1u << 18)

__device__ __forceinline__ unsigned xb_ld(unsigned* p)              { return __hip_atomic_load(p, __ATOMIC_RELAXED, __HIP_MEMORY_SCOPE_AGENT); }
__device__ __forceinline__ unsigned xb_add(unsigned* p, unsigned v) { return __hip_atomic_fetch_add(p, v, __ATOMIC_RELAXED, __HIP_MEMORY_SCOPE_AGENT); }
__device__ __forceinline__ unsigned xb_xcc_id() { return (unsigned)__builtin_amdgcn_s_getreg((3 << 11) | 20) & 0xFu; }
#define XB_SPIN(cond, bar) do { unsigned _sp = 0; while (cond) { __builtin_amdgcn_s_sleep(1); \
    if ((++_sp & 255u) == 0u) { if (xb_ld(&(bar)[XB_TMO])) break; if (_sp > XB_SPIN_CAP) { atomicAdd(&(bar)[XB_TMO], 1u); break; } } } } while (0)

struct XcdBarrier {
    unsigned* bar; unsigned x;
    volatile LAS unsigned* st;
};

__device__ __forceinline__ XcdBarrier xcd_barrier_post(unsigned* bar, volatile LAS unsigned* st) {
    XcdBarrier b; b.bar = bar; b.x = xb_xcc_id(); b.st = st;
    if (threadIdx.x == 0) (void)xb_add(&bar[XB_XCNT(b.x)], 1u);
    return b;
}
__device__ __forceinline__ void xcd_barrier_complete(unsigned* bar, unsigned x, unsigned& nloc, unsigned& nx) {
    const unsigned G = gridDim.x * gridDim.y * gridDim.z;
    unsigned sum, cnt, mine, sp = 0u;
    for (;;) {
        sum = 0u; cnt = 0u; mine = 0u;
#pragma unroll
        for (unsigned j = 0; j < 16; ++j) { const unsigned c = xb_ld(&bar[XB_XCNT(j)]); sum += c; cnt += (c > 0u) ? 1u : 0u; mine = (j == x) ? c : mine; }
        if (sum == G) break;
        __builtin_amdgcn_s_sleep(1);
        if ((++sp & 255u) == 0u) { if (xb_ld(&bar[XB_TMO])) break; if (sp > XB_SPIN_CAP) { atomicAdd(&bar[XB_TMO], 1u); break; } }
    }
    nloc = mine > 0u ? mine : 1u; nx = cnt > 0u ? cnt : 1u;
}

__device__ __forceinline__ void xcd_barrier(const XcdBarrier& b) {
    asm volatile("s_waitcnt vmcnt(0)" ::: "memory");
    __syncthreads();
    if (threadIdx.x == 0) {
        unsigned* bar = b.bar;
        __builtin_amdgcn_s_waitcnt(0);
        unsigned nloc = b.st[0], nx = b.st[1];
        if (nloc == 0u) { xcd_barrier_complete(bar, b.x, nloc, nx); b.st[0] = nloc; b.st[1] = nx; }
        const unsigned old = xb_add(&bar[XB_XSUB(b.x)], 1u);
        const unsigned gen = old / nloc;
        if (old + 1u == (gen + 1u) * nloc) {
            __builtin_amdgcn_fence(__ATOMIC_RELEASE, "agent");
            asm volatile("s_waitcnt vmcnt(0)" ::: "memory");
            const unsigned og = xb_add(&bar[XB_TOP], 1u);
            const unsigned tg = og / nx;
            if (og + 1u == (tg + 1u) * nx) xb_add(&bar[XB_TOPGEN], 1u);
            else XB_SPIN(xb_ld(&bar[XB_TOPGEN]) == tg, bar);
            __builtin_amdgcn_fence(__ATOMIC_ACQUIRE, "agent");
            xb_add(&bar[XB_XGEN(b.x)], 1u);
            asm volatile("s_waitcnt vmcnt(0)" ::: "memory");
        } else {
            XB_SPIN(xb_ld(&bar[XB_XGEN(b.x)]) == gen, bar);
            __builtin_amdgcn_fence(__ATOMIC_ACQUIRE, "agent");
            asm volatile("s_waitcnt vmcnt(0)" ::: "memory");
        }
    }
    __syncthreads();
}

#ifndef MK_DUMP
#define MK_DUMP 0
#endif
__device__ __forceinline__ void dump_phase(Frame& F) {
    const size_t NT = (size_t)F.G * NWAVES * 64, n = (size_t)MLAT * DM;
    for (size_t i = (size_t)blockIdx.x * (NWAVES * 64) + F.tid; i < n; i += NT) {
        float v = 0.f;
        if (MK_DUMP == 1) { v = bf1(((const bf16*)(F.ws + WS_H))[i]) + (i < (size_t)MCTX * DM ? bf1(((const bf16*)(F.ws + WS_H))[n + i]) : 0.f); }
        if (MK_DUMP == 2) { for (int k = 0; k < 4; ++k) v += bf1(((const bf16*)(F.ws + WS_XBC))[i + k * n]); for (int k = 0; k < 2; ++k) v += bf1(((const bf16*)(F.ws + WS_Z))[i + k * n]); if (i < (size_t)MALL * 64) v += ((const float*)(F.ws + WS_DT))[i]; }
        if (MK_DUMP == 3) { const size_t ns = (size_t)NUNIT * 8 * 8192; for (int k = 0; k < 5; ++k) if (i + k * n < ns) v += bf1(((const bf16*)(F.ws + WS_S))[i + k * n]); for (int k = 0; k < 4; ++k) v += bf1(((const bf16*)(F.ws + WS_XBC))[i + k * n]); if (i < (size_t)NUNIT * 8) v += ((const float*)(F.ws + WS_CD))[i]; }
        if (MK_DUMP == 4) { for (int k = 0; k < 2; ++k) v += bf1(((const bf16*)(F.ws + WS_Z))[i + k * n]); }
        if (MK_DUMP == 5) { v = bf1(((const bf16*)(F.ws + WS_Y))[i]); }
        F.out[i] = v;
    }
}

struct Args { const float* in[24]; float* out; unsigned char* ws; int ph_lo, ph_hi; };
__global__ void __launch_bounds__(NWAVES * 64, 2) fwd_kernel(Args args) {
    extern __shared__ __attribute__((aligned(16))) unsigned char lds[];
    Frame F;
    F.lds = (LAS unsigned char*)lds;
    F.MISC = (volatile LAS unsigned*)(F.lds + MISC_OFF);
    F.tid = threadIdx.x; F.lane = F.tid & 63; F.wave = __builtin_amdgcn_readfirstlane(F.tid >> 6);
    F.G = gridDim.x;
#pragma unroll
    for (int i = 0; i < 24; ++i) F.in[i] = args.in[i];
    F.out = args.out; F.ws = args.ws; F.ctl = (gu32*)(args.ws + WS_CTL);
    for (int u = F.tid; u < (LDS_BYTES - MISC_OFF) / 4; u += NWAVES * 64) ((LAS unsigned*)(F.lds + MISC_OFF))[u] = 0u;
    __syncthreads();
    XcdBarrier bar; bar.bar = (unsigned*)(F.ctl + CW_BAR); bar.x = 0; bar.st = nullptr;
    if (!MK_PER_PHASE) bar = xcd_barrier_post((unsigned*)(F.ctl + CW_BAR), F.MISC + 8);
    const int lo = args.ph_lo, hi = args.ph_hi;
#ifndef MK_PHASE_MASK
#define MK_PHASE_MASK 0x7ffff
#endif
#define IN(k) (((MK_PHASE_MASK >> (k)) & 1) && lo <= (k) && (k) < hi)
#define SEAM(k) do { if (!MK_PER_PHASE && IN((k) + 1)) xcd_barrier(bar); } while (0)
    bf16* const WS_bH = (bf16*)(F.ws + WS_H); bf16* const WS_bY = (bf16*)(F.ws + WS_Y); bf16* const WS_bZ = (bf16*)(F.ws + WS_Z);

    if (IN(0)) { p0_prologue(F); SEAM(0); }
    if (IN(1)) { p1_prenorm(F); SEAM(1); }
    if (IN(2)) {
        pg8::Gemm g{WS_bH, (const bf16*)(F.ws + WS_WIN), MALL, DINP_PAD, DM}; pg8::StaticOrder S; S.init(MALL, DINP_PAD, F.G, (int)blockIdx.x);
        pg8::EpiInProj E{WS_bZ, (bf16*)(F.ws + WS_XBC), (float*)(F.ws + WS_DT)};
        pg8::gemm_phase<pg8::EpiInProj, pg8::StaticOrder, true, true>(F.lds, g, S, E);
        SEAM(2);
    }
    if (IN(3)) { ssd_phase_a(F); SEAM(3); }
    if (IN(4)) { ssd_phase_b(F); SEAM(4); }
    if (IN(5)) { ssd_phase_c(F); SEAM(5); }
    if (IN(6)) {
        pg8::Gemm g{WS_bZ, (const bf16*)(F.ws + WS_WOUT), MLAT, DM, DIN}; pg8::StaticOrder S; S.init(MLAT, DM, F.G, (int)blockIdx.x);
        pg8::EpiBf16<0> E{WS_bY, DM, nullptr, 0, 0, 1.f};
        pg8::gemm_phase<pg8::EpiBf16<0>, pg8::StaticOrder, true, true>(F.lds, g, S, E);
        SEAM(6);
    }
    if (IN(7)) { resnorm_phase<true>(F, F.in[I_X], 0, 2, F.in[I_NPOST], F.in[I_NPRE] + 1024, 0, 4, 3); SEAM(7); }
    if (IN(8)) {
        pg8::Gemm g{WS_bH, (const bf16*)(F.ws + WS_WGU), MLAT, 2 * DFF, DM}; pg8::StaticOrder S; S.init(MLAT, 2 * DFF, F.G, (int)blockIdx.x);
        pg8::EpiSwiGLU E{(bf16*)(F.ws + WS_ACT0), DFF};
        pg8::gemm_phase<pg8::EpiSwiGLU, pg8::StaticOrder, true, true>(F.lds, g, S, E);
        SEAM(8);
    }
    if (IN(9)) {
        pg8::Gemm g{(const bf16*)(F.ws + WS_ACT0), (const bf16*)(F.ws + WS_WDN), MLAT, DM, DFF}; pg8::StaticOrder S; S.init(MLAT, DM, F.G, (int)blockIdx.x);
        pg8::EpiBf16<0> E{WS_bY, DM, nullptr, 0, 0, 1.f};
        pg8::gemm_phase<pg8::EpiBf16<0>, pg8::StaticOrder, true, true>(F.lds, g, S, E);
        SEAM(9);
    }
    if (IN(10)) { resnorm_phase<true>(F, F.out, 0, 5, F.in[I_NPOST] + 1024, F.in[I_NPRE] + 2048, 1, 1, 0); SEAM(10); }
    if (IN(11)) {
        pg8::Gemm g{WS_bH, (const bf16*)(F.ws + WS_WSCI), MLAT, 3072, DM}; pg8::StaticOrder S; S.init(MLAT, 3072, F.G, (int)blockIdx.x);
        pg8::EpiBf16<0> E{(bf16*)(F.ws + WS_SCP), 3072, nullptr, 0, 0, 1.f};
        pg8::gemm_phase<pg8::EpiBf16<0>, pg8::StaticOrder, true, true>(F.lds, g, S, E);
        SEAM(11);
    }
    if (IN(12)) { p12_shortconv(F); SEAM(12); }
    if (IN(13)) {
        pg8::Gemm g{WS_bH, (const bf16*)(F.ws + WS_WSCO), MLAT, DM, DM}; pg8::StaticOrder S; S.init(MLAT, DM, F.G, (int)blockIdx.x);
        pg8::EpiBf16<0> E{WS_bY, DM, nullptr, 0, 0, 1.f};
        pg8::gemm_phase<pg8::EpiBf16<0>, pg8::StaticOrder, true, true>(F.lds, g, S, E);
        SEAM(13);
    }
    if (IN(14)) { p14_resnorm_route(F); SEAM(14); }
    if (IN(15)) { p15_permute(F); SEAM(15); }
    if (IN(16)) {
        const int* texp = (const int*)(F.ws + WS_ROUTE + RT_TEXP); int nt = __builtin_amdgcn_readfirstlane(texp[300]); nt = nt < 0 ? 0 : (nt > MOE_ROWS / 256 ? MOE_ROWS / 256 : nt);
        pg8::Gemm g{(const bf16*)(F.ws + WS_HPERM), (const bf16*)(F.ws + WS_WMGU), 256 * nt, 2 * DFFE, DM};
        pg8::GroupedOrder S; S.init(256 * nt, 2 * DFFE, F.G, (int)blockIdx.x); S.texp = texp; S.estride = (size_t)2 * DFFE * DM * 2;
        pg8::EpiSwiGLU E{(bf16*)(F.ws + WS_ACT), DFFE};
        pg8::gemm_phase<pg8::EpiSwiGLU, pg8::GroupedOrder, true, true>(F.lds, g, S, E);
        SEAM(16);
    }
    if (IN(17)) {
        const int* texp = (const int*)(F.ws + WS_ROUTE + RT_TEXP); int nt = __builtin_amdgcn_readfirstlane(texp[300]); nt = nt < 0 ? 0 : (nt > MOE_ROWS / 256 ? MOE_ROWS / 256 : nt);
        pg8::Gemm g{(const bf16*)(F.ws + WS_ACT), (const bf16*)(F.ws + WS_WMDN), 256 * nt, DM, DFFE};
        pg8::GroupedOrder S; S.init(256 * nt, DM, F.G, (int)blockIdx.x); S.texp = texp; S.estride = (size_t)DM * DFFE * 2;
        pg8::EpiBf16<0> E{(bf16*)(F.ws + WS_HPERM), DM, nullptr, 0, 0, 1.f};
        pg8::gemm_phase<pg8::EpiBf16<0>, pg8::GroupedOrder, true, true>(F.lds, g, S, E);
        SEAM(17);
    }
    if (IN(18)) { p18_final(F); }
    if (MK_DUMP && lo <= 19 && 19 < hi) dump_phase(F);
#undef IN
#undef SEAM
}

extern "C" void kernel_launch(void* const* d_in, const int* in_sizes, int n_in, void* d_out, int out_size, void* d_ws, size_t ws_size, hipStream_t stream) {
    static int grid = 0;
    if (grid == 0) {
        if (n_in != 24 || out_size != MLAT * DM || ws_size < WS_END) { fprintf(stderr, "kernel_launch: unexpected problem (n_in %d, out %d, ws %zu)\n", n_in, out_size, ws_size); grid = -1; return; }
        int dev = 0, cus = 0, per_cu = 0;
        if (hipGetDevice(&dev) != hipSuccess || hipDeviceGetAttribute(&cus, hipDeviceAttributeMultiprocessorCount, dev) != hipSuccess) { grid = -1; return; }
        if (hipFuncSetAttribute((const void*)fwd_kernel, hipFuncAttributeMaxDynamicSharedMemorySize, LDS_BYTES) != hipSuccess) { fprintf(stderr, "kernel_launch: hipFuncSetAttribute failed\n"); grid = -1; return; }
        if (hipOccupancyMaxActiveBlocksPerMultiprocessor(&per_cu, (const void*)fwd_kernel, NWAVES * 64, LDS_BYTES) != hipSuccess || per_cu < 1) { fprintf(stderr, "kernel_launch: occupancy query reports %d\n", per_cu); }
        (void)hipGetLastError();
        grid = cus;
    }
    if (grid < 0) return;
    if (hipMemsetAsync((char*)d_ws + WS_CTL, 0, CTL_ZERO_BYTES, stream) != hipSuccess) return;
    Args a{};
    for (int i = 0; i < 24; ++i) a.in[i] = (const float*)d_in[i];
    a.out = (float*)d_out; a.ws = (unsigned char*)d_ws;
#if MK_PER_PHASE
    for (int p = 0; p <= MK_LAST_PHASE; ++p) { a.ph_lo = p; a.ph_hi = p + 1; hipLaunchKernelGGL(fwd_kernel, dim3(grid), dim3(NWAVES * 64), LDS_BYTES, stream, a); }
    if (MK_DUMP) { a.ph_lo = 19; a.ph_hi = 20; hipLaunchKernelGGL(fwd_kernel, dim3(grid), dim3(NWAVES * 64), LDS_BYTES, stream, a); }
#else
    a.ph_lo = 0; a.ph_hi = MK_LAST_PHASE + 1;
    hipLaunchKernelGGL(fwd_kernel, dim3(grid), dim3(NWAVES * 64), LDS_BYTES, stream, a);
#endif
}
```

```cpp
#include <hip/hip_runtime.h>
#include <cstdio>
#include <cstdint>
#define MK_PER_PHASE 0
#define MK_LAST_PHASE 18
#define MK_DUMP 0
#define MK_TWICE_MASK 0
#define MK_DRY_MASK 0
namespace pg8 {
#define PG8_LAS __attribute__((address_space(3)))
typedef unsigned short bf16_t;
typedef short bf16x8 __attribute__((ext_vector_type(8)));
typedef float f32x4 __attribute__((ext_vector_type(4)));
typedef unsigned u32x4 __attribute__((ext_vector_type(4)));
constexpr int BM = 256, BK = 64, HALF = 128, HTB = HALF * BK * 2  , STAGE_BYTES = 8 * HTB, NXCD = 8, WGM = 8;

__host__ __device__ __forceinline__ int lds_byte(int r, int c) { const int st = (r >> 4) * 2 + (c >> 5), rr = r & 15, cc = c & 31, ob = rr * 64 + cc * 2; return st * 1024 + (ob ^ (((ob >> 9) & 1) << 5)); }
__host__ __device__ __forceinline__ void stage_rc(int b, int& R, int& C) { const int st = b / 1024, sb = b % 1024, swz = sb ^ (((sb >> 9) & 1) << 5); R = (st >> 1) * 16 + swz / 64; C = (st & 1) * 32 + (swz % 64) / 2; }
__host__ __device__ __forceinline__ int perm32(int rho) { const int n = rho >> 4, i = rho & 15; return 8 * (i >> 2) + 4 * n + (i & 3); }

struct Unit { int pm, pn; };
struct Gemm { const bf16_t* A; const bf16_t* Bt; int M, N, K; };

struct StaticOrder {
    int nM, nN, nwg, G, c;
    __host__ __device__ void init(int M, int N, int G_, int c_) { nM = M / BM; nN = N / BM; nwg = nM * nN; G = G_; c = c_; }
    __host__ __device__ bool next(int i, Unit& u) const {
        const long L = (long)i * G + c; if (L >= nwg) return false;
        int wgid = (int)L; { const int q = nwg / NXCD, r = nwg % NXCD, xcd = wgid % NXCD, off = wgid / NXCD; wgid = (xcd < r ? xcd * (q + 1) : r * (q + 1) + (xcd - r) * q) + off; }
        const int nig = WGM * nN, gid = wgid / nig, fm = gid * WGM, gsz = (nM - fm) < WGM ? (nM - fm) : WGM;
        u.pm = fm + ((wgid % nig) % gsz); u.pn = (wgid % nig) / gsz; return true;
    }
    __device__ __forceinline__ void a_ready(const Unit&) const {}
    __device__ __forceinline__ void done(const Unit&) const {}
    __device__ __forceinline__ size_t boff(const Unit&) const { return 0; }
};

typedef float f32x2c __attribute__((ext_vector_type(2)));
typedef __bf16 bf16x2c __attribute__((ext_vector_type(2)));
__device__ __forceinline__ unsigned cvt_pk_bf16(float lo, float hi) { const f32x2c v = {lo, hi}; return __builtin_bit_cast(unsigned, __builtin_convertvector(v, bf16x2c)); }
typedef float f32x2 __attribute__((ext_vector_type(2)));
__device__ __forceinline__ f32x2 gelu_pk(f32x2 v) {
    const f32x2 av = __builtin_elementwise_abs(v), d = av * 0.2316418882f + 1.0f;
    f32x2 t; t.x = __builtin_amdgcn_rcpf(d.x); t.y = __builtin_amdgcn_rcpf(d.y);
    f32x2 q = t * 0.5307027145f + (-0.7265760135f); q = q * t + 0.7107068705f; q = q * t + (-0.142248368f); q = q * t + 0.127414796f; q = q * t;
    const f32x2 s = (v * v) * (-0.72134752044f);
    f32x2 e; e.x = __builtin_amdgcn_exp2f(s.x); e.y = __builtin_amdgcn_exp2f(s.y);
    const f32x2 m = v * (q * e), r = v - m;
    f32x2 o; o.x = v.x < 0.f ? m.x : r.x; o.y = v.y < 0.f ? m.y : r.y; return o;
}

template <int ACT  > struct EpiBf16 {
    static constexpr bool PERM = true, AFTER_DRAIN = false; static_assert(ACT == 0 || ACT == 1, "EpiBf16: ACT is 0 (none) or 1 (gelu_pk)");
    bf16_t* O; int ldc; const float* bias; int split_cols; size_t split_stride; float scale0;
    __device__ __forceinline__ void operator()(const f32x4 (&acc)[2][2][4][2], const Unit& u, int wr, int wc, int fr, int fq) const {
        const int row0 = u.pm * BM + wr * 64 + fr; int colt = u.pn * BM; bf16_t* base = O;
        float sc = 1.f; if (split_cols) { const int t = colt / split_cols; base += (size_t)t * split_stride; colt -= t * split_cols; if (t == 0) sc = scale0; }
        const int col0 = colt + wc * 32 + 8 * fq, bcol0 = u.pn * BM + wc * 32 + 8 * fq;
        f32x4 bv[2][2];
#pragma unroll
        for (int bj = 0; bj < 2; ++bj)
#pragma unroll
            for (int n = 0; n < 2; ++n) bv[bj][n] = bias ? *(const f32x4*)(bias + bcol0 + bj * HALF + 4 * n) : (f32x4){0.f, 0.f, 0.f, 0.f};
#pragma unroll
        for (int ai = 0; ai < 2; ++ai)
#pragma unroll
            for (int m = 0; m < 4; ++m) { bf16_t* rowp = base + (size_t)(row0 + ai * HALF + m * 16) * ldc + col0;
#pragma unroll
                for (int bj = 0; bj < 2; ++bj) { f32x4 v0 = acc[ai][bj][m][0] + bv[bj][0], v1 = acc[ai][bj][m][1] + bv[bj][1];
                    if (ACT == 1) { f32x2 a = gelu_pk((f32x2){v0[0], v0[1]}), b = gelu_pk((f32x2){v0[2], v0[3]}), c = gelu_pk((f32x2){v1[0], v1[1]}), d = gelu_pk((f32x2){v1[2], v1[3]});
                        v0 = (f32x4){a.x, a.y, b.x, b.y}; v1 = (f32x4){c.x, c.y, d.x, d.y}; }
                    v0 = v0 * sc; v1 = v1 * sc; u32x4 w; w.x = cvt_pk_bf16(v0[0], v0[1]); w.y = cvt_pk_bf16(v0[2], v0[3]); w.z = cvt_pk_bf16(v1[0], v1[1]); w.w = cvt_pk_bf16(v1[2], v1[3]);
                    *(u32x4*)(rowp + bj * HALF) = w; } }
    }
};

typedef int i32x4f __attribute__((ext_vector_type(4)));
typedef int i32x8f __attribute__((ext_vector_type(8)));
__device__ __forceinline__ i32x8f cat8(bf16x8 a, bf16x8 b) { const i32x4f lo = __builtin_bit_cast(i32x4f, a), hi = __builtin_bit_cast(i32x4f, b); return __builtin_shufflevector(lo, hi, 0, 1, 2, 3, 4, 5, 6, 7); }
template <class Epi, class Sched, bool ALIGN_EPI = false, bool SP2 = false, bool FP8 = false>
__device__ __forceinline__ void gemm_phase(PG8_LAS unsigned char* lds, const Gemm g, const Sched& S, const Epi& E) {
    const int tid = threadIdx.x, wid = __builtin_amdgcn_readfirstlane(tid >> 6), lane = tid & 63, wr = wid >> 2, wc = wid & 3, fr = lane & 15, fq = lane >> 4;
    const int K = g.K, nt = K / BK;
    unsigned voffA[2], voffB[2];
#pragma unroll
    for (int i = 0; i < 2; ++i) { int R, C; stage_rc(tid * 16 + i * 8192, R, C); const int Rb = Epi::PERM ? ((R & ~31) + perm32(R & 31)) : R;
        voffA[i] = (unsigned)(R * K + C) * 2u; voffB[i] = (unsigned)(Rb * K + C) * 2u; }
    const size_t kstep = (size_t)(BK * 2);
    const size_t hstep = (size_t)HALF * K * 2;
    const size_t tstep = 2 * hstep;
    const unsigned ldsw = (unsigned)wid * 1024u;
    const int aoff = lds_byte(wr * 64 + fr, fq * 8), boff = lds_byte(wc * 32 + fr, fq * 8);
#define PG8_SA(b, h) (((b) * 2 + (h)) * HTB)
#define PG8_SB(b, h) ((4 + (b) * 2 + (h)) * HTB)
#define PG8_STAGE(bufoff, gbase, voff) do { _Pragma("unroll") for (int _i = 0; _i < 2; ++_i) \
        __builtin_amdgcn_global_load_lds((const unsigned*)((const char*)(gbase) + (voff)[_i]), (PG8_LAS unsigned*)(lds + (bufoff) + ldsw + _i * 8192), 16, 0, 0); } while (0)
#define PG8_LDA(dst, b, h) do { _Pragma("unroll") for (int m = 0; m < 4; ++m) { const bf16x8 x0_ = *(const PG8_LAS bf16x8*)(lds + PG8_SA(b, h) + aoff + m * 2048), x1_ = *(const PG8_LAS bf16x8*)(lds + PG8_SA(b, h) + aoff + m * 2048 + 1024); \
        if constexpr (FP8) dst##8[m] = cat8(x0_, x1_); else { dst[m][0] = x0_; dst[m][1] = x1_; } } } while (0)
#define PG8_LDB(dst, b, h) do { _Pragma("unroll") for (int n = 0; n < 2; ++n) { const bf16x8 x0_ = *(const PG8_LAS bf16x8*)(lds + PG8_SB(b, h) + boff + n * 2048), x1_ = *(const PG8_LAS bf16x8*)(lds + PG8_SB(b, h) + boff + n * 2048 + 1024); \
        if constexpr (FP8) dst##8[n] = cat8(x0_, x1_); else { dst[n][0] = x0_; dst[n][1] = x1_; } } } while (0)
#define PG8_MMA(ai, bj, At, Bt) do { __builtin_amdgcn_s_setprio(1); _Pragma("unroll") for (int m = 0; m < 4; ++m) _Pragma("unroll") for (int n = 0; n < 2; ++n) { \
        if constexpr (FP8) asm volatile("v_mfma_f32_16x16x128_f8f6f4 %0, %1, %2, %0" : "+v"(acc[ai][bj][m][n]) : "v"(Bt##8[n]), "v"(At##8[m])); \
        else { _Pragma("unroll") for (int k = 0; k < 2; ++k) acc[ai][bj][m][n] = __builtin_amdgcn_mfma_f32_16x16x32_bf16(Bt[n][k], At[m][k], acc[ai][bj][m][n], 0, 0, 0); } } __builtin_amdgcn_s_setprio(0); } while (0)
#define PG8_WAIT_V(n) asm volatile("s_waitcnt vmcnt(" #n ")" ::: "memory")
#define PG8_WAIT_L(n) asm volatile("s_waitcnt lgkmcnt(" #n ")" ::: "memory")
#define PG8_BAR __builtin_amdgcn_s_barrier()
#define PG8_SCHED __builtin_amdgcn_sched_barrier(0)
    Unit cur, nxt; int ui = 0;
    if (!S.next(0, cur)) return;
    f32x4 acc[2][2][4][2];
#pragma unroll
    for (int a = 0; a < 2; ++a)
#pragma unroll
        for (int b = 0; b < 2; ++b)
#pragma unroll
            for (int m = 0; m < 4; ++m)
#pragma unroll
                for (int n = 0; n < 2; ++n) acc[a][b][m][n] = (f32x4){0.f, 0.f, 0.f, 0.f};
    bf16x8 At[4][2], B0[2][2], B1[2][2]; i32x8f At8[4], B08[2], B18[2];
    const char* cA = (const char*)g.A + (size_t)cur.pm * tstep; const char* cB = (const char*)g.Bt + S.boff(cur) + (size_t)cur.pn * tstep;
    S.a_ready(cur);
    if constexpr (SP2) {
        PG8_STAGE(PG8_SB(0, 0), cB, voffB); PG8_STAGE(PG8_SB(0, 1), cB + hstep, voffB); PG8_STAGE(PG8_SA(0, 0), cA, voffA); PG8_STAGE(PG8_SA(0, 1), cA + hstep, voffA);
        if (wr == 1) PG8_BAR;
        PG8_WAIT_V(2); PG8_BAR;
        PG8_STAGE(PG8_SB(1, 0), cB + kstep, voffB); PG8_STAGE(PG8_SA(1, 0), cA + kstep, voffA); PG8_STAGE(PG8_SB(1, 1), cB + hstep + kstep, voffB);
        PG8_WAIT_V(6); PG8_BAR;
    } else {
        PG8_STAGE(PG8_SB(0, 0), cB, voffB); PG8_STAGE(PG8_SA(0, 0), cA, voffA); PG8_STAGE(PG8_SB(0, 1), cB + hstep, voffB); PG8_STAGE(PG8_SA(0, 1), cA + hstep, voffA);
        if (wr == 1) PG8_BAR;
        PG8_WAIT_V(4); PG8_BAR;
        PG8_STAGE(PG8_SB(1, 0), cB + kstep, voffB); PG8_STAGE(PG8_SA(1, 0), cA + kstep, voffA); PG8_STAGE(PG8_SB(1, 1), cB + hstep + kstep, voffB);
        PG8_WAIT_V(6); PG8_BAR;
    }
    for (;;) {
        const bool has_next = S.next(ui + 1, nxt);
        const char* nA = has_next ? (const char*)g.A + (size_t)nxt.pm * tstep : cA; const char* nB = has_next ? (const char*)g.Bt + S.boff(nxt) + (size_t)nxt.pn * tstep : cB;
        for (int t = 0; t < nt; t += 2) {
            const bool last = (t == nt - 2);
            const char* a1 = cA + (size_t)(t + 1) * kstep;
            const char* a2 = last ? nA : cA + (size_t)(t + 2) * kstep; const char* b2 = last ? nB : cB + (size_t)(t + 2) * kstep;
            const char* a3 = a2 + kstep; const char* b3 = b2 + kstep;
            if (last && has_next) S.a_ready(nxt);
            if constexpr (SP2) {
            PG8_LDB(B0, 0, 0); PG8_LDB(B1, 0, 1); PG8_SCHED; PG8_LDA(At, 0, 0); PG8_STAGE(PG8_SA(1, 1), a1 + hstep, voffA);
            PG8_WAIT_V(8); PG8_WAIT_L(0); PG8_BAR; PG8_MMA(0, 0, At, B0); PG8_MMA(0, 1, At, B1); PG8_BAR; PG8_SCHED;
            PG8_LDA(At, 0, 1); PG8_STAGE(PG8_SB(0, 0), b2, voffB); PG8_STAGE(PG8_SB(0, 1), b2 + hstep, voffB); PG8_STAGE(PG8_SA(0, 0), a2, voffA);
            PG8_WAIT_V(8); PG8_WAIT_L(0); PG8_BAR; PG8_MMA(1, 0, At, B0); PG8_MMA(1, 1, At, B1); PG8_BAR; PG8_SCHED;
            PG8_LDB(B0, 1, 0); PG8_LDB(B1, 1, 1); PG8_SCHED; PG8_LDA(At, 1, 0); PG8_STAGE(PG8_SA(0, 1), a2 + hstep, voffA);
            PG8_WAIT_V(8); PG8_WAIT_L(0); PG8_BAR; PG8_MMA(0, 0, At, B0); PG8_MMA(0, 1, At, B1); PG8_BAR; PG8_SCHED;
            PG8_LDA(At, 1, 1); PG8_STAGE(PG8_SB(1, 0), b3, voffB); PG8_STAGE(PG8_SB(1, 1), b3 + hstep, voffB); PG8_STAGE(PG8_SA(1, 0), a3, voffA);
            PG8_WAIT_V(8); PG8_WAIT_L(0); PG8_BAR; PG8_MMA(1, 0, At, B0); PG8_MMA(1, 1, At, B1); PG8_BAR; PG8_SCHED;
            } else {
            PG8_LDB(B0, 0, 0); PG8_SCHED; PG8_LDA(At, 0, 0); PG8_STAGE(PG8_SA(1, 1), a1 + hstep, voffA);
            PG8_WAIT_L(8); PG8_BAR; PG8_WAIT_L(0); PG8_MMA(0, 0, At, B0); PG8_BAR; PG8_SCHED;
            PG8_LDB(B1, 0, 1); PG8_STAGE(PG8_SB(0, 0), b2, voffB);
            PG8_BAR; PG8_WAIT_L(0); PG8_MMA(0, 1, At, B1); PG8_BAR;
            PG8_LDA(At, 0, 1); PG8_STAGE(PG8_SA(0, 0), a2, voffA);
            PG8_BAR; PG8_WAIT_L(0); PG8_MMA(1, 0, At, B0); PG8_BAR; PG8_SCHED;
            PG8_STAGE(PG8_SB(0, 1), b2 + hstep, voffB);
            PG8_WAIT_V(6); PG8_BAR; PG8_MMA(1, 1, At, B1); PG8_BAR;
            PG8_LDB(B0, 1, 0); PG8_SCHED; PG8_LDA(At, 1, 0); PG8_STAGE(PG8_SA(0, 1), a2 + hstep, voffA);
            PG8_WAIT_L(8); PG8_BAR; PG8_WAIT_L(0); PG8_MMA(0, 0, At, B0); PG8_BAR; PG8_SCHED;
            PG8_LDB(B1, 1, 1); PG8_STAGE(PG8_SB(1, 0), b3, voffB);
            PG8_BAR; PG8_WAIT_L(0); PG8_MMA(0, 1, At, B1); PG8_BAR;
            PG8_LDA(At, 1, 1); PG8_STAGE(PG8_SA(1, 0), a3, voffA);
            PG8_BAR; PG8_WAIT_L(0); PG8_MMA(1, 0, At, B0); PG8_BAR; PG8_SCHED;
            PG8_STAGE(PG8_SB(1, 1), b3 + hstep, voffB);
            PG8_WAIT_V(6); PG8_BAR; PG8_MMA(1, 1, At, B1); PG8_BAR;
            }
        }
        if constexpr (FP8) asm volatile("s_nop 7\n\ts_nop 7\n\ts_nop 7" ::: "memory");
        if constexpr (ALIGN_EPI) { if (wr == 0) PG8_BAR; }
        if constexpr (!Epi::AFTER_DRAIN) { E(acc, cur, wr, wc, fr, fq); S.done(cur); }
        if (!has_next) break;
#pragma unroll
        for (int a = 0; a < 2; ++a)
#pragma unroll
            for (int b = 0; b < 2; ++b)
#pragma unroll
                for (int m = 0; m < 4; ++m)
#pragma unroll
                    for (int n = 0; n < 2; ++n) acc[a][b][m][n] = (f32x4){0.f, 0.f, 0.f, 0.f};
        cur = nxt; cA = nA; cB = nB; ++ui;
        if constexpr (ALIGN_EPI) { if (wr == 1) PG8_BAR; }
    }
    PG8_WAIT_V(0);
    if constexpr (!ALIGN_EPI) { if (wr == 0) PG8_BAR; }
    PG8_BAR;
    if constexpr (Epi::AFTER_DRAIN) { E.fused(acc, cur, wr, wc, fr, fq, lds, wid, lane); S.done(cur); }
#undef PG8_SA
#undef PG8_SB
#undef PG8_STAGE
#undef PG8_LDA
#undef PG8_LDB
#undef PG8_MMA
#undef PG8_WAIT_V
#undef PG8_WAIT_L
#undef PG8_BAR
#undef PG8_SCHED
}
}

constexpr int NWAVES = 8;
constexpr int DM = 1024, NB = 8, SEQ = 4096, CTXL = 256;
constexpr int MLAT = NB * SEQ, MCTX = NB * CTXL, MALL = MLAT + MCTX;
constexpr int DIN = 2048, CONVD = 4096, DINP = 6208, DINP_PAD = 6400;
constexpr int DFF = 2816, NE = 8, DFFE = 3584;
constexpr int NUNIT_LAT = NB * 32 * 8, NUNIT = NUNIT_LAT + NB * 2 * 8;
constexpr int MOE_ROWS = 67584;
constexpr float EPS = 1e-6f;
#ifndef MK_PER_PHASE
#define MK_PER_PHASE 0
#endif
#ifndef MK_LAST_PHASE
#define MK_LAST_PHASE 18
#endif
constexpr int N_PHASES = 19;

constexpr size_t MiB = 1u << 20;
constexpr size_t WS_CTL = 0, CTL_ZERO_BYTES = 1 * MiB;
constexpr size_t WS_MOD = 1 * MiB;
constexpr size_t WS_ROUTE = 2 * MiB;
constexpr size_t WS_CD = 4 * MiB;
constexpr size_t WS_WIN = 8 * MiB, WS_WOUT = 21 * MiB, WS_WGU = 25 * MiB, WS_WDN = 36 * MiB, WS_WSCI = 42 * MiB, WS_WSCO = 48 * MiB;
constexpr size_t WS_H = 56 * MiB;
constexpr size_t WS_Y = 124 * MiB;
constexpr size_t WS_Z = 188 * MiB;
constexpr size_t WS_XBC = 324 * MiB;
constexpr size_t WS_DT = 596 * MiB;
constexpr size_t WS_S = 606 * MiB;
constexpr size_t WS_ACT0 = 324 * MiB;
constexpr size_t WS_SCP = 324 * MiB;
constexpr size_t WS_HP8 = 124 * MiB;
constexpr size_t WS_YP = 190 * MiB;
constexpr size_t WS_WMGU = 322 * MiB, WS_WMDN = 378 * MiB;
constexpr size_t WS_ACT = 406 * MiB;
constexpr size_t WS_END = 640 * MiB;
constexpr float WGU_SCALE = 64.f, WDN_SCALE = 128.f;
static_assert(WS_S + (size_t)NUNIT * 8 * 8192 * 2 <= 878 * MiB && WS_HP8 + (size_t)MOE_ROWS * DM <= WS_YP && WS_YP + (size_t)MOE_ROWS * DM * 2 <= WS_WMGU && WS_WMGU + (size_t)8 * 2 * DFFE * DM <= WS_WMDN && WS_WMDN + (size_t)8 * DM * DFFE <= WS_ACT && WS_ACT + (size_t)MOE_ROWS * DFFE <= WS_END, "d_ws map");
constexpr size_t WS_NEED = 878 * MiB;
constexpr size_t RT_SELR = 0, RT_GATE = 256 * 1024, RT_POS = 512 * 1024, RT_CNT = 768 * 1024, RT_TEXP = 800 * 1024;
constexpr int CW_TMO = 0, CW_CODE = 1, CW_BAR = 4096;

constexpr int PXB = 528, PBB = 272, PMB = 272;
constexpr int XI_BYTES = 128 * PXB, BI_BYTES = 128 * PBB, MW_BYTES = 8 * 16 * PMB;
constexpr int SCAL_OFF = XI_BYTES + BI_BYTES + MW_BYTES;
constexpr int BPW_OFF = SCAL_OFF + 3 * 4096;
constexpr int MISC_OFF = BPW_OFF + 4096;
constexpr int LDS_BYTES = MISC_OFF + 512;
static_assert(LDS_BYTES <= 160 * 1024 && pg8::STAGE_BYTES <= MISC_OFF, "LDS map");

#define GAS __attribute__((address_space(1)))
#define LAS __attribute__((address_space(3)))
typedef unsigned short bf16;
typedef unsigned v4u __attribute__((ext_vector_type(4)));
typedef unsigned v2u __attribute__((ext_vector_type(2)));
typedef float f32x4 __attribute__((ext_vector_type(4)));
typedef short bf16x8 __attribute__((ext_vector_type(8)));
typedef short s16x4 __attribute__((ext_vector_type(4)));
typedef GAS unsigned gu32;
#define RLX_AGENT __ATOMIC_RELAXED, __HIP_MEMORY_SCOPE_AGENT
#define LDS_WAIT() asm volatile("s_waitcnt lgkmcnt(0)" ::: "memory")
#define VM_WAIT() asm volatile("s_waitcnt vmcnt(0)" ::: "memory")
typedef float f32x2n __attribute__((ext_vector_type(2)));
typedef __bf16 bf16x2n __attribute__((ext_vector_type(2)));
__device__ __forceinline__ unsigned pk2(float lo, float hi) { const f32x2n v = {lo, hi}; return __builtin_bit_cast(unsigned, __builtin_convertvector(v, bf16x2n)); }
__device__ __forceinline__ float bflo(unsigned u) { return __uint_as_float(u << 16); }
__device__ __forceinline__ float bfhi(unsigned u) { return __uint_as_float(u & 0xffff0000u); }
__device__ __forceinline__ float bf1(bf16 b) { return __uint_as_float(((unsigned)b) << 16); }
__device__ __forceinline__ f32x4 unpack4(v2u u) { return (f32x4){bflo(u.x), bfhi(u.x), bflo(u.y), bfhi(u.y)}; }
__device__ __forceinline__ v2u pack4(f32x4 v) { v2u r; r.x = pk2(v[0], v[1]); r.y = pk2(v[2], v[3]); return r; }
__device__ __forceinline__ unsigned pk4_fp8(float a, float b, float c, float d) {
    a = fminf(fmaxf(a, -448.f), 448.f); b = fminf(fmaxf(b, -448.f), 448.f); c = fminf(fmaxf(c, -448.f), 448.f); d = fminf(fmaxf(d, -448.f), 448.f);
    int v = __builtin_amdgcn_cvt_pk_fp8_f32(a, b, 0, false); v = __builtin_amdgcn_cvt_pk_fp8_f32(c, d, v, true); return (unsigned)v; }
__device__ __forceinline__ float silu_f(float v) { return v * __builtin_amdgcn_rcpf(1.0f + __builtin_amdgcn_exp2f(-1.44269504f * v)); }
__device__ __forceinline__ float wave_sum(float v) {
#pragma unroll
    for (int o = 1; o < 64; o <<= 1) v += __shfl_xor(v, o);
    return v;
}
__device__ __forceinline__ unsigned lds_addr(LAS unsigned char* p) { return (unsigned)(size_t)p; }
__device__ __forceinline__ bf16x8 tr_pair(const LAS unsigned char* p0, const LAS unsigned char* p1) {
    const s16x4 x = __builtin_amdgcn_ds_read_tr16_b64_v4i16((LAS s16x4*)p0), y = __builtin_amdgcn_ds_read_tr16_b64_v4i16((LAS s16x4*)p1);
    return (bf16x8){x[0], x[1], x[2], x[3], y[0], y[1], y[2], y[3]};
}
#define MFMA16(a, b, c) __builtin_amdgcn_mfma_f32_16x16x32_bf16((a), (b), (c), 0, 0, 0)

namespace pg8 {
struct EpiInProj {
    static constexpr bool PERM = true, AFTER_DRAIN = false;
    bf16_t* Z; bf16_t* XBC; float* DT;
    __device__ __forceinline__ void operator()(const f32x4 (&acc)[2][2][4][2], const Unit& u, int wr, int wc, int fr, int fq) const {
        const int row0 = u.pm * BM + wr * 64 + fr;
        if (u.pn < 24) {
            bf16_t* base; int ldc, colt;
            if (u.pn < 8) { base = Z; ldc = 2048; colt = u.pn * BM; } else { base = XBC; ldc = 4096; colt = (u.pn - 8) * BM; }
            const int col0 = colt + wc * 32 + 8 * fq;
#pragma unroll
            for (int ai = 0; ai < 2; ++ai)
#pragma unroll
                for (int m = 0; m < 4; ++m) { bf16_t* rowp = base + (size_t)(row0 + ai * HALF + m * 16) * ldc + col0;
#pragma unroll
                    for (int bj = 0; bj < 2; ++bj) { const f32x4 v0 = acc[ai][bj][m][0], v1 = acc[ai][bj][m][1];
                        u32x4 w; w.x = cvt_pk_bf16(v0[0], v0[1]); w.y = cvt_pk_bf16(v0[2], v0[3]); w.z = cvt_pk_bf16(v1[0], v1[1]); w.w = cvt_pk_bf16(v1[2], v1[3]);
                        *(u32x4*)(rowp + bj * HALF) = w; } }
        } else if (wc < 2) {
            const int col0 = wc * 32 + 8 * fq;
#pragma unroll
            for (int ai = 0; ai < 2; ++ai)
#pragma unroll
                for (int m = 0; m < 4; ++m) { float* rowp = DT + (size_t)(row0 + ai * HALF + m * 16) * 64 + col0;
                    *(f32x4*)(rowp) = acc[ai][0][m][0]; *(f32x4*)(rowp + 4) = acc[ai][0][m][1]; }
        }
    }
};
struct EpiSwiGLU {
    static constexpr bool PERM = true, AFTER_DRAIN = false;
    bf16_t* O; int ldc;
    __device__ __forceinline__ void operator()(const f32x4 (&acc)[2][2][4][2], const Unit& u, int wr, int wc, int fr, int fq) const {
        const int row0 = u.pm * BM + wr * 64 + fr, col0 = u.pn * HALF + wc * 32 + 8 * fq;
#pragma unroll
        for (int ai = 0; ai < 2; ++ai)
#pragma unroll
            for (int m = 0; m < 4; ++m) { bf16_t* rowp = O + (size_t)(row0 + ai * HALF + m * 16) * ldc + col0;
                float o[8];
#pragma unroll
                for (int n = 0; n < 2; ++n)
#pragma unroll
                    for (int j = 0; j < 4; ++j) { const float gt = acc[ai][0][m][n][j], up = acc[ai][1][m][n][j]; o[4 * n + j] = gt * __builtin_amdgcn_rcpf(1.0f + __expf(-gt)) * up; }
                u32x4 w; w.x = cvt_pk_bf16(o[0], o[1]); w.y = cvt_pk_bf16(o[2], o[3]); w.z = cvt_pk_bf16(o[4], o[5]); w.w = cvt_pk_bf16(o[6], o[7]);
                *(u32x4*)(rowp) = w; }
    }
};
struct EpiSwiGLU8 {
    static constexpr bool PERM = true, AFTER_DRAIN = false;
    unsigned char* O; int ldc; float sc;
    __device__ __forceinline__ void operator()(const f32x4 (&acc)[2][2][4][2], const Unit& u, int wr, int wc, int fr, int fq) const {
        const int row0 = u.pm * BM + wr * 64 + fr, col0 = u.pn * HALF + wc * 32 + 8 * fq;
#pragma unroll
        for (int ai = 0; ai < 2; ++ai)
#pragma unroll
            for (int m = 0; m < 4; ++m) { unsigned char* rowp = O + (size_t)(row0 + ai * HALF + m * 16) * ldc + col0;
                float o[8];
#pragma unroll
                for (int n = 0; n < 2; ++n)
#pragma unroll
                    for (int j = 0; j < 4; ++j) { const float gt = acc[ai][0][m][n][j] * sc, up = acc[ai][1][m][n][j] * sc; o[4 * n + j] = gt * __builtin_amdgcn_rcpf(1.0f + __builtin_amdgcn_exp2f(-1.44269504f * gt)) * up; }
                typedef unsigned u32x2e __attribute__((ext_vector_type(2)));
                u32x2e w; w.x = pk4_fp8(o[0], o[1], o[2], o[3]); w.y = pk4_fp8(o[4], o[5], o[6], o[7]);
                *(u32x2e*)(rowp) = w; }
    }
};
struct EpiBf16S {
    static constexpr bool PERM = true, AFTER_DRAIN = false;
    bf16_t* O; int ldc; float sc;
    __device__ __forceinline__ void operator()(const f32x4 (&acc)[2][2][4][2], const Unit& u, int wr, int wc, int fr, int fq) const {
        const int row0 = u.pm * BM + wr * 64 + fr, col0 = u.pn * BM + wc * 32 + 8 * fq;
#pragma unroll
        for (int ai = 0; ai < 2; ++ai)
#pragma unroll
            for (int m = 0; m < 4; ++m) { bf16_t* rowp = O + (size_t)(row0 + ai * HALF + m * 16) * ldc + col0;
#pragma unroll
                for (int bj = 0; bj < 2; ++bj) { const f32x4 v0 = acc[ai][bj][m][0] * sc, v1 = acc[ai][bj][m][1] * sc;
                    u32x4 w; w.x = cvt_pk_bf16(v0[0], v0[1]); w.y = cvt_pk_bf16(v0[2], v0[3]); w.z = cvt_pk_bf16(v1[0], v1[1]); w.w = cvt_pk_bf16(v1[2], v1[3]);
                    *(u32x4*)(rowp + bj * HALF) = w; } }
    }
};
struct GroupedOrder : StaticOrder {
    const int* texp; size_t estride;
    __device__ __forceinline__ size_t boff(const Unit& u) const { return (size_t)texp[u.pm] * estride; }
};
}

struct Frame {
    LAS unsigned char* lds;
    volatile LAS unsigned* MISC;
    gu32* ctl;
    int tid, lane, wave, G;
    const float* in[24]; float* out; unsigned char* ws;
};
enum { I_X = 0, I_C, I_CTX, I_CCTX, I_ADAW, I_ADAB, I_NPRE, I_NPOST, I_SWIN, I_SCONVW, I_SCONVB, I_SALOG, I_SDTB, I_SD, I_SNORM, I_SWOUT, I_SCWIN, I_SCCONV, I_SCWOUT, I_FGU, I_FDN, I_ROUTER, I_MGU, I_MDN };

__device__ __forceinline__ void cvt_item(const float* W, int K, int N, bf16* WT, LAS float* scr, int item, int lane, int mode, int dffx) {
    const int nblk = N / 32, kb = item / nblk, nb = item % nblk, k0 = 64 * kb, n0 = 32 * nb;
#pragma unroll 8
    for (int i = 0; i < 32; ++i) { const int kk = 2 * i + (lane >> 5); scr[kk * 33 + (lane & 31)] = W[(size_t)(k0 + kk) * N + n0 + (lane & 31)]; }
    LDS_WAIT(); asm volatile("" ::: "memory");
    const int c = lane & 7;
#pragma unroll
    for (int j = 0; j < 4; ++j) { const int n = (lane >> 3) + 8 * j; const LAS float* s = scr + (8 * c) * 33 + n;
        v4u o; o.x = pk2(s[0 * 33], s[1 * 33]); o.y = pk2(s[2 * 33], s[3 * 33]); o.z = pk2(s[4 * 33], s[5 * 33]); o.w = pk2(s[6 * 33], s[7 * 33]);
        int nd = n0 + n; if (mode) { const int half = nd >= dffx ? 1 : 0, i2 = nd - half * dffx; nd = 256 * (i2 >> 7) + 128 * half + (i2 & 127); }
        *(v4u*)(WT + (size_t)nd * K + k0 + 8 * c) = o; }
    LDS_WAIT(); asm volatile("" ::: "memory");
}
__device__ __forceinline__ void cvt_item8(const float* W, int K, int N, unsigned char* WT, LAS float* scr, int item, int lane, int mode, int dffx, float sc) {
    const int nblk = N / 32, kb = item / nblk, nb = item % nblk, k0 = 64 * kb, n0 = 32 * nb;
#pragma unroll 8
    for (int i = 0; i < 32; ++i) { const int kk = 2 * i + (lane >> 5); scr[kk * 33 + (lane & 31)] = W[(size_t)(k0 + kk) * N + n0 + (lane & 31)]; }
    LDS_WAIT(); asm volatile("" ::: "memory");
    const int c = lane & 7;
#pragma unroll
    for (int j = 0; j < 4; ++j) { const int n = (lane >> 3) + 8 * j; const LAS float* s = scr + (8 * c) * 33 + n;
        v2u o; o.x = pk4_fp8(s[0 * 33] * sc, s[1 * 33] * sc, s[2 * 33] * sc, s[3 * 33] * sc); o.y = pk4_fp8(s[4 * 33] * sc, s[5 * 33] * sc, s[6 * 33] * sc, s[7 * 33] * sc);
        int nd = n0 + n; if (mode) { const int half = nd >= dffx ? 1 : 0, i2 = nd - half * dffx; nd = 256 * (i2 >> 7) + 128 * half + (i2 & 127); }
        *(v2u*)(WT + (size_t)nd * K + k0 + 8 * c) = o; }
    LDS_WAIT(); asm volatile("" ::: "memory");
}
__device__ __forceinline__ void load_row_f32(const float* p, int lane, f32x4 (&v)[4]) {
#pragma unroll
    for (int j = 0; j < 4; ++j) v[j] = *(const f32x4*)(p + 4 * lane + 256 * j);
}
__device__ __forceinline__ void load_row_bf16(const bf16* p, int lane, f32x4 (&v)[4]) {
#pragma unroll
    for (int j = 0; j < 4; ++j) v[j] = unpack4(*(const v2u*)(p + 4 * lane + 256 * j));
}
__device__ __forceinline__ float row_ss(const f32x4 (&v)[4]) {
    float s = 0.f;
#pragma unroll
    for (int j = 0; j < 4; ++j) s += (v[j][0] * v[j][0] + v[j][1] * v[j][1]) + (v[j][2] * v[j][2] + v[j][3] * v[j][3]);
    return wave_sum(s);
}
__device__ __forceinline__ void prenorm_mod(f32x4 (&v)[4], const float* npre, const float* sc, const float* sh, int lane) {
    const float rr = rsqrtf(row_ss(v) * (1.0f / DM) + EPS);
#pragma unroll
    for (int j = 0; j < 4; ++j) { const int col = 4 * lane + 256 * j; const f32x4 w4 = *(const f32x4*)(npre + col), s4 = *(const f32x4*)(sc + col), h4 = *(const f32x4*)(sh + col);
        v[j] = (v[j] * rr * w4) * (s4 + 1.0f) + h4; }
}
__device__ __forceinline__ void store_row_bf16(bf16* p, int lane, const f32x4 (&v)[4]) {
#pragma unroll
    for (int j = 0; j < 4; ++j) *(v2u*)(p + 4 * lane + 256 * j) = pack4(v[j]);
}
__device__ __forceinline__ const float* mod_vec(Frame& F, int layer, int row, int chunk) { return (const float*)(F.ws + WS_MOD) + ((size_t)(layer * 9 + row) * 6144 + chunk * 1024); }

__device__ __forceinline__ void p0_prologue(Frame& F) {
    LAS float* scr = (LAS float*)(F.lds + F.wave * 8448);
    LAS float* SIL = (LAS float*)(F.lds + 69632);
    LAS float* RED = (LAS float*)(F.lds + 69632 + 36864);
    if ((int)blockIdx.x < 192) {
        for (int idx = F.tid; idx < 9 * 1024; idx += NWAVES * 64) { const int r = idx >> 10, k = idx & 1023; const float cv = r < 8 ? F.in[I_C][r * 1024 + k] : F.in[I_CCTX][k]; SIL[idx] = silu_f(cv); }
        __syncthreads();
        for (int t = blockIdx.x; t < 192; t += F.G) {
            const int i = t / 96, col0 = 64 * (t % 96);
            const float* wp = F.in[I_ADAW] + ((size_t)i * 1024 + F.wave * 128) * 6144 + col0 + F.lane;
            float acc[9];
#pragma unroll
            for (int r = 0; r < 9; ++r) acc[r] = 0.f;
            for (int k8 = 0; k8 < 128; k8 += 8) {
                float wv[8];
#pragma unroll
                for (int q = 0; q < 8; ++q) wv[q] = wp[(size_t)(k8 + q) * 6144];
#pragma unroll
                for (int q = 0; q < 8; ++q)
#pragma unroll
                    for (int r = 0; r < 9; ++r) acc[r] += SIL[r * 1024 + F.wave * 128 + k8 + q] * wv[q];
            }
#pragma unroll
            for (int r = 0; r < 9; ++r) RED[(F.wave * 9 + r) * 64 + F.lane] = acc[r];
            __syncthreads();
            for (int idx = F.tid; idx < 576; idx += NWAVES * 64) { const int r = idx >> 6, ln = idx & 63; float s = 0.f;
#pragma unroll
                for (int w = 0; w < 8; ++w) s += RED[(w * 9 + r) * 64 + ln];
                ((float*)(F.ws + WS_MOD))[(size_t)(i * 9 + r) * 6144 + col0 + ln] = s + F.in[I_ADAB][i * 6144 + col0 + ln]; }
            __syncthreads();
        }
    }
    const int gw = blockIdx.x * NWAVES + F.wave, NGW = F.G * NWAVES;
    constexpr int I0 = 16 * 194, I1 = 32 * 32, I2 = 16 * 176, I3 = 44 * 32, I4 = 16 * 96, I5 = 16 * 32;
    for (int it = gw; it < I0 + I1 + I2 + I3 + I4 + I5; it += NGW) {
        int r = it;
        if (r < I0) { cvt_item(F.in[I_SWIN], 1024, DINP, (bf16*)(F.ws + WS_WIN), scr, r, F.lane, 0, 0); continue; } r -= I0;
        if (r < I1) { cvt_item(F.in[I_SWOUT], 2048, 1024, (bf16*)(F.ws + WS_WOUT), scr, r, F.lane, 0, 0); continue; } r -= I1;
        if (r < I2) { cvt_item(F.in[I_FGU], 1024, 2 * DFF, (bf16*)(F.ws + WS_WGU), scr, r, F.lane, 1, DFF); continue; } r -= I2;
        if (r < I3) { cvt_item(F.in[I_FDN], DFF, 1024, (bf16*)(F.ws + WS_WDN), scr, r, F.lane, 0, 0); continue; } r -= I3;
        if (r < I4) { cvt_item(F.in[I_SCWIN], 1024, 3072, (bf16*)(F.ws + WS_WSCI), scr, r, F.lane, 0, 0); continue; } r -= I4;
        cvt_item(F.in[I_SCWOUT], 1024, 1024, (bf16*)(F.ws + WS_WSCO), scr, r, F.lane, 0, 0);
    }
    { v4u* zp = (v4u*)((bf16*)(F.ws + WS_WIN) + (size_t)DINP * 1024); const int n16 = (DINP_PAD - DINP) * 1024 / 8;
      for (int i = blockIdx.x * (NWAVES * 64) + F.tid; i < n16; i += F.G * NWAVES * 64) zp[i] = (v4u){0u, 0u, 0u, 0u}; }
}
__device__ __forceinline__ void p1_prenorm(Frame& F) {
    const int gw = blockIdx.x * NWAVES + F.wave, NGW = F.G * NWAVES;
    bf16* H = (bf16*)(F.ws + WS_H);
    for (int r = gw; r < MALL; r += NGW) {
        const float* src = r < MLAT ? F.in[I_X] + (size_t)r * DM : F.in[I_CTX] + (size_t)(r - MLAT) * DM; const int mr = r < MLAT ? (r >> 12) : 8;
        f32x4 v[4]; load_row_f32(src, F.lane, v);
        prenorm_mod(v, F.in[I_NPRE], mod_vec(F, 0, mr, 1), mod_vec(F, 0, mr, 0), F.lane);
        store_row_bf16(H + (size_t)r * DM, F.lane, v);
    }
}
template <bool NEXT>
__device__ __forceinline__ void resnorm_phase(Frame& F, const float* xin, int layer, int gchunk, const float* npost, const float* npre, int nlayer, int scchunk, int shchunk) {
    const int gw = blockIdx.x * NWAVES + F.wave, NGW = F.G * NWAVES;
    const bf16* Y = (const bf16*)(F.ws + WS_Y); bf16* H = (bf16*)(F.ws + WS_H);
    for (int r = gw; r < MLAT; r += NGW) {
        const int b = r >> 12;
        f32x4 y[4], x[4]; load_row_bf16(Y + (size_t)r * DM, F.lane, y); load_row_f32(xin + (size_t)r * DM, F.lane, x);
        const float rr = rsqrtf(row_ss(y) * (1.0f / DM) + EPS); const float* gt = mod_vec(F, layer, b, gchunk);
#pragma unroll
        for (int j = 0; j < 4; ++j) { const int col = 4 * F.lane + 256 * j; x[j] = x[j] + *(const f32x4*)(gt + col) * ((y[j] * rr) * *(const f32x4*)(npost + col)); *(f32x4*)(F.out + (size_t)r * DM + col) = x[j]; }
        if (NEXT) { prenorm_mod(x, npre, mod_vec(F, nlayer, b, scchunk), mod_vec(F, nlayer, b, shchunk), F.lane); store_row_bf16(H + (size_t)r * DM, F.lane, x); }
    }
}

__device__ __forceinline__ int ssd_sidx(int b, int cs, int g) { return (b * 34 + cs) * 8 + g; }
__device__ __forceinline__ void dt_scan(const float* DTR, int r0, int dcol, float bias, float A, int lane, float (&dt)[2], float (&dA)[2], float (&inc)[2], float& total) {
#pragma unroll
    for (int h = 0; h < 2; ++h) { const float x = DTR[(size_t)(r0 + lane + 64 * h) * 64 + dcol] + bias; dt[h] = x > 20.f ? x : log1pf(__expf(x)); dA[h] = dt[h] * A; }
    float s0 = dA[0], s1 = dA[1];
#pragma unroll
    for (int o = 1; o < 64; o <<= 1) { const float t0 = __shfl_up(s0, o), t1 = __shfl_up(s1, o); if (lane >= o) { s0 += t0; s1 += t1; } }
    const float tot0 = __shfl(s0, 63); s1 += tot0; inc[0] = s0; inc[1] = s1; total = __shfl(s1, 63);
}
__device__ __forceinline__ void ssd_phase_a(Frame& F, const bool dry) {
    LAS unsigned char* XI = F.lds; LAS unsigned char* BI = F.lds + XI_BYTES; LAS float* WS = (LAS float*)(F.lds + SCAL_OFF);
    const int lane = F.lane, w = F.wave, gq = lane >> 4, q4 = (lane & 15) >> 2, p4 = lane & 3, l15 = lane & 15;
    const LAS unsigned char* trX = XI + (8 * gq + q4) * PXB + 8 * p4; const LAS unsigned char* trB = BI + (8 * gq + q4) * PBB + 8 * p4;
    bf16* XBC = (bf16*)(F.ws + WS_XBC); const float* DTR = (const float*)(F.ws + WS_DT); bf16* S = (bf16*)(F.ws + WS_S); float* CD = (float*)(F.ws + WS_CD);
    for (int u = blockIdx.x; u < NUNIT; u += F.G) {
        int b, cs, g; bool isctx;
        if (u < NUNIT_LAT) { b = u >> 8; cs = (u >> 3) & 31; g = u & 7; isctx = false; } else { const int v = u - NUNIT_LAT; b = v >> 4; cs = 32 + ((v >> 3) & 1); g = v & 7; isctx = true; }
        const int r0 = isctx ? MLAT + b * CTXL + (cs - 32) * 128 : b * SEQ + cs * 128, sidx = ssd_sidx(b, cs, g);
        const int col = lane < 32 ? g * 256 + 8 * lane : (lane < 48 ? 2048 + g * 128 + 8 * (lane - 32) : 3072 + g * 128 + 8 * (lane - 48));
        const int l0 = 16 * w; int lo, hi; if (isctx) { lo = -(cs - 32) * 128; hi = lo + 255; } else { lo = l0 & ~63; hi = lo + 63; }
        v4u raw[20];
#pragma unroll
        for (int i = 0; i < 20; ++i) { const int lp = l0 - 2 + i; raw[i] = (lp >= lo && lp <= hi) ? *(const v4u*)(XBC + (long)(r0 + lp) * CONVD + col) : (v4u){0u, 0u, 0u, 0u}; }
        f32x2n wt[5][4], bs[4];
#pragma unroll
        for (int t = 0; t < 5; ++t) { const f32x4 a = *(const f32x4*)(F.in[I_SCONVW] + t * CONVD + col), c4 = *(const f32x4*)(F.in[I_SCONVW] + t * CONVD + col + 4);
            wt[t][0] = (f32x2n){a[0], a[1]}; wt[t][1] = (f32x2n){a[2], a[3]}; wt[t][2] = (f32x2n){c4[0], c4[1]}; wt[t][3] = (f32x2n){c4[2], c4[3]}; }
        { const f32x4 a = *(const f32x4*)(F.in[I_SCONVB] + col), c4 = *(const f32x4*)(F.in[I_SCONVB] + col + 4);
          bs[0] = (f32x2n){a[0], a[1]}; bs[1] = (f32x2n){a[2], a[3]}; bs[2] = (f32x2n){c4[0], c4[1]}; bs[3] = (f32x2n){c4[2], c4[3]}; }
        VM_WAIT(); __syncthreads();
        f32x2n f[5][4];
#define UNPK_ROW(dst, rw) do { dst[0] = (f32x2n){bflo(rw.x), bfhi(rw.x)}; dst[1] = (f32x2n){bflo(rw.y), bfhi(rw.y)}; dst[2] = (f32x2n){bflo(rw.z), bfhi(rw.z)}; dst[3] = (f32x2n){bflo(rw.w), bfhi(rw.w)}; } while (0)
#pragma unroll
        for (int i = 0; i < 4; ++i) UNPK_ROW(f[i], raw[i]);
#pragma unroll
        for (int i = 0; i < 16; ++i) {
            UNPK_ROW(f[(i + 4) % 5], raw[i + 4]);
            unsigned ow[4];
#pragma unroll
            for (int e = 0; e < 4; ++e) { f32x2n a = bs[e];
#pragma unroll
                for (int t = 0; t < 5; ++t) a = wt[t][e] * f[(i + t) % 5][e] + a;
                ow[e] = pk2(silu_f(a.x), silu_f(a.y)); }
            const v4u ov = {ow[0], ow[1], ow[2], ow[3]};
            const int l = l0 + i;
            if (lane < 32) *(LAS v4u*)(XI + l * PXB + 16 * lane) = ov; else if (lane < 48) *(LAS v4u*)(BI + l * PBB + 16 * (lane - 32)) = ov;
            if (!isctx && !dry) *(v4u*)(XBC + (size_t)(r0 + l) * CONVD + col) = ov;
        }
#undef UNPK_ROW
        { const int d = w >> 2, hh = g * 4 + (w & 3); float dt[2], dA[2], inc[2], total;
          dt_scan(DTR, r0, d * 32 + hh, F.in[I_SDTB][d * 32 + hh], -__expf(F.in[I_SALOG][d * 32 + hh]), lane, dt, dA, inc, total);
#pragma unroll
          for (int h = 0; h < 2; ++h) WS[w * 128 + lane + 64 * h] = dt[h] * (d == 0 ? __expf(total - inc[h]) : __expf(inc[h] - dA[h]));
          if (lane == 0) CD[sidx * 8 + w] = __expf(total); }
        __syncthreads();
        bf16x8 bt[4];
#pragma unroll
        for (int ks = 0; ks < 4; ++ks) bt[ks] = tr_pair(trB + (32 * ks) * PBB + 32 * w, trB + (32 * ks + 4) * PBB + 32 * w);
#pragma unroll 1
        for (int j = 0; j < 4; ++j) {
            bf16x8 as_[2][4];
#pragma unroll
            for (int d = 0; d < 2; ++d) {
                const int combo = d * 4 + j;
#pragma unroll
                for (int ks = 0; ks < 4; ++ks) { const f32x4 w0 = *(const LAS f32x4*)(WS + combo * 128 + 32 * ks + 8 * gq), w1 = *(const LAS f32x4*)(WS + combo * 128 + 32 * ks + 8 * gq + 4);
                    const bf16x8 r8 = bt[ks]; bf16x8 o8;
                    const unsigned u0 = pk2(bf1((bf16)r8[0]) * w0[0], bf1((bf16)r8[1]) * w0[1]), u1 = pk2(bf1((bf16)r8[2]) * w0[2], bf1((bf16)r8[3]) * w0[3]);
                    const unsigned u2 = pk2(bf1((bf16)r8[4]) * w1[0], bf1((bf16)r8[5]) * w1[1]), u3 = pk2(bf1((bf16)r8[6]) * w1[2], bf1((bf16)r8[7]) * w1[3]);
                    o8[0] = (short)(u0 & 0xffff); o8[1] = (short)(u0 >> 16); o8[2] = (short)(u1 & 0xffff); o8[3] = (short)(u1 >> 16); o8[4] = (short)(u2 & 0xffff); o8[5] = (short)(u2 >> 16); o8[6] = (short)(u3 & 0xffff); o8[7] = (short)(u3 >> 16);
                    as_[d][ks] = o8; }
            }
#pragma unroll
            for (int pt = 0; pt < 4; ++pt) {
                bf16x8 xf[4];
#pragma unroll
                for (int ks = 0; ks < 4; ++ks) xf[ks] = tr_pair(trX + (32 * ks) * PXB + (j * 64 + pt * 16) * 2, trX + (32 * ks + 4) * PXB + (j * 64 + pt * 16) * 2);
#pragma unroll
                for (int d = 0; d < 2; ++d) { const int combo = d * 4 + j; f32x4 acc = {0.f, 0.f, 0.f, 0.f};
#pragma unroll
                    for (int ks = 0; ks < 4; ++ks) acc = MFMA16(as_[d][ks], xf[ks], acc);
                    *(v2u*)(S + ((size_t)(sidx * 8 + combo) * 64 + pt * 16 + l15) * 128 + 16 * w + 4 * gq) = pack4(acc); }
            }
        }
        __syncthreads();
    }
}
__device__ __forceinline__ void ssd_phase_b(Frame& F) {
    bf16* S = (bf16*)(F.ws + WS_S); const float* CD = (const float*)(F.ws + WS_CD);
    const int NT = F.G * NWAVES * 64;
    for (int q = blockIdx.x * (NWAVES * 64) + F.tid; q < 512 * 1024; q += NT) {
        const int e8 = q & 1023, seq = q >> 10, combo = seq & 7, g = (seq >> 3) & 7, b = seq >> 6, d = combo >> 2;
        float h[8];
#pragma unroll
        for (int e = 0; e < 8; ++e) h[e] = 0.f;
#pragma unroll
        for (int k = 0; k < 2; ++k) { const int cs = d == 0 ? 32 + k : 33 - k, si = ssd_sidx(b, cs, g) * 8 + combo; const float dec = CD[si]; const v4u t = *(const v4u*)(S + (size_t)si * 8192 + e8 * 8);
            h[0] = dec * h[0] + bflo(t.x); h[1] = dec * h[1] + bfhi(t.x); h[2] = dec * h[2] + bflo(t.y); h[3] = dec * h[3] + bfhi(t.y); h[4] = dec * h[4] + bflo(t.z); h[5] = dec * h[5] + bfhi(t.z); h[6] = dec * h[6] + bflo(t.w); h[7] = dec * h[7] + bfhi(t.w); }
        for (int c0 = 0; c0 < 32; c0 += 8) {
            v4u t[8]; float dc[8];
#pragma unroll
            for (int k = 0; k < 8; ++k) { const int cs = d == 0 ? c0 + k : 31 - (c0 + k), si = ssd_sidx(b, cs, g) * 8 + combo; dc[k] = CD[si]; t[k] = *(const v4u*)(S + (size_t)si * 8192 + e8 * 8); }
#pragma unroll
            for (int k = 0; k < 8; ++k) { const int cs = d == 0 ? c0 + k : 31 - (c0 + k), si = ssd_sidx(b, cs, g) * 8 + combo;
                v4u o; o.x = pk2(h[0], h[1]); o.y = pk2(h[2], h[3]); o.z = pk2(h[4], h[5]); o.w = pk2(h[6], h[7]);
                *(v4u*)(S + (size_t)si * 8192 + e8 * 8) = o;
                const float dec = dc[k]; const v4u tt = t[k];
                h[0] = dec * h[0] + bflo(tt.x); h[1] = dec * h[1] + bfhi(tt.x); h[2] = dec * h[2] + bflo(tt.y); h[3] = dec * h[3] + bfhi(tt.y); h[4] = dec * h[4] + bflo(tt.z); h[5] = dec * h[5] + bfhi(tt.z); h[6] = dec * h[6] + bflo(tt.w); h[7] = dec * h[7] + bfhi(tt.w); }
        }
    }
}
__device__ __forceinline__ void ssd_phase_c(Frame& F, const bool dry) {
    LAS unsigned char* XI = F.lds; LAS unsigned char* BI = F.lds + XI_BYTES; LAS unsigned char* MWw = F.lds + XI_BYTES + BI_BYTES + F.wave * (16 * PMB);
    LAS float* DTS = (LAS float*)(F.lds + SCAL_OFF); LAS float* INC = DTS + 1024; LAS float* EXC = DTS + 2048; LAS float* BPw = (LAS float*)(F.lds + BPW_OFF) + F.wave * 128;
    const int tid = F.tid, lane = F.lane, w = F.wave, gq = lane >> 4, q4 = (lane & 15) >> 2, p4 = lane & 3, l15 = lane & 15, lme = 16 * w + l15;
    const LAS unsigned char* trX = XI + (8 * gq + q4) * PXB + 8 * p4;
    const bf16* XBC = (const bf16*)(F.ws + WS_XBC); const float* DTR = (const float*)(F.ws + WS_DT); const bf16* HIN = (const bf16*)(F.ws + WS_S); bf16* Z = (bf16*)(F.ws + WS_Z);
    for (int u = blockIdx.x; u < NUNIT_LAT; u += F.G) {
        const int b = u >> 8, c = (u >> 3) & 31, g = u & 7, r0 = b * SEQ + c * 128, sidx = ssd_sidx(b, c, g);
#pragma unroll
        for (int k = 0; k < 8; ++k) { const int id = tid + 512 * k, row = id >> 5, ch = id & 31; *(LAS v4u*)(XI + row * PXB + 16 * ch) = *(const v4u*)(XBC + (size_t)(r0 + row) * CONVD + g * 256 + 8 * ch); }
#pragma unroll
        for (int k = 0; k < 4; ++k) { const int id = tid + 512 * k, row = id >> 4, ch = id & 15; *(LAS v4u*)(BI + row * PBB + 16 * ch) = *(const v4u*)(XBC + (size_t)(r0 + row) * CONVD + 2048 + g * 128 + 8 * ch); }
        bf16x8 cf[4];
#pragma unroll
        for (int ks = 0; ks < 4; ++ks) cf[ks] = *(const bf16x8*)(XBC + (size_t)(r0 + lme) * CONVD + 3072 + g * 128 + 32 * ks + 8 * gq);
        v4u hp[2];
        const bf16* hbase = HIN + (size_t)sidx * 8 * 8192;
#pragma unroll
        for (int k = 0; k < 2; ++k) { const int id = tid + 512 * k; hp[k] = *(const v4u*)(hbase + (size_t)(id >> 4) * 128 + 8 * (id & 15)); }
        { const int d = w >> 2, hh = g * 4 + (w & 3); float dt[2], dA[2], inc[2], total;
          dt_scan(DTR, r0, d * 32 + hh, F.in[I_SDTB][d * 32 + hh], -__expf(F.in[I_SALOG][d * 32 + hh]), lane, dt, dA, inc, total);
#pragma unroll
          for (int h = 0; h < 2; ++h) { DTS[w * 128 + lane + 64 * h] = dt[h]; INC[w * 128 + lane + 64 * h] = inc[h]; EXC[w * 128 + lane + 64 * h] = inc[h] - dA[h]; } }
        __syncthreads();
        f32x4 Gt[8];
#pragma unroll
        for (int st = 0; st < 8; ++st) { f32x4 a = {0.f, 0.f, 0.f, 0.f};
#pragma unroll
            for (int ks = 0; ks < 4; ++ks) a = MFMA16(*(const LAS bf16x8*)(BI + (16 * st + l15) * PBB + (32 * ks + 8 * gq) * 2), cf[ks], a);
            Gt[st] = a; }
        __syncthreads();
        LAS unsigned char* HB0 = BI; LAS unsigned char* HB1 = BI + 64 * PBB;
#pragma unroll
        for (int k = 0; k < 2; ++k) { const int id = tid + 512 * k; *(LAS v4u*)(HB0 + (id >> 4) * PBB + 16 * (id & 15)) = hp[k]; }
#pragma unroll
        for (int k = 0; k < 2; ++k) { const int id = tid + 512 * k; hp[k] = *(const v4u*)(hbase + 4 * 8192 + (size_t)(id >> 4) * 128 + 8 * (id & 15)); }
        __syncthreads();
        float ssq = 0.f;
#pragma unroll 1
        for (int j = 0; j < 4; ++j) {
            f32x4 Y[4]; v2u zr[4];
#pragma unroll
            for (int pt = 0; pt < 4; ++pt) { Y[pt] = (f32x4){0.f, 0.f, 0.f, 0.f}; zr[pt] = *(const v2u*)(Z + (size_t)(r0 + lme) * DIN + g * 256 + j * 64 + pt * 16 + 4 * gq); }
#pragma unroll 1
            for (int d = 0; d < 2; ++d) {
                const int combo = d * 4 + j, ci = 2 * j + d;
                LAS unsigned char* HBc = (ci & 1) ? HB1 : HB0; LAS unsigned char* HBn = (ci & 1) ? HB0 : HB1;
                if (ci < 7) {
#pragma unroll
                    for (int k = 0; k < 2; ++k) { const int id = tid + 512 * k; *(LAS v4u*)(HBn + (id >> 4) * PBB + 16 * (id & 15)) = hp[k]; }
                    if (ci < 6) { const int cn = ci + 2, combn = (cn & 1) * 4 + (cn >> 1);
#pragma unroll
                        for (int k = 0; k < 2; ++k) { const int id = tid + 512 * k; hp[k] = *(const v4u*)(hbase + (size_t)combn * 8192 + (size_t)(id >> 4) * 128 + 8 * (id & 15)); } }
                }
                const LAS float* U = (d ? EXC : INC) + combo * 128; const LAS float* DTc = DTS + combo * 128;
                const float tot = INC[combo * 128 + 127], u_l = U[lme]; const int kd = w >> 1;
                const float u_ref = d ? (kd == 3 ? tot : U[32 * kd + 32]) : (kd == 0 ? 0.f : U[32 * kd - 1]);
                const float a_l = __expf(d ? (u_ref - u_l) : (u_l - u_ref)), e_ref = __expf(d ? (tot - u_ref) : u_ref);
#pragma unroll
                for (int h = 0; h < 2; ++h) { const int s = lane + 64 * h; const float ar = d ? (U[s] - u_ref) : (u_ref - U[s]); BPw[s] = __expf(fminf(ar, 0.f)) * DTc[s]; }
                f32x4 Yp[4];
#pragma unroll
                for (int pt = 0; pt < 4; ++pt) { f32x4 a = {0.f, 0.f, 0.f, 0.f};
#pragma unroll
                    for (int ks = 0; ks < 4; ++ks) a = MFMA16(*(const LAS bf16x8*)(HBc + (16 * pt + l15) * PBB + (32 * ks + 8 * gq) * 2), cf[ks], a);
                    Yp[pt] = a * e_ref; }
#pragma unroll
                for (int ks = 0; ks < 4; ++ks) {
                    const bool offd = d ? (ks > kd) : (ks < kd);
                    if (offd) {
#pragma unroll
                        for (int t2 = 0; t2 < 2; ++t2) { const int st = 2 * ks + t2, s0 = 16 * st + 4 * gq; const f32x4 bp = *(const LAS f32x4*)(BPw + s0);
                            *(LAS v2u*)(MWw + l15 * PMB + s0 * 2) = pack4(Gt[st] * bp); }
                        const bf16x8 mb = *(const LAS bf16x8*)(MWw + l15 * PMB + (32 * ks + 8 * gq) * 2);
#pragma unroll
                        for (int pt = 0; pt < 4; ++pt) { const bf16x8 xa = tr_pair(trX + (32 * ks) * PXB + (j * 64 + pt * 16) * 2, trX + (32 * ks + 4) * PXB + (j * 64 + pt * 16) * 2);
                            Yp[pt] = MFMA16(xa, mb, Yp[pt]); }
                    }
                }
#pragma unroll
                for (int pt = 0; pt < 4; ++pt) Y[pt] = Y[pt] + Yp[pt] * a_l;
#pragma unroll
                for (int ks = 0; ks < 4; ++ks) if (ks == kd) {
#pragma unroll
                    for (int t2 = 0; t2 < 2; ++t2) { const int st = 2 * ks + t2, s0 = 16 * st + 4 * gq; const f32x4 u_s = *(const LAS f32x4*)(U + s0), dt_s = *(const LAS f32x4*)(DTc + s0);
                        f32x4 val;
#pragma unroll
                        for (int e = 0; e < 4; ++e) { const int s = s0 + e; const bool valid = d ? (s >= lme) : (s <= lme); const float arg = d ? (u_s[e] - u_l) : (u_l - u_s[e]);
                            val[e] = valid ? Gt[st][e] * __expf(arg) * dt_s[e] : 0.f; }
                        *(LAS v2u*)(MWw + l15 * PMB + s0 * 2) = pack4(val); }
                    const bf16x8 mb = *(const LAS bf16x8*)(MWw + l15 * PMB + (32 * ks + 8 * gq) * 2);
#pragma unroll
                    for (int pt = 0; pt < 4; ++pt) { const bf16x8 xa = tr_pair(trX + (32 * ks) * PXB + (j * 64 + pt * 16) * 2, trX + (32 * ks + 4) * PXB + (j * 64 + pt * 16) * 2);
                        Y[pt] = MFMA16(xa, mb, Y[pt]); }
                }
                __syncthreads();
            }
            const float dsk = F.in[I_SD][g * 4 + j];
#pragma unroll
            for (int pt = 0; pt < 4; ++pt) { const int ch = j * 64 + pt * 16 + 4 * gq;
                const f32x4 xv = unpack4(*(const LAS v2u*)(XI + lme * PXB + ch * 2)), zv = unpack4(zr[pt]);
                f32x4 y = Y[pt] + xv * dsk;
#pragma unroll
                for (int e = 0; e < 4; ++e) { y[e] = y[e] * silu_f(zv[e]); ssq += y[e] * y[e]; }
                *(LAS v2u*)(XI + lme * PXB + ch * 2) = pack4(y); }
        }
        ssq += __shfl_xor(ssq, 16); ssq += __shfl_xor(ssq, 32);
        const float rr = rsqrtf(ssq * (1.0f / 256.0f) + EPS);
#pragma unroll
        for (int j = 0; j < 4; ++j)
#pragma unroll
            for (int pt = 0; pt < 4; ++pt) { const int cl = j * 64 + pt * 16 + 4 * gq, ch = g * 256 + cl; const f32x4 nw = *(const f32x4*)(F.in[I_SNORM] + ch);
                if (!dry) *(v2u*)(Z + (size_t)(r0 + lme) * DIN + ch) = pack4(unpack4(*(const LAS v2u*)(XI + lme * PXB + cl * 2)) * rr * nw); }
        __syncthreads();
    }
}

__device__ __forceinline__ void p12_shortconv(Frame& F) {
    const bf16* P = (const bf16*)(F.ws + WS_SCP); bf16* U = (bf16*)(F.ws + WS_H); const float* cw = F.in[I_SCCONV];
    const int NT = F.G * NWAVES * 64;
    for (int id = blockIdx.x * (NWAVES * 64) + F.tid; id < MLAT * 128; id += NT) {
        const int r = id >> 7, col = 8 * (id & 127), xpos = r & 63;
        float acc[8];
#pragma unroll
        for (int e = 0; e < 8; ++e) acc[e] = 0.f;
#pragma unroll
        for (int t = 0; t < 3; ++t) { const int xp = xpos + t - 1; if (xp >= 0 && xp < 64) {
            const v4u gc = *(const v4u*)(P + (size_t)(r + t - 1) * 3072 + 1024 + col), vv = *(const v4u*)(P + (size_t)(r + t - 1) * 3072 + 2048 + col);
            const f32x4 w0 = *(const f32x4*)(cw + t * 1024 + col), w1 = *(const f32x4*)(cw + t * 1024 + col + 4);
            acc[0] += w0[0] * (bflo(gc.x) * bflo(vv.x)); acc[1] += w0[1] * (bfhi(gc.x) * bfhi(vv.x)); acc[2] += w0[2] * (bflo(gc.y) * bflo(vv.y)); acc[3] += w0[3] * (bfhi(gc.y) * bfhi(vv.y));
            acc[4] += w1[0] * (bflo(gc.z) * bflo(vv.z)); acc[5] += w1[1] * (bfhi(gc.z) * bfhi(vv.z)); acc[6] += w1[2] * (bflo(gc.w) * bflo(vv.w)); acc[7] += w1[3] * (bfhi(gc.w) * bfhi(vv.w)); } }
        const v4u gb = *(const v4u*)(P + (size_t)r * 3072 + col);
        v4u o; o.x = pk2(bflo(gb.x) * acc[0], bfhi(gb.x) * acc[1]); o.y = pk2(bflo(gb.y) * acc[2], bfhi(gb.y) * acc[3]); o.z = pk2(bflo(gb.z) * acc[4], bfhi(gb.z) * acc[5]); o.w = pk2(bflo(gb.w) * acc[6], bfhi(gb.w) * acc[7]);
        *(v4u*)(U + (size_t)r * DM + col) = o;
    }
}

__device__ __forceinline__ void p14_resnorm_route(Frame& F) {
    LAS float* RW = (LAS float*)F.lds;
    LAS int* SEL = (LAS int*)(F.lds + 32768);
    const bf16* Y = (const bf16*)(F.ws + WS_Y); unsigned char* H8 = (unsigned char*)(F.ws + WS_H);
    int* SELR = (int*)(F.ws + WS_ROUTE + RT_SELR); float* GATE = (float*)(F.ws + WS_ROUTE + RT_GATE); int* CNT = (int*)(F.ws + WS_ROUTE + RT_CNT);
    for (int i = F.tid; i < 8192; i += NWAVES * 64) RW[i] = F.in[I_ROUTER][i];
    __syncthreads();
    const float* npost = F.in[I_NPOST] + 2 * 1024; const float* npre = F.in[I_NPRE] + 3 * 1024;
    for (int vb = blockIdx.x; vb < 256; vb += F.G) {
        for (int i = 0; i < 16; ++i) {
            const int tl = 16 * F.wave + i, r = 128 * vb + tl, b = r >> 12;
            f32x4 y[4], x[4]; load_row_bf16(Y + (size_t)r * DM, F.lane, y); load_row_f32(F.out + (size_t)r * DM, F.lane, x);
            const float rr = rsqrtf(row_ss(y) * (1.0f / DM) + EPS); const float* gt = mod_vec(F, 1, b, 2);
#pragma unroll
            for (int j = 0; j < 4; ++j) { const int col = 4 * F.lane + 256 * j; x[j] = x[j] + *(const f32x4*)(gt + col) * ((y[j] * rr) * *(const f32x4*)(npost + col)); *(f32x4*)(F.out + (size_t)r * DM + col) = x[j]; }
            prenorm_mod(x, npre, mod_vec(F, 1, b, 4), mod_vec(F, 1, b, 3), F.lane);
#pragma unroll
            for (int j = 0; j < 4; ++j) *(unsigned*)(H8 + (size_t)r * DM + 4 * F.lane + 256 * j) = pk4_fp8(x[j][0], x[j][1], x[j][2], x[j][3]);
            float lg[8];
#pragma unroll
            for (int e = 0; e < 8; ++e) lg[e] = 0.f;
#pragma unroll
            for (int j = 0; j < 4; ++j)
#pragma unroll
                for (int q = 0; q < 4; ++q) { const int col = 4 * F.lane + 256 * j + q; const f32x4 r0 = *(const LAS f32x4*)(RW + col * 8), r1 = *(const LAS f32x4*)(RW + col * 8 + 4); const float hv = x[j][q];
                    lg[0] += hv * r0[0]; lg[1] += hv * r0[1]; lg[2] += hv * r0[2]; lg[3] += hv * r0[3]; lg[4] += hv * r1[0]; lg[5] += hv * r1[1]; lg[6] += hv * r1[2]; lg[7] += hv * r1[3]; }
#pragma unroll
            for (int e = 0; e < 8; ++e) lg[e] = wave_sum(lg[e]);
            int e0 = 0; float v0 = lg[0];
#pragma unroll
            for (int e = 1; e < 8; ++e) if (lg[e] > v0) { v0 = lg[e]; e0 = e; }
            int e1 = -1; float v1 = 0.f;
#pragma unroll
            for (int e = 0; e < 8; ++e) if (e != e0 && (e1 < 0 || lg[e] > v1)) { v1 = lg[e]; e1 = e; }
            if (F.lane == 0) { const float g0 = 1.0f / (1.0f + __expf(v1 - v0)); GATE[2 * r] = g0; GATE[2 * r + 1] = 1.0f - g0; SEL[2 * tl] = e0; SEL[2 * tl + 1] = e1; }
        }
        __syncthreads();
        if (F.tid < 8) { int cnt = 0;
            for (int t = 0; t < 256; ++t) if (SEL[t] == F.tid) { SELR[256 * vb + t] = F.tid | (cnt << 8); ++cnt; }
            CNT[vb * 8 + F.tid] = cnt; }
        __syncthreads();
    }
}
__device__ __forceinline__ void p15_permute(Frame& F) {
    LAS int* CNTL = (LAS int*)(F.lds + 69632);
    LAS int* PRE = CNTL + 2048;
    LAS int* TOT = PRE + 2048;
    LAS int* SEG = TOT + 8;
    const int* CNT = (const int*)(F.ws + WS_ROUTE + RT_CNT); const int* SELR = (const int*)(F.ws + WS_ROUTE + RT_SELR);
    int* POS = (int*)(F.ws + WS_ROUTE + RT_POS); int* TEXP = (int*)(F.ws + WS_ROUTE + RT_TEXP);
    const unsigned char* H8 = (const unsigned char*)(F.ws + WS_H); unsigned char* HP = (unsigned char*)(F.ws + WS_HP8);
    for (int i = F.tid; i < 2048; i += NWAVES * 64) CNTL[i] = CNT[i];
    __syncthreads();
    if (F.tid < 8) { int run = 0; for (int v = 0; v < 256; ++v) { PRE[v * 8 + F.tid] = run; run += CNTL[v * 8 + F.tid]; } TOT[F.tid] = run; }
    __syncthreads();
    if (F.tid == 0) { int ss = 0; for (int e = 0; e < 8; ++e) { SEG[e] = ss; ss += (TOT[e] + 255) & ~255; } SEG[8] = ss;
        if (blockIdx.x == 0) { for (int e = 0; e < 8; ++e) for (int t = SEG[e] >> 8; t < (SEG[e + 1] >> 8); ++t) TEXP[t] = e; TEXP[300] = ss >> 8; } }
    __syncthreads();
    for (int vb = blockIdx.x; vb < 256; vb += F.G) {
        for (int i = 0; i < 16; ++i) { const int tl = 16 * F.wave + i, r = 128 * vb + tl;
            const v4u a = *(const v4u*)(H8 + (size_t)r * DM + 16 * F.lane);
#pragma unroll
            for (int k = 0; k < 2; ++k) { const int sr = SELR[2 * r + k], e = sr & 255, pos = SEG[e] + PRE[vb * 8 + e] + (sr >> 8);
                *(v4u*)(HP + (size_t)pos * DM + 16 * F.lane) = a;
                if (F.lane == 0) POS[2 * r + k] = pos; } }
    }
    if ((int)blockIdx.x < 8) { const int e = blockIdx.x;
        for (int row = SEG[e] + TOT[e] + F.wave; row < SEG[e + 1]; row += NWAVES) *(v4u*)(HP + (size_t)row * DM + 16 * F.lane) = (v4u){0u, 0u, 0u, 0u}; }
    LAS float* scr = (LAS float*)(F.lds + F.wave * 8448);
    const int gw = blockIdx.x * NWAVES + F.wave, NGW = F.G * NWAVES;
    constexpr int IG = 16 * 224, ID = 56 * 32;
    for (int it = gw; it < 8 * (IG + ID); it += NGW) {
        const int e = it / (IG + ID), r = it % (IG + ID);
        if (r < IG) cvt_item8(F.in[I_MGU] + (size_t)e * 1024 * 2 * DFFE, 1024, 2 * DFFE, (unsigned char*)(F.ws + WS_WMGU) + (size_t)e * 2 * DFFE * 1024, scr, r, F.lane, 1, DFFE, WGU_SCALE);
        else cvt_item8(F.in[I_MDN] + (size_t)e * DFFE * 1024, DFFE, 1024, (unsigned char*)(F.ws + WS_WMDN) + (size_t)e * 1024 * DFFE, scr, r - IG, F.lane, 0, 0, WDN_SCALE);
    }
}
__device__ __forceinline__ void p18_final(Frame& F) {
    const int gw = blockIdx.x * NWAVES + F.wave, NGW = F.G * NWAVES;
    const bf16* YP = (const bf16*)(F.ws + WS_YP); const int* POS = (const int*)(F.ws + WS_ROUTE + RT_POS); const float* GATE = (const float*)(F.ws + WS_ROUTE + RT_GATE);
    const float* npost = F.in[I_NPOST] + 3 * 1024;
    for (int r = gw; r < MLAT; r += NGW) {
        const int b = r >> 12, p0 = POS[2 * r], p1 = POS[2 * r + 1]; const float g0 = GATE[2 * r], g1 = GATE[2 * r + 1];
        f32x4 a[4], c[4], x[4]; load_row_bf16(YP + (size_t)p0 * DM, F.lane, a); load_row_bf16(YP + (size_t)p1 * DM, F.lane, c); load_row_f32(F.out + (size_t)r * DM, F.lane, x);
#pragma unroll
        for (int j = 0; j < 4; ++j) a[j] = a[j] * g0 + c[j] * g1;
        const float rr = rsqrtf(row_ss(a) * (1.0f / DM) + EPS); const float* gt = mod_vec(F, 1, b, 5);
#pragma unroll
        for (int j = 0; j < 4; ++j) { const int col = 4 * F.lane + 256 * j; *(f32x4*)(F.out + (size_t)r * DM + col) = x[j] + *(const f32x4*)(gt + col) * ((a[j] * rr) * *(const f32x4*)(npost + col)); }
    }
}

#define XB_TMO      128
#define XB_XCNT(j)  (256  + 64 * (j))
#define XB_XSUB(j)  (1280 + 64 * (j))
#define XB_XGEN(j)  (2304 + 64 * (j))
#define XB_TOP      3328
#define XB_TOPGEN   3392
#define XCD_BAR_WORDS 3456
#define XB_SPIN_CAP (1u << 18)

__device__ __forceinline__ unsigned xb_ld(unsigned* p)              { return __hip_atomic_load(p, __ATOMIC_RELAXED, __HIP_MEMORY_SCOPE_AGENT); }
__device__ __forceinline__ unsigned xb_add(unsigned* p, unsigned v) { return __hip_atomic_fetch_add(p, v, __ATOMIC_RELAXED, __HIP_MEMORY_SCOPE_AGENT); }
__device__ __forceinline__ unsigned xb_xcc_id() { return (unsigned)__builtin_amdgcn_s_getreg((3 << 11) | 20) & 0xFu; }
#define XB_SPIN(cond, bar) do { unsigned _sp = 0; while (cond) { __builtin_amdgcn_s_sleep(1); \
    if ((++_sp & 255u) == 0u) { if (xb_ld(&(bar)[XB_TMO])) break; if (_sp > XB_SPIN_CAP) { atomicAdd(&(bar)[XB_TMO], 1u); break; } } } } while (0)

struct XcdBarrier {
    unsigned* bar; unsigned x;
    volatile LAS unsigned* st;
};

__device__ __forceinline__ XcdBarrier xcd_barrier_post(unsigned* bar, volatile LAS unsigned* st) {
    XcdBarrier b; b.bar = bar; b.x = xb_xcc_id(); b.st = st;
    if (threadIdx.x == 0) (void)xb_add(&bar[XB_XCNT(b.x)], 1u);
    return b;
}
__device__ __forceinline__ void xcd_barrier_complete(unsigned* bar, unsigned x, unsigned& nloc, unsigned& nx) {
    const unsigned G = gridDim.x * gridDim.y * gridDim.z;
    unsigned sum, cnt, mine, sp = 0u;
    for (;;) {
        sum = 0u; cnt = 0u; mine = 0u;
#pragma unroll
        for (unsigned j = 0; j < 16; ++j) { const unsigned c = xb_ld(&bar[XB_XCNT(j)]); sum += c; cnt += (c > 0u) ? 1u : 0u; mine = (j == x) ? c : mine; }
        if (sum == G) break;
        __builtin_amdgcn_s_sleep(1);
        if ((++sp & 255u) == 0u) { if (xb_ld(&bar[XB_TMO])) break; if (sp > XB_SPIN_CAP) { atomicAdd(&bar[XB_TMO], 1u); break; } }
    }
    nloc = mine > 0u ? mine : 1u; nx = cnt > 0u ? cnt : 1u;
}

__device__ __forceinline__ void xcd_barrier(const XcdBarrier& b) {
    asm volatile("s_waitcnt vmcnt(0)" ::: "memory");
    __syncthreads();
    if (threadIdx.x == 0) {
        unsigned* bar = b.bar;
        __builtin_amdgcn_s_waitcnt(0);
        unsigned nloc = b.st[0], nx = b.st[1];
        if (nloc == 0u) { xcd_barrier_complete(bar, b.x, nloc, nx); b.st[0] = nloc; b.st[1] = nx; }
        const unsigned old = xb_add(&bar[XB_XSUB(b.x)], 1u);
        const unsigned gen = old / nloc;
        if (old + 1u == (gen + 1u) * nloc) {
            __builtin_amdgcn_fence(__ATOMIC_RELEASE, "agent");
            asm volatile("s_waitcnt vmcnt(0)" ::: "memory");
            const unsigned og = xb_add(&bar[XB_TOP], 1u);
            const unsigned tg = og / nx;
            if (og + 1u == (tg + 1u) * nx) xb_add(&bar[XB_TOPGEN], 1u);
            else XB_SPIN(xb_ld(&bar[XB_TOPGEN]) == tg, bar);
            __builtin_amdgcn_fence(__ATOMIC_ACQUIRE, "agent");
            xb_add(&bar[XB_XGEN(b.x)], 1u);
            asm volatile("s_waitcnt vmcnt(0)" ::: "memory");
        } else {
            XB_SPIN(xb_ld(&bar[XB_XGEN(b.x)]) == gen, bar);
            __builtin_amdgcn_fence(__ATOMIC_ACQUIRE, "agent");
            asm volatile("s_waitcnt vmcnt(0)" ::: "memory");
        }
    }
    __syncthreads();
}

#ifndef MK_DUMP
#define MK_DUMP 0
#endif
__device__ __forceinline__ void dump_phase(Frame& F) {
    const size_t NT = (size_t)F.G * NWAVES * 64, n = (size_t)MLAT * DM;
    for (size_t i = (size_t)blockIdx.x * (NWAVES * 64) + F.tid; i < n; i += NT) {
        float v = 0.f;
        if (MK_DUMP == 1) { v = bf1(((const bf16*)(F.ws + WS_H))[i]) + (i < (size_t)MCTX * DM ? bf1(((const bf16*)(F.ws + WS_H))[n + i]) : 0.f); }
        if (MK_DUMP == 2) { for (int k = 0; k < 4; ++k) v += bf1(((const bf16*)(F.ws + WS_XBC))[i + k * n]); for (int k = 0; k < 2; ++k) v += bf1(((const bf16*)(F.ws + WS_Z))[i + k * n]); if (i < (size_t)MALL * 64) v += ((const float*)(F.ws + WS_DT))[i]; }
        if (MK_DUMP == 3) { const size_t ns = (size_t)NUNIT * 8 * 8192; for (int k = 0; k < 5; ++k) if (i + k * n < ns) v += bf1(((const bf16*)(F.ws + WS_S))[i + k * n]); for (int k = 0; k < 4; ++k) v += bf1(((const bf16*)(F.ws + WS_XBC))[i + k * n]); if (i < (size_t)NUNIT * 8) v += ((const float*)(F.ws + WS_CD))[i]; }
        if (MK_DUMP == 4) { for (int k = 0; k < 2; ++k) v += bf1(((const bf16*)(F.ws + WS_Z))[i + k * n]); }
        if (MK_DUMP == 5) { v = bf1(((const bf16*)(F.ws + WS_Y))[i]); }
        F.out[i] = v;
    }
}

struct Args { const float* in[24]; float* out; unsigned char* ws; int ph_lo, ph_hi; };
__global__ void __launch_bounds__(NWAVES * 64, 2) fwd_kernel(Args args) {
    extern __shared__ __attribute__((aligned(16))) unsigned char lds[];
    Frame F;
    F.lds = (LAS unsigned char*)lds;
    F.MISC = (volatile LAS unsigned*)(F.lds + MISC_OFF);
    F.tid = threadIdx.x; F.lane = F.tid & 63; F.wave = __builtin_amdgcn_readfirstlane(F.tid >> 6);
    F.G = gridDim.x;
#pragma unroll
    for (int i = 0; i < 24; ++i) F.in[i] = args.in[i];
    F.out = args.out; F.ws = args.ws; F.ctl = (gu32*)(args.ws + WS_CTL);
    for (int u = F.tid; u < (LDS_BYTES - MISC_OFF) / 4; u += NWAVES * 64) ((LAS unsigned*)(F.lds + MISC_OFF))[u] = 0u;
    __syncthreads();
    XcdBarrier bar; bar.bar = (unsigned*)(F.ctl + CW_BAR); bar.x = 0; bar.st = nullptr;
    if (!MK_PER_PHASE) bar = xcd_barrier_post((unsigned*)(F.ctl + CW_BAR), F.MISC + 8);
    const int lo = args.ph_lo, hi = args.ph_hi & 0xff; const bool dry = (args.ph_hi & 0x100) != 0;
#ifndef MK_PHASE_MASK
#define MK_PHASE_MASK 0x7ffff
#endif
#define IN(k) (((MK_PHASE_MASK >> (k)) & 1) && lo <= (k) && (k) < hi)
#define SEAM(k) do { if (!MK_PER_PHASE && IN((k) + 1)) xcd_barrier(bar); } while (0)
    bf16* const WS_bH = (bf16*)(F.ws + WS_H); bf16* const WS_bY = (bf16*)(F.ws + WS_Y); bf16* const WS_bZ = (bf16*)(F.ws + WS_Z);

    if (IN(0)) { p0_prologue(F); SEAM(0); }
    if (IN(1)) { p1_prenorm(F); SEAM(1); }
    if (IN(2)) {
        pg8::Gemm g{WS_bH, (const bf16*)(F.ws + WS_WIN), MALL, DINP_PAD, DM}; pg8::StaticOrder S; S.init(MALL, DINP_PAD, F.G, (int)blockIdx.x);
        pg8::EpiInProj E{WS_bZ, (bf16*)(F.ws + WS_XBC), (float*)(F.ws + WS_DT)};
        pg8::gemm_phase<pg8::EpiInProj, pg8::StaticOrder, true, true>(F.lds, g, S, E);
        SEAM(2);
    }
    if (IN(3)) { ssd_phase_a(F, dry); SEAM(3); }
    if (IN(4)) { ssd_phase_b(F); SEAM(4); }
    if (IN(5)) { ssd_phase_c(F, dry); SEAM(5); }
    if (IN(6)) {
        pg8::Gemm g{WS_bZ, (const bf16*)(F.ws + WS_WOUT), MLAT, DM, DIN}; pg8::StaticOrder S; S.init(MLAT, DM, F.G, (int)blockIdx.x);
        pg8::EpiBf16<0> E{WS_bY, DM, nullptr, 0, 0, 1.f};
        pg8::gemm_phase<pg8::EpiBf16<0>, pg8::StaticOrder, true, true>(F.lds, g, S, E);
        SEAM(6);
    }
    if (IN(7)) { resnorm_phase<true>(F, F.in[I_X], 0, 2, F.in[I_NPOST], F.in[I_NPRE] + 1024, 0, 4, 3); SEAM(7); }
    if (IN(8)) {
        pg8::Gemm g{WS_bH, (const bf16*)(F.ws + WS_WGU), MLAT, 2 * DFF, DM}; pg8::StaticOrder S; S.init(MLAT, 2 * DFF, F.G, (int)blockIdx.x);
        pg8::EpiSwiGLU E{(bf16*)(F.ws + WS_ACT0), DFF};
        pg8::gemm_phase<pg8::EpiSwiGLU, pg8::StaticOrder, true, true>(F.lds, g, S, E);
        SEAM(8);
    }
    if (IN(9)) {
        pg8::Gemm g{(const bf16*)(F.ws + WS_ACT0), (const bf16*)(F.ws + WS_WDN), MLAT, DM, DFF}; pg8::StaticOrder S; S.init(MLAT, DM, F.G, (int)blockIdx.x);
        pg8::EpiBf16<0> E{WS_bY, DM, nullptr, 0, 0, 1.f};
        pg8::gemm_phase<pg8::EpiBf16<0>, pg8::StaticOrder, true, true>(F.lds, g, S, E);
        SEAM(9);
    }
    if (IN(10)) { resnorm_phase<true>(F, F.out, 0, 5, F.in[I_NPOST] + 1024, F.in[I_NPRE] + 2048, 1, 1, 0); SEAM(10); }
    if (IN(11)) {
        pg8::Gemm g{WS_bH, (const bf16*)(F.ws + WS_WSCI), MLAT, 3072, DM}; pg8::StaticOrder S; S.init(MLAT, 3072, F.G, (int)blockIdx.x);
        pg8::EpiBf16<0> E{(bf16*)(F.ws + WS_SCP), 3072, nullptr, 0, 0, 1.f};
        pg8::gemm_phase<pg8::EpiBf16<0>, pg8::StaticOrder, true, true>(F.lds, g, S, E);
        SEAM(11);
    }
    if (IN(12)) { p12_shortconv(F); SEAM(12); }
    if (IN(13)) {
        pg8::Gemm g{WS_bH, (const bf16*)(F.ws + WS_WSCO), MLAT, DM, DM}; pg8::StaticOrder S; S.init(MLAT, DM, F.G, (int)blockIdx.x);
        pg8::EpiBf16<0> E{WS_bY, DM, nullptr, 0, 0, 1.f};
        pg8::gemm_phase<pg8::EpiBf16<0>, pg8::StaticOrder, true, true>(F.lds, g, S, E);
        SEAM(13);
    }
    if (IN(14)) { p14_resnorm_route(F); SEAM(14); }
    if (IN(15)) { p15_permute(F); SEAM(15); }
    if (IN(16)) {
        const int* texp = (const int*)(F.ws + WS_ROUTE + RT_TEXP); int nt = __builtin_amdgcn_readfirstlane(texp[300]); nt = nt < 0 ? 0 : (nt > MOE_ROWS / 256 ? MOE_ROWS / 256 : nt);
        pg8::Gemm g{(const bf16*)(F.ws + WS_HP8), (const bf16*)(F.ws + WS_WMGU), 256 * nt, 2 * DFFE, DM / 2};
        pg8::GroupedOrder S; S.init(256 * nt, 2 * DFFE, F.G, (int)blockIdx.x); S.texp = texp; S.estride = (size_t)2 * DFFE * DM;
        pg8::EpiSwiGLU8 E{(unsigned char*)(F.ws + WS_ACT), DFFE, 1.0f / WGU_SCALE};
        pg8::gemm_phase<pg8::EpiSwiGLU8, pg8::GroupedOrder, true, true, true>(F.lds, g, S, E);
        SEAM(16);
    }
    if (IN(17)) {
        const int* texp = (const int*)(F.ws + WS_ROUTE + RT_TEXP); int nt = __builtin_amdgcn_readfirstlane(texp[300]); nt = nt < 0 ? 0 : (nt > MOE_ROWS / 256 ? MOE_ROWS / 256 : nt);
        pg8::Gemm g{(const bf16*)(F.ws + WS_ACT), (const bf16*)(F.ws + WS_WMDN), 256 * nt, DM, DFFE / 2};
        pg8::GroupedOrder S; S.init(256 * nt, DM, F.G, (int)blockIdx.x); S.texp = texp; S.estride = (size_t)DM * DFFE;
        pg8::EpiBf16S E{(bf16*)(F.ws + WS_YP), DM, 1.0f / WDN_SCALE};
        pg8::gemm_phase<pg8::EpiBf16S, pg8::GroupedOrder, true, true, true>(F.lds, g, S, E);
        SEAM(17);
    }
    if (IN(18)) { p18_final(F); }
    if (MK_DUMP && lo <= 19 && 19 < hi) dump_phase(F);
#undef IN
#undef SEAM
}

extern "C" void kernel_launch(void* const* d_in, const int* in_sizes, int n_in, void* d_out, int out_size, void* d_ws, size_t ws_size, hipStream_t stream) {
    static int grid = 0;
    if (grid == 0) {
        if (n_in != 24 || out_size != MLAT * DM || ws_size < WS_NEED) { fprintf(stderr, "kernel_launch: unexpected problem (n_in %d, out %d, ws %zu)\n", n_in, out_size, ws_size); grid = -1; return; }
        int dev = 0, cus = 0, per_cu = 0;
        if (hipGetDevice(&dev) != hipSuccess || hipDeviceGetAttribute(&cus, hipDeviceAttributeMultiprocessorCount, dev) != hipSuccess) { grid = -1; return; }
        if (hipFuncSetAttribute((const void*)fwd_kernel, hipFuncAttributeMaxDynamicSharedMemorySize, LDS_BYTES) != hipSuccess) { fprintf(stderr, "kernel_launch: hipFuncSetAttribute failed\n"); grid = -1; return; }
        if (hipOccupancyMaxActiveBlocksPerMultiprocessor(&per_cu, (const void*)fwd_kernel, NWAVES * 64, LDS_BYTES) != hipSuccess || per_cu < 1) { fprintf(stderr, "kernel_launch: occupancy query reports %d\n", per_cu); }
        (void)hipGetLastError();
        grid = cus;
    }
    if (grid < 0) return;
    if (hipMemsetAsync((char*)d_ws + WS_CTL, 0, CTL_ZERO_BYTES, stream) != hipSuccess) return;
    Args a{};
    for (int i = 0; i < 24; ++i) a.in[i] = (const float*)d_in[i];
    a.out = (float*)d_out; a.ws = (unsigned char*)d_ws;
#if MK_PER_PHASE
#ifndef MK_TWICE_MASK
#define MK_TWICE_MASK 0
#endif
#ifndef MK_DRY_MASK
#define MK_DRY_MASK 0
#endif
    for (int p = 0; p <= MK_LAST_PHASE; ++p) { a.ph_lo = p;
        if ((MK_DRY_MASK >> p) & 1) { a.ph_hi = (p + 1) | 0x100; hipLaunchKernelGGL(fwd_kernel, dim3(grid), dim3(NWAVES * 64), LDS_BYTES, stream, a); }
        a.ph_hi = p + 1; hipLaunchKernelGGL(fwd_kernel, dim3(grid), dim3(NWAVES * 64), LDS_BYTES, stream, a);
        if ((MK_TWICE_MASK >> p) & 1) hipLaunchKernelGGL(fwd_kernel, dim3(grid), dim3(NWAVES * 64), LDS_BYTES, stream, a); }
    if (MK_DUMP) { a.ph_lo = 19; a.ph_hi = 20; hipLaunchKernelGGL(fwd_kernel, dim3(grid), dim3(NWAVES * 64), LDS_BYTES, stream, a); }
#else
    a.ph_lo = 0; a.ph_hi = MK_LAST_PHASE + 1;
    hipLaunchKernelGGL(fwd_kernel, dim3(grid), dim3(NWAVES * 64), LDS_BYTES, stream, a);
#endif
}
```

```cpp
#include <hip/hip_runtime.h>
#include <cstdio>
#include <cstdint>
#define MK_PER_PHASE 0
#define MK_LAST_PHASE 18
#define MK_DUMP 0
#define MK_TWICE_MASK 0
#define MK_DRY_MASK 0
#define MK_DRY_LEVEL 1
namespace pg8 {
#define PG8_LAS __attribute__((address_space(3)))
typedef unsigned short bf16_t;
typedef short bf16x8 __attribute__((ext_vector_type(8)));
typedef float f32x4 __attribute__((ext_vector_type(4)));
typedef unsigned u32x4 __attribute__((ext_vector_type(4)));
constexpr int BM = 256, BK = 64, HALF = 128, HTB = HALF * BK * 2  , STAGE_BYTES = 8 * HTB, NXCD = 8, WGM = 8;

__host__ __device__ __forceinline__ int lds_byte(int r, int c) { const int st = (r >> 4) * 2 + (c >> 5), rr = r & 15, cc = c & 31, ob = rr * 64 + cc * 2; return st * 1024 + (ob ^ (((ob >> 9) & 1) << 5)); }
__host__ __device__ __forceinline__ void stage_rc(int b, int& R, int& C) { const int st = b / 1024, sb = b % 1024, swz = sb ^ (((sb >> 9) & 1) << 5); R = (st >> 1) * 16 + swz / 64; C = (st & 1) * 32 + (swz % 64) / 2; }
__host__ __device__ __forceinline__ int perm32(int rho) { const int n = rho >> 4, i = rho & 15; return 8 * (i >> 2) + 4 * n + (i & 3); }

struct Unit { int pm, pn; };
struct Gemm { const bf16_t* A; const bf16_t* Bt; int M, N, K; };

struct StaticOrder {
    int nM, nN, nwg, G, c;
    __host__ __device__ void init(int M, int N, int G_, int c_) { nM = M / BM; nN = N / BM; nwg = nM * nN; G = G_; c = c_; }
    __host__ __device__ bool next(int i, Unit& u) const {
        const long L = (long)i * G + c; if (L >= nwg) return false;
        int wgid = (int)L; { const int q = nwg / NXCD, r = nwg % NXCD, xcd = wgid % NXCD, off = wgid / NXCD; wgid = (xcd < r ? xcd * (q + 1) : r * (q + 1) + (xcd - r) * q) + off; }
        const int nig = WGM * nN, gid = wgid / nig, fm = gid * WGM, gsz = (nM - fm) < WGM ? (nM - fm) : WGM;
        u.pm = fm + ((wgid % nig) % gsz); u.pn = (wgid % nig) / gsz; return true;
    }
    __device__ __forceinline__ void a_ready(const Unit&) const {}
    __device__ __forceinline__ void done(const Unit&) const {}
    __device__ __forceinline__ size_t boff(const Unit&) const { return 0; }
};

typedef float f32x2c __attribute__((ext_vector_type(2)));
typedef __bf16 bf16x2c __attribute__((ext_vector_type(2)));
__device__ __forceinline__ unsigned cvt_pk_bf16(float lo, float hi) { const f32x2c v = {lo, hi}; return __builtin_bit_cast(unsigned, __builtin_convertvector(v, bf16x2c)); }
typedef float f32x2 __attribute__((ext_vector_type(2)));
__device__ __forceinline__ f32x2 gelu_pk(f32x2 v) {
    const f32x2 av = __builtin_elementwise_abs(v), d = av * 0.2316418882f + 1.0f;
    f32x2 t; t.x = __builtin_amdgcn_rcpf(d.x); t.y = __builtin_amdgcn_rcpf(d.y);
    f32x2 q = t * 0.5307027145f + (-0.7265760135f); q = q * t + 0.7107068705f; q = q * t + (-0.142248368f); q = q * t + 0.127414796f; q = q * t;
    const f32x2 s = (v * v) * (-0.72134752044f);
    f32x2 e; e.x = __builtin_amdgcn_exp2f(s.x); e.y = __builtin_amdgcn_exp2f(s.y);
    const f32x2 m = v * (q * e), r = v - m;
    f32x2 o; o.x = v.x < 0.f ? m.x : r.x; o.y = v.y < 0.f ? m.y : r.y; return o;
}

template <int ACT  > struct EpiBf16 {
    static constexpr bool PERM = true, AFTER_DRAIN = false; static_assert(ACT == 0 || ACT == 1, "EpiBf16: ACT is 0 (none) or 1 (gelu_pk)");
    bf16_t* O; int ldc; const float* bias; int split_cols; size_t split_stride; float scale0;
    __device__ __forceinline__ void operator()(const f32x4 (&acc)[2][2][4][2], const Unit& u, int wr, int wc, int fr, int fq) const {
        const int row0 = u.pm * BM + wr * 64 + fr; int colt = u.pn * BM; bf16_t* base = O;
        float sc = 1.f; if (split_cols) { const int t = colt / split_cols; base += (size_t)t * split_stride; colt -= t * split_cols; if (t == 0) sc = scale0; }
        const int col0 = colt + wc * 32 + 8 * fq, bcol0 = u.pn * BM + wc * 32 + 8 * fq;
        f32x4 bv[2][2];
#pragma unroll
        for (int bj = 0; bj < 2; ++bj)
#pragma unroll
            for (int n = 0; n < 2; ++n) bv[bj][n] = bias ? *(const f32x4*)(bias + bcol0 + bj * HALF + 4 * n) : (f32x4){0.f, 0.f, 0.f, 0.f};
#pragma unroll
        for (int ai = 0; ai < 2; ++ai)
#pragma unroll
            for (int m = 0; m < 4; ++m) { bf16_t* rowp = base + (size_t)(row0 + ai * HALF + m * 16) * ldc + col0;
#pragma unroll
                for (int bj = 0; bj < 2; ++bj) { f32x4 v0 = acc[ai][bj][m][0] + bv[bj][0], v1 = acc[ai][bj][m][1] + bv[bj][1];
                    if (ACT == 1) { f32x2 a = gelu_pk((f32x2){v0[0], v0[1]}), b = gelu_pk((f32x2){v0[2], v0[3]}), c = gelu_pk((f32x2){v1[0], v1[1]}), d = gelu_pk((f32x2){v1[2], v1[3]});
                        v0 = (f32x4){a.x, a.y, b.x, b.y}; v1 = (f32x4){c.x, c.y, d.x, d.y}; }
                    v0 = v0 * sc; v1 = v1 * sc; u32x4 w; w.x = cvt_pk_bf16(v0[0], v0[1]); w.y = cvt_pk_bf16(v0[2], v0[3]); w.z = cvt_pk_bf16(v1[0], v1[1]); w.w = cvt_pk_bf16(v1[2], v1[3]);
                    *(u32x4*)(rowp + bj * HALF) = w; } }
    }
};

typedef int i32x4f __attribute__((ext_vector_type(4)));
typedef int i32x8f __attribute__((ext_vector_type(8)));
__device__ __forceinline__ i32x8f cat8(bf16x8 a, bf16x8 b) { const i32x4f lo = __builtin_bit_cast(i32x4f, a), hi = __builtin_bit_cast(i32x4f, b); return __builtin_shufflevector(lo, hi, 0, 1, 2, 3, 4, 5, 6, 7); }
template <class Epi, class Sched, bool ALIGN_EPI = false, bool SP2 = false, bool FP8 = false>
__device__ __forceinline__ void gemm_phase(PG8_LAS unsigned char* lds, const Gemm g, const Sched& S, const Epi& E) {
    const int tid = threadIdx.x, wid = __builtin_amdgcn_readfirstlane(tid >> 6), lane = tid & 63, wr = wid >> 2, wc = wid & 3, fr = lane & 15, fq = lane >> 4;
    const int K = g.K, nt = K / BK;
    unsigned voffA[2], voffB[2];
#pragma unroll
    for (int i = 0; i < 2; ++i) { int R, C; stage_rc(tid * 16 + i * 8192, R, C); const int Rb = Epi::PERM ? ((R & ~31) + perm32(R & 31)) : R;
        voffA[i] = (unsigned)(R * K + C) * 2u; voffB[i] = (unsigned)(Rb * K + C) * 2u; }
    const size_t kstep = (size_t)(BK * 2);
    const size_t hstep = (size_t)HALF * K * 2;
    const size_t tstep = 2 * hstep;
    const unsigned ldsw = (unsigned)wid * 1024u;
    const int aoff = lds_byte(wr * 64 + fr, fq * 8), boff = lds_byte(wc * 32 + fr, fq * 8);
#define PG8_SA(b, h) (((b) * 2 + (h)) * HTB)
#define PG8_SB(b, h) ((4 + (b) * 2 + (h)) * HTB)
#define PG8_STAGE(bufoff, gbase, voff) do { _Pragma("unroll") for (int _i = 0; _i < 2; ++_i) \
        __builtin_amdgcn_global_load_lds((const unsigned*)((const char*)(gbase) + (voff)[_i]), (PG8_LAS unsigned*)(lds + (bufoff) + ldsw + _i * 8192), 16, 0, 0); } while (0)
#define PG8_LDA(dst, b, h) do { _Pragma("unroll") for (int m = 0; m < 4; ++m) { const bf16x8 x0_ = *(const PG8_LAS bf16x8*)(lds + PG8_SA(b, h) + aoff + m * 2048), x1_ = *(const PG8_LAS bf16x8*)(lds + PG8_SA(b, h) + aoff + m * 2048 + 1024); \
        if constexpr (FP8) dst##8[m] = cat8(x0_, x1_); else { dst[m][0] = x0_; dst[m][1] = x1_; } } } while (0)
#define PG8_LDB(dst, b, h) do { _Pragma("unroll") for (int n = 0; n < 2; ++n) { const bf16x8 x0_ = *(const PG8_LAS bf16x8*)(lds + PG8_SB(b, h) + boff + n * 2048), x1_ = *(const PG8_LAS bf16x8*)(lds + PG8_SB(b, h) + boff + n * 2048 + 1024); \
        if constexpr (FP8) dst##8[n] = cat8(x0_, x1_); else { dst[n][0] = x0_; dst[n][1] = x1_; } } } while (0)
#define PG8_MMA(ai, bj, At, Bt) do { __builtin_amdgcn_s_setprio(1); _Pragma("unroll") for (int m = 0; m < 4; ++m) _Pragma("unroll") for (int n = 0; n < 2; ++n) { \
        if constexpr (FP8) asm volatile("v_mfma_f32_16x16x128_f8f6f4 %0, %1, %2, %0" : "+v"(acc[ai][bj][m][n]) : "v"(Bt##8[n]), "v"(At##8[m])); \
        else { _Pragma("unroll") for (int k = 0; k < 2; ++k) acc[ai][bj][m][n] = __builtin_amdgcn_mfma_f32_16x16x32_bf16(Bt[n][k], At[m][k], acc[ai][bj][m][n], 0, 0, 0); } } __builtin_amdgcn_s_setprio(0); } while (0)
#define PG8_WAIT_V(n) asm volatile("s_waitcnt vmcnt(" #n ")" ::: "memory")
#define PG8_WAIT_L(n) asm volatile("s_waitcnt lgkmcnt(" #n ")" ::: "memory")
#define PG8_BAR __builtin_amdgcn_s_barrier()
#define PG8_SCHED __builtin_amdgcn_sched_barrier(0)
    Unit cur, nxt; int ui = 0;
    if (!S.next(0, cur)) return;
    f32x4 acc[2][2][4][2];
#pragma unroll
    for (int a = 0; a < 2; ++a)
#pragma unroll
        for (int b = 0; b < 2; ++b)
#pragma unroll
            for (int m = 0; m < 4; ++m)
#pragma unroll
                for (int n = 0; n < 2; ++n) acc[a][b][m][n] = (f32x4){0.f, 0.f, 0.f, 0.f};
    bf16x8 At[4][2], B0[2][2], B1[2][2]; i32x8f At8[4], B08[2], B18[2];
    const char* cA = (const char*)g.A + (size_t)cur.pm * tstep; const char* cB = (const char*)g.Bt + S.boff(cur) + (size_t)cur.pn * tstep;
    S.a_ready(cur);
    if constexpr (SP2) {
        PG8_STAGE(PG8_SB(0, 0), cB, voffB); PG8_STAGE(PG8_SB(0, 1), cB + hstep, voffB); PG8_STAGE(PG8_SA(0, 0), cA, voffA); PG8_STAGE(PG8_SA(0, 1), cA + hstep, voffA);
        if (wr == 1) PG8_BAR;
        PG8_WAIT_V(2); PG8_BAR;
        PG8_STAGE(PG8_SB(1, 0), cB + kstep, voffB); PG8_STAGE(PG8_SA(1, 0), cA + kstep, voffA); PG8_STAGE(PG8_SB(1, 1), cB + hstep + kstep, voffB);
        PG8_WAIT_V(6); PG8_BAR;
    } else {
        PG8_STAGE(PG8_SB(0, 0), cB, voffB); PG8_STAGE(PG8_SA(0, 0), cA, voffA); PG8_STAGE(PG8_SB(0, 1), cB + hstep, voffB); PG8_STAGE(PG8_SA(0, 1), cA + hstep, voffA);
        if (wr == 1) PG8_BAR;
        PG8_WAIT_V(4); PG8_BAR;
        PG8_STAGE(PG8_SB(1, 0), cB + kstep, voffB); PG8_STAGE(PG8_SA(1, 0), cA + kstep, voffA); PG8_STAGE(PG8_SB(1, 1), cB + hstep + kstep, voffB);
        PG8_WAIT_V(6); PG8_BAR;
    }
    for (;;) {
        const bool has_next = S.next(ui + 1, nxt);
        const char* nA = has_next ? (const char*)g.A + (size_t)nxt.pm * tstep : cA; const char* nB = has_next ? (const char*)g.Bt + S.boff(nxt) + (size_t)nxt.pn * tstep : cB;
        for (int t = 0; t < nt; t += 2) {
            const bool last = (t == nt - 2);
            const char* a1 = cA + (size_t)(t + 1) * kstep;
            const char* a2 = last ? nA : cA + (size_t)(t + 2) * kstep; const char* b2 = last ? nB : cB + (size_t)(t + 2) * kstep;
            const char* a3 = a2 + kstep; const char* b3 = b2 + kstep;
            if (last && has_next) S.a_ready(nxt);
            if constexpr (SP2) {
            PG8_LDB(B0, 0, 0); PG8_LDB(B1, 0, 1); PG8_SCHED; PG8_LDA(At, 0, 0); PG8_STAGE(PG8_SA(1, 1), a1 + hstep, voffA);
            PG8_WAIT_V(8); PG8_WAIT_L(0); PG8_BAR; PG8_MMA(0, 0, At, B0); PG8_MMA(0, 1, At, B1); PG8_BAR; PG8_SCHED;
            PG8_LDA(At, 0, 1); PG8_STAGE(PG8_SB(0, 0), b2, voffB); PG8_STAGE(PG8_SB(0, 1), b2 + hstep, voffB); PG8_STAGE(PG8_SA(0, 0), a2, voffA);
            PG8_WAIT_V(8); PG8_WAIT_L(0); PG8_BAR; PG8_MMA(1, 0, At, B0); PG8_MMA(1, 1, At, B1); PG8_BAR; PG8_SCHED;
            PG8_LDB(B0, 1, 0); PG8_LDB(B1, 1, 1); PG8_SCHED; PG8_LDA(At, 1, 0); PG8_STAGE(PG8_SA(0, 1), a2 + hstep, voffA);
            PG8_WAIT_V(8); PG8_WAIT_L(0); PG8_BAR; PG8_MMA(0, 0, At, B0); PG8_MMA(0, 1, At, B1); PG8_BAR; PG8_SCHED;
            PG8_LDA(At, 1, 1); PG8_STAGE(PG8_SB(1, 0), b3, voffB); PG8_STAGE(PG8_SB(1, 1), b3 + hstep, voffB); PG8_STAGE(PG8_SA(1, 0), a3, voffA);
            PG8_WAIT_V(8); PG8_WAIT_L(0); PG8_BAR; PG8_MMA(1, 0, At, B0); PG8_MMA(1, 1, At, B1); PG8_BAR; PG8_SCHED;
            } else {
            PG8_LDB(B0, 0, 0); PG8_SCHED; PG8_LDA(At, 0, 0); PG8_STAGE(PG8_SA(1, 1), a1 + hstep, voffA);
            PG8_WAIT_L(8); PG8_BAR; PG8_WAIT_L(0); PG8_MMA(0, 0, At, B0); PG8_BAR; PG8_SCHED;
            PG8_LDB(B1, 0, 1); PG8_STAGE(PG8_SB(0, 0), b2, voffB);
            PG8_BAR; PG8_WAIT_L(0); PG8_MMA(0, 1, At, B1); PG8_BAR;
            PG8_LDA(At, 0, 1); PG8_STAGE(PG8_SA(0, 0), a2, voffA);
            PG8_BAR; PG8_WAIT_L(0); PG8_MMA(1, 0, At, B0); PG8_BAR; PG8_SCHED;
            PG8_STAGE(PG8_SB(0, 1), b2 + hstep, voffB);
            PG8_WAIT_V(6); PG8_BAR; PG8_MMA(1, 1, At, B1); PG8_BAR;
            PG8_LDB(B0, 1, 0); PG8_SCHED; PG8_LDA(At, 1, 0); PG8_STAGE(PG8_SA(0, 1), a2 + hstep, voffA);
            PG8_WAIT_L(8); PG8_BAR; PG8_WAIT_L(0); PG8_MMA(0, 0, At, B0); PG8_BAR; PG8_SCHED;
            PG8_LDB(B1, 1, 1); PG8_STAGE(PG8_SB(1, 0), b3, voffB);
            PG8_BAR; PG8_WAIT_L(0); PG8_MMA(0, 1, At, B1); PG8_BAR;
            PG8_LDA(At, 1, 1); PG8_STAGE(PG8_SA(1, 0), a3, voffA);
            PG8_BAR; PG8_WAIT_L(0); PG8_MMA(1, 0, At, B0); PG8_BAR; PG8_SCHED;
            PG8_STAGE(PG8_SB(1, 1), b3 + hstep, voffB);
            PG8_WAIT_V(6); PG8_BAR; PG8_MMA(1, 1, At, B1); PG8_BAR;
            }
        }
        if constexpr (FP8) asm volatile("s_nop 7\n\ts_nop 7\n\ts_nop 7" ::: "memory");
        if constexpr (ALIGN_EPI) { if (wr == 0) PG8_BAR; }
        if constexpr (!Epi::AFTER_DRAIN) { E(acc, cur, wr, wc, fr, fq); S.done(cur); }
        if (!has_next) break;
#pragma unroll
        for (int a = 0; a < 2; ++a)
#pragma unroll
            for (int b = 0; b < 2; ++b)
#pragma unroll
                for (int m = 0; m < 4; ++m)
#pragma unroll
                    for (int n = 0; n < 2; ++n) acc[a][b][m][n] = (f32x4){0.f, 0.f, 0.f, 0.f};
        cur = nxt; cA = nA; cB = nB; ++ui;
        if constexpr (ALIGN_EPI) { if (wr == 1) PG8_BAR; }
    }
    PG8_WAIT_V(0);
    if constexpr (!ALIGN_EPI) { if (wr == 0) PG8_BAR; }
    PG8_BAR;
    if constexpr (Epi::AFTER_DRAIN) { E.fused(acc, cur, wr, wc, fr, fq, lds, wid, lane); S.done(cur); }
#undef PG8_SA
#undef PG8_SB
#undef PG8_STAGE
#undef PG8_LDA
#undef PG8_LDB
#undef PG8_MMA
#undef PG8_WAIT_V
#undef PG8_WAIT_L
#undef PG8_BAR
#undef PG8_SCHED
}
}

constexpr int NWAVES = 8;
constexpr int DM = 1024, NB = 8, SEQ = 4096, CTXL = 256;
constexpr int MLAT = NB * SEQ, MCTX = NB * CTXL, MALL = MLAT + MCTX;
constexpr int DIN = 2048, CONVD = 4096, DINP = 6208, DINP_PAD = 6400;
constexpr int DFF = 2816, NE = 8, DFFE = 3584;
constexpr int NUNIT_LAT = NB * 32 * 8, NUNIT = NUNIT_LAT + NB * 2 * 8;
constexpr int MOE_ROWS = 67584;
constexpr float EPS = 1e-6f;
#ifndef MK_PER_PHASE
#define MK_PER_PHASE 0
#endif
#ifndef MK_LAST_PHASE
#define MK_LAST_PHASE 18
#endif
constexpr int N_PHASES = 19;

constexpr size_t MiB = 1u << 20;
constexpr size_t WS_CTL = 0, CTL_ZERO_BYTES = 1 * MiB;
constexpr size_t WS_MOD = 1 * MiB;
constexpr size_t WS_ROUTE = 2 * MiB;
constexpr size_t WS_CD = 4 * MiB;
constexpr size_t WS_WIN = 8 * MiB, WS_WOUT = 21 * MiB, WS_WGU = 25 * MiB, WS_WDN = 36 * MiB, WS_WSCI = 42 * MiB, WS_WSCO = 48 * MiB;
constexpr size_t WS_H = 56 * MiB;
constexpr size_t WS_Y = 124 * MiB;
constexpr size_t WS_Z = 188 * MiB;
constexpr size_t WS_XBC = 324 * MiB;
constexpr size_t WS_DT = 596 * MiB;
constexpr size_t WS_S = 606 * MiB;
constexpr size_t WS_ACT0 = 324 * MiB;
constexpr size_t WS_SCP = 324 * MiB;
constexpr size_t WS_HP8 = 124 * MiB;
constexpr size_t WS_YP = 190 * MiB;
constexpr size_t WS_WMGU = 322 * MiB, WS_WMDN = 378 * MiB;
constexpr size_t WS_ACT = 406 * MiB;
constexpr size_t WS_END = 640 * MiB;
constexpr float WGU_SCALE = 64.f, WDN_SCALE = 128.f;
#ifndef MK_FFN_FP8
#define MK_FFN_FP8 0
#endif
constexpr int FFN_FP8 = MK_FFN_FP8;
static_assert(WS_S + (size_t)NUNIT * 8 * 8192 * 2 <= 878 * MiB && WS_HP8 + (size_t)MOE_ROWS * DM <= WS_YP && WS_YP + (size_t)MOE_ROWS * DM * 2 <= WS_WMGU && WS_WMGU + (size_t)8 * 2 * DFFE * DM <= WS_WMDN && WS_WMDN + (size_t)8 * DM * DFFE <= WS_ACT && WS_ACT + (size_t)MOE_ROWS * DFFE <= WS_END, "d_ws map");
constexpr size_t WS_NEED = 878 * MiB;
constexpr size_t RT_SELR = 0, RT_GATE = 256 * 1024, RT_POS = 512 * 1024, RT_CNT = 768 * 1024, RT_TEXP = 800 * 1024;
constexpr int CW_TMO = 0, CW_CODE = 1, CW_BAR = 4096;

constexpr int PXB = 528, PBB = 272, PMB = 272;
constexpr int XI_BYTES = 128 * PXB, BI_BYTES = 128 * PBB, MW_BYTES = 8 * 16 * PMB;
constexpr int SCAL_OFF = XI_BYTES + BI_BYTES + MW_BYTES;
constexpr int BPW_OFF = SCAL_OFF + 3 * 4096;
constexpr int MISC_OFF = BPW_OFF + 4096;
constexpr int LDS_BYTES = MISC_OFF + 512;
static_assert(LDS_BYTES <= 160 * 1024 && pg8::STAGE_BYTES <= MISC_OFF, "LDS map");

#define GAS __attribute__((address_space(1)))
#define LAS __attribute__((address_space(3)))
typedef unsigned short bf16;
typedef unsigned v4u __attribute__((ext_vector_type(4)));
typedef unsigned v2u __attribute__((ext_vector_type(2)));
typedef float f32x4 __attribute__((ext_vector_type(4)));
typedef short bf16x8 __attribute__((ext_vector_type(8)));
typedef short s16x4 __attribute__((ext_vector_type(4)));
typedef GAS unsigned gu32;
#define RLX_AGENT __ATOMIC_RELAXED, __HIP_MEMORY_SCOPE_AGENT
#define LDS_WAIT() asm volatile("s_waitcnt lgkmcnt(0)" ::: "memory")
#define VM_WAIT() asm volatile("s_waitcnt vmcnt(0)" ::: "memory")
#define LDS_BARRIER() do { asm volatile("s_waitcnt lgkmcnt(0)" ::: "memory"); __builtin_amdgcn_s_barrier(); asm volatile("" ::: "memory"); } while (0)
typedef float f32x2n __attribute__((ext_vector_type(2)));
typedef __bf16 bf16x2n __attribute__((ext_vector_type(2)));
__device__ __forceinline__ unsigned pk2(float lo, float hi) { const f32x2n v = {lo, hi}; return __builtin_bit_cast(unsigned, __builtin_convertvector(v, bf16x2n)); }
__device__ __forceinline__ float bflo(unsigned u) { return __uint_as_float(u << 16); }
__device__ __forceinline__ float bfhi(unsigned u) { return __uint_as_float(u & 0xffff0000u); }
__device__ __forceinline__ float bf1(bf16 b) { return __uint_as_float(((unsigned)b) << 16); }
__device__ __forceinline__ f32x4 unpack4(v2u u) { return (f32x4){bflo(u.x), bfhi(u.x), bflo(u.y), bfhi(u.y)}; }
__device__ __forceinline__ v2u pack4(f32x4 v) { v2u r; r.x = pk2(v[0], v[1]); r.y = pk2(v[2], v[3]); return r; }
__device__ __forceinline__ unsigned pk4_fp8(float a, float b, float c, float d) {
    a = fminf(fmaxf(a, -448.f), 448.f); b = fminf(fmaxf(b, -448.f), 448.f); c = fminf(fmaxf(c, -448.f), 448.f); d = fminf(fmaxf(d, -448.f), 448.f);
    int v = __builtin_amdgcn_cvt_pk_fp8_f32(a, b, 0, false); v = __builtin_amdgcn_cvt_pk_fp8_f32(c, d, v, true); return (unsigned)v; }
__device__ __forceinline__ float silu_f(float v) { return v * __builtin_amdgcn_rcpf(1.0f + __builtin_amdgcn_exp2f(-1.44269504f * v)); }
__device__ __forceinline__ float wave_sum(float v) {
#pragma unroll
    for (int o = 1; o < 64; o <<= 1) v += __shfl_xor(v, o);
    return v;
}
__device__ __forceinline__ unsigned lds_addr(LAS unsigned char* p) { return (unsigned)(size_t)p; }
__device__ __forceinline__ bf16x8 tr_pair(const LAS unsigned char* p0, const LAS unsigned char* p1) {
    const s16x4 x = __builtin_amdgcn_ds_read_tr16_b64_v4i16((LAS s16x4*)p0), y = __builtin_amdgcn_ds_read_tr16_b64_v4i16((LAS s16x4*)p1);
    return (bf16x8){x[0], x[1], x[2], x[3], y[0], y[1], y[2], y[3]};
}
#define MFMA16(a, b, c) __builtin_amdgcn_mfma_f32_16x16x32_bf16((a), (b), (c), 0, 0, 0)

namespace pg8 {
struct EpiInProj {
    static constexpr bool PERM = true, AFTER_DRAIN = false;
    bf16_t* Z; bf16_t* XBC; float* DT;
    __device__ __forceinline__ void operator()(const f32x4 (&acc)[2][2][4][2], const Unit& u, int wr, int wc, int fr, int fq) const {
        const int row0 = u.pm * BM + wr * 64 + fr;
        if (u.pn < 24) {
            bf16_t* base; int ldc, colt;
            if (u.pn < 8) { base = Z; ldc = 2048; colt = u.pn * BM; } else { base = XBC; ldc = 4096; colt = (u.pn - 8) * BM; }
            const int col0 = colt + wc * 32 + 8 * fq;
#pragma unroll
            for (int ai = 0; ai < 2; ++ai)
#pragma unroll
                for (int m = 0; m < 4; ++m) { bf16_t* rowp = base + (size_t)(row0 + ai * HALF + m * 16) * ldc + col0;
#pragma unroll
                    for (int bj = 0; bj < 2; ++bj) { const f32x4 v0 = acc[ai][bj][m][0], v1 = acc[ai][bj][m][1];
                        u32x4 w; w.x = cvt_pk_bf16(v0[0], v0[1]); w.y = cvt_pk_bf16(v0[2], v0[3]); w.z = cvt_pk_bf16(v1[0], v1[1]); w.w = cvt_pk_bf16(v1[2], v1[3]);
                        *(u32x4*)(rowp + bj * HALF) = w; } }
        } else if (wc < 2) {
            const int col0 = wc * 32 + 8 * fq;
#pragma unroll
            for (int ai = 0; ai < 2; ++ai)
#pragma unroll
                for (int m = 0; m < 4; ++m) { float* rowp = DT + (size_t)(row0 + ai * HALF + m * 16) * 64 + col0;
                    *(f32x4*)(rowp) = acc[ai][0][m][0]; *(f32x4*)(rowp + 4) = acc[ai][0][m][1]; }
        }
    }
};
struct EpiSwiGLU {
    static constexpr bool PERM = true, AFTER_DRAIN = false;
    bf16_t* O; int ldc;
    __device__ __forceinline__ void operator()(const f32x4 (&acc)[2][2][4][2], const Unit& u, int wr, int wc, int fr, int fq) const {
        const int row0 = u.pm * BM + wr * 64 + fr, col0 = u.pn * HALF + wc * 32 + 8 * fq;
#pragma unroll
        for (int ai = 0; ai < 2; ++ai)
#pragma unroll
            for (int m = 0; m < 4; ++m) { bf16_t* rowp = O + (size_t)(row0 + ai * HALF + m * 16) * ldc + col0;
                float o[8];
#pragma unroll
                for (int n = 0; n < 2; ++n)
#pragma unroll
                    for (int j = 0; j < 4; ++j) { const float gt = acc[ai][0][m][n][j], up = acc[ai][1][m][n][j]; o[4 * n + j] = gt * __builtin_amdgcn_rcpf(1.0f + __expf(-gt)) * up; }
                u32x4 w; w.x = cvt_pk_bf16(o[0], o[1]); w.y = cvt_pk_bf16(o[2], o[3]); w.z = cvt_pk_bf16(o[4], o[5]); w.w = cvt_pk_bf16(o[6], o[7]);
                *(u32x4*)(rowp) = w; }
    }
};
struct EpiSwiGLU8 {
    static constexpr bool PERM = true, AFTER_DRAIN = false;
    unsigned char* O; int ldc; float sc;
    __device__ __forceinline__ void operator()(const f32x4 (&acc)[2][2][4][2], const Unit& u, int wr, int wc, int fr, int fq) const {
        const int row0 = u.pm * BM + wr * 64 + fr, col0 = u.pn * HALF + wc * 32 + 8 * fq;
#pragma unroll
        for (int ai = 0; ai < 2; ++ai)
#pragma unroll
            for (int m = 0; m < 4; ++m) { unsigned char* rowp = O + (size_t)(row0 + ai * HALF + m * 16) * ldc + col0;
                float o[8];
#pragma unroll
                for (int n = 0; n < 2; ++n)
#pragma unroll
                    for (int j = 0; j < 4; ++j) { const float gt = acc[ai][0][m][n][j] * sc, up = acc[ai][1][m][n][j] * sc; o[4 * n + j] = gt * __builtin_amdgcn_rcpf(1.0f + __builtin_amdgcn_exp2f(-1.44269504f * gt)) * up; }
                typedef unsigned u32x2e __attribute__((ext_vector_type(2)));
                u32x2e w; w.x = pk4_fp8(o[0], o[1], o[2], o[3]); w.y = pk4_fp8(o[4], o[5], o[6], o[7]);
                *(u32x2e*)(rowp) = w; }
    }
};
struct EpiBf16S {
    static constexpr bool PERM = true, AFTER_DRAIN = false;
    bf16_t* O; int ldc; float sc;
    __device__ __forceinline__ void operator()(const f32x4 (&acc)[2][2][4][2], const Unit& u, int wr, int wc, int fr, int fq) const {
        const int row0 = u.pm * BM + wr * 64 + fr, col0 = u.pn * BM + wc * 32 + 8 * fq;
#pragma unroll
        for (int ai = 0; ai < 2; ++ai)
#pragma unroll
            for (int m = 0; m < 4; ++m) { bf16_t* rowp = O + (size_t)(row0 + ai * HALF + m * 16) * ldc + col0;
#pragma unroll
                for (int bj = 0; bj < 2; ++bj) { const f32x4 v0 = acc[ai][bj][m][0] * sc, v1 = acc[ai][bj][m][1] * sc;
                    u32x4 w; w.x = cvt_pk_bf16(v0[0], v0[1]); w.y = cvt_pk_bf16(v0[2], v0[3]); w.z = cvt_pk_bf16(v1[0], v1[1]); w.w = cvt_pk_bf16(v1[2], v1[3]);
                    *(u32x4*)(rowp + bj * HALF) = w; } }
    }
};
struct InProjOrder : StaticOrder {
    __device__ __forceinline__ bool next(int i, Unit& u) const {
        const long L = (long)i * G + c; if (L >= nwg + 104) return false;
        if (L < nwg) return StaticOrder::next(i, u);
        const int idx = (int)(L - nwg), px = idx % 13; u.pm = nM + idx / 13; u.pn = px < 12 ? 8 + px : 24; return true;
    }
};
struct EpiNull {
    static constexpr bool PERM = true, AFTER_DRAIN = false;
    float* sink;
    __device__ __forceinline__ void operator()(const f32x4 (&acc)[2][2][4][2], const Unit& u, int wr, int wc, int fr, int fq) const {
        float s = 0.f;
#pragma unroll
        for (int ai = 0; ai < 2; ++ai)
#pragma unroll
            for (int bj = 0; bj < 2; ++bj)
#pragma unroll
                for (int m = 0; m < 4; ++m)
#pragma unroll
                    for (int n = 0; n < 2; ++n) s += acc[ai][bj][m][n][0];
        if (s == 12345.678f) sink[0] = s;
    }
};
struct GroupedOrder : StaticOrder {
    const int* texp; size_t estride;
    __device__ __forceinline__ size_t boff(const Unit& u) const { return (size_t)texp[u.pm] * estride; }
};
}

struct Frame {
    LAS unsigned char* lds;
    volatile LAS unsigned* MISC;
    gu32* ctl;
    int tid, lane, wave, G;
    const float* in[24]; float* out; unsigned char* ws;
};
enum { I_X = 0, I_C, I_CTX, I_CCTX, I_ADAW, I_ADAB, I_NPRE, I_NPOST, I_SWIN, I_SCONVW, I_SCONVB, I_SALOG, I_SDTB, I_SD, I_SNORM, I_SWOUT, I_SCWIN, I_SCCONV, I_SCWOUT, I_FGU, I_FDN, I_ROUTER, I_MGU, I_MDN };

__device__ __forceinline__ void cvt_item(const float* W, int K, int N, bf16* WT, LAS float* scr, int item, int lane, int mode, int dffx) {
    const int nblk = N / 32, kb = item / nblk, nb = item % nblk, k0 = 64 * kb, n0 = 32 * nb;
#pragma unroll 8
    for (int i = 0; i < 32; ++i) { const int kk = 2 * i + (lane >> 5); scr[kk * 33 + (lane & 31)] = W[(size_t)(k0 + kk) * N + n0 + (lane & 31)]; }
    LDS_WAIT(); asm volatile("" ::: "memory");
    const int c = lane & 7;
#pragma unroll
    for (int j = 0; j < 4; ++j) { const int n = (lane >> 3) + 8 * j; const LAS float* s = scr + (8 * c) * 33 + n;
        v4u o; o.x = pk2(s[0 * 33], s[1 * 33]); o.y = pk2(s[2 * 33], s[3 * 33]); o.z = pk2(s[4 * 33], s[5 * 33]); o.w = pk2(s[6 * 33], s[7 * 33]);
        int nd = n0 + n; if (mode) { const int half = nd >= dffx ? 1 : 0, i2 = nd - half * dffx; nd = 256 * (i2 >> 7) + 128 * half + (i2 & 127); }
        *(v4u*)(WT + (size_t)nd * K + k0 + 8 * c) = o; }
    LDS_WAIT(); asm volatile("" ::: "memory");
}
__device__ __forceinline__ void cvt_item8(const float* W, int K, int N, unsigned char* WT, LAS float* scr, int item, int lane, int mode, int dffx, float sc) {
    const int nblk = N / 32, kb = item / nblk, nb = item % nblk, k0 = 64 * kb, n0 = 32 * nb;
#pragma unroll 8
    for (int i = 0; i < 32; ++i) { const int kk = 2 * i + (lane >> 5); scr[kk * 33 + (lane & 31)] = W[(size_t)(k0 + kk) * N + n0 + (lane & 31)]; }
    LDS_WAIT(); asm volatile("" ::: "memory");
    const int c = lane & 7;
#pragma unroll
    for (int j = 0; j < 4; ++j) { const int n = (lane >> 3) + 8 * j; const LAS float* s = scr + (8 * c) * 33 + n;
        v2u o; o.x = pk4_fp8(s[0 * 33] * sc, s[1 * 33] * sc, s[2 * 33] * sc, s[3 * 33] * sc); o.y = pk4_fp8(s[4 * 33] * sc, s[5 * 33] * sc, s[6 * 33] * sc, s[7 * 33] * sc);
        int nd = n0 + n; if (mode) { const int half = nd >= dffx ? 1 : 0, i2 = nd - half * dffx; nd = 256 * (i2 >> 7) + 128 * half + (i2 & 127); }
        *(v2u*)(WT + (size_t)nd * K + k0 + 8 * c) = o; }
    LDS_WAIT(); asm volatile("" ::: "memory");
}
__device__ __forceinline__ void load_row_f32(const float* p, int lane, f32x4 (&v)[4]) {
#pragma unroll
    for (int j = 0; j < 4; ++j) v[j] = *(const f32x4*)(p + 4 * lane + 256 * j);
}
__device__ __forceinline__ void load_row_bf16(const bf16* p, int lane, f32x4 (&v)[4]) {
#pragma unroll
    for (int j = 0; j < 4; ++j) v[j] = unpack4(*(const v2u*)(p + 4 * lane + 256 * j));
}
__device__ __forceinline__ float row_ss(const f32x4 (&v)[4]) {
    float s = 0.f;
#pragma unroll
    for (int j = 0; j < 4; ++j) s += (v[j][0] * v[j][0] + v[j][1] * v[j][1]) + (v[j][2] * v[j][2] + v[j][3] * v[j][3]);
    return wave_sum(s);
}
__device__ __forceinline__ void prenorm_mod(f32x4 (&v)[4], const float* npre, const float* sc, const float* sh, int lane) {
    const float rr = rsqrtf(row_ss(v) * (1.0f / DM) + EPS);
#pragma unroll
    for (int j = 0; j < 4; ++j) { const int col = 4 * lane + 256 * j; const f32x4 w4 = *(const f32x4*)(npre + col), s4 = *(const f32x4*)(sc + col), h4 = *(const f32x4*)(sh + col);
        v[j] = (v[j] * rr * w4) * (s4 + 1.0f) + h4; }
}
__device__ __forceinline__ void store_row_bf16(bf16* p, int lane, const f32x4 (&v)[4]) {
#pragma unroll
    for (int j = 0; j < 4; ++j) *(v2u*)(p + 4 * lane + 256 * j) = pack4(v[j]);
}
__device__ __forceinline__ const float* mod_vec(Frame& F, int layer, int row, int chunk) { return (const float*)(F.ws + WS_MOD) + ((size_t)(layer * 9 + row) * 6144 + chunk * 1024); }


struct CvtDesc { const float* W; void* WT; int K, N, item, mode, dffx, fp8; float sc; };
__device__ __forceinline__ void cvt_load(const CvtDesc& d, int lane, float (&v)[32]) {
    const int nblk = d.N / 32, kb = d.item / nblk, nb = d.item % nblk; const float* p = d.W + (size_t)(64 * kb + (lane >> 5)) * d.N + 32 * nb + (lane & 31);
#pragma unroll
    for (int i = 0; i < 32; ++i) v[i] = p[(size_t)(2 * i) * d.N];
}
__device__ __forceinline__ void cvt_finish(const CvtDesc& d, LAS float* scr, int lane, const float (&v)[32]) {
    const int nblk = d.N / 32, kb = d.item / nblk, nb = d.item % nblk, k0 = 64 * kb, n0 = 32 * nb;
#pragma unroll
    for (int i = 0; i < 32; ++i) scr[(2 * i + (lane >> 5)) * 33 + (lane & 31)] = v[i];
    LDS_WAIT(); asm volatile("" ::: "memory");
    const int c = lane & 7;
#pragma unroll
    for (int j = 0; j < 4; ++j) { const int n = (lane >> 3) + 8 * j; const LAS float* s = scr + (8 * c) * 33 + n;
        int nd = n0 + n; if (d.mode) { const int half = nd >= d.dffx ? 1 : 0, i2 = nd - half * d.dffx; nd = 256 * (i2 >> 7) + 128 * half + (i2 & 127); }
        if (d.fp8) { const float sc = d.sc; v2u o; o.x = pk4_fp8(s[0 * 33] * sc, s[1 * 33] * sc, s[2 * 33] * sc, s[3 * 33] * sc); o.y = pk4_fp8(s[4 * 33] * sc, s[5 * 33] * sc, s[6 * 33] * sc, s[7 * 33] * sc);
            *(v2u*)((unsigned char*)d.WT + (size_t)nd * d.K + k0 + 8 * c) = o; }
        else { v4u o; o.x = pk2(s[0 * 33], s[1 * 33]); o.y = pk2(s[2 * 33], s[3 * 33]); o.z = pk2(s[4 * 33], s[5 * 33]); o.w = pk2(s[6 * 33], s[7 * 33]);
            *(v4u*)((bf16*)d.WT + (size_t)nd * d.K + k0 + 8 * c) = o; } }
    LDS_WAIT(); asm volatile("" ::: "memory");
}
template <class Dec> __device__ __forceinline__ void cvt_stream(const Dec& dec, int total, int first, int stride, LAS float* scr, int lane) {
    int it = first; if (it >= total) return;
    float v[32]; dec(it, true, scr, lane, v);
    for (;;) {
        const int itn = it + stride; const bool hn = itn < total; float vn[32];
        if (hn) dec(itn, true, scr, lane, vn);
        dec(it, false, scr, lane, v);
        if (!hn) break;
        it = itn;
#pragma unroll
        for (int i = 0; i < 32; ++i) v[i] = vn[i];
    }
}
__device__ __forceinline__ void cvt_do(const CvtDesc& d, bool load, LAS float* scr, int lane, float (&v)[32]) { if (load) cvt_load(d, lane, v); else cvt_finish(d, scr, lane, v); }
__device__ __forceinline__ void p0_prologue(Frame& F) {
    LAS float* scr = (LAS float*)(F.lds + F.wave * 8448);
    LAS float* SIL = (LAS float*)(F.lds + 69632);
    LAS float* RED = (LAS float*)(F.lds + 69632 + 36864);
    if ((int)blockIdx.x < 192) {
        for (int idx = F.tid; idx < 9 * 1024; idx += NWAVES * 64) { const int r = idx >> 10, k = idx & 1023; const float cv = r < 8 ? F.in[I_C][r * 1024 + k] : F.in[I_CCTX][k]; SIL[idx] = silu_f(cv); }
        __syncthreads();
        for (int t = blockIdx.x; t < 192; t += F.G) {
            const int i = t / 96, col0 = 64 * (t % 96);
            const float* wp = F.in[I_ADAW] + ((size_t)i * 1024 + F.wave * 128) * 6144 + col0 + F.lane;
            float acc[9];
#pragma unroll
            for (int r = 0; r < 9; ++r) acc[r] = 0.f;
            for (int k8 = 0; k8 < 128; k8 += 8) {
                float wv[8];
#pragma unroll
                for (int q = 0; q < 8; ++q) wv[q] = wp[(size_t)(k8 + q) * 6144];
#pragma unroll
                for (int q = 0; q < 8; ++q)
#pragma unroll
                    for (int r = 0; r < 9; ++r) acc[r] += SIL[r * 1024 + F.wave * 128 + k8 + q] * wv[q];
            }
#pragma unroll
            for (int r = 0; r < 9; ++r) RED[(F.wave * 9 + r) * 64 + F.lane] = acc[r];
            __syncthreads();
            for (int idx = F.tid; idx < 576; idx += NWAVES * 64) { const int r = idx >> 6, ln = idx & 63; float s = 0.f;
#pragma unroll
                for (int w = 0; w < 8; ++w) s += RED[(w * 9 + r) * 64 + ln];
                ((float*)(F.ws + WS_MOD))[(size_t)(i * 9 + r) * 6144 + col0 + ln] = s + F.in[I_ADAB][i * 6144 + col0 + ln]; }
            __syncthreads();
        }
    }
    const int gw = blockIdx.x * NWAVES + F.wave, NGW = F.G * NWAVES;
    constexpr int I0 = 16 * 194, I1 = 32 * 32, I2 = 16 * 176, I3 = 44 * 32, I4 = 16 * 96, I5 = 16 * 32;
    { const float* w0 = F.in[I_SWIN]; const float* w1 = F.in[I_SWOUT]; const float* w2 = F.in[I_FGU]; const float* w3 = F.in[I_FDN]; const float* w4 = F.in[I_SCWIN]; const float* w5 = F.in[I_SCWOUT]; unsigned char* ws = F.ws;
      auto dec = [w0, w1, w2, w3, w4, w5, ws](int it, bool load, LAS float* scr_, int lane_, float (&v)[32]) { CvtDesc d; d.mode = 0; d.dffx = 0; d.fp8 = 0; d.sc = 1.f; int r = it;
          if (r < I0) { d.W = w0; d.WT = ws + WS_WIN; d.K = 1024; d.N = DINP; d.item = r; cvt_do(d, load, scr_, lane_, v); return; } r -= I0;
          if (r < I1) { d.W = w1; d.WT = ws + WS_WOUT; d.K = 2048; d.N = 1024; d.item = r; cvt_do(d, load, scr_, lane_, v); return; } r -= I1;
          if (r < I2) { d.W = w2; d.WT = ws + WS_WGU; d.K = 1024; d.N = 2 * DFF; d.item = r; d.mode = 1; d.dffx = DFF; d.fp8 = FFN_FP8; d.sc = FFN_FP8 ? WGU_SCALE : 1.f; cvt_do(d, load, scr_, lane_, v); return; } r -= I2;
          if (r < I3) { d.W = w3; d.WT = ws + WS_WDN; d.K = DFF; d.N = 1024; d.item = r; d.fp8 = FFN_FP8; d.sc = FFN_FP8 ? WDN_SCALE : 1.f; cvt_do(d, load, scr_, lane_, v); return; } r -= I3;
          if (r < I4) { d.W = w4; d.WT = ws + WS_WSCI; d.K = 1024; d.N = 3072; d.item = r; cvt_do(d, load, scr_, lane_, v); return; } r -= I4;
          d.W = w5; d.WT = ws + WS_WSCO; d.K = 1024; d.N = 1024; d.item = r; cvt_do(d, load, scr_, lane_, v); };
      cvt_stream(dec, I0 + I1 + I2 + I3 + I4 + I5, gw, NGW, scr, F.lane); }
    { v4u* zp = (v4u*)((bf16*)(F.ws + WS_WIN) + (size_t)DINP * 1024); const int n16 = (DINP_PAD - DINP) * 1024 / 8;
      for (int i = blockIdx.x * (NWAVES * 64) + F.tid; i < n16; i += F.G * NWAVES * 64) zp[i] = (v4u){0u, 0u, 0u, 0u}; }
}
__device__ __forceinline__ void p1_prenorm(Frame& F) {
    const int gw = blockIdx.x * NWAVES + F.wave, NGW = F.G * NWAVES;
    bf16* H = (bf16*)(F.ws + WS_H);
    for (int r = gw; r < MALL; r += NGW) {
        const float* src = r < MLAT ? F.in[I_X] + (size_t)r * DM : F.in[I_CTX] + (size_t)(r - MLAT) * DM; const int mr = r < MLAT ? (r >> 12) : 8;
        f32x4 v[4]; load_row_f32(src, F.lane, v);
        prenorm_mod(v, F.in[I_NPRE], mod_vec(F, 0, mr, 1), mod_vec(F, 0, mr, 0), F.lane);
        store_row_bf16(H + (size_t)r * DM, F.lane, v);
    }
}
template <bool NEXT, bool H8OUT = false>
__device__ __forceinline__ void resnorm_phase(Frame& F, const float* xin, int layer, int gchunk, const float* npost, const float* npre, int nlayer, int scchunk, int shchunk) {
    const int gw = blockIdx.x * NWAVES + F.wave, NGW = F.G * NWAVES;
    const bf16* Y = (const bf16*)(F.ws + WS_Y); bf16* H = (bf16*)(F.ws + WS_H);
    for (int r = gw; r < MLAT; r += NGW) {
        const int b = r >> 12;
        f32x4 y[4], x[4]; load_row_bf16(Y + (size_t)r * DM, F.lane, y); load_row_f32(xin + (size_t)r * DM, F.lane, x);
        const float rr = rsqrtf(row_ss(y) * (1.0f / DM) + EPS); const float* gt = mod_vec(F, layer, b, gchunk);
#pragma unroll
        for (int j = 0; j < 4; ++j) { const int col = 4 * F.lane + 256 * j; x[j] = x[j] + *(const f32x4*)(gt + col) * ((y[j] * rr) * *(const f32x4*)(npost + col)); *(f32x4*)(F.out + (size_t)r * DM + col) = x[j]; }
        if (NEXT) { prenorm_mod(x, npre, mod_vec(F, nlayer, b, scchunk), mod_vec(F, nlayer, b, shchunk), F.lane);
            if (H8OUT) {
#pragma unroll
                for (int j = 0; j < 4; ++j) *(unsigned*)((unsigned char*)H + (size_t)r * DM + 4 * F.lane + 256 * j) = pk4_fp8(x[j][0], x[j][1], x[j][2], x[j][3]); }
            else store_row_bf16(H + (size_t)r * DM, F.lane, x); }
    }
}

__device__ __forceinline__ int ssd_sidx(int b, int cs, int g) { return (b * 34 + cs) * 8 + g; }
__device__ __forceinline__ void dt_scan(const float* DTR, int r0, int dcol, float bias, float A, int lane, float (&dt)[2], float (&dA)[2], float (&inc)[2], float& total) {
#pragma unroll
    for (int h = 0; h < 2; ++h) { const float x = DTR[(size_t)(r0 + lane + 64 * h) * 64 + dcol] + bias; dt[h] = x > 20.f ? x : log1pf(__expf(x)); dA[h] = dt[h] * A; }
    float s0 = dA[0], s1 = dA[1];
#pragma unroll
    for (int o = 1; o < 64; o <<= 1) { const float t0 = __shfl_up(s0, o), t1 = __shfl_up(s1, o); if (lane >= o) { s0 += t0; s1 += t1; } }
    const float tot0 = __shfl(s0, 63); s1 += tot0; inc[0] = s0; inc[1] = s1; total = __shfl(s1, 63);
}
__device__ __forceinline__ void ssd_phase_a(Frame& F, const int dry) {
    LAS unsigned char* XI = F.lds; LAS unsigned char* BI = F.lds + XI_BYTES; LAS float* WS = (LAS float*)(F.lds + SCAL_OFF);
    const int lane = F.lane, w = F.wave, gq = lane >> 4, q4 = (lane & 15) >> 2, p4 = lane & 3, l15 = lane & 15;
    const LAS unsigned char* trX = XI + (8 * gq + q4) * PXB + 8 * p4; const LAS unsigned char* trB = BI + (8 * gq + q4) * PBB + 8 * p4;
    bf16* XBC = (bf16*)(F.ws + WS_XBC); const float* DTR = (const float*)(F.ws + WS_DT); bf16* S = (bf16*)(F.ws + WS_S); float* CD = (float*)(F.ws + WS_CD);
    for (int u = blockIdx.x; u < NUNIT; u += F.G) {
        int b, cs, g; bool isctx;
        if (u < NUNIT_LAT) { b = u >> 8; cs = (u >> 3) & 31; g = u & 7; isctx = false; } else { const int v = u - NUNIT_LAT; b = v >> 4; cs = 32 + ((v >> 3) & 1); g = v & 7; isctx = true; }
        const int r0 = isctx ? MLAT + b * CTXL + (cs - 32) * 128 : b * SEQ + cs * 128, sidx = ssd_sidx(b, cs, g);
        const int col = lane < 32 ? g * 256 + 8 * lane : (lane < 48 ? 2048 + g * 128 + 8 * (lane - 32) : 3072 + g * 128 + 8 * (lane - 48));
        const int l0 = 16 * w; int lo, hi; if (isctx) { lo = -(cs - 32) * 128; hi = lo + 255; } else { lo = l0 & ~63; hi = lo + 63; }
        v4u raw[20];
#pragma unroll
        for (int i = 0; i < 20; ++i) { const int lp = l0 - 2 + i; raw[i] = (lp >= lo && lp <= hi) ? *(const v4u*)(XBC + (long)(r0 + lp) * CONVD + col) : (v4u){0u, 0u, 0u, 0u}; }
        f32x2n wt[5][4], bs[4];
#pragma unroll
        for (int t = 0; t < 5; ++t) { const f32x4 a = *(const f32x4*)(F.in[I_SCONVW] + t * CONVD + col), c4 = *(const f32x4*)(F.in[I_SCONVW] + t * CONVD + col + 4);
            wt[t][0] = (f32x2n){a[0], a[1]}; wt[t][1] = (f32x2n){a[2], a[3]}; wt[t][2] = (f32x2n){c4[0], c4[1]}; wt[t][3] = (f32x2n){c4[2], c4[3]}; }
        { const f32x4 a = *(const f32x4*)(F.in[I_SCONVB] + col), c4 = *(const f32x4*)(F.in[I_SCONVB] + col + 4);
          bs[0] = (f32x2n){a[0], a[1]}; bs[1] = (f32x2n){a[2], a[3]}; bs[2] = (f32x2n){c4[0], c4[1]}; bs[3] = (f32x2n){c4[2], c4[3]}; }
        VM_WAIT(); LDS_BARRIER();
        f32x2n f[5][4];
#define UNPK_ROW(dst, rw) do { dst[0] = (f32x2n){bflo(rw.x), bfhi(rw.x)}; dst[1] = (f32x2n){bflo(rw.y), bfhi(rw.y)}; dst[2] = (f32x2n){bflo(rw.z), bfhi(rw.z)}; dst[3] = (f32x2n){bflo(rw.w), bfhi(rw.w)}; } while (0)
#pragma unroll
        for (int i = 0; i < 4; ++i) UNPK_ROW(f[i], raw[i]);
#pragma unroll
        for (int i = 0; i < 16; ++i) {
            UNPK_ROW(f[(i + 4) % 5], raw[i + 4]);
            unsigned ow[4];
#pragma unroll
            for (int e = 0; e < 4; ++e) { f32x2n a = bs[e];
#pragma unroll
                for (int t = 0; t < 5; ++t) a = wt[t][e] * f[(i + t) % 5][e] + a;
                ow[e] = pk2(silu_f(a.x), silu_f(a.y)); }
            const v4u ov = {ow[0], ow[1], ow[2], ow[3]};
            const int l = l0 + i;
            if (lane < 32) *(LAS v4u*)(XI + l * PXB + 16 * lane) = ov; else if (lane < 48) *(LAS v4u*)(BI + l * PBB + 16 * (lane - 32)) = ov;
            if (!isctx && !dry) *(v4u*)(XBC + (size_t)(r0 + l) * CONVD + col) = ov;
        }
#undef UNPK_ROW
        { const int d = w >> 2, hh = g * 4 + (w & 3); float dt[2], dA[2], inc[2], total;
          dt_scan(DTR, r0, d * 32 + hh, F.in[I_SDTB][d * 32 + hh], -__expf(F.in[I_SALOG][d * 32 + hh]), lane, dt, dA, inc, total);
#pragma unroll
          for (int h = 0; h < 2; ++h) WS[w * 128 + lane + 64 * h] = dt[h] * (d == 0 ? __expf(total - inc[h]) : __expf(inc[h] - dA[h]));
          if (lane == 0) CD[sidx * 8 + w] = __expf(total); }
        LDS_BARRIER();
        bf16x8 bt[4];
#pragma unroll
        for (int ks = 0; ks < 4; ++ks) bt[ks] = tr_pair(trB + (32 * ks) * PBB + 32 * w, trB + (32 * ks + 4) * PBB + 32 * w);
#pragma unroll 1
        for (int j = 0; j < (dry == 2 ? 0 : 4); ++j) {
            bf16x8 as_[2][4];
#pragma unroll
            for (int d = 0; d < 2; ++d) {
                const int combo = d * 4 + j;
#pragma unroll
                for (int ks = 0; ks < 4; ++ks) { const f32x4 w0 = *(const LAS f32x4*)(WS + combo * 128 + 32 * ks + 8 * gq), w1 = *(const LAS f32x4*)(WS + combo * 128 + 32 * ks + 8 * gq + 4);
                    const bf16x8 r8 = bt[ks]; bf16x8 o8;
                    const unsigned u0 = pk2(bf1((bf16)r8[0]) * w0[0], bf1((bf16)r8[1]) * w0[1]), u1 = pk2(bf1((bf16)r8[2]) * w0[2], bf1((bf16)r8[3]) * w0[3]);
                    const unsigned u2 = pk2(bf1((bf16)r8[4]) * w1[0], bf1((bf16)r8[5]) * w1[1]), u3 = pk2(bf1((bf16)r8[6]) * w1[2], bf1((bf16)r8[7]) * w1[3]);
                    o8[0] = (short)(u0 & 0xffff); o8[1] = (short)(u0 >> 16); o8[2] = (short)(u1 & 0xffff); o8[3] = (short)(u1 >> 16); o8[4] = (short)(u2 & 0xffff); o8[5] = (short)(u2 >> 16); o8[6] = (short)(u3 & 0xffff); o8[7] = (short)(u3 >> 16);
                    as_[d][ks] = o8; }
            }
#pragma unroll
            for (int pt = 0; pt < 4; ++pt) {
                bf16x8 xf[4];
#pragma unroll
                for (int ks = 0; ks < 4; ++ks) xf[ks] = tr_pair(trX + (32 * ks) * PXB + (j * 64 + pt * 16) * 2, trX + (32 * ks + 4) * PXB + (j * 64 + pt * 16) * 2);
#pragma unroll
                for (int d = 0; d < 2; ++d) { const int combo = d * 4 + j; f32x4 acc = {0.f, 0.f, 0.f, 0.f};
#pragma unroll
                    for (int ks = 0; ks < 4; ++ks) acc = MFMA16(as_[d][ks], xf[ks], acc);
                    *(v2u*)(S + ((size_t)(sidx * 8 + combo) * 64 + pt * 16 + l15) * 128 + 16 * w + 4 * gq) = pack4(acc); }
            }
        }
        LDS_BARRIER();
    }
}
__device__ __forceinline__ void ssd_phase_b(Frame& F) {
    bf16* S = (bf16*)(F.ws + WS_S); const float* CD = (const float*)(F.ws + WS_CD);
    const int NT = F.G * NWAVES * 64;
    for (int q = blockIdx.x * (NWAVES * 64) + F.tid; q < 512 * 1024; q += NT) {
        const int e8 = q & 1023, seq = q >> 10, combo = seq & 7, g = (seq >> 3) & 7, b = seq >> 6, d = combo >> 2;
        float h[8];
#pragma unroll
        for (int e = 0; e < 8; ++e) h[e] = 0.f;
#pragma unroll
        for (int k = 0; k < 2; ++k) { const int cs = d == 0 ? 32 + k : 33 - k, si = ssd_sidx(b, cs, g) * 8 + combo; const float dec = CD[si]; const v4u t = *(const v4u*)(S + (size_t)si * 8192 + e8 * 8);
            h[0] = dec * h[0] + bflo(t.x); h[1] = dec * h[1] + bfhi(t.x); h[2] = dec * h[2] + bflo(t.y); h[3] = dec * h[3] + bfhi(t.y); h[4] = dec * h[4] + bflo(t.z); h[5] = dec * h[5] + bfhi(t.z); h[6] = dec * h[6] + bflo(t.w); h[7] = dec * h[7] + bfhi(t.w); }
        for (int c0 = 0; c0 < 32; c0 += 8) {
            v4u t[8]; float dc[8];
#pragma unroll
            for (int k = 0; k < 8; ++k) { const int cs = d == 0 ? c0 + k : 31 - (c0 + k), si = ssd_sidx(b, cs, g) * 8 + combo; dc[k] = CD[si]; t[k] = *(const v4u*)(S + (size_t)si * 8192 + e8 * 8); }
#pragma unroll
            for (int k = 0; k < 8; ++k) { const int cs = d == 0 ? c0 + k : 31 - (c0 + k), si = ssd_sidx(b, cs, g) * 8 + combo;
                v4u o; o.x = pk2(h[0], h[1]); o.y = pk2(h[2], h[3]); o.z = pk2(h[4], h[5]); o.w = pk2(h[6], h[7]);
                *(v4u*)(S + (size_t)si * 8192 + e8 * 8) = o;
                const float dec = dc[k]; const v4u tt = t[k];
                h[0] = dec * h[0] + bflo(tt.x); h[1] = dec * h[1] + bfhi(tt.x); h[2] = dec * h[2] + bflo(tt.y); h[3] = dec * h[3] + bfhi(tt.y); h[4] = dec * h[4] + bflo(tt.z); h[5] = dec * h[5] + bfhi(tt.z); h[6] = dec * h[6] + bflo(tt.w); h[7] = dec * h[7] + bfhi(tt.w); }
        }
    }
}
__device__ __forceinline__ void ssd_phase_c(Frame& F, const int dry) {
    LAS unsigned char* XI = F.lds; LAS unsigned char* BI = F.lds + XI_BYTES; LAS unsigned char* MWw = F.lds + XI_BYTES + BI_BYTES + F.wave * (16 * PMB);
    LAS float* DTS = (LAS float*)(F.lds + SCAL_OFF); LAS float* INC = DTS + 1024; LAS float* EXC = DTS + 2048; LAS float* BPw = (LAS float*)(F.lds + BPW_OFF) + F.wave * 128;
    const int tid = F.tid, lane = F.lane, w = F.wave, gq = lane >> 4, q4 = (lane & 15) >> 2, p4 = lane & 3, l15 = lane & 15, lme = 16 * w + l15;
    const LAS unsigned char* trX = XI + (8 * gq + q4) * PXB + 8 * p4;
    const bf16* XBC = (const bf16*)(F.ws + WS_XBC); const float* DTR = (const float*)(F.ws + WS_DT); const bf16* HIN = (const bf16*)(F.ws + WS_S); bf16* Z = (bf16*)(F.ws + WS_Z);
    for (int u = blockIdx.x; u < NUNIT_LAT; u += F.G) {
        const int b = u >> 8, c = (u >> 3) & 31, g = u & 7, r0 = b * SEQ + c * 128, sidx = ssd_sidx(b, c, g);
#pragma unroll
        for (int k = 0; k < 8; ++k) { const int id = tid + 512 * k, row = id >> 5, ch = id & 31; *(LAS v4u*)(XI + row * PXB + 16 * ch) = *(const v4u*)(XBC + (size_t)(r0 + row) * CONVD + g * 256 + 8 * ch); }
#pragma unroll
        for (int k = 0; k < 4; ++k) { const int id = tid + 512 * k, row = id >> 4, ch = id & 15; *(LAS v4u*)(BI + row * PBB + 16 * ch) = *(const v4u*)(XBC + (size_t)(r0 + row) * CONVD + 2048 + g * 128 + 8 * ch); }
        bf16x8 cf[4];
#pragma unroll
        for (int ks = 0; ks < 4; ++ks) cf[ks] = *(const bf16x8*)(XBC + (size_t)(r0 + lme) * CONVD + 3072 + g * 128 + 32 * ks + 8 * gq);
        v4u hp[2];
        const bf16* hbase = HIN + (size_t)sidx * 8 * 8192;
#pragma unroll
        for (int k = 0; k < 2; ++k) { const int id = tid + 512 * k; hp[k] = *(const v4u*)(hbase + (size_t)(id >> 4) * 128 + 8 * (id & 15)); }
        { const int d = w >> 2, hh = g * 4 + (w & 3); float dt[2], dA[2], inc[2], total;
          dt_scan(DTR, r0, d * 32 + hh, F.in[I_SDTB][d * 32 + hh], -__expf(F.in[I_SALOG][d * 32 + hh]), lane, dt, dA, inc, total);
#pragma unroll
          for (int h = 0; h < 2; ++h) { DTS[w * 128 + lane + 64 * h] = dt[h]; INC[w * 128 + lane + 64 * h] = inc[h]; EXC[w * 128 + lane + 64 * h] = inc[h] - dA[h]; } }
        LDS_BARRIER();
        f32x4 Gt[8];
#pragma unroll
        for (int st = 0; st < 8; ++st) { f32x4 a = {0.f, 0.f, 0.f, 0.f};
#pragma unroll
            for (int ks = 0; ks < 4; ++ks) a = MFMA16(*(const LAS bf16x8*)(BI + (16 * st + l15) * PBB + (32 * ks + 8 * gq) * 2), cf[ks], a);
            Gt[st] = a; }
        LDS_BARRIER();
        LAS unsigned char* HB0 = BI; LAS unsigned char* HB1 = BI + 64 * PBB;
#pragma unroll
        for (int k = 0; k < 2; ++k) { const int id = tid + 512 * k; *(LAS v4u*)(HB0 + (id >> 4) * PBB + 16 * (id & 15)) = hp[k]; }
        v4u hq[2];
#pragma unroll
        for (int k = 0; k < 2; ++k) { const int id = tid + 512 * k; hp[k] = *(const v4u*)(hbase + 4 * 8192 + (size_t)(id >> 4) * 128 + 8 * (id & 15));
                                      hq[k] = *(const v4u*)(hbase + 1 * 8192 + (size_t)(id >> 4) * 128 + 8 * (id & 15)); }
        LDS_BARRIER();
        float ssq = 0.f;
#pragma unroll 1
        for (int j = 0; j < 4; ++j) {
            f32x4 Y[4]; v2u zr[4];
#pragma unroll
            for (int pt = 0; pt < 4; ++pt) { Y[pt] = (f32x4){0.f, 0.f, 0.f, 0.f}; zr[pt] = *(const v2u*)(Z + (size_t)(r0 + lme) * DIN + g * 256 + j * 64 + pt * 16 + 4 * gq); }
#pragma unroll 1
            for (int d = 0; d < (dry == 2 ? 0 : 2); ++d) {
                const int combo = d * 4 + j, ci = 2 * j + d;
                LAS unsigned char* HBc = (ci & 1) ? HB1 : HB0; LAS unsigned char* HBn = (ci & 1) ? HB0 : HB1;
                if (ci < 7) {
#pragma unroll
                    for (int k = 0; k < 2; ++k) { const int id = tid + 512 * k; *(LAS v4u*)(HBn + (id >> 4) * PBB + 16 * (id & 15)) = hp[k]; }
#pragma unroll
                    for (int k = 0; k < 2; ++k) hp[k] = hq[k];
                    if (ci < 5) { const int cn = ci + 3, combn = (cn & 1) * 4 + (cn >> 1);
#pragma unroll
                        for (int k = 0; k < 2; ++k) { const int id = tid + 512 * k; hq[k] = *(const v4u*)(hbase + (size_t)combn * 8192 + (size_t)(id >> 4) * 128 + 8 * (id & 15)); } }
                }
                const LAS float* U = (d ? EXC : INC) + combo * 128; const LAS float* DTc = DTS + combo * 128;
                const float tot = INC[combo * 128 + 127], u_l = U[lme]; const int kd = w >> 1;
                const float u_ref = d ? (kd == 3 ? tot : U[32 * kd + 32]) : (kd == 0 ? 0.f : U[32 * kd - 1]);
                const float a_l = __expf(d ? (u_ref - u_l) : (u_l - u_ref)), e_ref = __expf(d ? (tot - u_ref) : u_ref);
#pragma unroll
                for (int h = 0; h < 2; ++h) { const int s = lane + 64 * h; const float ar = d ? (U[s] - u_ref) : (u_ref - U[s]); BPw[s] = __expf(fminf(ar, 0.f)) * DTc[s]; }
                f32x4 Yp[4];
#pragma unroll
                for (int pt = 0; pt < 4; ++pt) { f32x4 a = {0.f, 0.f, 0.f, 0.f};
#pragma unroll
                    for (int ks = 0; ks < 4; ++ks) a = MFMA16(*(const LAS bf16x8*)(HBc + (16 * pt + l15) * PBB + (32 * ks + 8 * gq) * 2), cf[ks], a);
                    Yp[pt] = a * e_ref; }
#pragma unroll
                for (int ks = 0; ks < 4; ++ks) {
                    const bool offd = d ? (ks > kd) : (ks < kd);
                    if (offd) {
#pragma unroll
                        for (int t2 = 0; t2 < 2; ++t2) { const int st = 2 * ks + t2, s0 = 16 * st + 4 * gq; const f32x4 bp = *(const LAS f32x4*)(BPw + s0);
                            *(LAS v2u*)(MWw + l15 * PMB + s0 * 2) = pack4(Gt[st] * bp); }
                        const bf16x8 mb = *(const LAS bf16x8*)(MWw + l15 * PMB + (32 * ks + 8 * gq) * 2);
#pragma unroll
                        for (int pt = 0; pt < 4; ++pt) { const bf16x8 xa = tr_pair(trX + (32 * ks) * PXB + (j * 64 + pt * 16) * 2, trX + (32 * ks + 4) * PXB + (j * 64 + pt * 16) * 2);
                            Yp[pt] = MFMA16(xa, mb, Yp[pt]); }
                    }
                }
#pragma unroll
                for (int pt = 0; pt < 4; ++pt) Y[pt] = Y[pt] + Yp[pt] * a_l;
#pragma unroll
                for (int ks = 0; ks < 4; ++ks) if (ks == kd) {
#pragma unroll
                    for (int t2 = 0; t2 < 2; ++t2) { const int st = 2 * ks + t2, s0 = 16 * st + 4 * gq; const f32x4 u_s = *(const LAS f32x4*)(U + s0), dt_s = *(const LAS f32x4*)(DTc + s0);
                        f32x4 val;
#pragma unroll
                        for (int e = 0; e < 4; ++e) { const int s = s0 + e; const bool valid = d ? (s >= lme) : (s <= lme); const float arg = d ? (u_s[e] - u_l) : (u_l - u_s[e]);
                            val[e] = valid ? Gt[st][e] * __expf(arg) * dt_s[e] : 0.f; }
                        *(LAS v2u*)(MWw + l15 * PMB + s0 * 2) = pack4(val); }
                    const bf16x8 mb = *(const LAS bf16x8*)(MWw + l15 * PMB + (32 * ks + 8 * gq) * 2);
#pragma unroll
                    for (int pt = 0; pt < 4; ++pt) { const bf16x8 xa = tr_pair(trX + (32 * ks) * PXB + (j * 64 + pt * 16) * 2, trX + (32 * ks + 4) * PXB + (j * 64 + pt * 16) * 2);
                        Y[pt] = MFMA16(xa, mb, Y[pt]); }
                }
                LDS_BARRIER();
            }
            const float dsk = F.in[I_SD][g * 4 + j];
#pragma unroll
            for (int pt = 0; pt < 4; ++pt) { const int ch = j * 64 + pt * 16 + 4 * gq;
                const f32x4 xv = unpack4(*(const LAS v2u*)(XI + lme * PXB + ch * 2)), zv = unpack4(zr[pt]);
                f32x4 y = Y[pt] + xv * dsk;
#pragma unroll
                for (int e = 0; e < 4; ++e) { y[e] = y[e] * silu_f(zv[e]); ssq += y[e] * y[e]; }
                *(LAS v2u*)(XI + lme * PXB + ch * 2) = pack4(y); }
        }
        ssq += __shfl_xor(ssq, 16); ssq += __shfl_xor(ssq, 32);
        const float rr = rsqrtf(ssq * (1.0f / 256.0f) + EPS);
#pragma unroll
        for (int j = 0; j < 4; ++j)
#pragma unroll
            for (int pt = 0; pt < 4; ++pt) { const int cl = j * 64 + pt * 16 + 4 * gq, ch = g * 256 + cl; const f32x4 nw = *(const f32x4*)(F.in[I_SNORM] + ch);
                if (!dry) *(v2u*)(Z + (size_t)(r0 + lme) * DIN + ch) = pack4(unpack4(*(const LAS v2u*)(XI + lme * PXB + cl * 2)) * rr * nw); }
        LDS_BARRIER();
    }
}

__device__ __forceinline__ void p12_shortconv(Frame& F) {
    const bf16* P = (const bf16*)(F.ws + WS_SCP); bf16* U = (bf16*)(F.ws + WS_H); const float* cw = F.in[I_SCCONV];
    const int NT = F.G * NWAVES * 64;
    for (int id = blockIdx.x * (NWAVES * 64) + F.tid; id < MLAT * 128; id += NT) {
        const int r = id >> 7, col = 8 * (id & 127), xpos = r & 63;
        float acc[8];
#pragma unroll
        for (int e = 0; e < 8; ++e) acc[e] = 0.f;
#pragma unroll
        for (int t = 0; t < 3; ++t) { const int xp = xpos + t - 1; if (xp >= 0 && xp < 64) {
            const v4u gc = *(const v4u*)(P + (size_t)(r + t - 1) * 3072 + 1024 + col), vv = *(const v4u*)(P + (size_t)(r + t - 1) * 3072 + 2048 + col);
            const f32x4 w0 = *(const f32x4*)(cw + t * 1024 + col), w1 = *(const f32x4*)(cw + t * 1024 + col + 4);
            acc[0] += w0[0] * (bflo(gc.x) * bflo(vv.x)); acc[1] += w0[1] * (bfhi(gc.x) * bfhi(vv.x)); acc[2] += w0[2] * (bflo(gc.y) * bflo(vv.y)); acc[3] += w0[3] * (bfhi(gc.y) * bfhi(vv.y));
            acc[4] += w1[0] * (bflo(gc.z) * bflo(vv.z)); acc[5] += w1[1] * (bfhi(gc.z) * bfhi(vv.z)); acc[6] += w1[2] * (bflo(gc.w) * bflo(vv.w)); acc[7] += w1[3] * (bfhi(gc.w) * bfhi(vv.w)); } }
        const v4u gb = *(const v4u*)(P + (size_t)r * 3072 + col);
        v4u o; o.x = pk2(bflo(gb.x) * acc[0], bfhi(gb.x) * acc[1]); o.y = pk2(bflo(gb.y) * acc[2], bfhi(gb.y) * acc[3]); o.z = pk2(bflo(gb.z) * acc[4], bfhi(gb.z) * acc[5]); o.w = pk2(bflo(gb.w) * acc[6], bfhi(gb.w) * acc[7]);
        *(v4u*)(U + (size_t)r * DM + col) = o;
    }
}

__device__ __forceinline__ void p14_resnorm_route(Frame& F) {
    LAS float* RW = (LAS float*)F.lds;
    LAS int* SEL = (LAS int*)(F.lds + 32768);
    const bf16* Y = (const bf16*)(F.ws + WS_Y); unsigned char* H8 = (unsigned char*)(F.ws + WS_H);
    int* SELR = (int*)(F.ws + WS_ROUTE + RT_SELR); float* GATE = (float*)(F.ws + WS_ROUTE + RT_GATE); int* CNT = (int*)(F.ws + WS_ROUTE + RT_CNT);
    for (int i = F.tid; i < 8192; i += NWAVES * 64) RW[i] = F.in[I_ROUTER][i];
    __syncthreads();
    const float* npost = F.in[I_NPOST] + 2 * 1024; const float* npre = F.in[I_NPRE] + 3 * 1024;
    for (int vb = blockIdx.x; vb < 256; vb += F.G) {
        for (int i = 0; i < 16; ++i) {
            const int tl = 16 * F.wave + i, r = 128 * vb + tl, b = r >> 12;
            f32x4 y[4], x[4]; load_row_bf16(Y + (size_t)r * DM, F.lane, y); load_row_f32(F.out + (size_t)r * DM, F.lane, x);
            const float rr = rsqrtf(row_ss(y) * (1.0f / DM) + EPS); const float* gt = mod_vec(F, 1, b, 2);
#pragma unroll
            for (int j = 0; j < 4; ++j) { const int col = 4 * F.lane + 256 * j; x[j] = x[j] + *(const f32x4*)(gt + col) * ((y[j] * rr) * *(const f32x4*)(npost + col)); *(f32x4*)(F.out + (size_t)r * DM + col) = x[j]; }
            prenorm_mod(x, npre, mod_vec(F, 1, b, 4), mod_vec(F, 1, b, 3), F.lane);
#pragma unroll
            for (int j = 0; j < 4; ++j) *(unsigned*)(H8 + (size_t)r * DM + 4 * F.lane + 256 * j) = pk4_fp8(x[j][0], x[j][1], x[j][2], x[j][3]);
            float lg[8];
#pragma unroll
            for (int e = 0; e < 8; ++e) lg[e] = 0.f;
#pragma unroll
            for (int j = 0; j < 4; ++j)
#pragma unroll
                for (int q = 0; q < 4; ++q) { const int col = 4 * F.lane + 256 * j + q; const f32x4 r0 = *(const LAS f32x4*)(RW + col * 8), r1 = *(const LAS f32x4*)(RW + col * 8 + 4); const float hv = x[j][q];
                    lg[0] += hv * r0[0]; lg[1] += hv * r0[1]; lg[2] += hv * r0[2]; lg[3] += hv * r0[3]; lg[4] += hv * r1[0]; lg[5] += hv * r1[1]; lg[6] += hv * r1[2]; lg[7] += hv * r1[3]; }
#pragma unroll
            for (int e = 0; e < 8; ++e) lg[e] = wave_sum(lg[e]);
            int e0 = 0; float v0 = lg[0];
#pragma unroll
            for (int e = 1; e < 8; ++e) if (lg[e] > v0) { v0 = lg[e]; e0 = e; }
            int e1 = -1; float v1 = 0.f;
#pragma unroll
            for (int e = 0; e < 8; ++e) if (e != e0 && (e1 < 0 || lg[e] > v1)) { v1 = lg[e]; e1 = e; }
            if (F.lane == 0) { const float g0 = 1.0f / (1.0f + __expf(v1 - v0)); GATE[2 * r] = g0; GATE[2 * r + 1] = 1.0f - g0; SEL[2 * tl] = e0; SEL[2 * tl + 1] = e1; }
        }
        __syncthreads();
        if (F.tid < 8) { int cnt = 0;
            for (int t = 0; t < 256; ++t) if (SEL[t] == F.tid) { SELR[256 * vb + t] = F.tid | (cnt << 8); ++cnt; }
            CNT[vb * 8 + F.tid] = cnt; }
        __syncthreads();
    }
}
__device__ __forceinline__ void p15_permute(Frame& F) {
    LAS int* CNTL = (LAS int*)(F.lds + 69632);
    LAS int* PRE = CNTL + 2048;
    LAS int* TOT = PRE + 2048;
    LAS int* SEG = TOT + 8;
    const int* CNT = (const int*)(F.ws + WS_ROUTE + RT_CNT); const int* SELR = (const int*)(F.ws + WS_ROUTE + RT_SELR);
    int* POS = (int*)(F.ws + WS_ROUTE + RT_POS); int* TEXP = (int*)(F.ws + WS_ROUTE + RT_TEXP);
    const unsigned char* H8 = (const unsigned char*)(F.ws + WS_H); unsigned char* HP = (unsigned char*)(F.ws + WS_HP8);
    for (int i = F.tid; i < 2048; i += NWAVES * 64) CNTL[i] = CNT[i];
    __syncthreads();
    if (F.tid < 8) { int run = 0; for (int v = 0; v < 256; ++v) { PRE[v * 8 + F.tid] = run; run += CNTL[v * 8 + F.tid]; } TOT[F.tid] = run; }
    __syncthreads();
    if (F.tid == 0) { int ss = 0; for (int e = 0; e < 8; ++e) { SEG[e] = ss; ss += (TOT[e] + 255) & ~255; } SEG[8] = ss;
        if (blockIdx.x == 0) { for (int e = 0; e < 8; ++e) for (int t = SEG[e] >> 8; t < (SEG[e + 1] >> 8); ++t) TEXP[t] = e; TEXP[300] = ss >> 8; } }
    __syncthreads();
    for (int vb = blockIdx.x; vb < 256; vb += F.G) {
        for (int i = 0; i < 16; ++i) { const int tl = 16 * F.wave + i, r = 128 * vb + tl;
            const v4u a = *(const v4u*)(H8 + (size_t)r * DM + 16 * F.lane);
#pragma unroll
            for (int k = 0; k < 2; ++k) { const int sr = SELR[2 * r + k], e = sr & 255, pos = SEG[e] + PRE[vb * 8 + e] + (sr >> 8);
                *(v4u*)(HP + (size_t)pos * DM + 16 * F.lane) = a;
                if (F.lane == 0) POS[2 * r + k] = pos; } }
    }
    if ((int)blockIdx.x < 8) { const int e = blockIdx.x;
        for (int row = SEG[e] + TOT[e] + F.wave; row < SEG[e + 1]; row += NWAVES) *(v4u*)(HP + (size_t)row * DM + 16 * F.lane) = (v4u){0u, 0u, 0u, 0u}; }
    LAS float* scr = (LAS float*)(F.lds + F.wave * 8448);
    const int gw = blockIdx.x * NWAVES + F.wave, NGW = F.G * NWAVES;
    constexpr int IG = 16 * 224, ID = 56 * 32;
    { const float* mg = F.in[I_MGU]; const float* md = F.in[I_MDN]; unsigned char* ws = F.ws;
      auto dec = [mg, md, ws](int it, bool load, LAS float* scr_, int lane_, float (&v)[32]) { CvtDesc d; d.fp8 = 1; const int e = it / (IG + ID), r = it % (IG + ID);
          if (r < IG) { d.W = mg + (size_t)e * 1024 * 2 * DFFE; d.WT = ws + WS_WMGU + (size_t)e * 2 * DFFE * 1024; d.K = 1024; d.N = 2 * DFFE; d.item = r; d.mode = 1; d.dffx = DFFE; d.sc = WGU_SCALE; cvt_do(d, load, scr_, lane_, v); }
          else { d.W = md + (size_t)e * DFFE * 1024; d.WT = ws + WS_WMDN + (size_t)e * 1024 * DFFE; d.K = DFFE; d.N = 1024; d.item = r - IG; d.mode = 0; d.dffx = 0; d.sc = WDN_SCALE; cvt_do(d, load, scr_, lane_, v); } };
      cvt_stream(dec, 8 * (IG + ID), gw, NGW, scr, F.lane); }
}
__device__ __forceinline__ void p18_final(Frame& F) {
    const int gw = blockIdx.x * NWAVES + F.wave, NGW = F.G * NWAVES;
    const bf16* YP = (const bf16*)(F.ws + WS_YP); const int* POS = (const int*)(F.ws + WS_ROUTE + RT_POS); const float* GATE = (const float*)(F.ws + WS_ROUTE + RT_GATE);
    const float* npost = F.in[I_NPOST] + 3 * 1024;
    for (int r = gw; r < MLAT; r += NGW) {
        const int b = r >> 12, p0 = POS[2 * r], p1 = POS[2 * r + 1]; const float g0 = GATE[2 * r], g1 = GATE[2 * r + 1];
        f32x4 a[4], c[4], x[4]; load_row_bf16(YP + (size_t)p0 * DM, F.lane, a); load_row_bf16(YP + (size_t)p1 * DM, F.lane, c); load_row_f32(F.out + (size_t)r * DM, F.lane, x);
#pragma unroll
        for (int j = 0; j < 4; ++j) a[j] = a[j] * g0 + c[j] * g1;
        const float rr = rsqrtf(row_ss(a) * (1.0f / DM) + EPS); const float* gt = mod_vec(F, 1, b, 5);
#pragma unroll
        for (int j = 0; j < 4; ++j) { const int col = 4 * F.lane + 256 * j; *(f32x4*)(F.out + (size_t)r * DM + col) = x[j] + *(const f32x4*)(gt + col) * ((a[j] * rr) * *(const f32x4*)(npost + col)); }
    }
}

#define XB_TMO      128
#define XB_XCNT(j)  (256  + 64 * (j))
#define XB_XSUB(j)  (1280 + 64 * (j))
#define XB_XGEN(j)  (2304 + 64 * (j))
#define XB_TOP      3328
#define XB_TOPGEN   3392
#define XCD_BAR_WORDS 3456
#define XB_SPIN_CAP (1u << 18)

__device__ __forceinline__ unsigned xb_ld(unsigned* p)              { return __hip_atomic_load(p, __ATOMIC_RELAXED, __HIP_MEMORY_SCOPE_AGENT); }
__device__ __forceinline__ unsigned xb_add(unsigned* p, unsigned v) { return __hip_atomic_fetch_add(p, v, __ATOMIC_RELAXED, __HIP_MEMORY_SCOPE_AGENT); }
__device__ __forceinline__ unsigned xb_xcc_id() { return (unsigned)__builtin_amdgcn_s_getreg((3 << 11) | 20) & 0xFu; }
#define XB_SPIN(cond, bar) do { unsigned _sp = 0; while (cond) { __builtin_amdgcn_s_sleep(1); \
    if ((++_sp & 255u) == 0u) { if (xb_ld(&(bar)[XB_TMO])) break; if (_sp > XB_SPIN_CAP) { atomicAdd(&(bar)[XB_TMO], 1u); break; } } } } while (0)

struct XcdBarrier {
    unsigned* bar; unsigned x;
    volatile LAS unsigned* st;
};

__device__ __forceinline__ XcdBarrier xcd_barrier_post(unsigned* bar, volatile LAS unsigned* st) {
    XcdBarrier b; b.bar = bar; b.x = xb_xcc_id(); b.st = st;
    if (threadIdx.x == 0) (void)xb_add(&bar[XB_XCNT(b.x)], 1u);
    return b;
}
__device__ __forceinline__ void xcd_barrier_complete(unsigned* bar, unsigned x, unsigned& nloc, unsigned& nx) {
    const unsigned G = gridDim.x * gridDim.y * gridDim.z;
    unsigned sum, cnt, mine, sp = 0u;
    for (;;) {
        sum = 0u; cnt = 0u; mine = 0u;
#pragma unroll
        for (unsigned j = 0; j < 16; ++j) { const unsigned c = xb_ld(&bar[XB_XCNT(j)]); sum += c; cnt += (c > 0u) ? 1u : 0u; mine = (j == x) ? c : mine; }
        if (sum == G) break;
        __builtin_amdgcn_s_sleep(1);
        if ((++sp & 255u) == 0u) { if (xb_ld(&bar[XB_TMO])) break; if (sp > XB_SPIN_CAP) { atomicAdd(&bar[XB_TMO], 1u); break; } }
    }
    nloc = mine > 0u ? mine : 1u; nx = cnt > 0u ? cnt : 1u;
}

__device__ __forceinline__ void xcd_barrier(const XcdBarrier& b) {
    asm volatile("s_waitcnt vmcnt(0)" ::: "memory");
    __syncthreads();
    if (threadIdx.x == 0) {
        unsigned* bar = b.bar;
        __builtin_amdgcn_s_waitcnt(0);
        unsigned nloc = b.st[0], nx = b.st[1];
        if (nloc == 0u) { xcd_barrier_complete(bar, b.x, nloc, nx); b.st[0] = nloc; b.st[1] = nx; }
        const unsigned old = xb_add(&bar[XB_XSUB(b.x)], 1u);
        const unsigned gen = old / nloc;
        if (old + 1u == (gen + 1u) * nloc) {
            __builtin_amdgcn_fence(__ATOMIC_RELEASE, "agent");
            asm volatile("s_waitcnt vmcnt(0)" ::: "memory");
            const unsigned og = xb_add(&bar[XB_TOP], 1u);
            const unsigned tg = og / nx;
            if (og + 1u == (tg + 1u) * nx) xb_add(&bar[XB_TOPGEN], 1u);
            else XB_SPIN(xb_ld(&bar[XB_TOPGEN]) == tg, bar);
            __builtin_amdgcn_fence(__ATOMIC_ACQUIRE, "agent");
            xb_add(&bar[XB_XGEN(b.x)], 1u);
            asm volatile("s_waitcnt vmcnt(0)" ::: "memory");
        } else {
            XB_SPIN(xb_ld(&bar[XB_XGEN(b.x)]) == gen, bar);
            __builtin_amdgcn_fence(__ATOMIC_ACQUIRE, "agent");
            asm volatile("s_waitcnt vmcnt(0)" ::: "memory");
        }
    }
    __syncthreads();
}

#ifndef MK_DUMP
#define MK_DUMP 0
#endif
__device__ __forceinline__ void dump_phase(Frame& F) {
    const size_t NT = (size_t)F.G * NWAVES * 64, n = (size_t)MLAT * DM;
    for (size_t i = (size_t)blockIdx.x * (NWAVES * 64) + F.tid; i < n; i += NT) {
        float v = 0.f;
        if (MK_DUMP == 1) { v = bf1(((const bf16*)(F.ws + WS_H))[i]) + (i < (size_t)MCTX * DM ? bf1(((const bf16*)(F.ws + WS_H))[n + i]) : 0.f); }
        if (MK_DUMP == 2) { for (int k = 0; k < 4; ++k) v += bf1(((const bf16*)(F.ws + WS_XBC))[i + k * n]); for (int k = 0; k < 2; ++k) v += bf1(((const bf16*)(F.ws + WS_Z))[i + k * n]); if (i < (size_t)MALL * 64) v += ((const float*)(F.ws + WS_DT))[i]; }
        if (MK_DUMP == 3) { const size_t ns = (size_t)NUNIT * 8 * 8192; for (int k = 0; k < 5; ++k) if (i + k * n < ns) v += bf1(((const bf16*)(F.ws + WS_S))[i + k * n]); for (int k = 0; k < 4; ++k) v += bf1(((const bf16*)(F.ws + WS_XBC))[i + k * n]); if (i < (size_t)NUNIT * 8) v += ((const float*)(F.ws + WS_CD))[i]; }
        if (MK_DUMP == 4) { for (int k = 0; k < 2; ++k) v += bf1(((const bf16*)(F.ws + WS_Z))[i + k * n]); }
        if (MK_DUMP == 5) { v = bf1(((const bf16*)(F.ws + WS_Y))[i]); }
        F.out[i] = v;
    }
}

struct Args { const float* in[24]; float* out; unsigned char* ws; int ph_lo, ph_hi; };
__global__ void __launch_bounds__(NWAVES * 64, 2) fwd_kernel(Args args) {
    extern __shared__ __attribute__((aligned(16))) unsigned char lds[];
    Frame F;
    F.lds = (LAS unsigned char*)lds;
    F.MISC = (volatile LAS unsigned*)(F.lds + MISC_OFF);
    F.tid = threadIdx.x; F.lane = F.tid & 63; F.wave = __builtin_amdgcn_readfirstlane(F.tid >> 6);
    F.G = gridDim.x;
#pragma unroll
    for (int i = 0; i < 24; ++i) F.in[i] = args.in[i];
    F.out = args.out; F.ws = args.ws; F.ctl = (gu32*)(args.ws + WS_CTL);
    for (int u = F.tid; u < (LDS_BYTES - MISC_OFF) / 4; u += NWAVES * 64) ((LAS unsigned*)(F.lds + MISC_OFF))[u] = 0u;
    __syncthreads();
    XcdBarrier bar; bar.bar = (unsigned*)(F.ctl + CW_BAR); bar.x = 0; bar.st = nullptr;
    if (!MK_PER_PHASE) bar = xcd_barrier_post((unsigned*)(F.ctl + CW_BAR), F.MISC + 8);
    const int lo = args.ph_lo, hi = args.ph_hi & 0xff; const int dry = (args.ph_hi >> 8) & 3;
#ifndef MK_PHASE_MASK
#define MK_PHASE_MASK 0x7ffff
#endif
#define IN(k) (((MK_PHASE_MASK >> (k)) & 1) && lo <= (k) && (k) < hi)
#define SEAM(k) do { if (!MK_PER_PHASE && IN((k) + 1)) xcd_barrier(bar); } while (0)
    bf16* const WS_bH = (bf16*)(F.ws + WS_H); bf16* const WS_bY = (bf16*)(F.ws + WS_Y); bf16* const WS_bZ = (bf16*)(F.ws + WS_Z);

    if (IN(0)) { p0_prologue(F); SEAM(0); }
    if (IN(1)) { p1_prenorm(F); SEAM(1); }
    if (IN(2)) {
        pg8::Gemm g{WS_bH, (const bf16*)(F.ws + WS_WIN), MALL, DINP_PAD, DM}; pg8::InProjOrder S; S.init(MLAT, DINP_PAD, F.G, (int)blockIdx.x);
        pg8::EpiInProj E{WS_bZ, (bf16*)(F.ws + WS_XBC), (float*)(F.ws + WS_DT)};
        pg8::gemm_phase<pg8::EpiInProj, pg8::InProjOrder, true, true>(F.lds, g, S, E);
        SEAM(2);
    }
    if (IN(3)) { ssd_phase_a(F, dry); SEAM(3); }
    if (IN(4)) { ssd_phase_b(F); SEAM(4); }
    if (IN(5)) { ssd_phase_c(F, dry); SEAM(5); }
    if (IN(6)) {
        pg8::Gemm g{WS_bZ, (const bf16*)(F.ws + WS_WOUT), MLAT, DM, DIN}; pg8::StaticOrder S; S.init(MLAT, DM, F.G, (int)blockIdx.x);
        pg8::EpiBf16<0> E{WS_bY, DM, nullptr, 0, 0, 1.f};
        pg8::gemm_phase<pg8::EpiBf16<0>, pg8::StaticOrder, true, true>(F.lds, g, S, E);
        SEAM(6);
    }
    if (IN(7)) { resnorm_phase<true, FFN_FP8 != 0>(F, F.in[I_X], 0, 2, F.in[I_NPOST], F.in[I_NPRE] + 1024, 0, 4, 3); SEAM(7); }
    if (IN(8)) {
        if constexpr (FFN_FP8) {
            pg8::Gemm g{WS_bH, (const bf16*)(F.ws + WS_WGU), MLAT, 2 * DFF, DM / 2}; pg8::StaticOrder S; S.init(MLAT, 2 * DFF, F.G, (int)blockIdx.x);
            pg8::EpiSwiGLU8 E{(unsigned char*)(F.ws + WS_ACT0), DFF, 1.0f / WGU_SCALE};
            pg8::gemm_phase<pg8::EpiSwiGLU8, pg8::StaticOrder, true, true, true>(F.lds, g, S, E);
        } else {
            pg8::Gemm g{WS_bH, (const bf16*)(F.ws + WS_WGU), MLAT, 2 * DFF, DM}; pg8::StaticOrder S; S.init(MLAT, 2 * DFF, F.G, (int)blockIdx.x);
            pg8::EpiSwiGLU E{(bf16*)(F.ws + WS_ACT0), DFF};
            pg8::gemm_phase<pg8::EpiSwiGLU, pg8::StaticOrder, true, true>(F.lds, g, S, E);
        }
        SEAM(8);
    }
    if (IN(9)) {
        if constexpr (FFN_FP8) {
            pg8::Gemm g{(const bf16*)(F.ws + WS_ACT0), (const bf16*)(F.ws + WS_WDN), MLAT, DM, DFF / 2}; pg8::StaticOrder S; S.init(MLAT, DM, F.G, (int)blockIdx.x);
            pg8::EpiBf16S E{WS_bY, DM, 1.0f / WDN_SCALE};
            pg8::gemm_phase<pg8::EpiBf16S, pg8::StaticOrder, true, true, true>(F.lds, g, S, E);
        } else {
            pg8::Gemm g{(const bf16*)(F.ws + WS_ACT0), (const bf16*)(F.ws + WS_WDN), MLAT, DM, DFF}; pg8::StaticOrder S; S.init(MLAT, DM, F.G, (int)blockIdx.x);
            pg8::EpiBf16<0> E{WS_bY, DM, nullptr, 0, 0, 1.f};
            pg8::gemm_phase<pg8::EpiBf16<0>, pg8::StaticOrder, true, true>(F.lds, g, S, E);
        }
        SEAM(9);
    }
    if (IN(10)) { resnorm_phase<true>(F, F.out, 0, 5, F.in[I_NPOST] + 1024, F.in[I_NPRE] + 2048, 1, 1, 0); SEAM(10); }
    if (IN(11)) {
        pg8::Gemm g{WS_bH, (const bf16*)(F.ws + WS_WSCI), MLAT, 3072, DM}; pg8::StaticOrder S; S.init(MLAT, 3072, F.G, (int)blockIdx.x);
        pg8::EpiBf16<0> E{(bf16*)(F.ws + WS_SCP), 3072, nullptr, 0, 0, 1.f};
        pg8::gemm_phase<pg8::EpiBf16<0>, pg8::StaticOrder, true, true>(F.lds, g, S, E);
        SEAM(11);
    }
    if (IN(12)) { p12_shortconv(F); SEAM(12); }
    if (IN(13)) {
        pg8::Gemm g{WS_bH, (const bf16*)(F.ws + WS_WSCO), MLAT, DM, DM}; pg8::StaticOrder S; S.init(MLAT, DM, F.G, (int)blockIdx.x);
        pg8::EpiBf16<0> E{WS_bY, DM, nullptr, 0, 0, 1.f};
        pg8::gemm_phase<pg8::EpiBf16<0>, pg8::StaticOrder, true, true>(F.lds, g, S, E);
        SEAM(13);
    }
    if (IN(14)) { p14_resnorm_route(F); SEAM(14); }
    if (IN(15)) { p15_permute(F); SEAM(15); }
    if (MK_PER_PHASE && dry && lo == 16) {
        const int* texp = (const int*)(F.ws + WS_ROUTE + RT_TEXP); int nt = __builtin_amdgcn_readfirstlane(texp[300]); nt = nt < 0 ? 0 : (nt > MOE_ROWS / 256 ? MOE_ROWS / 256 : nt);
        pg8::Gemm g{(const bf16*)(F.ws + WS_HP8), (const bf16*)(F.ws + WS_WMGU), 256 * nt, 2 * DFFE, DM / 2};
        pg8::GroupedOrder S; S.init(256 * nt, 2 * DFFE, F.G, (int)blockIdx.x); S.texp = texp; S.estride = (size_t)2 * DFFE * DM;
        pg8::EpiNull E{(float*)(F.ws + WS_CD)};
        pg8::gemm_phase<pg8::EpiNull, pg8::GroupedOrder, true, true, true>(F.lds, g, S, E);
        return;
    }
    if (IN(16)) {
        const int* texp = (const int*)(F.ws + WS_ROUTE + RT_TEXP); int nt = __builtin_amdgcn_readfirstlane(texp[300]); nt = nt < 0 ? 0 : (nt > MOE_ROWS / 256 ? MOE_ROWS / 256 : nt);
        pg8::Gemm g{(const bf16*)(F.ws + WS_HP8), (const bf16*)(F.ws + WS_WMGU), 256 * nt, 2 * DFFE, DM / 2};
        pg8::GroupedOrder S; S.init(256 * nt, 2 * DFFE, F.G, (int)blockIdx.x); S.texp = texp; S.estride = (size_t)2 * DFFE * DM;
        pg8::EpiSwiGLU8 E{(unsigned char*)(F.ws + WS_ACT), DFFE, 1.0f / WGU_SCALE};
        pg8::gemm_phase<pg8::EpiSwiGLU8, pg8::GroupedOrder, true, true, true>(F.lds, g, S, E);
        SEAM(16);
    }
    if (IN(17)) {
        const int* texp = (const int*)(F.ws + WS_ROUTE + RT_TEXP); int nt = __builtin_amdgcn_readfirstlane(texp[300]); nt = nt < 0 ? 0 : (nt > MOE_ROWS / 256 ? MOE_ROWS / 256 : nt);
        pg8::Gemm g{(const bf16*)(F.ws + WS_ACT), (const bf16*)(F.ws + WS_WMDN), 256 * nt, DM, DFFE / 2};
        pg8::GroupedOrder S; S.init(256 * nt, DM, F.G, (int)blockIdx.x); S.texp = texp; S.estride = (size_t)DM * DFFE;
        pg8::EpiBf16S E{(bf16*)(F.ws + WS_YP), DM, 1.0f / WDN_SCALE};
        pg8::gemm_phase<pg8::EpiBf16S, pg8::GroupedOrder, true, true, true>(F.lds, g, S, E);
        SEAM(17);
    }
    if (IN(18)) { p18_final(F); }
    if (MK_DUMP && lo <= 19 && 19 < hi) dump_phase(F);
#undef IN
#undef SEAM
}

extern "C" void kernel_launch(void* const* d_in, const int* in_sizes, int n_in, void* d_out, int out_size, void* d_ws, size_t ws_size, hipStream_t stream) {
    static int grid = 0;
    if (grid == 0) {
        if (n_in != 24 || out_size != MLAT * DM || ws_size < WS_NEED) { fprintf(stderr, "kernel_launch: unexpected problem (n_in %d, out %d, ws %zu)\n", n_in, out_size, ws_size); grid = -1; return; }
        int dev = 0, cus = 0, per_cu = 0;
        if (hipGetDevice(&dev) != hipSuccess || hipDeviceGetAttribute(&cus, hipDeviceAttributeMultiprocessorCount, dev) != hipSuccess) { grid = -1; return; }
        if (hipFuncSetAttribute((const void*)fwd_kernel, hipFuncAttributeMaxDynamicSharedMemorySize, LDS_BYTES) != hipSuccess) { fprintf(stderr, "kernel_launch: hipFuncSetAttribute failed\n"); grid = -1; return; }
        if (hipOccupancyMaxActiveBlocksPerMultiprocessor(&per_cu, (const void*)fwd_kernel, NWAVES * 64, LDS_BYTES) != hipSuccess || per_cu < 1) { fprintf(stderr, "kernel_launch: occupancy query reports %d\n", per_cu); }
        (void)hipGetLastError();
        grid = cus;
    }
    if (grid < 0) return;
    if (hipMemsetAsync((char*)d_ws + WS_CTL, 0, CTL_ZERO_BYTES, stream) != hipSuccess) return;
    Args a{};
    for (int i = 0; i < 24; ++i) a.in[i] = (const float*)d_in[i];
    a.out = (float*)d_out; a.ws = (unsigned char*)d_ws;
#if MK_PER_PHASE
#ifndef MK_TWICE_MASK
#define MK_TWICE_MASK 0
#endif
#ifndef MK_DRY_MASK
#define MK_DRY_MASK 0
#endif
#ifndef MK_DRY_LEVEL
#define MK_DRY_LEVEL 1
#endif
    for (int p = 0; p <= MK_LAST_PHASE; ++p) { a.ph_lo = p;
        if ((MK_DRY_MASK >> p) & 1) { a.ph_hi = (p + 1) | (MK_DRY_LEVEL << 8); hipLaunchKernelGGL(fwd_kernel, dim3(grid), dim3(NWAVES * 64), LDS_BYTES, stream, a); }
        a.ph_hi = p + 1; hipLaunchKernelGGL(fwd_kernel, dim3(grid), dim3(NWAVES * 64), LDS_BYTES, stream, a);
        if ((MK_TWICE_MASK >> p) & 1) hipLaunchKernelGGL(fwd_kernel, dim3(grid), dim3(NWAVES * 64), LDS_BYTES, stream, a); }
    if (MK_DUMP) { a.ph_lo = 19; a.ph_hi = 20; hipLaunchKernelGGL(fwd_kernel, dim3(grid), dim3(NWAVES * 64), LDS_BYTES, stream, a); }
#else
    a.ph_lo = 0; a.ph_hi = MK_LAST_PHASE + 1;
    hipLaunchKernelGGL(fwd_kernel, dim3(grid), dim3(NWAVES * 64), LDS_BYTES, stream, a);
#endif
}
```

```cpp
#include <hip/hip_runtime.h>
#include <cstdio>
#include <cstdint>
#define MK_PER_PHASE 0
#define MK_LAST_PHASE 18
#define MK_DUMP 0
#define MK_TWICE_MASK 0
#define MK_DRY_MASK 0
#define MK_DRY_LEVEL 1
namespace pg8 {
#define PG8_LAS __attribute__((address_space(3)))
typedef unsigned short bf16_t;
typedef short bf16x8 __attribute__((ext_vector_type(8)));
typedef float f32x4 __attribute__((ext_vector_type(4)));
typedef unsigned u32x4 __attribute__((ext_vector_type(4)));
constexpr int BM = 256, BK = 64, HALF = 128, HTB = HALF * BK * 2  , STAGE_BYTES = 8 * HTB, NXCD = 8, WGM = 8;

__host__ __device__ __forceinline__ int lds_byte(int r, int c) { const int st = (r >> 4) * 2 + (c >> 5), rr = r & 15, cc = c & 31, ob = rr * 64 + cc * 2; return st * 1024 + (ob ^ (((ob >> 9) & 1) << 5)); }
__host__ __device__ __forceinline__ void stage_rc(int b, int& R, int& C) { const int st = b / 1024, sb = b % 1024, swz = sb ^ (((sb >> 9) & 1) << 5); R = (st >> 1) * 16 + swz / 64; C = (st & 1) * 32 + (swz % 64) / 2; }
__host__ __device__ __forceinline__ int perm32(int rho) { const int n = rho >> 4, i = rho & 15; return 8 * (i >> 2) + 4 * n + (i & 3); }

struct Unit { int pm, pn; };
struct Gemm { const bf16_t* A; const bf16_t* Bt; int M, N, K; };

struct StaticOrder {
    int nM, nN, nwg, G, c;
    __host__ __device__ void init(int M, int N, int G_, int c_) { nM = M / BM; nN = N / BM; nwg = nM * nN; G = G_; c = c_; }
    __host__ __device__ bool next(int i, Unit& u) const {
        const long L = (long)i * G + c; if (L >= nwg) return false;
        int wgid = (int)L; { const int q = nwg / NXCD, r = nwg % NXCD, xcd = wgid % NXCD, off = wgid / NXCD; wgid = (xcd < r ? xcd * (q + 1) : r * (q + 1) + (xcd - r) * q) + off; }
        const int nig = WGM * nN, gid = wgid / nig, fm = gid * WGM, gsz = (nM - fm) < WGM ? (nM - fm) : WGM;
        u.pm = fm + ((wgid % nig) % gsz); u.pn = (wgid % nig) / gsz; return true;
    }
    __device__ __forceinline__ void a_ready(const Unit&) const {}
    __device__ __forceinline__ void done(const Unit&) const {}
    __device__ __forceinline__ size_t boff(const Unit&) const { return 0; }
};

typedef float f32x2c __attribute__((ext_vector_type(2)));
typedef __bf16 bf16x2c __attribute__((ext_vector_type(2)));
__device__ __forceinline__ unsigned cvt_pk_bf16(float lo, float hi) { const f32x2c v = {lo, hi}; return __builtin_bit_cast(unsigned, __builtin_convertvector(v, bf16x2c)); }
typedef float f32x2 __attribute__((ext_vector_type(2)));
__device__ __forceinline__ f32x2 gelu_pk(f32x2 v) {
    const f32x2 av = __builtin_elementwise_abs(v), d = av * 0.2316418882f + 1.0f;
    f32x2 t; t.x = __builtin_amdgcn_rcpf(d.x); t.y = __builtin_amdgcn_rcpf(d.y);
    f32x2 q = t * 0.5307027145f + (-0.7265760135f); q = q * t + 0.7107068705f; q = q * t + (-0.142248368f); q = q * t + 0.127414796f; q = q * t;
    const f32x2 s = (v * v) * (-0.72134752044f);
    f32x2 e; e.x = __builtin_amdgcn_exp2f(s.x); e.y = __builtin_amdgcn_exp2f(s.y);
    const f32x2 m = v * (q * e), r = v - m;
    f32x2 o; o.x = v.x < 0.f ? m.x : r.x; o.y = v.y < 0.f ? m.y : r.y; return o;
}

template <int ACT  > struct EpiBf16 {
    static constexpr bool PERM = true, AFTER_DRAIN = false; static_assert(ACT == 0 || ACT == 1, "EpiBf16: ACT is 0 (none) or 1 (gelu_pk)");
    bf16_t* O; int ldc; const float* bias; int split_cols; size_t split_stride; float scale0;
    __device__ __forceinline__ void operator()(const f32x4 (&acc)[2][2][4][2], const Unit& u, int wr, int wc, int fr, int fq) const {
        const int row0 = u.pm * BM + wr * 64 + fr; int colt = u.pn * BM; bf16_t* base = O;
        float sc = 1.f; if (split_cols) { const int t = colt / split_cols; base += (size_t)t * split_stride; colt -= t * split_cols; if (t == 0) sc = scale0; }
        const int col0 = colt + wc * 32 + 8 * fq, bcol0 = u.pn * BM + wc * 32 + 8 * fq;
        f32x4 bv[2][2];
#pragma unroll
        for (int bj = 0; bj < 2; ++bj)
#pragma unroll
            for (int n = 0; n < 2; ++n) bv[bj][n] = bias ? *(const f32x4*)(bias + bcol0 + bj * HALF + 4 * n) : (f32x4){0.f, 0.f, 0.f, 0.f};
#pragma unroll
        for (int ai = 0; ai < 2; ++ai)
#pragma unroll
            for (int m = 0; m < 4; ++m) { bf16_t* rowp = base + (size_t)(row0 + ai * HALF + m * 16) * ldc + col0;
#pragma unroll
                for (int bj = 0; bj < 2; ++bj) { f32x4 v0 = acc[ai][bj][m][0] + bv[bj][0], v1 = acc[ai][bj][m][1] + bv[bj][1];
                    if (ACT == 1) { f32x2 a = gelu_pk((f32x2){v0[0], v0[1]}), b = gelu_pk((f32x2){v0[2], v0[3]}), c = gelu_pk((f32x2){v1[0], v1[1]}), d = gelu_pk((f32x2){v1[2], v1[3]});
                        v0 = (f32x4){a.x, a.y, b.x, b.y}; v1 = (f32x4){c.x, c.y, d.x, d.y}; }
                    v0 = v0 * sc; v1 = v1 * sc; u32x4 w; w.x = cvt_pk_bf16(v0[0], v0[1]); w.y = cvt_pk_bf16(v0[2], v0[3]); w.z = cvt_pk_bf16(v1[0], v1[1]); w.w = cvt_pk_bf16(v1[2], v1[3]);
                    *(u32x4*)(rowp + bj * HALF) = w; } }
    }
};

typedef int i32x4f __attribute__((ext_vector_type(4)));
typedef int i32x8f __attribute__((ext_vector_type(8)));
__device__ __forceinline__ i32x8f cat8(bf16x8 a, bf16x8 b) { const i32x4f lo = __builtin_bit_cast(i32x4f, a), hi = __builtin_bit_cast(i32x4f, b); return __builtin_shufflevector(lo, hi, 0, 1, 2, 3, 4, 5, 6, 7); }
template <class Epi, class Sched, bool ALIGN_EPI = false, bool SP2 = false, bool FP8 = false>
__device__ __forceinline__ void gemm_phase(PG8_LAS unsigned char* lds, const Gemm g, const Sched& S, const Epi& E) {
    const int tid = threadIdx.x, wid = __builtin_amdgcn_readfirstlane(tid >> 6), lane = tid & 63, wr = wid >> 2, wc = wid & 3, fr = lane & 15, fq = lane >> 4;
    const int K = g.K, nt = K / BK;
    unsigned voffA[2], voffB[2];
#pragma unroll
    for (int i = 0; i < 2; ++i) { int R, C; stage_rc(tid * 16 + i * 8192, R, C); const int Rb = Epi::PERM ? ((R & ~31) + perm32(R & 31)) : R;
        voffA[i] = (unsigned)(R * K + C) * 2u; voffB[i] = (unsigned)(Rb * K + C) * 2u; }
    const size_t kstep = (size_t)(BK * 2);
    const size_t hstep = (size_t)HALF * K * 2;
    const size_t tstep = 2 * hstep;
    const unsigned ldsw = (unsigned)wid * 1024u;
    const int aoff = lds_byte(wr * 64 + fr, fq * 8), boff = lds_byte(wc * 32 + fr, fq * 8);
#define PG8_SA(b, h) (((b) * 2 + (h)) * HTB)
#define PG8_SB(b, h) ((4 + (b) * 2 + (h)) * HTB)
#define PG8_STAGE(bufoff, gbase, voff) do { _Pragma("unroll") for (int _i = 0; _i < 2; ++_i) \
        __builtin_amdgcn_global_load_lds((const unsigned*)((const char*)(gbase) + (voff)[_i]), (PG8_LAS unsigned*)(lds + (bufoff) + ldsw + _i * 8192), 16, 0, 0); } while (0)
#define PG8_LDA(dst, b, h) do { _Pragma("unroll") for (int m = 0; m < 4; ++m) { const bf16x8 x0_ = *(const PG8_LAS bf16x8*)(lds + PG8_SA(b, h) + aoff + m * 2048), x1_ = *(const PG8_LAS bf16x8*)(lds + PG8_SA(b, h) + aoff + m * 2048 + 1024); \
        if constexpr (FP8) dst##8[m] = cat8(x0_, x1_); else { dst[m][0] = x0_; dst[m][1] = x1_; } } } while (0)
#define PG8_LDB(dst, b, h) do { _Pragma("unroll") for (int n = 0; n < 2; ++n) { const bf16x8 x0_ = *(const PG8_LAS bf16x8*)(lds + PG8_SB(b, h) + boff + n * 2048), x1_ = *(const PG8_LAS bf16x8*)(lds + PG8_SB(b, h) + boff + n * 2048 + 1024); \
        if constexpr (FP8) dst##8[n] = cat8(x0_, x1_); else { dst[n][0] = x0_; dst[n][1] = x1_; } } } while (0)
#define PG8_MMA(ai, bj, At, Bt) do { __builtin_amdgcn_s_setprio(1); _Pragma("unroll") for (int m = 0; m < 4; ++m) _Pragma("unroll") for (int n = 0; n < 2; ++n) { \
        if constexpr (FP8) asm volatile("v_mfma_f32_16x16x128_f8f6f4 %0, %1, %2, %0" : "+v"(acc[ai][bj][m][n]) : "v"(Bt##8[n]), "v"(At##8[m])); \
        else { _Pragma("unroll") for (int k = 0; k < 2; ++k) acc[ai][bj][m][n] = __builtin_amdgcn_mfma_f32_16x16x32_bf16(Bt[n][k], At[m][k], acc[ai][bj][m][n], 0, 0, 0); } } __builtin_amdgcn_s_setprio(0); } while (0)
#define PG8_WAIT_V(n) asm volatile("s_waitcnt vmcnt(" #n ")" ::: "memory")
#define PG8_WAIT_L(n) asm volatile("s_waitcnt lgkmcnt(" #n ")" ::: "memory")
#define PG8_BAR __builtin_amdgcn_s_barrier()
#define PG8_SCHED __builtin_amdgcn_sched_barrier(0)
    Unit cur, nxt; int ui = 0;
    if (!S.next(0, cur)) return;
    f32x4 acc[2][2][4][2];
#pragma unroll
    for (int a = 0; a < 2; ++a)
#pragma unroll
        for (int b = 0; b < 2; ++b)
#pragma unroll
            for (int m = 0; m < 4; ++m)
#pragma unroll
                for (int n = 0; n < 2; ++n) acc[a][b][m][n] = (f32x4){0.f, 0.f, 0.f, 0.f};
    bf16x8 At[4][2], B0[2][2], B1[2][2]; i32x8f At8[4], B08[2], B18[2];
    const char* cA = (const char*)g.A + (size_t)cur.pm * tstep; const char* cB = (const char*)g.Bt + S.boff(cur) + (size_t)cur.pn * tstep;
    S.a_ready(cur);
    if constexpr (SP2) {
        PG8_STAGE(PG8_SB(0, 0), cB, voffB); PG8_STAGE(PG8_SB(0, 1), cB + hstep, voffB); PG8_STAGE(PG8_SA(0, 0), cA, voffA); PG8_STAGE(PG8_SA(0, 1), cA + hstep, voffA);
        if (wr == 1) PG8_BAR;
        PG8_WAIT_V(2); PG8_BAR;
        PG8_STAGE(PG8_SB(1, 0), cB + kstep, voffB); PG8_STAGE(PG8_SA(1, 0), cA + kstep, voffA); PG8_STAGE(PG8_SB(1, 1), cB + hstep + kstep, voffB);
        PG8_WAIT_V(6); PG8_BAR;
    } else {
        PG8_STAGE(PG8_SB(0, 0), cB, voffB); PG8_STAGE(PG8_SA(0, 0), cA, voffA); PG8_STAGE(PG8_SB(0, 1), cB + hstep, voffB); PG8_STAGE(PG8_SA(0, 1), cA + hstep, voffA);
        if (wr == 1) PG8_BAR;
        PG8_WAIT_V(4); PG8_BAR;
        PG8_STAGE(PG8_SB(1, 0), cB + kstep, voffB); PG8_STAGE(PG8_SA(1, 0), cA + kstep, voffA); PG8_STAGE(PG8_SB(1, 1), cB + hstep + kstep, voffB);
        PG8_WAIT_V(6); PG8_BAR;
    }
    for (;;) {
        const bool has_next = S.next(ui + 1, nxt);
        const char* nA = has_next ? (const char*)g.A + (size_t)nxt.pm * tstep : cA; const char* nB = has_next ? (const char*)g.Bt + S.boff(nxt) + (size_t)nxt.pn * tstep : cB;
        for (int t = 0; t < nt; t += 2) {
            const bool last = (t == nt - 2);
            const char* a1 = cA + (size_t)(t + 1) * kstep;
            const char* a2 = last ? nA : cA + (size_t)(t + 2) * kstep; const char* b2 = last ? nB : cB + (size_t)(t + 2) * kstep;
            const char* a3 = a2 + kstep; const char* b3 = b2 + kstep;
            if (last && has_next) S.a_ready(nxt);
            if constexpr (SP2) {
            PG8_LDB(B0, 0, 0); PG8_LDB(B1, 0, 1); PG8_SCHED; PG8_LDA(At, 0, 0); PG8_STAGE(PG8_SA(1, 1), a1 + hstep, voffA);
            PG8_WAIT_V(8); PG8_WAIT_L(0); PG8_BAR; PG8_MMA(0, 0, At, B0); PG8_MMA(0, 1, At, B1); PG8_BAR; PG8_SCHED;
            PG8_LDA(At, 0, 1); PG8_STAGE(PG8_SB(0, 0), b2, voffB); PG8_STAGE(PG8_SB(0, 1), b2 + hstep, voffB); PG8_STAGE(PG8_SA(0, 0), a2, voffA);
            PG8_WAIT_V(8); PG8_WAIT_L(0); PG8_BAR; PG8_MMA(1, 0, At, B0); PG8_MMA(1, 1, At, B1); PG8_BAR; PG8_SCHED;
            PG8_LDB(B0, 1, 0); PG8_LDB(B1, 1, 1); PG8_SCHED; PG8_LDA(At, 1, 0); PG8_STAGE(PG8_SA(0, 1), a2 + hstep, voffA);
            PG8_WAIT_V(8); PG8_WAIT_L(0); PG8_BAR; PG8_MMA(0, 0, At, B0); PG8_MMA(0, 1, At, B1); PG8_BAR; PG8_SCHED;
            PG8_LDA(At, 1, 1); PG8_STAGE(PG8_SB(1, 0), b3, voffB); PG8_STAGE(PG8_SB(1, 1), b3 + hstep, voffB); PG8_STAGE(PG8_SA(1, 0), a3, voffA);
            PG8_WAIT_V(8); PG8_WAIT_L(0); PG8_BAR; PG8_MMA(1, 0, At, B0); PG8_MMA(1, 1, At, B1); PG8_BAR; PG8_SCHED;
            } else {
            PG8_LDB(B0, 0, 0); PG8_SCHED; PG8_LDA(At, 0, 0); PG8_STAGE(PG8_SA(1, 1), a1 + hstep, voffA);
            PG8_WAIT_L(8); PG8_BAR; PG8_WAIT_L(0); PG8_MMA(0, 0, At, B0); PG8_BAR; PG8_SCHED;
            PG8_LDB(B1, 0, 1); PG8_STAGE(PG8_SB(0, 0), b2, voffB);
            PG8_BAR; PG8_WAIT_L(0); PG8_MMA(0, 1, At, B1); PG8_BAR;
            PG8_LDA(At, 0, 1); PG8_STAGE(PG8_SA(0, 0), a2, voffA);
            PG8_BAR; PG8_WAIT_L(0); PG8_MMA(1, 0, At, B0); PG8_BAR; PG8_SCHED;
            PG8_STAGE(PG8_SB(0, 1), b2 + hstep, voffB);
            PG8_WAIT_V(6); PG8_BAR; PG8_MMA(1, 1, At, B1); PG8_BAR;
            PG8_LDB(B0, 1, 0); PG8_SCHED; PG8_LDA(At, 1, 0); PG8_STAGE(PG8_SA(0, 1), a2 + hstep, voffA);
            PG8_WAIT_L(8); PG8_BAR; PG8_WAIT_L(0); PG8_MMA(0, 0, At, B0); PG8_BAR; PG8_SCHED;
            PG8_LDB(B1, 1, 1); PG8_STAGE(PG8_SB(1, 0), b3, voffB);
            PG8_BAR; PG8_WAIT_L(0); PG8_MMA(0, 1, At, B1); PG8_BAR;
            PG8_LDA(At, 1, 1); PG8_STAGE(PG8_SA(1, 0), a3, voffA);
            PG8_BAR; PG8_WAIT_L(0); PG8_MMA(1, 0, At, B0); PG8_BAR; PG8_SCHED;
            PG8_STAGE(PG8_SB(1, 1), b3 + hstep, voffB);
            PG8_WAIT_V(6); PG8_BAR; PG8_MMA(1, 1, At, B1); PG8_BAR;
            }
        }
        if constexpr (FP8) asm volatile("s_nop 7\n\ts_nop 7\n\ts_nop 7" ::: "memory");
        if constexpr (ALIGN_EPI) { if (wr == 0) PG8_BAR; }
        if constexpr (!Epi::AFTER_DRAIN) { E(acc, cur, wr, wc, fr, fq); S.done(cur); }
        if (!has_next) break;
#pragma unroll
        for (int a = 0; a < 2; ++a)
#pragma unroll
            for (int b = 0; b < 2; ++b)
#pragma unroll
                for (int m = 0; m < 4; ++m)
#pragma unroll
                    for (int n = 0; n < 2; ++n) acc[a][b][m][n] = (f32x4){0.f, 0.f, 0.f, 0.f};
        cur = nxt; cA = nA; cB = nB; ++ui;
        if constexpr (ALIGN_EPI) { if (wr == 1) PG8_BAR; }
    }
    PG8_WAIT_V(0);
    if constexpr (!ALIGN_EPI) { if (wr == 0) PG8_BAR; }
    PG8_BAR;
    if constexpr (Epi::AFTER_DRAIN) { E.fused(acc, cur, wr, wc, fr, fq, lds, wid, lane); S.done(cur); }
#undef PG8_SA
#undef PG8_SB
#undef PG8_STAGE
#undef PG8_LDA
#undef PG8_LDB
#undef PG8_MMA
#undef PG8_WAIT_V
#undef PG8_WAIT_L
#undef PG8_BAR
#undef PG8_SCHED
}
}

constexpr int NWAVES = 8;
constexpr int DM = 1024, NB = 8, SEQ = 4096, CTXL = 256;
constexpr int MLAT = NB * SEQ, MCTX = NB * CTXL, MALL = MLAT + MCTX;
constexpr int DIN = 2048, CONVD = 4096, DINP = 6208, DINP_PAD = 6400;
constexpr int DFF = 2816, NE = 8, DFFE = 3584;
constexpr int NUNIT_LAT = NB * 32 * 8, NUNIT = NUNIT_LAT + NB * 2 * 8;
constexpr int MOE_ROWS = 67584;
constexpr float EPS = 1e-6f;
#ifndef MK_PER_PHASE
#define MK_PER_PHASE 0
#endif
#ifndef MK_LAST_PHASE
#define MK_LAST_PHASE 18
#endif
constexpr int N_PHASES = 19;

constexpr size_t MiB = 1u << 20;
constexpr size_t WS_CTL = 0, CTL_ZERO_BYTES = 1 * MiB;
constexpr size_t WS_MOD = 1 * MiB;
constexpr size_t WS_ROUTE = 2 * MiB;
constexpr size_t WS_CD = 4 * MiB;
constexpr size_t WS_WIN = 8 * MiB, WS_WOUT = 21 * MiB, WS_WGU = 25 * MiB, WS_WDN = 36 * MiB, WS_WSCI = 42 * MiB, WS_WSCO = 48 * MiB;
constexpr size_t WS_H = 56 * MiB;
constexpr size_t WS_Y = 124 * MiB;
constexpr size_t WS_Z = 188 * MiB;
constexpr size_t WS_XBC = 324 * MiB;
constexpr size_t WS_DT = 596 * MiB;
constexpr size_t WS_S = 606 * MiB;
constexpr size_t WS_ACT0 = 324 * MiB;
constexpr size_t WS_SCP = 324 * MiB;
constexpr size_t WS_HP8 = 124 * MiB;
constexpr size_t WS_YP = 190 * MiB;
constexpr size_t WS_WMGU = 322 * MiB, WS_WMDN = 378 * MiB;
constexpr size_t WS_ACT = 406 * MiB;
constexpr size_t WS_END = 640 * MiB;
constexpr float WGU_SCALE = 64.f, WDN_SCALE = 128.f;
#ifndef MK_FFN_FP8
#define MK_FFN_FP8 0
#endif
constexpr int FFN_FP8 = MK_FFN_FP8;
static_assert(WS_S + (size_t)NUNIT * 8 * 8192 * 2 <= 878 * MiB && WS_HP8 + (size_t)MOE_ROWS * DM <= WS_YP && WS_YP + (size_t)MOE_ROWS * DM * 2 <= WS_WMGU && WS_WMGU + (size_t)8 * 2 * DFFE * DM <= WS_WMDN && WS_WMDN + (size_t)8 * DM * DFFE <= WS_ACT && WS_ACT + (size_t)MOE_ROWS * DFFE <= WS_END, "d_ws map");
constexpr size_t WS_NEED = 878 * MiB;
constexpr size_t RT_SELR = 0, RT_GATE = 256 * 1024, RT_POS = 512 * 1024, RT_CNT = 768 * 1024, RT_TEXP = 800 * 1024;
constexpr int CW_TMO = 0, CW_CODE = 1, CW_BAR = 4096;

constexpr int PXB = 528, PBB = 272, PMB = 272;
constexpr int XI_BYTES = 128 * PXB, BI_BYTES = 128 * PBB, MW_BYTES = 8 * 16 * PMB;
constexpr int SCAL_OFF = XI_BYTES + BI_BYTES + MW_BYTES;
constexpr int BPW_OFF = SCAL_OFF + 3 * 4096;
constexpr int MISC_OFF = BPW_OFF + 4096;
constexpr int LDS_BYTES = MISC_OFF + 512;
static_assert(LDS_BYTES <= 160 * 1024 && pg8::STAGE_BYTES <= MISC_OFF, "LDS map");

#define GAS __attribute__((address_space(1)))
#define LAS __attribute__((address_space(3)))
typedef unsigned short bf16;
typedef unsigned v4u __attribute__((ext_vector_type(4)));
typedef unsigned v2u __attribute__((ext_vector_type(2)));
typedef float f32x4 __attribute__((ext_vector_type(4)));
typedef short bf16x8 __attribute__((ext_vector_type(8)));
typedef short s16x4 __attribute__((ext_vector_type(4)));
typedef GAS unsigned gu32;
#define RLX_AGENT __ATOMIC_RELAXED, __HIP_MEMORY_SCOPE_AGENT
#define LDS_WAIT() asm volatile("s_waitcnt lgkmcnt(0)" ::: "memory")
#define VM_WAIT() asm volatile("s_waitcnt vmcnt(0)" ::: "memory")
#define LDS_BARRIER() do { asm volatile("s_waitcnt lgkmcnt(0)" ::: "memory"); __builtin_amdgcn_s_barrier(); asm volatile("" ::: "memory"); } while (0)
typedef float f32x2n __attribute__((ext_vector_type(2)));
typedef __bf16 bf16x2n __attribute__((ext_vector_type(2)));
__device__ __forceinline__ unsigned pk2(float lo, float hi) { const f32x2n v = {lo, hi}; return __builtin_bit_cast(unsigned, __builtin_convertvector(v, bf16x2n)); }
__device__ __forceinline__ float bflo(unsigned u) { return __uint_as_float(u << 16); }
__device__ __forceinline__ float bfhi(unsigned u) { return __uint_as_float(u & 0xffff0000u); }
__device__ __forceinline__ float bf1(bf16 b) { return __uint_as_float(((unsigned)b) << 16); }
__device__ __forceinline__ f32x4 unpack4(v2u u) { return (f32x4){bflo(u.x), bfhi(u.x), bflo(u.y), bfhi(u.y)}; }
__device__ __forceinline__ v2u pack4(f32x4 v) { v2u r; r.x = pk2(v[0], v[1]); r.y = pk2(v[2], v[3]); return r; }
__device__ __forceinline__ unsigned pk4_fp8(float a, float b, float c, float d) {
    a = fminf(fmaxf(a, -448.f), 448.f); b = fminf(fmaxf(b, -448.f), 448.f); c = fminf(fmaxf(c, -448.f), 448.f); d = fminf(fmaxf(d, -448.f), 448.f);
    int v = __builtin_amdgcn_cvt_pk_fp8_f32(a, b, 0, false); v = __builtin_amdgcn_cvt_pk_fp8_f32(c, d, v, true); return (unsigned)v; }
__device__ __forceinline__ float silu_f(float v) { return v * __builtin_amdgcn_rcpf(1.0f + __builtin_amdgcn_exp2f(-1.44269504f * v)); }
__device__ __forceinline__ float wave_sum(float v) {
#pragma unroll
    for (int o = 1; o < 64; o <<= 1) v += __shfl_xor(v, o);
    return v;
}
__device__ __forceinline__ unsigned lds_addr(LAS unsigned char* p) { return (unsigned)(size_t)p; }
__device__ __forceinline__ bf16x8 tr_pair(const LAS unsigned char* p0, const LAS unsigned char* p1) {
    const s16x4 x = __builtin_amdgcn_ds_read_tr16_b64_v4i16((LAS s16x4*)p0), y = __builtin_amdgcn_ds_read_tr16_b64_v4i16((LAS s16x4*)p1);
    return (bf16x8){x[0], x[1], x[2], x[3], y[0], y[1], y[2], y[3]};
}
#define MFMA16(a, b, c) __builtin_amdgcn_mfma_f32_16x16x32_bf16((a), (b), (c), 0, 0, 0)

namespace pg8 {
struct EpiInProj {
    static constexpr bool PERM = true, AFTER_DRAIN = false;
    bf16_t* Z; bf16_t* XBC; float* DT;
    __device__ __forceinline__ void operator()(const f32x4 (&acc)[2][2][4][2], const Unit& u, int wr, int wc, int fr, int fq) const {
        const int row0 = u.pm * BM + wr * 64 + fr;
        if (u.pn < 24) {
            bf16_t* base; int ldc, colt;
            if (u.pn < 8) { base = Z; ldc = 2048; colt = u.pn * BM; } else { base = XBC; ldc = 4096; colt = (u.pn - 8) * BM; }
            const int col0 = colt + wc * 32 + 8 * fq;
#pragma unroll
            for (int ai = 0; ai < 2; ++ai)
#pragma unroll
                for (int m = 0; m < 4; ++m) { bf16_t* rowp = base + (size_t)(row0 + ai * HALF + m * 16) * ldc + col0;
#pragma unroll
                    for (int bj = 0; bj < 2; ++bj) { const f32x4 v0 = acc[ai][bj][m][0], v1 = acc[ai][bj][m][1];
                        u32x4 w; w.x = cvt_pk_bf16(v0[0], v0[1]); w.y = cvt_pk_bf16(v0[2], v0[3]); w.z = cvt_pk_bf16(v1[0], v1[1]); w.w = cvt_pk_bf16(v1[2], v1[3]);
                        *(u32x4*)(rowp + bj * HALF) = w; } }
        } else if (wc < 2) {
            const int col0 = wc * 32 + 8 * fq;
#pragma unroll
            for (int ai = 0; ai < 2; ++ai)
#pragma unroll
                for (int m = 0; m < 4; ++m) { float* rowp = DT + (size_t)(row0 + ai * HALF + m * 16) * 64 + col0;
                    *(f32x4*)(rowp) = acc[ai][0][m][0]; *(f32x4*)(rowp + 4) = acc[ai][0][m][1]; }
        }
    }
};
struct EpiSwiGLU {
    static constexpr bool PERM = true, AFTER_DRAIN = false;
    bf16_t* O; int ldc;
    __device__ __forceinline__ void operator()(const f32x4 (&acc)[2][2][4][2], const Unit& u, int wr, int wc, int fr, int fq) const {
        const int row0 = u.pm * BM + wr * 64 + fr, col0 = u.pn * HALF + wc * 32 + 8 * fq;
#pragma unroll
        for (int ai = 0; ai < 2; ++ai)
#pragma unroll
            for (int m = 0; m < 4; ++m) { bf16_t* rowp = O + (size_t)(row0 + ai * HALF + m * 16) * ldc + col0;
                float o[8];
#pragma unroll
                for (int n = 0; n < 2; ++n)
#pragma unroll
                    for (int j = 0; j < 4; ++j) { const float gt = acc[ai][0][m][n][j], up = acc[ai][1][m][n][j]; o[4 * n + j] = gt * __builtin_amdgcn_rcpf(1.0f + __expf(-gt)) * up; }
                u32x4 w; w.x = cvt_pk_bf16(o[0], o[1]); w.y = cvt_pk_bf16(o[2], o[3]); w.z = cvt_pk_bf16(o[4], o[5]); w.w = cvt_pk_bf16(o[6], o[7]);
                *(u32x4*)(rowp) = w; }
    }
};
struct EpiSwiGLU8 {
    static constexpr bool PERM = true, AFTER_DRAIN = false;
    unsigned char* O; int ldc; float sc;
    __device__ __forceinline__ void operator()(const f32x4 (&acc)[2][2][4][2], const Unit& u, int wr, int wc, int fr, int fq) const {
        const int row0 = u.pm * BM + wr * 64 + fr, col0 = u.pn * HALF + wc * 32 + 8 * fq;
#pragma unroll
        for (int ai = 0; ai < 2; ++ai)
#pragma unroll
            for (int m = 0; m < 4; ++m) { unsigned char* rowp = O + (size_t)(row0 + ai * HALF + m * 16) * ldc + col0;
                float o[8];
#pragma unroll
                for (int n = 0; n < 2; ++n)
#pragma unroll
                    for (int j = 0; j < 4; ++j) { const float gt = acc[ai][0][m][n][j] * sc, up = acc[ai][1][m][n][j] * sc; o[4 * n + j] = gt * __builtin_amdgcn_rcpf(1.0f + __builtin_amdgcn_exp2f(-1.44269504f * gt)) * up; }
                typedef unsigned u32x2e __attribute__((ext_vector_type(2)));
                u32x2e w; w.x = pk4_fp8(o[0], o[1], o[2], o[3]); w.y = pk4_fp8(o[4], o[5], o[6], o[7]);
                *(u32x2e*)(rowp) = w; }
    }
};
struct EpiBf16S {
    static constexpr bool PERM = true, AFTER_DRAIN = false;
    bf16_t* O; int ldc; float sc;
    __device__ __forceinline__ void operator()(const f32x4 (&acc)[2][2][4][2], const Unit& u, int wr, int wc, int fr, int fq) const {
        const int row0 = u.pm * BM + wr * 64 + fr, col0 = u.pn * BM + wc * 32 + 8 * fq;
#pragma unroll
        for (int ai = 0; ai < 2; ++ai)
#pragma unroll
            for (int m = 0; m < 4; ++m) { bf16_t* rowp = O + (size_t)(row0 + ai * HALF + m * 16) * ldc + col0;
#pragma unroll
                for (int bj = 0; bj < 2; ++bj) { const f32x4 v0 = acc[ai][bj][m][0] * sc, v1 = acc[ai][bj][m][1] * sc;
                    u32x4 w; w.x = cvt_pk_bf16(v0[0], v0[1]); w.y = cvt_pk_bf16(v0[2], v0[3]); w.z = cvt_pk_bf16(v1[0], v1[1]); w.w = cvt_pk_bf16(v1[2], v1[3]);
                    *(u32x4*)(rowp + bj * HALF) = w; } }
    }
};
struct InProjOrder : StaticOrder {
    __device__ __forceinline__ bool next(int i, Unit& u) const {
        const long L = (long)i * G + c; if (L >= nwg + 104) return false;
        if (L < nwg) return StaticOrder::next(i, u);
        const int idx = (int)(L - nwg), px = idx % 13; u.pm = nM + idx / 13; u.pn = px < 12 ? 8 + px : 24; return true;
    }
};
struct EpiNull {
    static constexpr bool PERM = true, AFTER_DRAIN = false;
    float* sink;
    __device__ __forceinline__ void operator()(const f32x4 (&acc)[2][2][4][2], const Unit& u, int wr, int wc, int fr, int fq) const {
        float s = 0.f;
#pragma unroll
        for (int ai = 0; ai < 2; ++ai)
#pragma unroll
            for (int bj = 0; bj < 2; ++bj)
#pragma unroll
                for (int m = 0; m < 4; ++m)
#pragma unroll
                    for (int n = 0; n < 2; ++n) s += acc[ai][bj][m][n][0];
        if (s == 12345.678f) sink[0] = s;
    }
};
struct GroupedOrder : StaticOrder {
    const int* texp; size_t estride;
    __device__ __forceinline__ size_t boff(const Unit& u) const { return (size_t)texp[u.pm] * estride; }
};
}

struct Frame {
    LAS unsigned char* lds;
    volatile LAS unsigned* MISC;
    gu32* ctl;
    int tid, lane, wave, G;
    const float* in[24]; float* out; unsigned char* ws;
};
enum { I_X = 0, I_C, I_CTX, I_CCTX, I_ADAW, I_ADAB, I_NPRE, I_NPOST, I_SWIN, I_SCONVW, I_SCONVB, I_SALOG, I_SDTB, I_SD, I_SNORM, I_SWOUT, I_SCWIN, I_SCCONV, I_SCWOUT, I_FGU, I_FDN, I_ROUTER, I_MGU, I_MDN };

__device__ __forceinline__ void cvt_item(const float* W, int K, int N, bf16* WT, LAS float* scr, int item, int lane, int mode, int dffx) {
    const int nblk = N / 32, kb = item / nblk, nb = item % nblk, k0 = 64 * kb, n0 = 32 * nb;
#pragma unroll 8
    for (int i = 0; i < 32; ++i) { const int kk = 2 * i + (lane >> 5); scr[kk * 33 + (lane & 31)] = W[(size_t)(k0 + kk) * N + n0 + (lane & 31)]; }
    LDS_WAIT(); asm volatile("" ::: "memory");
    const int c = lane & 7;
#pragma unroll
    for (int j = 0; j < 4; ++j) { const int n = (lane >> 3) + 8 * j; const LAS float* s = scr + (8 * c) * 33 + n;
        v4u o; o.x = pk2(s[0 * 33], s[1 * 33]); o.y = pk2(s[2 * 33], s[3 * 33]); o.z = pk2(s[4 * 33], s[5 * 33]); o.w = pk2(s[6 * 33], s[7 * 33]);
        int nd = n0 + n; if (mode) { const int half = nd >= dffx ? 1 : 0, i2 = nd - half * dffx; nd = 256 * (i2 >> 7) + 128 * half + (i2 & 127); }
        *(v4u*)(WT + (size_t)nd * K + k0 + 8 * c) = o; }
    LDS_WAIT(); asm volatile("" ::: "memory");
}
__device__ __forceinline__ void cvt_item8(const float* W, int K, int N, unsigned char* WT, LAS float* scr, int item, int lane, int mode, int dffx, float sc) {
    const int nblk = N / 32, kb = item / nblk, nb = item % nblk, k0 = 64 * kb, n0 = 32 * nb;
#pragma unroll 8
    for (int i = 0; i < 32; ++i) { const int kk = 2 * i + (lane >> 5); scr[kk * 33 + (lane & 31)] = W[(size_t)(k0 + kk) * N + n0 + (lane & 31)]; }
    LDS_WAIT(); asm volatile("" ::: "memory");
    const int c = lane & 7;
#pragma unroll
    for (int j = 0; j < 4; ++j) { const int n = (lane >> 3) + 8 * j; const LAS float* s = scr + (8 * c) * 33 + n;
        v2u o; o.x = pk4_fp8(s[0 * 33] * sc, s[1 * 33] * sc, s[2 * 33] * sc, s[3 * 33] * sc); o.y = pk4_fp8(s[4 * 33] * sc, s[5 * 33] * sc, s[6 * 33] * sc, s[7 * 33] * sc);
        int nd = n0 + n; if (mode) { const int half = nd >= dffx ? 1 : 0, i2 = nd - half * dffx; nd = 256 * (i2 >> 7) + 128 * half + (i2 & 127); }
        *(v2u*)(WT + (size_t)nd * K + k0 + 8 * c) = o; }
    LDS_WAIT(); asm volatile("" ::: "memory");
}
__device__ __forceinline__ void load_row_f32(const float* p, int lane, f32x4 (&v)[4]) {
#pragma unroll
    for (int j = 0; j < 4; ++j) v[j] = *(const f32x4*)(p + 4 * lane + 256 * j);
}
__device__ __forceinline__ void load_row_bf16(const bf16* p, int lane, f32x4 (&v)[4]) {
#pragma unroll
    for (int j = 0; j < 4; ++j) v[j] = unpack4(*(const v2u*)(p + 4 * lane + 256 * j));
}
__device__ __forceinline__ float row_ss(const f32x4 (&v)[4]) {
    float s = 0.f;
#pragma unroll
    for (int j = 0; j < 4; ++j) s += (v[j][0] * v[j][0] + v[j][1] * v[j][1]) + (v[j][2] * v[j][2] + v[j][3] * v[j][3]);
    return wave_sum(s);
}
__device__ __forceinline__ void prenorm_mod(f32x4 (&v)[4], const float* npre, const float* sc, const float* sh, int lane) {
    const float rr = rsqrtf(row_ss(v) * (1.0f / DM) + EPS);
#pragma unroll
    for (int j = 0; j < 4; ++j) { const int col = 4 * lane + 256 * j; const f32x4 w4 = *(const f32x4*)(npre + col), s4 = *(const f32x4*)(sc + col), h4 = *(const f32x4*)(sh + col);
        v[j] = (v[j] * rr * w4) * (s4 + 1.0f) + h4; }
}
__device__ __forceinline__ void store_row_bf16(bf16* p, int lane, const f32x4 (&v)[4]) {
#pragma unroll
    for (int j = 0; j < 4; ++j) *(v2u*)(p + 4 * lane + 256 * j) = pack4(v[j]);
}
__device__ __forceinline__ const float* mod_vec(Frame& F, int layer, int row, int chunk) { return (const float*)(F.ws + WS_MOD) + ((size_t)(layer * 9 + row) * 6144 + chunk * 1024); }


struct CvtDesc { const float* W; void* WT; int K, N, item, mode, dffx, fp8; float sc; };
__device__ __forceinline__ void cvt_load(const CvtDesc& d, int lane, float (&v)[32]) {
    const int nblk = d.N / 32, kb = d.item / nblk, nb = d.item % nblk; const float* p = d.W + (size_t)(64 * kb + (lane >> 5)) * d.N + 32 * nb + (lane & 31);
#pragma unroll
    for (int i = 0; i < 32; ++i) v[i] = p[(size_t)(2 * i) * d.N];
}
__device__ __forceinline__ void cvt_finish(const CvtDesc& d, LAS float* scr, int lane, const float (&v)[32]) {
    const int nblk = d.N / 32, kb = d.item / nblk, nb = d.item % nblk, k0 = 64 * kb, n0 = 32 * nb;
#pragma unroll
    for (int i = 0; i < 32; ++i) scr[(2 * i + (lane >> 5)) * 33 + (lane & 31)] = v[i];
    LDS_WAIT(); asm volatile("" ::: "memory");
    const int c = lane & 7;
#pragma unroll
    for (int j = 0; j < 4; ++j) { const int n = (lane >> 3) + 8 * j; const LAS float* s = scr + (8 * c) * 33 + n;
        int nd = n0 + n; if (d.mode) { const int half = nd >= d.dffx ? 1 : 0, i2 = nd - half * d.dffx; nd = 256 * (i2 >> 7) + 128 * half + (i2 & 127); }
        if (d.fp8) { const float sc = d.sc; v2u o; o.x = pk4_fp8(s[0 * 33] * sc, s[1 * 33] * sc, s[2 * 33] * sc, s[3 * 33] * sc); o.y = pk4_fp8(s[4 * 33] * sc, s[5 * 33] * sc, s[6 * 33] * sc, s[7 * 33] * sc);
            *(v2u*)((unsigned char*)d.WT + (size_t)nd * d.K + k0 + 8 * c) = o; }
        else { v4u o; o.x = pk2(s[0 * 33], s[1 * 33]); o.y = pk2(s[2 * 33], s[3 * 33]); o.z = pk2(s[4 * 33], s[5 * 33]); o.w = pk2(s[6 * 33], s[7 * 33]);
            *(v4u*)((bf16*)d.WT + (size_t)nd * d.K + k0 + 8 * c) = o; } }
    LDS_WAIT(); asm volatile("" ::: "memory");
}
template <class Dec> __device__ __forceinline__ void cvt_stream(const Dec& dec, int total, int first, int stride, LAS float* scr, int lane) {
    int it = first; if (it >= total) return;
    float v[32]; dec(it, true, scr, lane, v);
    for (;;) {
        const int itn = it + stride; const bool hn = itn < total; float vn[32];
        if (hn) dec(itn, true, scr, lane, vn);
        dec(it, false, scr, lane, v);
        if (!hn) break;
        it = itn;
#pragma unroll
        for (int i = 0; i < 32; ++i) v[i] = vn[i];
    }
}
__device__ __forceinline__ void cvt_do(const CvtDesc& d, bool load, LAS float* scr, int lane, float (&v)[32]) { if (load) cvt_load(d, lane, v); else cvt_finish(d, scr, lane, v); }
__device__ __forceinline__ void p0_prologue(Frame& F) {
    LAS float* scr = (LAS float*)(F.lds + F.wave * 8448);
    LAS float* SIL = (LAS float*)(F.lds + 69632);
    LAS float* RED = (LAS float*)(F.lds + 69632 + 36864);
    if ((int)blockIdx.x < 192) {
        for (int idx = F.tid; idx < 9 * 1024; idx += NWAVES * 64) { const int r = idx >> 10, k = idx & 1023; const float cv = r < 8 ? F.in[I_C][r * 1024 + k] : F.in[I_CCTX][k]; SIL[idx] = silu_f(cv); }
        __syncthreads();
        for (int t = blockIdx.x; t < 192; t += F.G) {
            const int i = t / 96, col0 = 64 * (t % 96);
            const float* wp = F.in[I_ADAW] + ((size_t)i * 1024 + F.wave * 128) * 6144 + col0 + F.lane;
            float acc[9];
#pragma unroll
            for (int r = 0; r < 9; ++r) acc[r] = 0.f;
            for (int k8 = 0; k8 < 128; k8 += 8) {
                float wv[8];
#pragma unroll
                for (int q = 0; q < 8; ++q) wv[q] = wp[(size_t)(k8 + q) * 6144];
#pragma unroll
                for (int q = 0; q < 8; ++q)
#pragma unroll
                    for (int r = 0; r < 9; ++r) acc[r] += SIL[r * 1024 + F.wave * 128 + k8 + q] * wv[q];
            }
#pragma unroll
            for (int r = 0; r < 9; ++r) RED[(F.wave * 9 + r) * 64 + F.lane] = acc[r];
            __syncthreads();
            for (int idx = F.tid; idx < 576; idx += NWAVES * 64) { const int r = idx >> 6, ln = idx & 63; float s = 0.f;
#pragma unroll
                for (int w = 0; w < 8; ++w) s += RED[(w * 9 + r) * 64 + ln];
                ((float*)(F.ws + WS_MOD))[(size_t)(i * 9 + r) * 6144 + col0 + ln] = s + F.in[I_ADAB][i * 6144 + col0 + ln]; }
            __syncthreads();
        }
    }
    const int gw = blockIdx.x * NWAVES + F.wave, NGW = F.G * NWAVES;
    constexpr int I0 = 16 * 194, I1 = 32 * 32, I2 = 16 * 176, I3 = 44 * 32, I4 = 16 * 96, I5 = 16 * 32;
    { const float* w0 = F.in[I_SWIN]; const float* w1 = F.in[I_SWOUT]; const float* w2 = F.in[I_FGU]; const float* w3 = F.in[I_FDN]; const float* w4 = F.in[I_SCWIN]; const float* w5 = F.in[I_SCWOUT]; unsigned char* ws = F.ws;
      auto dec = [w0, w1, w2, w3, w4, w5, ws](int it, bool load, LAS float* scr_, int lane_, float (&v)[32]) { CvtDesc d; d.mode = 0; d.dffx = 0; d.fp8 = 0; d.sc = 1.f; int r = it;
          if (r < I0) { d.W = w0; d.WT = ws + WS_WIN; d.K = 1024; d.N = DINP; d.item = r; cvt_do(d, load, scr_, lane_, v); return; } r -= I0;
          if (r < I1) { d.W = w1; d.WT = ws + WS_WOUT; d.K = 2048; d.N = 1024; d.item = r; cvt_do(d, load, scr_, lane_, v); return; } r -= I1;
          if (r < I2) { d.W = w2; d.WT = ws + WS_WGU; d.K = 1024; d.N = 2 * DFF; d.item = r; d.mode = 1; d.dffx = DFF; d.fp8 = FFN_FP8; d.sc = FFN_FP8 ? WGU_SCALE : 1.f; cvt_do(d, load, scr_, lane_, v); return; } r -= I2;
          if (r < I3) { d.W = w3; d.WT = ws + WS_WDN; d.K = DFF; d.N = 1024; d.item = r; d.fp8 = FFN_FP8; d.sc = FFN_FP8 ? WDN_SCALE : 1.f; cvt_do(d, load, scr_, lane_, v); return; } r -= I3;
          if (r < I4) { d.W = w4; d.WT = ws + WS_WSCI; d.K = 1024; d.N = 3072; d.item = r; cvt_do(d, load, scr_, lane_, v); return; } r -= I4;
          d.W = w5; d.WT = ws + WS_WSCO; d.K = 1024; d.N = 1024; d.item = r; cvt_do(d, load, scr_, lane_, v); };
      cvt_stream(dec, I0 + I1 + I2 + I3 + I4 + I5, gw, NGW, scr, F.lane); }
    { v4u* zp = (v4u*)((bf16*)(F.ws + WS_WIN) + (size_t)DINP * 1024); const int n16 = (DINP_PAD - DINP) * 1024 / 8;
      for (int i = blockIdx.x * (NWAVES * 64) + F.tid; i < n16; i += F.G * NWAVES * 64) zp[i] = (v4u){0u, 0u, 0u, 0u}; }
}
__device__ __forceinline__ void wave_sum2(float& a, float& b) {
#pragma unroll
    for (int o = 1; o < 64; o <<= 1) { const float ta = __shfl_xor(a, o), tb = __shfl_xor(b, o); a += ta; b += tb; }
}
__device__ __forceinline__ float ss_part(const f32x4 (&v)[4]) {
    float s = 0.f;
#pragma unroll
    for (int j = 0; j < 4; ++j) s += (v[j][0] * v[j][0] + v[j][1] * v[j][1]) + (v[j][2] * v[j][2] + v[j][3] * v[j][3]);
    return s;
}
__device__ __forceinline__ void p1_prenorm(Frame& F) {
    const int gw = blockIdx.x * NWAVES + F.wave, NGW = F.G * NWAVES, rstep = 2 * NGW;
    bf16* H = (bf16*)(F.ws + WS_H); const int c0 = 4 * F.lane;
    { const int r_beg = 2 * gw, r_end = MALL;
        f32x4 xq[2][4];
#define P1_SRC(rr_) ((rr_) < MLAT ? F.in[I_X] + (size_t)(rr_) * DM : F.in[I_CTX] + (size_t)((rr_) - MLAT) * DM)
#define P1_LOAD(rr_, s_) do { if ((rr_) < r_end) { const float* p_ = P1_SRC(rr_); _Pragma("unroll") for (int j = 0; j < 4; ++j) xq[s_][j] = *(const f32x4*)(p_ + c0 + 256 * j); } } while (0)
        P1_LOAD(r_beg, 0); P1_LOAD(r_beg + 1, 1);
        int mcur = -1; f32x4 npr[4], sc[4], sh[4];
        for (int r = r_beg; r < r_end; r += rstep) {
            const bool two = (r + 1) < r_end;
            f32x4 x0[4], x1[4];
#pragma unroll
            for (int j = 0; j < 4; ++j) { x0[j] = xq[0][j]; x1[j] = xq[1][j]; }
            P1_LOAD(r + rstep, 0); P1_LOAD(r + rstep + 1, 1);
            const int mr = r < MLAT ? (r >> 12) : 8;
            if (mr != mcur) { mcur = mr; const float* s_ = mod_vec(F, 0, mr, 1); const float* h_ = mod_vec(F, 0, mr, 0);
#pragma unroll
                for (int j = 0; j < 4; ++j) { npr[j] = *(const f32x4*)(F.in[I_NPRE] + c0 + 256 * j); sc[j] = *(const f32x4*)(s_ + c0 + 256 * j) + 1.0f; sh[j] = *(const f32x4*)(h_ + c0 + 256 * j); } }
            float t0 = ss_part(x0), t1 = ss_part(x1); wave_sum2(t0, t1);
            const float p0 = rsqrtf(t0 * (1.0f / DM) + EPS), p1 = rsqrtf(t1 * (1.0f / DM) + EPS);
#pragma unroll
            for (int j = 0; j < 4; ++j) { x0[j] = (x0[j] * p0 * npr[j]) * sc[j] + sh[j]; x1[j] = (x1[j] * p1 * npr[j]) * sc[j] + sh[j]; }
            store_row_bf16(H + (size_t)r * DM, F.lane, x0); if (two) store_row_bf16(H + (size_t)(r + 1) * DM, F.lane, x1);
        }
#undef P1_LOAD
#undef P1_SRC
    }
}
template <bool NEXT, bool H8OUT = false>
__device__ __forceinline__ void resnorm_phase(Frame& F, const float* xin, int layer, int gchunk, const float* npost, const float* npre, int nlayer, int scchunk, int shchunk) {
    const int gw = blockIdx.x * NWAVES + F.wave, NGW = F.G * NWAVES, rstep = 2 * NGW;
    const int r_beg = 2 * gw, r_end = MLAT;
    if (r_beg >= r_end) return;
    const bf16* Y = (const bf16*)(F.ws + WS_Y); bf16* H = (bf16*)(F.ws + WS_H);
    const int c0 = 4 * F.lane;
    v2u yq[2][4]; f32x4 xq[2][4];
#define RN_LOAD(rr_, s_) do { if ((rr_) < r_end) { _Pragma("unroll") for (int j = 0; j < 4; ++j) { yq[s_][j] = *(const v2u*)(Y + (size_t)(rr_) * DM + c0 + 256 * j); xq[s_][j] = *(const f32x4*)(xin + (size_t)(rr_) * DM + c0 + 256 * j); } } } while (0)
    RN_LOAD(r_beg, 0); RN_LOAD(r_beg + 1, 1);
    int bcur = -1; f32x4 gt[4], np[4], npr[4], sc[4], sh[4];
    for (int r = r_beg; r < r_end; r += rstep) {
        const bool two = (r + 1) < r_end;
        f32x4 y0[4], y1[4], x0[4], x1[4];
#pragma unroll
        for (int j = 0; j < 4; ++j) { y0[j] = unpack4(yq[0][j]); y1[j] = unpack4(yq[1][j]); x0[j] = xq[0][j]; x1[j] = xq[1][j]; }
        RN_LOAD(r + rstep, 0); RN_LOAD(r + rstep + 1, 1);
        const int b = r >> 12;
        if (b != bcur) { bcur = b; const float* g_ = mod_vec(F, layer, b, gchunk);
#pragma unroll
            for (int j = 0; j < 4; ++j) { gt[j] = *(const f32x4*)(g_ + c0 + 256 * j); np[j] = *(const f32x4*)(npost + c0 + 256 * j); }
            if (NEXT) { const float* s_ = mod_vec(F, nlayer, b, scchunk); const float* h_ = mod_vec(F, nlayer, b, shchunk);
#pragma unroll
                for (int j = 0; j < 4; ++j) { npr[j] = *(const f32x4*)(npre + c0 + 256 * j); sc[j] = *(const f32x4*)(s_ + c0 + 256 * j) + 1.0f; sh[j] = *(const f32x4*)(h_ + c0 + 256 * j); } } }
        float s0 = ss_part(y0), s1 = ss_part(y1); wave_sum2(s0, s1);
        const float q0 = rsqrtf(s0 * (1.0f / DM) + EPS), q1 = rsqrtf(s1 * (1.0f / DM) + EPS);
#pragma unroll
        for (int j = 0; j < 4; ++j) { x0[j] = x0[j] + gt[j] * ((y0[j] * q0) * np[j]); x1[j] = x1[j] + gt[j] * ((y1[j] * q1) * np[j]);
            *(f32x4*)(F.out + (size_t)r * DM + c0 + 256 * j) = x0[j]; if (two) *(f32x4*)(F.out + (size_t)(r + 1) * DM + c0 + 256 * j) = x1[j]; }
        if (NEXT) {
            float t0 = ss_part(x0), t1 = ss_part(x1); wave_sum2(t0, t1);
            const float p0 = rsqrtf(t0 * (1.0f / DM) + EPS), p1 = rsqrtf(t1 * (1.0f / DM) + EPS);
#pragma unroll
            for (int j = 0; j < 4; ++j) { x0[j] = (x0[j] * p0 * npr[j]) * sc[j] + sh[j]; x1[j] = (x1[j] * p1 * npr[j]) * sc[j] + sh[j]; }
            if (H8OUT) {
#pragma unroll
                for (int j = 0; j < 4; ++j) { *(unsigned*)((unsigned char*)H + (size_t)r * DM + c0 + 256 * j) = pk4_fp8(x0[j][0], x0[j][1], x0[j][2], x0[j][3]);
                    if (two) *(unsigned*)((unsigned char*)H + (size_t)(r + 1) * DM + c0 + 256 * j) = pk4_fp8(x1[j][0], x1[j][1], x1[j][2], x1[j][3]); } }
            else { store_row_bf16(H + (size_t)r * DM, F.lane, x0); if (two) store_row_bf16(H + (size_t)(r + 1) * DM, F.lane, x1); }
        }
    }
#undef RN_LOAD
}
__device__ __forceinline__ int ssd_sidx(int b, int cs, int g) { return (b * 34 + cs) * 8 + g; }
__device__ __forceinline__ void dt_scan(const float* DTR, int r0, int dcol, float bias, float A, int lane, float (&dt)[2], float (&dA)[2], float (&inc)[2], float& total) {
#pragma unroll
    for (int h = 0; h < 2; ++h) { const float x = DTR[(size_t)(r0 + lane + 64 * h) * 64 + dcol] + bias; dt[h] = x > 20.f ? x : log1pf(__expf(x)); dA[h] = dt[h] * A; }
    float s0 = dA[0], s1 = dA[1];
#pragma unroll
    for (int o = 1; o < 64; o <<= 1) { const float t0 = __shfl_up(s0, o), t1 = __shfl_up(s1, o); if (lane >= o) { s0 += t0; s1 += t1; } }
    const float tot0 = __shfl(s0, 63); s1 += tot0; inc[0] = s0; inc[1] = s1; total = __shfl(s1, 63);
}
__device__ __forceinline__ void ssd_phase_a(Frame& F, const int dry) {
    LAS unsigned char* XI = F.lds; LAS unsigned char* BI = F.lds + XI_BYTES; LAS float* WS = (LAS float*)(F.lds + SCAL_OFF);
    const int lane = F.lane, w = F.wave, gq = lane >> 4, q4 = (lane & 15) >> 2, p4 = lane & 3, l15 = lane & 15;
    const LAS unsigned char* trX = XI + (8 * gq + q4) * PXB + 8 * p4; const LAS unsigned char* trB = BI + (8 * gq + q4) * PBB + 8 * p4;
    bf16* XBC = (bf16*)(F.ws + WS_XBC); const float* DTR = (const float*)(F.ws + WS_DT); bf16* S = (bf16*)(F.ws + WS_S); float* CD = (float*)(F.ws + WS_CD);
    for (int u = blockIdx.x; u < NUNIT; u += F.G) {
        int b, cs, g; bool isctx;
        if (u < NUNIT_LAT) { b = u >> 8; cs = (u >> 3) & 31; g = u & 7; isctx = false; } else { const int v = u - NUNIT_LAT; b = v >> 4; cs = 32 + ((v >> 3) & 1); g = v & 7; isctx = true; }
        const int r0 = isctx ? MLAT + b * CTXL + (cs - 32) * 128 : b * SEQ + cs * 128, sidx = ssd_sidx(b, cs, g);
        const int col = lane < 32 ? g * 256 + 8 * lane : (lane < 48 ? 2048 + g * 128 + 8 * (lane - 32) : 3072 + g * 128 + 8 * (lane - 48));
        const int l0 = 16 * w; int lo, hi; if (isctx) { lo = -(cs - 32) * 128; hi = lo + 255; } else { lo = l0 & ~63; hi = lo + 63; }
        v4u raw[20];
#pragma unroll
        for (int i = 0; i < 20; ++i) { const int lp = l0 - 2 + i; raw[i] = (lp >= lo && lp <= hi) ? *(const v4u*)(XBC + (long)(r0 + lp) * CONVD + col) : (v4u){0u, 0u, 0u, 0u}; }
        f32x2n wt[5][4], bs[4];
#pragma unroll
        for (int t = 0; t < 5; ++t) { const f32x4 a = *(const f32x4*)(F.in[I_SCONVW] + t * CONVD + col), c4 = *(const f32x4*)(F.in[I_SCONVW] + t * CONVD + col + 4);
            wt[t][0] = (f32x2n){a[0], a[1]}; wt[t][1] = (f32x2n){a[2], a[3]}; wt[t][2] = (f32x2n){c4[0], c4[1]}; wt[t][3] = (f32x2n){c4[2], c4[3]}; }
        { const f32x4 a = *(const f32x4*)(F.in[I_SCONVB] + col), c4 = *(const f32x4*)(F.in[I_SCONVB] + col + 4);
          bs[0] = (f32x2n){a[0], a[1]}; bs[1] = (f32x2n){a[2], a[3]}; bs[2] = (f32x2n){c4[0], c4[1]}; bs[3] = (f32x2n){c4[2], c4[3]}; }
        VM_WAIT(); LDS_BARRIER();
        f32x2n f[5][4];
#define UNPK_ROW(dst, rw) do { dst[0] = (f32x2n){bflo(rw.x), bfhi(rw.x)}; dst[1] = (f32x2n){bflo(rw.y), bfhi(rw.y)}; dst[2] = (f32x2n){bflo(rw.z), bfhi(rw.z)}; dst[3] = (f32x2n){bflo(rw.w), bfhi(rw.w)}; } while (0)
#pragma unroll
        for (int i = 0; i < 4; ++i) UNPK_ROW(f[i], raw[i]);
#pragma unroll
        for (int i = 0; i < 16; ++i) {
            UNPK_ROW(f[(i + 4) % 5], raw[i + 4]);
            unsigned ow[4];
#pragma unroll
            for (int e = 0; e < 4; ++e) { f32x2n a = bs[e];
#pragma unroll
                for (int t = 0; t < 5; ++t) a = wt[t][e] * f[(i + t) % 5][e] + a;
                ow[e] = pk2(silu_f(a.x), silu_f(a.y)); }
            const v4u ov = {ow[0], ow[1], ow[2], ow[3]};
            const int l = l0 + i;
            if (lane < 32) *(LAS v4u*)(XI + l * PXB + 16 * lane) = ov; else if (lane < 48) *(LAS v4u*)(BI + l * PBB + 16 * (lane - 32)) = ov;
            if (!isctx && !dry) *(v4u*)(XBC + (size_t)(r0 + l) * CONVD + col) = ov;
        }
#undef UNPK_ROW
        { const int d = w >> 2, hh = g * 4 + (w & 3); float dt[2], dA[2], inc[2], total;
          dt_scan(DTR, r0, d * 32 + hh, F.in[I_SDTB][d * 32 + hh], -__expf(F.in[I_SALOG][d * 32 + hh]), lane, dt, dA, inc, total);
#pragma unroll
          for (int h = 0; h < 2; ++h) WS[w * 128 + lane + 64 * h] = dt[h] * (d == 0 ? __expf(total - inc[h]) : __expf(inc[h] - dA[h]));
          if (lane == 0) CD[sidx * 8 + w] = __expf(total); }
        LDS_BARRIER();
        bf16x8 bt[4];
#pragma unroll
        for (int ks = 0; ks < 4; ++ks) bt[ks] = tr_pair(trB + (32 * ks) * PBB + 32 * w, trB + (32 * ks + 4) * PBB + 32 * w);
#pragma unroll 1
        for (int j = 0; j < (dry == 2 ? 0 : 4); ++j) {
            bf16x8 as_[2][4];
#pragma unroll
            for (int d = 0; d < 2; ++d) {
                const int combo = d * 4 + j;
#pragma unroll
                for (int ks = 0; ks < 4; ++ks) { const f32x4 w0 = *(const LAS f32x4*)(WS + combo * 128 + 32 * ks + 8 * gq), w1 = *(const LAS f32x4*)(WS + combo * 128 + 32 * ks + 8 * gq + 4);
                    const bf16x8 r8 = bt[ks]; bf16x8 o8;
                    const unsigned u0 = pk2(bf1((bf16)r8[0]) * w0[0], bf1((bf16)r8[1]) * w0[1]), u1 = pk2(bf1((bf16)r8[2]) * w0[2], bf1((bf16)r8[3]) * w0[3]);
                    const unsigned u2 = pk2(bf1((bf16)r8[4]) * w1[0], bf1((bf16)r8[5]) * w1[1]), u3 = pk2(bf1((bf16)r8[6]) * w1[2], bf1((bf16)r8[7]) * w1[3]);
                    o8[0] = (short)(u0 & 0xffff); o8[1] = (short)(u0 >> 16); o8[2] = (short)(u1 & 0xffff); o8[3] = (short)(u1 >> 16); o8[4] = (short)(u2 & 0xffff); o8[5] = (short)(u2 >> 16); o8[6] = (short)(u3 & 0xffff); o8[7] = (short)(u3 >> 16);
                    as_[d][ks] = o8; }
            }
#pragma unroll
            for (int pt = 0; pt < 4; ++pt) {
                bf16x8 xf[4];
#pragma unroll
                for (int ks = 0; ks < 4; ++ks) xf[ks] = tr_pair(trX + (32 * ks) * PXB + (j * 64 + pt * 16) * 2, trX + (32 * ks + 4) * PXB + (j * 64 + pt * 16) * 2);
#pragma unroll
                for (int d = 0; d < 2; ++d) { const int combo = d * 4 + j; f32x4 acc = {0.f, 0.f, 0.f, 0.f};
#pragma unroll
                    for (int ks = 0; ks < 4; ++ks) acc = MFMA16(as_[d][ks], xf[ks], acc);
                    *(v2u*)(S + ((size_t)(sidx * 8 + combo) * 64 + pt * 16 + l15) * 128 + 16 * w + 4 * gq) = pack4(acc); }
            }
        }
        LDS_BARRIER();
    }
}
__device__ __forceinline__ void ssd_phase_b(Frame& F) {
    bf16* S = (bf16*)(F.ws + WS_S); const float* CD = (const float*)(F.ws + WS_CD);
    const int NT = F.G * NWAVES * 64;
    for (int q = blockIdx.x * (NWAVES * 64) + F.tid; q < 512 * 1024; q += NT) {
        const int e8 = q & 1023, seq = q >> 10, combo = seq & 7, g = (seq >> 3) & 7, b = seq >> 6, d = combo >> 2;
        float h[8];
#pragma unroll
        for (int e = 0; e < 8; ++e) h[e] = 0.f;
#pragma unroll
        for (int k = 0; k < 2; ++k) { const int cs = d == 0 ? 32 + k : 33 - k, si = ssd_sidx(b, cs, g) * 8 + combo; const float dec = CD[si]; const v4u t = *(const v4u*)(S + (size_t)si * 8192 + e8 * 8);
            h[0] = dec * h[0] + bflo(t.x); h[1] = dec * h[1] + bfhi(t.x); h[2] = dec * h[2] + bflo(t.y); h[3] = dec * h[3] + bfhi(t.y); h[4] = dec * h[4] + bflo(t.z); h[5] = dec * h[5] + bfhi(t.z); h[6] = dec * h[6] + bflo(t.w); h[7] = dec * h[7] + bfhi(t.w); }
        for (int c0 = 0; c0 < 32; c0 += 8) {
            v4u t[8]; float dc[8];
#pragma unroll
            for (int k = 0; k < 8; ++k) { const int cs = d == 0 ? c0 + k : 31 - (c0 + k), si = ssd_sidx(b, cs, g) * 8 + combo; dc[k] = CD[si]; t[k] = *(const v4u*)(S + (size_t)si * 8192 + e8 * 8); }
#pragma unroll
            for (int k = 0; k < 8; ++k) { const int cs = d == 0 ? c0 + k : 31 - (c0 + k), si = ssd_sidx(b, cs, g) * 8 + combo;
                v4u o; o.x = pk2(h[0], h[1]); o.y = pk2(h[2], h[3]); o.z = pk2(h[4], h[5]); o.w = pk2(h[6], h[7]);
                *(v4u*)(S + (size_t)si * 8192 + e8 * 8) = o;
                const float dec = dc[k]; const v4u tt = t[k];
                h[0] = dec * h[0] + bflo(tt.x); h[1] = dec * h[1] + bfhi(tt.x); h[2] = dec * h[2] + bflo(tt.y); h[3] = dec * h[3] + bfhi(tt.y); h[4] = dec * h[4] + bflo(tt.z); h[5] = dec * h[5] + bfhi(tt.z); h[6] = dec * h[6] + bflo(tt.w); h[7] = dec * h[7] + bfhi(tt.w); }
        }
    }
}
__device__ __forceinline__ void ssd_phase_c(Frame& F, const int dry) {
    LAS unsigned char* XI = F.lds; LAS unsigned char* BI = F.lds + XI_BYTES; LAS unsigned char* MWw = F.lds + XI_BYTES + BI_BYTES + F.wave * (16 * PMB);
    LAS float* DTS = (LAS float*)(F.lds + SCAL_OFF); LAS float* INC = DTS + 1024; LAS float* EXC = DTS + 2048; LAS float* BPw = (LAS float*)(F.lds + BPW_OFF) + F.wave * 128;
    const int tid = F.tid, lane = F.lane, w = F.wave, gq = lane >> 4, q4 = (lane & 15) >> 2, p4 = lane & 3, l15 = lane & 15, lme = 16 * w + l15;
    const LAS unsigned char* trX = XI + (8 * gq + q4) * PXB + 8 * p4;
    const bf16* XBC = (const bf16*)(F.ws + WS_XBC); const float* DTR = (const float*)(F.ws + WS_DT); const bf16* HIN = (const bf16*)(F.ws + WS_S); bf16* Z = (bf16*)(F.ws + WS_Z);
    for (int u = blockIdx.x; u < NUNIT_LAT; u += F.G) {
        const int b = u >> 8, c = (u >> 3) & 31, g = u & 7, r0 = b * SEQ + c * 128, sidx = ssd_sidx(b, c, g);
#pragma unroll
        for (int k = 0; k < 8; ++k) { const int id = tid + 512 * k, row = id >> 5, ch = id & 31; *(LAS v4u*)(XI + row * PXB + 16 * ch) = *(const v4u*)(XBC + (size_t)(r0 + row) * CONVD + g * 256 + 8 * ch); }
#pragma unroll
        for (int k = 0; k < 4; ++k) { const int id = tid + 512 * k, row = id >> 4, ch = id & 15; *(LAS v4u*)(BI + row * PBB + 16 * ch) = *(const v4u*)(XBC + (size_t)(r0 + row) * CONVD + 2048 + g * 128 + 8 * ch); }
        bf16x8 cf[4];
#pragma unroll
        for (int ks = 0; ks < 4; ++ks) cf[ks] = *(const bf16x8*)(XBC + (size_t)(r0 + lme) * CONVD + 3072 + g * 128 + 32 * ks + 8 * gq);
        v4u hp[2];
        const bf16* hbase = HIN + (size_t)sidx * 8 * 8192;
#pragma unroll
        for (int k = 0; k < 2; ++k) { const int id = tid + 512 * k; hp[k] = *(const v4u*)(hbase + (size_t)(id >> 4) * 128 + 8 * (id & 15)); }
        { const int d = w >> 2, hh = g * 4 + (w & 3); float dt[2], dA[2], inc[2], total;
          dt_scan(DTR, r0, d * 32 + hh, F.in[I_SDTB][d * 32 + hh], -__expf(F.in[I_SALOG][d * 32 + hh]), lane, dt, dA, inc, total);
#pragma unroll
          for (int h = 0; h < 2; ++h) { DTS[w * 128 + lane + 64 * h] = dt[h]; INC[w * 128 + lane + 64 * h] = inc[h]; EXC[w * 128 + lane + 64 * h] = inc[h] - dA[h]; } }
        LDS_BARRIER();
        f32x4 Gt[8];
#pragma unroll
        for (int st = 0; st < 8; ++st) { f32x4 a = {0.f, 0.f, 0.f, 0.f};
#pragma unroll
            for (int ks = 0; ks < 4; ++ks) a = MFMA16(*(const LAS bf16x8*)(BI + (16 * st + l15) * PBB + (32 * ks + 8 * gq) * 2), cf[ks], a);
            Gt[st] = a; }
        LDS_BARRIER();
        LAS unsigned char* HB0 = BI; LAS unsigned char* HB1 = BI + 64 * PBB;
#pragma unroll
        for (int k = 0; k < 2; ++k) { const int id = tid + 512 * k; *(LAS v4u*)(HB0 + (id >> 4) * PBB + 16 * (id & 15)) = hp[k]; }
        v4u hq[2];
#pragma unroll
        for (int k = 0; k < 2; ++k) { const int id = tid + 512 * k; hp[k] = *(const v4u*)(hbase + 4 * 8192 + (size_t)(id >> 4) * 128 + 8 * (id & 15));
                                      hq[k] = *(const v4u*)(hbase + 1 * 8192 + (size_t)(id >> 4) * 128 + 8 * (id & 15)); }
        LDS_BARRIER();
        float ssq = 0.f;
#pragma unroll 1
        for (int j = 0; j < 4; ++j) {
            f32x4 Y[4]; v2u zr[4];
#pragma unroll
            for (int pt = 0; pt < 4; ++pt) { Y[pt] = (f32x4){0.f, 0.f, 0.f, 0.f}; zr[pt] = *(const v2u*)(Z + (size_t)(r0 + lme) * DIN + g * 256 + j * 64 + pt * 16 + 4 * gq); }
#pragma unroll 1
            for (int d = 0; d < (dry == 2 ? 0 : 2); ++d) {
                const int combo = d * 4 + j, ci = 2 * j + d;
                LAS unsigned char* HBc = (ci & 1) ? HB1 : HB0; LAS unsigned char* HBn = (ci & 1) ? HB0 : HB1;
                if (ci < 7) {
#pragma unroll
                    for (int k = 0; k < 2; ++k) { const int id = tid + 512 * k; *(LAS v4u*)(HBn + (id >> 4) * PBB + 16 * (id & 15)) = hp[k]; }
#pragma unroll
                    for (int k = 0; k < 2; ++k) hp[k] = hq[k];
                    if (ci < 5) { const int cn = ci + 3, combn = (cn & 1) * 4 + (cn >> 1);
#pragma unroll
                        for (int k = 0; k < 2; ++k) { const int id = tid + 512 * k; hq[k] = *(const v4u*)(hbase + (size_t)combn * 8192 + (size_t)(id >> 4) * 128 + 8 * (id & 15)); } }
                }
                const LAS float* U = (d ? EXC : INC) + combo * 128; const LAS float* DTc = DTS + combo * 128;
                const float tot = INC[combo * 128 + 127], u_l = U[lme]; const int kd = w >> 1;
                const float u_ref = d ? (kd == 3 ? tot : U[32 * kd + 32]) : (kd == 0 ? 0.f : U[32 * kd - 1]);
                const float a_l = __expf(d ? (u_ref - u_l) : (u_l - u_ref)), e_ref = __expf(d ? (tot - u_ref) : u_ref);
#pragma unroll
                for (int h = 0; h < 2; ++h) { const int s = lane + 64 * h; const float ar = d ? (U[s] - u_ref) : (u_ref - U[s]); BPw[s] = __expf(fminf(ar, 0.f)) * DTc[s]; }
                f32x4 Yp[4];
#pragma unroll
                for (int pt = 0; pt < 4; ++pt) { f32x4 a = {0.f, 0.f, 0.f, 0.f};
#pragma unroll
                    for (int ks = 0; ks < 4; ++ks) a = MFMA16(*(const LAS bf16x8*)(HBc + (16 * pt + l15) * PBB + (32 * ks + 8 * gq) * 2), cf[ks], a);
                    Yp[pt] = a * e_ref; }
#pragma unroll
                for (int ks = 0; ks < 4; ++ks) {
                    const bool offd = d ? (ks > kd) : (ks < kd);
                    if (offd) {
#pragma unroll
                        for (int t2 = 0; t2 < 2; ++t2) { const int st = 2 * ks + t2, s0 = 16 * st + 4 * gq; const f32x4 bp = *(const LAS f32x4*)(BPw + s0);
                            *(LAS v2u*)(MWw + l15 * PMB + s0 * 2) = pack4(Gt[st] * bp); }
                        const bf16x8 mb = *(const LAS bf16x8*)(MWw + l15 * PMB + (32 * ks + 8 * gq) * 2);
#pragma unroll
                        for (int pt = 0; pt < 4; ++pt) { const bf16x8 xa = tr_pair(trX + (32 * ks) * PXB + (j * 64 + pt * 16) * 2, trX + (32 * ks + 4) * PXB + (j * 64 + pt * 16) * 2);
                            Yp[pt] = MFMA16(xa, mb, Yp[pt]); }
                    }
                }
#pragma unroll
                for (int pt = 0; pt < 4; ++pt) Y[pt] = Y[pt] + Yp[pt] * a_l;
#pragma unroll
                for (int ks = 0; ks < 4; ++ks) if (ks == kd) {
#pragma unroll
                    for (int t2 = 0; t2 < 2; ++t2) { const int st = 2 * ks + t2, s0 = 16 * st + 4 * gq; const f32x4 u_s = *(const LAS f32x4*)(U + s0), dt_s = *(const LAS f32x4*)(DTc + s0);
                        f32x4 val;
#pragma unroll
                        for (int e = 0; e < 4; ++e) { const int s = s0 + e; const bool valid = d ? (s >= lme) : (s <= lme); const float arg = d ? (u_s[e] - u_l) : (u_l - u_s[e]);
                            val[e] = valid ? Gt[st][e] * __expf(arg) * dt_s[e] : 0.f; }
                        *(LAS v2u*)(MWw + l15 * PMB + s0 * 2) = pack4(val); }
                    const bf16x8 mb = *(const LAS bf16x8*)(MWw + l15 * PMB + (32 * ks + 8 * gq) * 2);
#pragma unroll
                    for (int pt = 0; pt < 4; ++pt) { const bf16x8 xa = tr_pair(trX + (32 * ks) * PXB + (j * 64 + pt * 16) * 2, trX + (32 * ks + 4) * PXB + (j * 64 + pt * 16) * 2);
                        Y[pt] = MFMA16(xa, mb, Y[pt]); }
                }
                LDS_BARRIER();
            }
            const float dsk = F.in[I_SD][g * 4 + j];
#pragma unroll
            for (int pt = 0; pt < 4; ++pt) { const int ch = j * 64 + pt * 16 + 4 * gq;
                const f32x4 xv = unpack4(*(const LAS v2u*)(XI + lme * PXB + ch * 2)), zv = unpack4(zr[pt]);
                f32x4 y = Y[pt] + xv * dsk;
#pragma unroll
                for (int e = 0; e < 4; ++e) { y[e] = y[e] * silu_f(zv[e]); ssq += y[e] * y[e]; }
                *(LAS v2u*)(XI + lme * PXB + ch * 2) = pack4(y); }
        }
        ssq += __shfl_xor(ssq, 16); ssq += __shfl_xor(ssq, 32);
        const float rr = rsqrtf(ssq * (1.0f / 256.0f) + EPS);
#pragma unroll
        for (int j = 0; j < 4; ++j)
#pragma unroll
            for (int pt = 0; pt < 4; ++pt) { const int cl = j * 64 + pt * 16 + 4 * gq, ch = g * 256 + cl; const f32x4 nw = *(const f32x4*)(F.in[I_SNORM] + ch);
                if (!dry) *(v2u*)(Z + (size_t)(r0 + lme) * DIN + ch) = pack4(unpack4(*(const LAS v2u*)(XI + lme * PXB + cl * 2)) * rr * nw); }
        LDS_BARRIER();
    }
}

__device__ __forceinline__ void p12_shortconv(Frame& F) {
    const bf16* P = (const bf16*)(F.ws + WS_SCP); bf16* U = (bf16*)(F.ws + WS_H); const float* cw = F.in[I_SCCONV];
    const int NT = F.G * NWAVES * 64;
    for (int id = blockIdx.x * (NWAVES * 64) + F.tid; id < MLAT * 128; id += NT) {
        const int r = id >> 7, col = 8 * (id & 127), xpos = r & 63;
        float acc[8];
#pragma unroll
        for (int e = 0; e < 8; ++e) acc[e] = 0.f;
#pragma unroll
        for (int t = 0; t < 3; ++t) { const int xp = xpos + t - 1; if (xp >= 0 && xp < 64) {
            const v4u gc = *(const v4u*)(P + (size_t)(r + t - 1) * 3072 + 1024 + col), vv = *(const v4u*)(P + (size_t)(r + t - 1) * 3072 + 2048 + col);
            const f32x4 w0 = *(const f32x4*)(cw + t * 1024 + col), w1 = *(const f32x4*)(cw + t * 1024 + col + 4);
            acc[0] += w0[0] * (bflo(gc.x) * bflo(vv.x)); acc[1] += w0[1] * (bfhi(gc.x) * bfhi(vv.x)); acc[2] += w0[2] * (bflo(gc.y) * bflo(vv.y)); acc[3] += w0[3] * (bfhi(gc.y) * bfhi(vv.y));
            acc[4] += w1[0] * (bflo(gc.z) * bflo(vv.z)); acc[5] += w1[1] * (bfhi(gc.z) * bfhi(vv.z)); acc[6] += w1[2] * (bflo(gc.w) * bflo(vv.w)); acc[7] += w1[3] * (bfhi(gc.w) * bfhi(vv.w)); } }
        const v4u gb = *(const v4u*)(P + (size_t)r * 3072 + col);
        v4u o; o.x = pk2(bflo(gb.x) * acc[0], bfhi(gb.x) * acc[1]); o.y = pk2(bflo(gb.y) * acc[2], bfhi(gb.y) * acc[3]); o.z = pk2(bflo(gb.z) * acc[4], bfhi(gb.z) * acc[5]); o.w = pk2(bflo(gb.w) * acc[6], bfhi(gb.w) * acc[7]);
        *(v4u*)(U + (size_t)r * DM + col) = o;
    }
}

__device__ __forceinline__ void p14_resnorm_route(Frame& F) {
    LAS float* RW = (LAS float*)F.lds;
    LAS int* SEL = (LAS int*)(F.lds + 32768);
    const bf16* Y = (const bf16*)(F.ws + WS_Y); unsigned char* H8 = (unsigned char*)(F.ws + WS_H);
    int* SELR = (int*)(F.ws + WS_ROUTE + RT_SELR); float* GATE = (float*)(F.ws + WS_ROUTE + RT_GATE); int* CNT = (int*)(F.ws + WS_ROUTE + RT_CNT);
    for (int i = F.tid; i < 8192; i += NWAVES * 64) RW[i] = F.in[I_ROUTER][i];
    __syncthreads();
    const float* npost = F.in[I_NPOST] + 2 * 1024; const float* npre = F.in[I_NPRE] + 3 * 1024;
    for (int vb = blockIdx.x; vb < 256; vb += F.G) {
        for (int i = 0; i < 16; ++i) {
            const int tl = 16 * F.wave + i, r = 128 * vb + tl, b = r >> 12;
            f32x4 y[4], x[4]; load_row_bf16(Y + (size_t)r * DM, F.lane, y); load_row_f32(F.out + (size_t)r * DM, F.lane, x);
            const float rr = rsqrtf(row_ss(y) * (1.0f / DM) + EPS); const float* gt = mod_vec(F, 1, b, 2);
#pragma unroll
            for (int j = 0; j < 4; ++j) { const int col = 4 * F.lane + 256 * j; x[j] = x[j] + *(const f32x4*)(gt + col) * ((y[j] * rr) * *(const f32x4*)(npost + col)); *(f32x4*)(F.out + (size_t)r * DM + col) = x[j]; }
            prenorm_mod(x, npre, mod_vec(F, 1, b, 4), mod_vec(F, 1, b, 3), F.lane);
#pragma unroll
            for (int j = 0; j < 4; ++j) *(unsigned*)(H8 + (size_t)r * DM + 4 * F.lane + 256 * j) = pk4_fp8(x[j][0], x[j][1], x[j][2], x[j][3]);
            float lg[8];
#pragma unroll
            for (int e = 0; e < 8; ++e) lg[e] = 0.f;
#pragma unroll
            for (int j = 0; j < 4; ++j)
#pragma unroll
                for (int q = 0; q < 4; ++q) { const int col = 4 * F.lane + 256 * j + q; const f32x4 r0 = *(const LAS f32x4*)(RW + col * 8), r1 = *(const LAS f32x4*)(RW + col * 8 + 4); const float hv = x[j][q];
                    lg[0] += hv * r0[0]; lg[1] += hv * r0[1]; lg[2] += hv * r0[2]; lg[3] += hv * r0[3]; lg[4] += hv * r1[0]; lg[5] += hv * r1[1]; lg[6] += hv * r1[2]; lg[7] += hv * r1[3]; }
#pragma unroll
            for (int e = 0; e < 8; ++e) lg[e] = wave_sum(lg[e]);
            int e0 = 0; float v0 = lg[0];
#pragma unroll
            for (int e = 1; e < 8; ++e) if (lg[e] > v0) { v0 = lg[e]; e0 = e; }
            int e1 = -1; float v1 = 0.f;
#pragma unroll
            for (int e = 0; e < 8; ++e) if (e != e0 && (e1 < 0 || lg[e] > v1)) { v1 = lg[e]; e1 = e; }
            if (F.lane == 0) { const float g0 = 1.0f / (1.0f + __expf(v1 - v0)); GATE[2 * r] = g0; GATE[2 * r + 1] = 1.0f - g0; SEL[2 * tl] = e0; SEL[2 * tl + 1] = e1; }
        }
        __syncthreads();
        if (F.tid < 8) { int cnt = 0;
            for (int t = 0; t < 256; ++t) if (SEL[t] == F.tid) { SELR[256 * vb + t] = F.tid | (cnt << 8); ++cnt; }
            CNT[vb * 8 + F.tid] = cnt; }
        __syncthreads();
    }
}
__device__ __forceinline__ void p15_permute(Frame& F) {
    LAS int* CNTL = (LAS int*)(F.lds + 69632);
    LAS int* PRE = CNTL + 2048;
    LAS int* TOT = PRE + 2048;
    LAS int* SEG = TOT + 8;
    const int* CNT = (const int*)(F.ws + WS_ROUTE + RT_CNT); const int* SELR = (const int*)(F.ws + WS_ROUTE + RT_SELR);
    int* POS = (int*)(F.ws + WS_ROUTE + RT_POS); int* TEXP = (int*)(F.ws + WS_ROUTE + RT_TEXP);
    const unsigned char* H8 = (const unsigned char*)(F.ws + WS_H); unsigned char* HP = (unsigned char*)(F.ws + WS_HP8);
    for (int i = F.tid; i < 2048; i += NWAVES * 64) CNTL[i] = CNT[i];
    __syncthreads();
    if (F.tid < 8) { int run = 0; for (int v = 0; v < 256; ++v) { PRE[v * 8 + F.tid] = run; run += CNTL[v * 8 + F.tid]; } TOT[F.tid] = run; }
    __syncthreads();
    if (F.tid == 0) { int ss = 0; for (int e = 0; e < 8; ++e) { SEG[e] = ss; ss += (TOT[e] + 255) & ~255; } SEG[8] = ss;
        if (blockIdx.x == 0) { for (int e = 0; e < 8; ++e) for (int t = SEG[e] >> 8; t < (SEG[e + 1] >> 8); ++t) TEXP[t] = e; TEXP[300] = ss >> 8; } }
    __syncthreads();
    for (int vb = blockIdx.x; vb < 256; vb += F.G) {
        for (int i = 0; i < 16; ++i) { const int tl = 16 * F.wave + i, r = 128 * vb + tl;
            const v4u a = *(const v4u*)(H8 + (size_t)r * DM + 16 * F.lane);
#pragma unroll
            for (int k = 0; k < 2; ++k) { const int sr = SELR[2 * r + k], e = sr & 255, pos = SEG[e] + PRE[vb * 8 + e] + (sr >> 8);
                *(v4u*)(HP + (size_t)pos * DM + 16 * F.lane) = a;
                if (F.lane == 0) POS[2 * r + k] = pos; } }
    }
    if ((int)blockIdx.x < 8) { const int e = blockIdx.x;
        for (int row = SEG[e] + TOT[e] + F.wave; row < SEG[e + 1]; row += NWAVES) *(v4u*)(HP + (size_t)row * DM + 16 * F.lane) = (v4u){0u, 0u, 0u, 0u}; }
    LAS float* scr = (LAS float*)(F.lds + F.wave * 8448);
    const int gw = blockIdx.x * NWAVES + F.wave, NGW = F.G * NWAVES;
    constexpr int IG = 16 * 224, ID = 56 * 32;
    { const float* mg = F.in[I_MGU]; const float* md = F.in[I_MDN]; unsigned char* ws = F.ws;
      auto dec = [mg, md, ws](int it, bool load, LAS float* scr_, int lane_, float (&v)[32]) { CvtDesc d; d.fp8 = 1; const int e = it / (IG + ID), r = it % (IG + ID);
          if (r < IG) { d.W = mg + (size_t)e * 1024 * 2 * DFFE; d.WT = ws + WS_WMGU + (size_t)e * 2 * DFFE * 1024; d.K = 1024; d.N = 2 * DFFE; d.item = r; d.mode = 1; d.dffx = DFFE; d.sc = WGU_SCALE; cvt_do(d, load, scr_, lane_, v); }
          else { d.W = md + (size_t)e * DFFE * 1024; d.WT = ws + WS_WMDN + (size_t)e * 1024 * DFFE; d.K = DFFE; d.N = 1024; d.item = r - IG; d.mode = 0; d.dffx = 0; d.sc = WDN_SCALE; cvt_do(d, load, scr_, lane_, v); } };
      cvt_stream(dec, 8 * (IG + ID), gw, NGW, scr, F.lane); }
}
__device__ __forceinline__ void p18_final(Frame& F) {
    const int gw = blockIdx.x * NWAVES + F.wave, NGW = F.G * NWAVES;
    const bf16* YP = (const bf16*)(F.ws + WS_YP); const int* POS = (const int*)(F.ws + WS_ROUTE + RT_POS); const float* GATE = (const float*)(F.ws + WS_ROUTE + RT_GATE);
    const float* npost = F.in[I_NPOST] + 3 * 1024;
    for (int r = gw; r < MLAT; r += NGW) {
        const int b = r >> 12, p0 = POS[2 * r], p1 = POS[2 * r + 1]; const float g0 = GATE[2 * r], g1 = GATE[2 * r + 1];
        f32x4 a[4], c[4], x[4]; load_row_bf16(YP + (size_t)p0 * DM, F.lane, a); load_row_bf16(YP + (size_t)p1 * DM, F.lane, c); load_row_f32(F.out + (size_t)r * DM, F.lane, x);
#pragma unroll
        for (int j = 0; j < 4; ++j) a[j] = a[j] * g0 + c[j] * g1;
        const float rr = rsqrtf(row_ss(a) * (1.0f / DM) + EPS); const float* gt = mod_vec(F, 1, b, 5);
#pragma unroll
        for (int j = 0; j < 4; ++j) { const int col = 4 * F.lane + 256 * j; *(f32x4*)(F.out + (size_t)r * DM + col) = x[j] + *(const f32x4*)(gt + col) * ((a[j] * rr) * *(const f32x4*)(npost + col)); }
    }
}

#define XB_TMO      128
#define XB_XCNT(j)  (256  + 64 * (j))
#define XB_XSUB(j)  (1280 + 64 * (j))
#define XB_XGEN(j)  (2304 + 64 * (j))
#define XB_TOP      3328
#define XB_TOPGEN   3392
#define XCD_BAR_WORDS 3456
#define XB_SPIN_CAP (1u << 18)

__device__ __forceinline__ unsigned xb_ld(unsigned* p)              { return __hip_atomic_load(p, __ATOMIC_RELAXED, __HIP_MEMORY_SCOPE_AGENT); }
__device__ __forceinline__ unsigned xb_add(unsigned* p, unsigned v) { return __hip_atomic_fetch_add(p, v, __ATOMIC_RELAXED, __HIP_MEMORY_SCOPE_AGENT); }
__device__ __forceinline__ unsigned xb_xcc_id() { return (unsigned)__builtin_amdgcn_s_getreg((3 << 11) | 20) & 0xFu; }
#define XB_SPIN(cond, bar) do { unsigned _sp = 0; while (cond) { __builtin_amdgcn_s_sleep(1); \
    if ((++_sp & 255u) == 0u) { if (xb_ld(&(bar)[XB_TMO])) break; if (_sp > XB_SPIN_CAP) { atomicAdd(&(bar)[XB_TMO], 1u); break; } } } } while (0)

struct XcdBarrier {
    unsigned* bar; unsigned x;
    volatile LAS unsigned* st;
};

__device__ __forceinline__ XcdBarrier xcd_barrier_post(unsigned* bar, volatile LAS unsigned* st) {
    XcdBarrier b; b.bar = bar; b.x = xb_xcc_id(); b.st = st;
    if (threadIdx.x == 0) (void)xb_add(&bar[XB_XCNT(b.x)], 1u);
    return b;
}
__device__ __forceinline__ void xcd_barrier_complete(unsigned* bar, unsigned x, unsigned& nloc, unsigned& nx) {
    const unsigned G = gridDim.x * gridDim.y * gridDim.z;
    unsigned sum, cnt, mine, sp = 0u;
    for (;;) {
        sum = 0u; cnt = 0u; mine = 0u;
#pragma unroll
        for (unsigned j = 0; j < 16; ++j) { const unsigned c = xb_ld(&bar[XB_XCNT(j)]); sum += c; cnt += (c > 0u) ? 1u : 0u; mine = (j == x) ? c : mine; }
        if (sum == G) break;
        __builtin_amdgcn_s_sleep(1);
        if ((++sp & 255u) == 0u) { if (xb_ld(&bar[XB_TMO])) break; if (sp > XB_SPIN_CAP) { atomicAdd(&bar[XB_TMO], 1u); break; } }
    }
    nloc = mine > 0u ? mine : 1u; nx = cnt > 0u ? cnt : 1u;
}

__device__ __forceinline__ void xcd_barrier(const XcdBarrier& b) {
    asm volatile("s_waitcnt vmcnt(0)" ::: "memory");
    __syncthreads();
    if (threadIdx.x == 0) {
        unsigned* bar = b.bar;
        __builtin_amdgcn_s_waitcnt(0);
        unsigned nloc = b.st[0], nx = b.st[1];
        if (nloc == 0u) { xcd_barrier_complete(bar, b.x, nloc, nx); b.st[0] = nloc; b.st[1] = nx; }
        const unsigned old = xb_add(&bar[XB_XSUB(b.x)], 1u);
        const unsigned gen = old / nloc;
        if (old + 1u == (gen + 1u) * nloc) {
            __builtin_amdgcn_fence(__ATOMIC_RELEASE, "agent");
            asm volatile("s_waitcnt vmcnt(0)" ::: "memory");
            const unsigned og = xb_add(&bar[XB_TOP], 1u);
            const unsigned tg = og / nx;
            if (og + 1u == (tg + 1u) * nx) xb_add(&bar[XB_TOPGEN], 1u);
            else XB_SPIN(xb_ld(&bar[XB_TOPGEN]) == tg, bar);
            __builtin_amdgcn_fence(__ATOMIC_ACQUIRE, "agent");
            xb_add(&bar[XB_XGEN(b.x)], 1u);
            asm volatile("s_waitcnt vmcnt(0)" ::: "memory");
        } else {
            XB_SPIN(xb_ld(&bar[XB_XGEN(b.x)]) == gen, bar);
            __builtin_amdgcn_fence(__ATOMIC_ACQUIRE, "agent");
            asm volatile("s_waitcnt vmcnt(0)" ::: "memory");
        }
    }
    __syncthreads();
}

#ifndef MK_DUMP
#define MK_DUMP 0
#endif
__device__ __forceinline__ void dump_phase(Frame& F) {
    const size_t NT = (size_t)F.G * NWAVES * 64, n = (size_t)MLAT * DM;
    for (size_t i = (size_t)blockIdx.x * (NWAVES * 64) + F.tid; i < n; i += NT) {
        float v = 0.f;
        if (MK_DUMP == 1) { v = bf1(((const bf16*)(F.ws + WS_H))[i]) + (i < (size_t)MCTX * DM ? bf1(((const bf16*)(F.ws + WS_H))[n + i]) : 0.f); }
        if (MK_DUMP == 2) { for (int k = 0; k < 4; ++k) v += bf1(((const bf16*)(F.ws + WS_XBC))[i + k * n]); for (int k = 0; k < 2; ++k) v += bf1(((const bf16*)(F.ws + WS_Z))[i + k * n]); if (i < (size_t)MALL * 64) v += ((const float*)(F.ws + WS_DT))[i]; }
        if (MK_DUMP == 3) { const size_t ns = (size_t)NUNIT * 8 * 8192; for (int k = 0; k < 5; ++k) if (i + k * n < ns) v += bf1(((const bf16*)(F.ws + WS_S))[i + k * n]); for (int k = 0; k < 4; ++k) v += bf1(((const bf16*)(F.ws + WS_XBC))[i + k * n]); if (i < (size_t)NUNIT * 8) v += ((const float*)(F.ws + WS_CD))[i]; }
        if (MK_DUMP == 4) { for (int k = 0; k < 2; ++k) v += bf1(((const bf16*)(F.ws + WS_Z))[i + k * n]); }
        if (MK_DUMP == 5) { v = bf1(((const bf16*)(F.ws + WS_Y))[i]); }
        F.out[i] = v;
    }
}

struct Args { const float* in[24]; float* out; unsigned char* ws; int ph_lo, ph_hi; };
__global__ void __launch_bounds__(NWAVES * 64, 2) fwd_kernel(Args args) {
    extern __shared__ __attribute__((aligned(16))) unsigned char lds[];
    Frame F;
    F.lds = (LAS unsigned char*)lds;
    F.MISC = (volatile LAS unsigned*)(F.lds + MISC_OFF);
    F.tid = threadIdx.x; F.lane = F.tid & 63; F.wave = __builtin_amdgcn_readfirstlane(F.tid >> 6);
    F.G = gridDim.x;
#pragma unroll
    for (int i = 0; i < 24; ++i) F.in[i] = args.in[i];
    F.out = args.out; F.ws = args.ws; F.ctl = (gu32*)(args.ws + WS_CTL);
    for (int u = F.tid; u < (LDS_BYTES - MISC_OFF) / 4; u += NWAVES * 64) ((LAS unsigned*)(F.lds + MISC_OFF))[u] = 0u;
    __syncthreads();
    XcdBarrier bar; bar.bar = (unsigned*)(F.ctl + CW_BAR); bar.x = 0; bar.st = nullptr;
    if (!MK_PER_PHASE) bar = xcd_barrier_post((unsigned*)(F.ctl + CW_BAR), F.MISC + 8);
    const int lo = args.ph_lo, hi = args.ph_hi & 0xff; const int dry = (args.ph_hi >> 8) & 3;
#ifndef MK_PHASE_MASK
#define MK_PHASE_MASK 0x7ffff
#endif
#define IN(k) (((MK_PHASE_MASK >> (k)) & 1) && lo <= (k) && (k) < hi)
#define SEAM(k) do { if (!MK_PER_PHASE && IN((k) + 1)) xcd_barrier(bar); } while (0)
    bf16* const WS_bH = (bf16*)(F.ws + WS_H); bf16* const WS_bY = (bf16*)(F.ws + WS_Y); bf16* const WS_bZ = (bf16*)(F.ws + WS_Z);

    if (IN(0)) { p0_prologue(F); SEAM(0); }
    if (IN(1)) { p1_prenorm(F); SEAM(1); }
    if (IN(2)) {
        pg8::Gemm g{WS_bH, (const bf16*)(F.ws + WS_WIN), MALL, DINP_PAD, DM}; pg8::InProjOrder S; S.init(MLAT, DINP_PAD, F.G, (int)blockIdx.x);
        pg8::EpiInProj E{WS_bZ, (bf16*)(F.ws + WS_XBC), (float*)(F.ws + WS_DT)};
        pg8::gemm_phase<pg8::EpiInProj, pg8::InProjOrder, true, true>(F.lds, g, S, E);
        SEAM(2);
    }
    if (IN(3)) { ssd_phase_a(F, dry); SEAM(3); }
    if (IN(4)) { ssd_phase_b(F); SEAM(4); }
    if (IN(5)) { ssd_phase_c(F, dry); SEAM(5); }
    if (IN(6)) {
        pg8::Gemm g{WS_bZ, (const bf16*)(F.ws + WS_WOUT), MLAT, DM, DIN}; pg8::StaticOrder S; S.init(MLAT, DM, F.G, (int)blockIdx.x);
        pg8::EpiBf16<0> E{WS_bY, DM, nullptr, 0, 0, 1.f};
        pg8::gemm_phase<pg8::EpiBf16<0>, pg8::StaticOrder, true, true>(F.lds, g, S, E);
        SEAM(6);
    }
    if (IN(7)) { resnorm_phase<true, FFN_FP8 != 0>(F, F.in[I_X], 0, 2, F.in[I_NPOST], F.in[I_NPRE] + 1024, 0, 4, 3); SEAM(7); }
    if (IN(8)) {
        if constexpr (FFN_FP8) {
            pg8::Gemm g{WS_bH, (const bf16*)(F.ws + WS_WGU), MLAT, 2 * DFF, DM / 2}; pg8::StaticOrder S; S.init(MLAT, 2 * DFF, F.G, (int)blockIdx.x);
            pg8::EpiSwiGLU8 E{(unsigned char*)(F.ws + WS_ACT0), DFF, 1.0f / WGU_SCALE};
            pg8::gemm_phase<pg8::EpiSwiGLU8, pg8::StaticOrder, true, true, true>(F.lds, g, S, E);
        } else {
            pg8::Gemm g{WS_bH, (const bf16*)(F.ws + WS_WGU), MLAT, 2 * DFF, DM}; pg8::StaticOrder S; S.init(MLAT, 2 * DFF, F.G, (int)blockIdx.x);
            pg8::EpiSwiGLU E{(bf16*)(F.ws + WS_ACT0), DFF};
            pg8::gemm_phase<pg8::EpiSwiGLU, pg8::StaticOrder, true, true>(F.lds, g, S, E);
        }
        SEAM(8);
    }
    if (IN(9)) {
        if constexpr (FFN_FP8) {
            pg8::Gemm g{(const bf16*)(F.ws + WS_ACT0), (const bf16*)(F.ws + WS_WDN), MLAT, DM, DFF / 2}; pg8::StaticOrder S; S.init(MLAT, DM, F.G, (int)blockIdx.x);
            pg8::EpiBf16S E{WS_bY, DM, 1.0f / WDN_SCALE};
            pg8::gemm_phase<pg8::EpiBf16S, pg8::StaticOrder, true, true, true>(F.lds, g, S, E);
        } else {
            pg8::Gemm g{(const bf16*)(F.ws + WS_ACT0), (const bf16*)(F.ws + WS_WDN), MLAT, DM, DFF}; pg8::StaticOrder S; S.init(MLAT, DM, F.G, (int)blockIdx.x);
            pg8::EpiBf16<0> E{WS_bY, DM, nullptr, 0, 0, 1.f};
            pg8::gemm_phase<pg8::EpiBf16<0>, pg8::StaticOrder, true, true>(F.lds, g, S, E);
        }
        SEAM(9);
    }
    if (IN(10)) { resnorm_phase<true>(F, F.out, 0, 5, F.in[I_NPOST] + 1024, F.in[I_NPRE] + 2048, 1, 1, 0); SEAM(10); }
    if (IN(11)) {
        pg8::Gemm g{WS_bH, (const bf16*)(F.ws + WS_WSCI), MLAT, 3072, DM}; pg8::StaticOrder S; S.init(MLAT, 3072, F.G, (int)blockIdx.x);
        pg8::EpiBf16<0> E{(bf16*)(F.ws + WS_SCP), 3072, nullptr, 0, 0, 1.f};
        pg8::gemm_phase<pg8::EpiBf16<0>, pg8::StaticOrder, true, true>(F.lds, g, S, E);
        SEAM(11);
    }
    if (IN(12)) { p12_shortconv(F); SEAM(12); }
    if (IN(13)) {
        pg8::Gemm g{WS_bH, (const bf16*)(F.ws + WS_WSCO), MLAT, DM, DM}; pg8::StaticOrder S; S.init(MLAT, DM, F.G, (int)blockIdx.x);
        pg8::EpiBf16<0> E{WS_bY, DM, nullptr, 0, 0, 1.f};
        pg8::gemm_phase<pg8::EpiBf16<0>, pg8::StaticOrder, true, true>(F.lds, g, S, E);
        SEAM(13);
    }
    if (IN(14)) { p14_resnorm_route(F); SEAM(14); }
    if (IN(15)) { p15_permute(F); SEAM(15); }
    if (MK_PER_PHASE && dry && lo == 16) {
        const int* texp = (const int*)(F.ws + WS_ROUTE + RT_TEXP); int nt = __builtin_amdgcn_readfirstlane(texp[300]); nt = nt < 0 ? 0 : (nt > MOE_ROWS / 256 ? MOE_ROWS / 256 : nt);
        pg8::Gemm g{(const bf16*)(F.ws + WS_HP8), (const bf16*)(F.ws + WS_WMGU), 256 * nt, 2 * DFFE, DM / 2};
        pg8::GroupedOrder S; S.init(256 * nt, 2 * DFFE, F.G, (int)blockIdx.x); S.texp = texp; S.estride = (size_t)2 * DFFE * DM;
        pg8::EpiNull E{(float*)(F.ws + WS_CD)};
        pg8::gemm_phase<pg8::EpiNull, pg8::GroupedOrder, true, true, true>(F.lds, g, S, E);
        return;
    }
    if (IN(16)) {
        const int* texp = (const int*)(F.ws + WS_ROUTE + RT_TEXP); int nt = __builtin_amdgcn_readfirstlane(texp[300]); nt = nt < 0 ? 0 : (nt > MOE_ROWS / 256 ? MOE_ROWS / 256 : nt);
        pg8::Gemm g{(const bf16*)(F.ws + WS_HP8), (const bf16*)(F.ws + WS_WMGU), 256 * nt, 2 * DFFE, DM / 2};
        pg8::GroupedOrder S; S.init(256 * nt, 2 * DFFE, F.G, (int)blockIdx.x); S.texp = texp; S.estride = (size_t)2 * DFFE * DM;
        pg8::EpiSwiGLU8 E{(unsigned char*)(F.ws + WS_ACT), DFFE, 1.0f / WGU_SCALE};
        pg8::gemm_phase<pg8::EpiSwiGLU8, pg8::GroupedOrder, true, true, true>(F.lds, g, S, E);
        SEAM(16);
    }
    if (IN(17)) {
        const int* texp = (const int*)(F.ws + WS_ROUTE + RT_TEXP); int nt = __builtin_amdgcn_readfirstlane(texp[300]); nt = nt < 0 ? 0 : (nt > MOE_ROWS / 256 ? MOE_ROWS / 256 : nt);
        pg8::Gemm g{(const bf16*)(F.ws + WS_ACT), (const bf16*)(F.ws + WS_WMDN), 256 * nt, DM, DFFE / 2};
        pg8::GroupedOrder S; S.init(256 * nt, DM, F.G, (int)blockIdx.x); S.texp = texp; S.estride = (size_t)DM * DFFE;
        pg8::EpiBf16S E{(bf16*)(F.ws + WS_YP), DM, 1.0f / WDN_SCALE};
        pg8::gemm_phase<pg8::EpiBf16S, pg8::GroupedOrder, true, true, true>(F.lds, g, S, E);
        SEAM(17);
    }
    if (IN(18)) { p18_final(F); }
    if (MK_DUMP && lo <= 19 && 19 < hi) dump_phase(F);
#undef IN
#undef SEAM
}

extern "C" void kernel_launch(void* const* d_in, const int* in_sizes, int n_in, void* d_out, int out_size, void* d_ws, size_t ws_size, hipStream_t stream) {
    static int grid = 0;
    if (grid == 0) {
        if (n_in != 24 || out_size != MLAT * DM || ws_size < WS_NEED) { fprintf(stderr, "kernel_launch: unexpected problem (n_in %d, out %d, ws %zu)\n", n_in, out_size, ws_size); grid = -1; return; }
        int dev = 0, cus = 0, per_cu = 0;
        if (hipGetDevice(&dev) != hipSuccess || hipDeviceGetAttribute(&cus, hipDeviceAttributeMultiprocessorCount, dev) != hipSuccess) { grid = -1; return; }
        if (hipFuncSetAttribute((const void*)fwd_kernel, hipFuncAttributeMaxDynamicSharedMemorySize, LDS_BYTES) != hipSuccess) { fprintf(stderr, "kernel_launch: hipFuncSetAttribute failed\n"); grid = -1; return; }
        if (hipOccupancyMaxActiveBlocksPerMultiprocessor(&per_cu, (const void*)fwd_kernel, NWAVES * 64, LDS_BYTES) != hipSuccess || per_cu < 1) { fprintf(stderr, "kernel_launch: occupancy query reports %d\n", per_cu); }
        (void)hipGetLastError();
        grid = cus;
    }
    if (grid < 0) return;
    if (hipMemsetAsync((char*)d_ws + WS_CTL, 0, CTL_ZERO_BYTES, stream) != hipSuccess) return;
    Args a{};
    for (int i = 0; i < 24; ++i) a.in[i] = (const float*)d_in[i];
    a.out = (float*)d_out; a.ws = (unsigned char*)d_ws;
#if MK_PER_PHASE
#ifndef MK_TWICE_MASK
#define MK_TWICE_MASK 0
#endif
#ifndef MK_DRY_MASK
#define MK_DRY_MASK 0
#endif
#ifndef MK_DRY_LEVEL
#define MK_DRY_LEVEL 1
#endif
    for (int p = 0; p <= MK_LAST_PHASE; ++p) { a.ph_lo = p;
        if ((MK_DRY_MASK >> p) & 1) { a.ph_hi = (p + 1) | (MK_DRY_LEVEL << 8); hipLaunchKernelGGL(fwd_kernel, dim3(grid), dim3(NWAVES * 64), LDS_BYTES, stream, a); }
        a.ph_hi = p + 1; hipLaunchKernelGGL(fwd_kernel, dim3(grid), dim3(NWAVES * 64), LDS_BYTES, stream, a);
        if ((MK_TWICE_MASK >> p) & 1) hipLaunchKernelGGL(fwd_kernel, dim3(grid), dim3(NWAVES * 64), LDS_BYTES, stream, a); }
    if (MK_DUMP) { a.ph_lo = 19; a.ph_hi = 20; hipLaunchKernelGGL(fwd_kernel, dim3(grid), dim3(NWAVES * 64), LDS_BYTES, stream, a); }
#else
    a.ph_lo = 0; a.ph_hi = MK_LAST_PHASE + 1;
    hipLaunchKernelGGL(fwd_kernel, dim3(grid), dim3(NWAVES * 64), LDS_BYTES, stream, a);
#endif
}
```

```cpp
#include <hip/hip_runtime.h>
#include <cstdio>
#include <cstdint>
#define MK_PER_PHASE 0
#define MK_LAST_PHASE 18
#define MK_DUMP 0
#define MK_TWICE_MASK 0
#define MK_DRY_MASK 0
#define MK_DRY_LEVEL 1
namespace pg8 {
#define PG8_LAS __attribute__((address_space(3)))
typedef unsigned short bf16_t;
typedef short bf16x8 __attribute__((ext_vector_type(8)));
typedef float f32x4 __attribute__((ext_vector_type(4)));
typedef unsigned u32x4 __attribute__((ext_vector_type(4)));
constexpr int BM = 256, BK = 64, HALF = 128, HTB = HALF * BK * 2  , STAGE_BYTES = 8 * HTB, NXCD = 8, WGM = 8;

__host__ __device__ __forceinline__ int lds_byte(int r, int c) { const int st = (r >> 4) * 2 + (c >> 5), rr = r & 15, cc = c & 31, ob = rr * 64 + cc * 2; return st * 1024 + (ob ^ (((ob >> 9) & 1) << 5)); }
__host__ __device__ __forceinline__ void stage_rc(int b, int& R, int& C) { const int st = b / 1024, sb = b % 1024, swz = sb ^ (((sb >> 9) & 1) << 5); R = (st >> 1) * 16 + swz / 64; C = (st & 1) * 32 + (swz % 64) / 2; }
__host__ __device__ __forceinline__ int perm32(int rho) { const int n = rho >> 4, i = rho & 15; return 8 * (i >> 2) + 4 * n + (i & 3); }

struct Unit { int pm, pn; };
struct Gemm { const bf16_t* A; const bf16_t* Bt; int M, N, K; };

struct StaticOrder {
    int nM, nN, nwg, G, c;
    __host__ __device__ void init(int M, int N, int G_, int c_) { nM = M / BM; nN = N / BM; nwg = nM * nN; G = G_; c = c_; }
    __host__ __device__ bool next(int i, Unit& u) const {
        const long L = (long)i * G + c; if (L >= nwg) return false;
        int wgid = (int)L; { const int q = nwg / NXCD, r = nwg % NXCD, xcd = wgid % NXCD, off = wgid / NXCD; wgid = (xcd < r ? xcd * (q + 1) : r * (q + 1) + (xcd - r) * q) + off; }
        const int nig = WGM * nN, gid = wgid / nig, fm = gid * WGM, gsz = (nM - fm) < WGM ? (nM - fm) : WGM;
        u.pm = fm + ((wgid % nig) % gsz); u.pn = (wgid % nig) / gsz; return true;
    }
    __device__ __forceinline__ void a_ready(const Unit&) const {}
    __device__ __forceinline__ void done(const Unit&) const {}
    __device__ __forceinline__ size_t boff(const Unit&) const { return 0; }
};

typedef float f32x2c __attribute__((ext_vector_type(2)));
typedef __bf16 bf16x2c __attribute__((ext_vector_type(2)));
__device__ __forceinline__ unsigned cvt_pk_bf16(float lo, float hi) { const f32x2c v = {lo, hi}; return __builtin_bit_cast(unsigned, __builtin_convertvector(v, bf16x2c)); }
typedef float f32x2 __attribute__((ext_vector_type(2)));
__device__ __forceinline__ f32x2 gelu_pk(f32x2 v) {
    const f32x2 av = __builtin_elementwise_abs(v), d = av * 0.2316418882f + 1.0f;
    f32x2 t; t.x = __builtin_amdgcn_rcpf(d.x); t.y = __builtin_amdgcn_rcpf(d.y);
    f32x2 q = t * 0.5307027145f + (-0.7265760135f); q = q * t + 0.7107068705f; q = q * t + (-0.142248368f); q = q * t + 0.127414796f; q = q * t;
    const f32x2 s = (v * v) * (-0.72134752044f);
    f32x2 e; e.x = __builtin_amdgcn_exp2f(s.x); e.y = __builtin_amdgcn_exp2f(s.y);
    const f32x2 m = v * (q * e), r = v - m;
    f32x2 o; o.x = v.x < 0.f ? m.x : r.x; o.y = v.y < 0.f ? m.y : r.y; return o;
}

template <int ACT  > struct EpiBf16 {
    static constexpr bool PERM = true, AFTER_DRAIN = false; static_assert(ACT == 0 || ACT == 1, "EpiBf16: ACT is 0 (none) or 1 (gelu_pk)");
    bf16_t* O; int ldc; const float* bias; int split_cols; size_t split_stride; float scale0;
    __device__ __forceinline__ void operator()(const f32x4 (&acc)[2][2][4][2], const Unit& u, int wr, int wc, int fr, int fq) const {
        const int row0 = u.pm * BM + wr * 64 + fr; int colt = u.pn * BM; bf16_t* base = O;
        float sc = 1.f; if (split_cols) { const int t = colt / split_cols; base += (size_t)t * split_stride; colt -= t * split_cols; if (t == 0) sc = scale0; }
        const int col0 = colt + wc * 32 + 8 * fq, bcol0 = u.pn * BM + wc * 32 + 8 * fq;
        f32x4 bv[2][2];
#pragma unroll
        for (int bj = 0; bj < 2; ++bj)
#pragma unroll
            for (int n = 0; n < 2; ++n) bv[bj][n] = bias ? *(const f32x4*)(bias + bcol0 + bj * HALF + 4 * n) : (f32x4){0.f, 0.f, 0.f, 0.f};
#pragma unroll
        for (int ai = 0; ai < 2; ++ai)
#pragma unroll
            for (int m = 0; m < 4; ++m) { bf16_t* rowp = base + (size_t)(row0 + ai * HALF + m * 16) * ldc + col0;
#pragma unroll
                for (int bj = 0; bj < 2; ++bj) { f32x4 v0 = acc[ai][bj][m][0] + bv[bj][0], v1 = acc[ai][bj][m][1] + bv[bj][1];
                    if (ACT == 1) { f32x2 a = gelu_pk((f32x2){v0[0], v0[1]}), b = gelu_pk((f32x2){v0[2], v0[3]}), c = gelu_pk((f32x2){v1[0], v1[1]}), d = gelu_pk((f32x2){v1[2], v1[3]});
                        v0 = (f32x4){a.x, a.y, b.x, b.y}; v1 = (f32x4){c.x, c.y, d.x, d.y}; }
                    v0 = v0 * sc; v1 = v1 * sc; u32x4 w; w.x = cvt_pk_bf16(v0[0], v0[1]); w.y = cvt_pk_bf16(v0[2], v0[3]); w.z = cvt_pk_bf16(v1[0], v1[1]); w.w = cvt_pk_bf16(v1[2], v1[3]);
                    *(u32x4*)(rowp + bj * HALF) = w; } }
    }
};

typedef int i32x4f __attribute__((ext_vector_type(4)));
typedef int i32x8f __attribute__((ext_vector_type(8)));
__device__ __forceinline__ i32x8f cat8(bf16x8 a, bf16x8 b) { const i32x4f lo = __builtin_bit_cast(i32x4f, a), hi = __builtin_bit_cast(i32x4f, b); return __builtin_shufflevector(lo, hi, 0, 1, 2, 3, 4, 5, 6, 7); }
template <class Epi, class Sched, bool ALIGN_EPI = false, bool SP2 = false, bool FP8 = false>
__device__ __forceinline__ void gemm_phase(PG8_LAS unsigned char* lds, const Gemm g, const Sched& S, const Epi& E) {
    const int tid = threadIdx.x, wid = __builtin_amdgcn_readfirstlane(tid >> 6), lane = tid & 63, wr = wid >> 2, wc = wid & 3, fr = lane & 15, fq = lane >> 4;
    const int K = g.K, nt = K / BK;
    unsigned voffA[2], voffB[2];
#pragma unroll
    for (int i = 0; i < 2; ++i) { int R, C; stage_rc(tid * 16 + i * 8192, R, C); const int Rb = Epi::PERM ? ((R & ~31) + perm32(R & 31)) : R;
        voffA[i] = (unsigned)(R * K + C) * 2u; voffB[i] = (unsigned)(Rb * K + C) * 2u; }
    const size_t kstep = (size_t)(BK * 2);
    const size_t hstep = (size_t)HALF * K * 2;
    const size_t tstep = 2 * hstep;
    const unsigned ldsw = (unsigned)wid * 1024u;
    const int aoff = lds_byte(wr * 64 + fr, fq * 8), boff = lds_byte(wc * 32 + fr, fq * 8);
#define PG8_SA(b, h) (((b) * 2 + (h)) * HTB)
#define PG8_SB(b, h) ((4 + (b) * 2 + (h)) * HTB)
#define PG8_STAGE(bufoff, gbase, voff) do { _Pragma("unroll") for (int _i = 0; _i < 2; ++_i) \
        __builtin_amdgcn_global_load_lds((const unsigned*)((const char*)(gbase) + (voff)[_i]), (PG8_LAS unsigned*)(lds + (bufoff) + ldsw + _i * 8192), 16, 0, 0); } while (0)
#define PG8_LDA(dst, b, h) do { _Pragma("unroll") for (int m = 0; m < 4; ++m) { const bf16x8 x0_ = *(const PG8_LAS bf16x8*)(lds + PG8_SA(b, h) + aoff + m * 2048), x1_ = *(const PG8_LAS bf16x8*)(lds + PG8_SA(b, h) + aoff + m * 2048 + 1024); \
        if constexpr (FP8) dst##8[m] = cat8(x0_, x1_); else { dst[m][0] = x0_; dst[m][1] = x1_; } } } while (0)
#define PG8_LDB(dst, b, h) do { _Pragma("unroll") for (int n = 0; n < 2; ++n) { const bf16x8 x0_ = *(const PG8_LAS bf16x8*)(lds + PG8_SB(b, h) + boff + n * 2048), x1_ = *(const PG8_LAS bf16x8*)(lds + PG8_SB(b, h) + boff + n * 2048 + 1024); \
        if constexpr (FP8) dst##8[n] = cat8(x0_, x1_); else { dst[n][0] = x0_; dst[n][1] = x1_; } } } while (0)
#define PG8_MMA(ai, bj, At, Bt) do { __builtin_amdgcn_s_setprio(1); _Pragma("unroll") for (int m = 0; m < 4; ++m) _Pragma("unroll") for (int n = 0; n < 2; ++n) { \
        if constexpr (FP8) asm volatile("v_mfma_f32_16x16x128_f8f6f4 %0, %1, %2, %0" : "+v"(acc[ai][bj][m][n]) : "v"(Bt##8[n]), "v"(At##8[m])); \
        else { _Pragma("unroll") for (int k = 0; k < 2; ++k) acc[ai][bj][m][n] = __builtin_amdgcn_mfma_f32_16x16x32_bf16(Bt[n][k], At[m][k], acc[ai][bj][m][n], 0, 0, 0); } } __builtin_amdgcn_s_setprio(0); } while (0)
#define PG8_WAIT_V(n) asm volatile("s_waitcnt vmcnt(" #n ")" ::: "memory")
#define PG8_WAIT_L(n) asm volatile("s_waitcnt lgkmcnt(" #n ")" ::: "memory")
#define PG8_BAR __builtin_amdgcn_s_barrier()
#define PG8_SCHED __builtin_amdgcn_sched_barrier(0)
    Unit cur, nxt; int ui = 0;
    if (!S.next(0, cur)) return;
    f32x4 acc[2][2][4][2];
#pragma unroll
    for (int a = 0; a < 2; ++a)
#pragma unroll
        for (int b = 0; b < 2; ++b)
#pragma unroll
            for (int m = 0; m < 4; ++m)
#pragma unroll
                for (int n = 0; n < 2; ++n) acc[a][b][m][n] = (f32x4){0.f, 0.f, 0.f, 0.f};
    bf16x8 At[4][2], B0[2][2], B1[2][2]; i32x8f At8[4], B08[2], B18[2];
    const char* cA = (const char*)g.A + (size_t)cur.pm * tstep; const char* cB = (const char*)g.Bt + S.boff(cur) + (size_t)cur.pn * tstep;
    S.a_ready(cur);
    if constexpr (SP2) {
        PG8_STAGE(PG8_SB(0, 0), cB, voffB); PG8_STAGE(PG8_SB(0, 1), cB + hstep, voffB); PG8_STAGE(PG8_SA(0, 0), cA, voffA); PG8_STAGE(PG8_SA(0, 1), cA + hstep, voffA);
        if (wr == 1) PG8_BAR;
        PG8_WAIT_V(2); PG8_BAR;
        PG8_STAGE(PG8_SB(1, 0), cB + kstep, voffB); PG8_STAGE(PG8_SA(1, 0), cA + kstep, voffA); PG8_STAGE(PG8_SB(1, 1), cB + hstep + kstep, voffB);
        PG8_WAIT_V(6); PG8_BAR;
    } else {
        PG8_STAGE(PG8_SB(0, 0), cB, voffB); PG8_STAGE(PG8_SA(0, 0), cA, voffA); PG8_STAGE(PG8_SB(0, 1), cB + hstep, voffB); PG8_STAGE(PG8_SA(0, 1), cA + hstep, voffA);
        if (wr == 1) PG8_BAR;
        PG8_WAIT_V(4); PG8_BAR;
        PG8_STAGE(PG8_SB(1, 0), cB + kstep, voffB); PG8_STAGE(PG8_SA(1, 0), cA + kstep, voffA); PG8_STAGE(PG8_SB(1, 1), cB + hstep + kstep, voffB);
        PG8_WAIT_V(6); PG8_BAR;
    }
    for (;;) {
        const bool has_next = S.next(ui + 1, nxt);
        const char* nA = has_next ? (const char*)g.A + (size_t)nxt.pm * tstep : cA; const char* nB = has_next ? (const char*)g.Bt + S.boff(nxt) + (size_t)nxt.pn * tstep : cB;
        for (int t = 0; t < nt; t += 2) {
            const bool last = (t == nt - 2);
            const char* a1 = cA + (size_t)(t + 1) * kstep;
            const char* a2 = last ? nA : cA + (size_t)(t + 2) * kstep; const char* b2 = last ? nB : cB + (size_t)(t + 2) * kstep;
            const char* a3 = a2 + kstep; const char* b3 = b2 + kstep;
            if (last && has_next) S.a_ready(nxt);
            if constexpr (SP2) {
            PG8_LDB(B0, 0, 0); PG8_LDB(B1, 0, 1); PG8_SCHED; PG8_LDA(At, 0, 0); PG8_STAGE(PG8_SA(1, 1), a1 + hstep, voffA);
            PG8_WAIT_V(8); PG8_WAIT_L(0); PG8_BAR; PG8_MMA(0, 0, At, B0); PG8_MMA(0, 1, At, B1); PG8_BAR; PG8_SCHED;
            PG8_LDA(At, 0, 1); PG8_STAGE(PG8_SB(0, 0), b2, voffB); PG8_STAGE(PG8_SB(0, 1), b2 + hstep, voffB); PG8_STAGE(PG8_SA(0, 0), a2, voffA);
            PG8_WAIT_V(8); PG8_WAIT_L(0); PG8_BAR; PG8_MMA(1, 0, At, B0); PG8_MMA(1, 1, At, B1); PG8_BAR; PG8_SCHED;
            PG8_LDB(B0, 1, 0); PG8_LDB(B1, 1, 1); PG8_SCHED; PG8_LDA(At, 1, 0); PG8_STAGE(PG8_SA(0, 1), a2 + hstep, voffA);
            PG8_WAIT_V(8); PG8_WAIT_L(0); PG8_BAR; PG8_MMA(0, 0, At, B0); PG8_MMA(0, 1, At, B1); PG8_BAR; PG8_SCHED;
            PG8_LDA(At, 1, 1); PG8_STAGE(PG8_SB(1, 0), b3, voffB); PG8_STAGE(PG8_SB(1, 1), b3 + hstep, voffB); PG8_STAGE(PG8_SA(1, 0), a3, voffA);
            PG8_WAIT_V(8); PG8_WAIT_L(0); PG8_BAR; PG8_MMA(1, 0, At, B0); PG8_MMA(1, 1, At, B1); PG8_BAR; PG8_SCHED;
            } else {
            PG8_LDB(B0, 0, 0); PG8_SCHED; PG8_LDA(At, 0, 0); PG8_STAGE(PG8_SA(1, 1), a1 + hstep, voffA);
            PG8_WAIT_L(8); PG8_BAR; PG8_WAIT_L(0); PG8_MMA(0, 0, At, B0); PG8_BAR; PG8_SCHED;
            PG8_LDB(B1, 0, 1); PG8_STAGE(PG8_SB(0, 0), b2, voffB);
            PG8_BAR; PG8_WAIT_L(0); PG8_MMA(0, 1, At, B1); PG8_BAR;
            PG8_LDA(At, 0, 1); PG8_STAGE(PG8_SA(0, 0), a2, voffA);
            PG8_BAR; PG8_WAIT_L(0); PG8_MMA(1, 0, At, B0); PG8_BAR; PG8_SCHED;
            PG8_STAGE(PG8_SB(0, 1), b2 + hstep, voffB);
            PG8_WAIT_V(6); PG8_BAR; PG8_MMA(1, 1, At, B1); PG8_BAR;
            PG8_LDB(B0, 1, 0); PG8_SCHED; PG8_LDA(At, 1, 0); PG8_STAGE(PG8_SA(0, 1), a2 + hstep, voffA);
            PG8_WAIT_L(8); PG8_BAR; PG8_WAIT_L(0); PG8_MMA(0, 0, At, B0); PG8_BAR; PG8_SCHED;
            PG8_LDB(B1, 1, 1); PG8_STAGE(PG8_SB(1, 0), b3, voffB);
            PG8_BAR; PG8_WAIT_L(0); PG8_MMA(0, 1, At, B1); PG8_BAR;
            PG8_LDA(At, 1, 1); PG8_STAGE(PG8_SA(1, 0), a3, voffA);
            PG8_BAR; PG8_WAIT_L(0); PG8_MMA(1, 0, At, B0); PG8_BAR; PG8_SCHED;
            PG8_STAGE(PG8_SB(1, 1), b3 + hstep, voffB);
            PG8_WAIT_V(6); PG8_BAR; PG8_MMA(1, 1, At, B1); PG8_BAR;
            }
        }
        if constexpr (FP8) asm volatile("s_nop 7\n\ts_nop 7\n\ts_nop 7" ::: "memory");
        if constexpr (ALIGN_EPI) { if (wr == 0) PG8_BAR; }
        if constexpr (!Epi::AFTER_DRAIN) { E(acc, cur, wr, wc, fr, fq); S.done(cur); }
        if (!has_next) break;
#pragma unroll
        for (int a = 0; a < 2; ++a)
#pragma unroll
            for (int b = 0; b < 2; ++b)
#pragma unroll
                for (int m = 0; m < 4; ++m)
#pragma unroll
                    for (int n = 0; n < 2; ++n) acc[a][b][m][n] = (f32x4){0.f, 0.f, 0.f, 0.f};
        cur = nxt; cA = nA; cB = nB; ++ui;
        if constexpr (ALIGN_EPI) { if (wr == 1) PG8_BAR; }
    }
    PG8_WAIT_V(0);
    if constexpr (!ALIGN_EPI) { if (wr == 0) PG8_BAR; }
    PG8_BAR;
    if constexpr (Epi::AFTER_DRAIN) { E.fused(acc, cur, wr, wc, fr, fq, lds, wid, lane); S.done(cur); }
#undef PG8_SA
#undef PG8_SB
#undef PG8_STAGE
#undef PG8_LDA
#undef PG8_LDB
#undef PG8_MMA
#undef PG8_WAIT_V
#undef PG8_WAIT_L
#undef PG8_BAR
#undef PG8_SCHED
}
}

constexpr int NWAVES = 8;
constexpr int DM = 1024, NB = 8, SEQ = 4096, CTXL = 256;
constexpr int MLAT = NB * SEQ, MCTX = NB * CTXL, MALL = MLAT + MCTX;
constexpr int DIN = 2048, CONVD = 4096, DINP = 6208, DINP_PAD = 6400;
constexpr int DFF = 2816, NE = 8, DFFE = 3584;
constexpr int NUNIT_LAT = NB * 32 * 8, NUNIT = NUNIT_LAT + NB * 2 * 8;
constexpr int MOE_ROWS = 67584;
constexpr float EPS = 1e-6f;
#ifndef MK_PER_PHASE
#define MK_PER_PHASE 0
#endif
#ifndef MK_LAST_PHASE
#define MK_LAST_PHASE 18
#endif
constexpr int N_PHASES = 19;

constexpr size_t MiB = 1u << 20;
constexpr size_t WS_CTL = 0, CTL_ZERO_BYTES = 1 * MiB;
constexpr size_t WS_MOD = 1 * MiB;
constexpr size_t WS_ROUTE = 2 * MiB;
constexpr size_t WS_CD = 4 * MiB;
constexpr size_t WS_WIN = 8 * MiB, WS_WOUT = 21 * MiB, WS_WGU = 25 * MiB, WS_WDN = 36 * MiB, WS_WSCI = 42 * MiB, WS_WSCO = 48 * MiB;
constexpr size_t WS_H = 56 * MiB;
constexpr size_t WS_Y = 124 * MiB;
constexpr size_t WS_Z = 188 * MiB;
constexpr size_t WS_XBC = 324 * MiB;
constexpr size_t WS_DT = 596 * MiB;
constexpr size_t WS_S = 606 * MiB;
constexpr size_t WS_ACT0 = 324 * MiB;
constexpr size_t WS_SCP = 324 * MiB;
constexpr size_t WS_HP8 = 124 * MiB;
constexpr size_t WS_YP = 190 * MiB;
constexpr size_t WS_WMGU = 322 * MiB, WS_WMDN = 378 * MiB;
constexpr size_t WS_ACT = 406 * MiB;
constexpr size_t WS_END = 640 * MiB;
constexpr float WGU_SCALE = 64.f, WDN_SCALE = 128.f;
#ifndef MK_FFN_FP8
#define MK_FFN_FP8 0
#endif
constexpr int FFN_FP8 = MK_FFN_FP8;
static_assert(WS_S + (size_t)NUNIT * 8 * 8192 * 2 <= 878 * MiB && WS_HP8 + (size_t)MOE_ROWS * DM <= WS_YP && WS_YP + (size_t)MOE_ROWS * DM * 2 <= WS_WMGU && WS_WMGU + (size_t)8 * 2 * DFFE * DM <= WS_WMDN && WS_WMDN + (size_t)8 * DM * DFFE <= WS_ACT && WS_ACT + (size_t)MOE_ROWS * DFFE <= WS_END, "d_ws map");
constexpr size_t WS_NEED = 878 * MiB;
constexpr size_t RT_SELR = 0, RT_GATE = 256 * 1024, RT_POS = 512 * 1024, RT_CNT = 768 * 1024, RT_TEXP = 800 * 1024;
constexpr int CW_TMO = 0, CW_CODE = 1, CW_BAR = 4096;

constexpr int PXB = 528, PBB = 272, PMB = 272;
constexpr int XI_BYTES = 128 * PXB, BI_BYTES = 128 * PBB, MW_BYTES = 8 * 16 * PMB;
constexpr int SCAL_OFF = XI_BYTES + BI_BYTES + MW_BYTES;
constexpr int BPW_OFF = SCAL_OFF + 3 * 4096;
constexpr int MISC_OFF = BPW_OFF + 4096;
constexpr int LDS_BYTES = MISC_OFF + 512;
static_assert(LDS_BYTES <= 160 * 1024 && pg8::STAGE_BYTES <= MISC_OFF, "LDS map");

#define GAS __attribute__((address_space(1)))
#define LAS __attribute__((address_space(3)))
typedef unsigned short bf16;
typedef unsigned v4u __attribute__((ext_vector_type(4)));
typedef unsigned v2u __attribute__((ext_vector_type(2)));
typedef float f32x4 __attribute__((ext_vector_type(4)));
typedef short bf16x8 __attribute__((ext_vector_type(8)));
typedef short s16x4 __attribute__((ext_vector_type(4)));
typedef GAS unsigned gu32;
#define RLX_AGENT __ATOMIC_RELAXED, __HIP_MEMORY_SCOPE_AGENT
#define LDS_WAIT() asm volatile("s_waitcnt lgkmcnt(0)" ::: "memory")
#define VM_WAIT() asm volatile("s_waitcnt vmcnt(0)" ::: "memory")
#define LDS_BARRIER() do { asm volatile("s_waitcnt lgkmcnt(0)" ::: "memory"); __builtin_amdgcn_s_barrier(); asm volatile("" ::: "memory"); } while (0)
typedef float f32x2n __attribute__((ext_vector_type(2)));
typedef __bf16 bf16x2n __attribute__((ext_vector_type(2)));
__device__ __forceinline__ unsigned pk2(float lo, float hi) { const f32x2n v = {lo, hi}; return __builtin_bit_cast(unsigned, __builtin_convertvector(v, bf16x2n)); }
__device__ __forceinline__ float bflo(unsigned u) { return __uint_as_float(u << 16); }
__device__ __forceinline__ float bfhi(unsigned u) { return __uint_as_float(u & 0xffff0000u); }
__device__ __forceinline__ float bf1(bf16 b) { return __uint_as_float(((unsigned)b) << 16); }
__device__ __forceinline__ f32x4 unpack4(v2u u) { return (f32x4){bflo(u.x), bfhi(u.x), bflo(u.y), bfhi(u.y)}; }
__device__ __forceinline__ v2u pack4(f32x4 v) { v2u r; r.x = pk2(v[0], v[1]); r.y = pk2(v[2], v[3]); return r; }
__device__ __forceinline__ unsigned pk4_fp8(float a, float b, float c, float d) {
    a = fminf(fmaxf(a, -448.f), 448.f); b = fminf(fmaxf(b, -448.f), 448.f); c = fminf(fmaxf(c, -448.f), 448.f); d = fminf(fmaxf(d, -448.f), 448.f);
    int v = __builtin_amdgcn_cvt_pk_fp8_f32(a, b, 0, false); v = __builtin_amdgcn_cvt_pk_fp8_f32(c, d, v, true); return (unsigned)v; }
__device__ __forceinline__ float silu_f(float v) { return v * __builtin_amdgcn_rcpf(1.0f + __builtin_amdgcn_exp2f(-1.44269504f * v)); }
__device__ __forceinline__ float wave_sum(float v) {
#pragma unroll
    for (int o = 1; o < 64; o <<= 1) v += __shfl_xor(v, o);
    return v;
}
__device__ __forceinline__ unsigned lds_addr(LAS unsigned char* p) { return (unsigned)(size_t)p; }
__device__ __forceinline__ bf16x8 tr_pair(const LAS unsigned char* p0, const LAS unsigned char* p1) {
    const s16x4 x = __builtin_amdgcn_ds_read_tr16_b64_v4i16((LAS s16x4*)p0), y = __builtin_amdgcn_ds_read_tr16_b64_v4i16((LAS s16x4*)p1);
    return (bf16x8){x[0], x[1], x[2], x[3], y[0], y[1], y[2], y[3]};
}
#define MFMA16(a, b, c) __builtin_amdgcn_mfma_f32_16x16x32_bf16((a), (b), (c), 0, 0, 0)

namespace pg8 {
struct EpiInProj {
    static constexpr bool PERM = true, AFTER_DRAIN = false;
    bf16_t* Z; bf16_t* XBC; float* DT;
    __device__ __forceinline__ void operator()(const f32x4 (&acc)[2][2][4][2], const Unit& u, int wr, int wc, int fr, int fq) const {
        const int row0 = u.pm * BM + wr * 64 + fr;
        if (u.pn < 24) {
            bf16_t* base; int ldc, colt;
            if (u.pn < 8) { base = Z; ldc = 2048; colt = u.pn * BM; } else { base = XBC; ldc = 4096; colt = (u.pn - 8) * BM; }
            const int col0 = colt + wc * 32 + 8 * fq;
#pragma unroll
            for (int ai = 0; ai < 2; ++ai)
#pragma unroll
                for (int m = 0; m < 4; ++m) { bf16_t* rowp = base + (size_t)(row0 + ai * HALF + m * 16) * ldc + col0;
#pragma unroll
                    for (int bj = 0; bj < 2; ++bj) { const f32x4 v0 = acc[ai][bj][m][0], v1 = acc[ai][bj][m][1];
                        u32x4 w; w.x = cvt_pk_bf16(v0[0], v0[1]); w.y = cvt_pk_bf16(v0[2], v0[3]); w.z = cvt_pk_bf16(v1[0], v1[1]); w.w = cvt_pk_bf16(v1[2], v1[3]);
                        *(u32x4*)(rowp + bj * HALF) = w; } }
        } else if (wc < 2) {
            const int col0 = wc * 32 + 8 * fq;
#pragma unroll
            for (int ai = 0; ai < 2; ++ai)
#pragma unroll
                for (int m = 0; m < 4; ++m) { float* rowp = DT + (size_t)(row0 + ai * HALF + m * 16) * 64 + col0;
                    *(f32x4*)(rowp) = acc[ai][0][m][0]; *(f32x4*)(rowp + 4) = acc[ai][0][m][1]; }
        }
    }
};
struct EpiSwiGLU {
    static constexpr bool PERM = true, AFTER_DRAIN = false;
    bf16_t* O; int ldc;
    __device__ __forceinline__ void operator()(const f32x4 (&acc)[2][2][4][2], const Unit& u, int wr, int wc, int fr, int fq) const {
        const int row0 = u.pm * BM + wr * 64 + fr, col0 = u.pn * HALF + wc * 32 + 8 * fq;
#pragma unroll
        for (int ai = 0; ai < 2; ++ai)
#pragma unroll
            for (int m = 0; m < 4; ++m) { bf16_t* rowp = O + (size_t)(row0 + ai * HALF + m * 16) * ldc + col0;
                float o[8];
#pragma unroll
                for (int n = 0; n < 2; ++n)
#pragma unroll
                    for (int j = 0; j < 4; ++j) { const float gt = acc[ai][0][m][n][j], up = acc[ai][1][m][n][j]; o[4 * n + j] = gt * __builtin_amdgcn_rcpf(1.0f + __expf(-gt)) * up; }
                u32x4 w; w.x = cvt_pk_bf16(o[0], o[1]); w.y = cvt_pk_bf16(o[2], o[3]); w.z = cvt_pk_bf16(o[4], o[5]); w.w = cvt_pk_bf16(o[6], o[7]);
                *(u32x4*)(rowp) = w; }
    }
};
struct EpiSwiGLU8 {
    static constexpr bool PERM = true, AFTER_DRAIN = false;
    unsigned char* O; int ldc; float sc;
    __device__ __forceinline__ void operator()(const f32x4 (&acc)[2][2][4][2], const Unit& u, int wr, int wc, int fr, int fq) const {
        const int row0 = u.pm * BM + wr * 64 + fr, col0 = u.pn * HALF + wc * 32 + 8 * fq;
#pragma unroll
        for (int ai = 0; ai < 2; ++ai)
#pragma unroll
            for (int m = 0; m < 4; ++m) { unsigned char* rowp = O + (size_t)(row0 + ai * HALF + m * 16) * ldc + col0;
                float o[8];
#pragma unroll
                for (int n = 0; n < 2; ++n)
#pragma unroll
                    for (int j = 0; j < 4; ++j) { const float gt = acc[ai][0][m][n][j] * sc, up = acc[ai][1][m][n][j] * sc; o[4 * n + j] = gt * __builtin_amdgcn_rcpf(1.0f + __builtin_amdgcn_exp2f(-1.44269504f * gt)) * up; }
                typedef unsigned u32x2e __attribute__((ext_vector_type(2)));
                u32x2e w; w.x = pk4_fp8(o[0], o[1], o[2], o[3]); w.y = pk4_fp8(o[4], o[5], o[6], o[7]);
                *(u32x2e*)(rowp) = w; }
    }
};
struct EpiBf16S {
    static constexpr bool PERM = true, AFTER_DRAIN = false;
    bf16_t* O; int ldc; float sc;
    __device__ __forceinline__ void operator()(const f32x4 (&acc)[2][2][4][2], const Unit& u, int wr, int wc, int fr, int fq) const {
        const int row0 = u.pm * BM + wr * 64 + fr, col0 = u.pn * BM + wc * 32 + 8 * fq;
#pragma unroll
        for (int ai = 0; ai < 2; ++ai)
#pragma unroll
            for (int m = 0; m < 4; ++m) { bf16_t* rowp = O + (size_t)(row0 + ai * HALF + m * 16) * ldc + col0;
#pragma unroll
                for (int bj = 0; bj < 2; ++bj) { const f32x4 v0 = acc[ai][bj][m][0] * sc, v1 = acc[ai][bj][m][1] * sc;
                    u32x4 w; w.x = cvt_pk_bf16(v0[0], v0[1]); w.y = cvt_pk_bf16(v0[2], v0[3]); w.z = cvt_pk_bf16(v1[0], v1[1]); w.w = cvt_pk_bf16(v1[2], v1[3]);
                    *(u32x4*)(rowp + bj * HALF) = w; } }
    }
};
struct InProjOrder : StaticOrder {
    __device__ __forceinline__ bool next(int i, Unit& u) const {
        const long L = (long)i * G + c; if (L >= nwg + 104) return false;
        if (L < nwg) return StaticOrder::next(i, u);
        const int idx = (int)(L - nwg), px = idx % 13; u.pm = nM + idx / 13; u.pn = px < 12 ? 8 + px : 24; return true;
    }
};
struct EpiNull {
    static constexpr bool PERM = true, AFTER_DRAIN = false;
    float* sink;
    __device__ __forceinline__ void operator()(const f32x4 (&acc)[2][2][4][2], const Unit& u, int wr, int wc, int fr, int fq) const {
        float s = 0.f;
#pragma unroll
        for (int ai = 0; ai < 2; ++ai)
#pragma unroll
            for (int bj = 0; bj < 2; ++bj)
#pragma unroll
                for (int m = 0; m < 4; ++m)
#pragma unroll
                    for (int n = 0; n < 2; ++n) s += acc[ai][bj][m][n][0];
        if (s == 12345.678f) sink[0] = s;
    }
};
struct GroupedOrder : StaticOrder {
    const int* texp; size_t estride;
    __device__ __forceinline__ size_t boff(const Unit& u) const { return (size_t)texp[u.pm] * estride; }
};
}

struct Frame {
    LAS unsigned char* lds;
    volatile LAS unsigned* MISC;
    gu32* ctl;
    int tid, lane, wave, G;
    const float* in[24]; float* out; unsigned char* ws;
};
enum { I_X = 0, I_C, I_CTX, I_CCTX, I_ADAW, I_ADAB, I_NPRE, I_NPOST, I_SWIN, I_SCONVW, I_SCONVB, I_SALOG, I_SDTB, I_SD, I_SNORM, I_SWOUT, I_SCWIN, I_SCCONV, I_SCWOUT, I_FGU, I_FDN, I_ROUTER, I_MGU, I_MDN };

__device__ __forceinline__ void cvt_item(const float* W, int K, int N, bf16* WT, LAS float* scr, int item, int lane, int mode, int dffx) {
    const int nblk = N / 32, kb = item / nblk, nb = item % nblk, k0 = 64 * kb, n0 = 32 * nb;
#pragma unroll 8
    for (int i = 0; i < 32; ++i) { const int kk = 2 * i + (lane >> 5); scr[kk * 33 + (lane & 31)] = W[(size_t)(k0 + kk) * N + n0 + (lane & 31)]; }
    LDS_WAIT(); asm volatile("" ::: "memory");
    const int c = lane & 7;
#pragma unroll
    for (int j = 0; j < 4; ++j) { const int n = (lane >> 3) + 8 * j; const LAS float* s = scr + (8 * c) * 33 + n;
        v4u o; o.x = pk2(s[0 * 33], s[1 * 33]); o.y = pk2(s[2 * 33], s[3 * 33]); o.z = pk2(s[4 * 33], s[5 * 33]); o.w = pk2(s[6 * 33], s[7 * 33]);
        int nd = n0 + n; if (mode) { const int half = nd >= dffx ? 1 : 0, i2 = nd - half * dffx; nd = 256 * (i2 >> 7) + 128 * half + (i2 & 127); }
        *(v4u*)(WT + (size_t)nd * K + k0 + 8 * c) = o; }
    LDS_WAIT(); asm volatile("" ::: "memory");
}
__device__ __forceinline__ void cvt_item8(const float* W, int K, int N, unsigned char* WT, LAS float* scr, int item, int lane, int mode, int dffx, float sc) {
    const int nblk = N / 32, kb = item / nblk, nb = item % nblk, k0 = 64 * kb, n0 = 32 * nb;
#pragma unroll 8
    for (int i = 0; i < 32; ++i) { const int kk = 2 * i + (lane >> 5); scr[kk * 33 + (lane & 31)] = W[(size_t)(k0 + kk) * N + n0 + (lane & 31)]; }
    LDS_WAIT(); asm volatile("" ::: "memory");
    const int c = lane & 7;
#pragma unroll
    for (int j = 0; j < 4; ++j) { const int n = (lane >> 3) + 8 * j; const LAS float* s = scr + (8 * c) * 33 + n;
        v2u o; o.x = pk4_fp8(s[0 * 33] * sc, s[1 * 33] * sc, s[2 * 33] * sc, s[3 * 33] * sc); o.y = pk4_fp8(s[4 * 33] * sc, s[5 * 33] * sc, s[6 * 33] * sc, s[7 * 33] * sc);
        int nd = n0 + n; if (mode) { const int half = nd >= dffx ? 1 : 0, i2 = nd - half * dffx; nd = 256 * (i2 >> 7) + 128 * half + (i2 & 127); }
        *(v2u*)(WT + (size_t)nd * K + k0 + 8 * c) = o; }
    LDS_WAIT(); asm volatile("" ::: "memory");
}
__device__ __forceinline__ void load_row_f32(const float* p, int lane, f32x4 (&v)[4]) {
#pragma unroll
    for (int j = 0; j < 4; ++j) v[j] = *(const f32x4*)(p + 4 * lane + 256 * j);
}
__device__ __forceinline__ void load_row_bf16(const bf16* p, int lane, f32x4 (&v)[4]) {
#pragma unroll
    for (int j = 0; j < 4; ++j) v[j] = unpack4(*(const v2u*)(p + 4 * lane + 256 * j));
}
__device__ __forceinline__ float row_ss(const f32x4 (&v)[4]) {
    float s = 0.f;
#pragma unroll
    for (int j = 0; j < 4; ++j) s += (v[j][0] * v[j][0] + v[j][1] * v[j][1]) + (v[j][2] * v[j][2] + v[j][3] * v[j][3]);
    return wave_sum(s);
}
__device__ __forceinline__ void prenorm_mod(f32x4 (&v)[4], const float* npre, const float* sc, const float* sh, int lane) {
    const float rr = rsqrtf(row_ss(v) * (1.0f / DM) + EPS);
#pragma unroll
    for (int j = 0; j < 4; ++j) { const int col = 4 * lane + 256 * j; const f32x4 w4 = *(const f32x4*)(npre + col), s4 = *(const f32x4*)(sc + col), h4 = *(const f32x4*)(sh + col);
        v[j] = (v[j] * rr * w4) * (s4 + 1.0f) + h4; }
}
__device__ __forceinline__ void store_row_bf16(bf16* p, int lane, const f32x4 (&v)[4]) {
#pragma unroll
    for (int j = 0; j < 4; ++j) *(v2u*)(p + 4 * lane + 256 * j) = pack4(v[j]);
}
__device__ __forceinline__ const float* mod_vec(Frame& F, int layer, int row, int chunk) { return (const float*)(F.ws + WS_MOD) + ((size_t)(layer * 9 + row) * 6144 + chunk * 1024); }


struct CvtDesc { const float* W; void* WT; int K, N, item, mode, dffx, fp8; float sc; };
__device__ __forceinline__ void cvt_load(const CvtDesc& d, int lane, float (&v)[32]) {
    const int nblk = d.N / 32, kb = d.item / nblk, nb = d.item % nblk; const float* p = d.W + (size_t)(64 * kb + (lane >> 5)) * d.N + 32 * nb + (lane & 31);
#pragma unroll
    for (int i = 0; i < 32; ++i) v[i] = p[(size_t)(2 * i) * d.N];
}
__device__ __forceinline__ void cvt_finish(const CvtDesc& d, LAS float* scr, int lane, const float (&v)[32]) {
    const int nblk = d.N / 32, kb = d.item / nblk, nb = d.item % nblk, k0 = 64 * kb, n0 = 32 * nb;
#pragma unroll
    for (int i = 0; i < 32; ++i) scr[(2 * i + (lane >> 5)) * 33 + (lane & 31)] = v[i];
    LDS_WAIT(); asm volatile("" ::: "memory");
    const int c = lane & 7;
#pragma unroll
    for (int j = 0; j < 4; ++j) { const int n = (lane >> 3) + 8 * j; const LAS float* s = scr + (8 * c) * 33 + n;
        int nd = n0 + n; if (d.mode) { const int half = nd >= d.dffx ? 1 : 0, i2 = nd - half * d.dffx; nd = 256 * (i2 >> 7) + 128 * half + (i2 & 127); }
        if (d.fp8) { const float sc = d.sc; v2u o; o.x = pk4_fp8(s[0 * 33] * sc, s[1 * 33] * sc, s[2 * 33] * sc, s[3 * 33] * sc); o.y = pk4_fp8(s[4 * 33] * sc, s[5 * 33] * sc, s[6 * 33] * sc, s[7 * 33] * sc);
            *(v2u*)((unsigned char*)d.WT + (size_t)nd * d.K + k0 + 8 * c) = o; }
        else { v4u o; o.x = pk2(s[0 * 33], s[1 * 33]); o.y = pk2(s[2 * 33], s[3 * 33]); o.z = pk2(s[4 * 33], s[5 * 33]); o.w = pk2(s[6 * 33], s[7 * 33]);
            *(v4u*)((bf16*)d.WT + (size_t)nd * d.K + k0 + 8 * c) = o; } }
    LDS_WAIT(); asm volatile("" ::: "memory");
}
template <class Dec> __device__ __forceinline__ void cvt_stream(const Dec& dec, int total, int first, int stride, LAS float* scr, int lane) {
    int it = first; if (it >= total) return;
    float v[32]; dec(it, true, scr, lane, v);
    for (;;) {
        const int itn = it + stride; const bool hn = itn < total; float vn[32];
        if (hn) dec(itn, true, scr, lane, vn);
        dec(it, false, scr, lane, v);
        if (!hn) break;
        it = itn;
#pragma unroll
        for (int i = 0; i < 32; ++i) v[i] = vn[i];
    }
}
__device__ __forceinline__ void cvt_do(const CvtDesc& d, bool load, LAS float* scr, int lane, float (&v)[32]) { if (load) cvt_load(d, lane, v); else cvt_finish(d, scr, lane, v); }
__device__ __forceinline__ void p0_prologue(Frame& F) {
    LAS float* scr = (LAS float*)(F.lds + F.wave * 8448);
    LAS float* SIL = (LAS float*)(F.lds + 69632);
    LAS float* RED = (LAS float*)(F.lds + 69632 + 36864);
    if ((int)blockIdx.x < 192) {
        for (int idx = F.tid; idx < 9 * 1024; idx += NWAVES * 64) { const int r = idx >> 10, k = idx & 1023; const float cv = r < 8 ? F.in[I_C][r * 1024 + k] : F.in[I_CCTX][k]; SIL[idx] = silu_f(cv); }
        __syncthreads();
        for (int t = blockIdx.x; t < 192; t += F.G) {
            const int i = t / 96, col0 = 64 * (t % 96);
            const float* wp = F.in[I_ADAW] + ((size_t)i * 1024 + F.wave * 128) * 6144 + col0 + F.lane;
            float acc[9];
#pragma unroll
            for (int r = 0; r < 9; ++r) acc[r] = 0.f;
            for (int k8 = 0; k8 < 128; k8 += 8) {
                float wv[8];
#pragma unroll
                for (int q = 0; q < 8; ++q) wv[q] = wp[(size_t)(k8 + q) * 6144];
#pragma unroll
                for (int q = 0; q < 8; ++q)
#pragma unroll
                    for (int r = 0; r < 9; ++r) acc[r] += SIL[r * 1024 + F.wave * 128 + k8 + q] * wv[q];
            }
#pragma unroll
            for (int r = 0; r < 9; ++r) RED[(F.wave * 9 + r) * 64 + F.lane] = acc[r];
            __syncthreads();
            for (int idx = F.tid; idx < 576; idx += NWAVES * 64) { const int r = idx >> 6, ln = idx & 63; float s = 0.f;
#pragma unroll
                for (int w = 0; w < 8; ++w) s += RED[(w * 9 + r) * 64 + ln];
                ((float*)(F.ws + WS_MOD))[(size_t)(i * 9 + r) * 6144 + col0 + ln] = s + F.in[I_ADAB][i * 6144 + col0 + ln]; }
            __syncthreads();
        }
    }
    const int gw = blockIdx.x * NWAVES + F.wave, NGW = F.G * NWAVES;
    constexpr int I0 = 16 * 194, I1 = 32 * 32, I2 = 16 * 176, I3 = 44 * 32, I4 = 16 * 96, I5 = 16 * 32;
    { const float* w0 = F.in[I_SWIN]; const float* w1 = F.in[I_SWOUT]; const float* w2 = F.in[I_FGU]; const float* w3 = F.in[I_FDN]; const float* w4 = F.in[I_SCWIN]; const float* w5 = F.in[I_SCWOUT]; unsigned char* ws = F.ws;
      auto dec = [w0, w1, w2, w3, w4, w5, ws](int it, bool load, LAS float* scr_, int lane_, float (&v)[32]) { CvtDesc d; d.mode = 0; d.dffx = 0; d.fp8 = 0; d.sc = 1.f; int r = it;
          if (r < I0) { d.W = w0; d.WT = ws + WS_WIN; d.K = 1024; d.N = DINP; d.item = r; cvt_do(d, load, scr_, lane_, v); return; } r -= I0;
          if (r < I1) { d.W = w1; d.WT = ws + WS_WOUT; d.K = 2048; d.N = 1024; d.item = r; cvt_do(d, load, scr_, lane_, v); return; } r -= I1;
          if (r < I2) { d.W = w2; d.WT = ws + WS_WGU; d.K = 1024; d.N = 2 * DFF; d.item = r; d.mode = 1; d.dffx = DFF; d.fp8 = FFN_FP8; d.sc = FFN_FP8 ? WGU_SCALE : 1.f; cvt_do(d, load, scr_, lane_, v); return; } r -= I2;
          if (r < I3) { d.W = w3; d.WT = ws + WS_WDN; d.K = DFF; d.N = 1024; d.item = r; d.fp8 = FFN_FP8; d.sc = FFN_FP8 ? WDN_SCALE : 1.f; cvt_do(d, load, scr_, lane_, v); return; } r -= I3;
          if (r < I4) { d.W = w4; d.WT = ws + WS_WSCI; d.K = 1024; d.N = 3072; d.item = r; cvt_do(d, load, scr_, lane_, v); return; } r -= I4;
          d.W = w5; d.WT = ws + WS_WSCO; d.K = 1024; d.N = 1024; d.item = r; cvt_do(d, load, scr_, lane_, v); };
      cvt_stream(dec, I0 + I1 + I2 + I3 + I4 + I5, gw, NGW, scr, F.lane); }
    { v4u* zp = (v4u*)((bf16*)(F.ws + WS_WIN) + (size_t)DINP * 1024); const int n16 = (DINP_PAD - DINP) * 1024 / 8;
      for (int i = blockIdx.x * (NWAVES * 64) + F.tid; i < n16; i += F.G * NWAVES * 64) zp[i] = (v4u){0u, 0u, 0u, 0u}; }
}
__device__ __forceinline__ void p1_prenorm(Frame& F) {
    const int gw = blockIdx.x * NWAVES + F.wave, NGW = F.G * NWAVES;
    bf16* H = (bf16*)(F.ws + WS_H);
    for (int r = gw; r < MALL; r += NGW) {
        const float* src = r < MLAT ? F.in[I_X] + (size_t)r * DM : F.in[I_CTX] + (size_t)(r - MLAT) * DM; const int mr = r < MLAT ? (r >> 12) : 8;
        f32x4 v[4]; load_row_f32(src, F.lane, v);
        prenorm_mod(v, F.in[I_NPRE], mod_vec(F, 0, mr, 1), mod_vec(F, 0, mr, 0), F.lane);
        store_row_bf16(H + (size_t)r * DM, F.lane, v);
    }
}
template <bool NEXT, bool H8OUT = false>
__device__ __forceinline__ void resnorm_phase(Frame& F, const float* xin, int layer, int gchunk, const float* npost, const float* npre, int nlayer, int scchunk, int shchunk) {
    const int gw = blockIdx.x * NWAVES + F.wave, NGW = F.G * NWAVES;
    const bf16* Y = (const bf16*)(F.ws + WS_Y); bf16* H = (bf16*)(F.ws + WS_H);
    for (int r = gw; r < MLAT; r += NGW) {
        const int b = r >> 12;
        f32x4 y[4], x[4]; load_row_bf16(Y + (size_t)r * DM, F.lane, y); load_row_f32(xin + (size_t)r * DM, F.lane, x);
        const float rr = rsqrtf(row_ss(y) * (1.0f / DM) + EPS); const float* gt = mod_vec(F, layer, b, gchunk);
#pragma unroll
        for (int j = 0; j < 4; ++j) { const int col = 4 * F.lane + 256 * j; x[j] = x[j] + *(const f32x4*)(gt + col) * ((y[j] * rr) * *(const f32x4*)(npost + col)); *(f32x4*)(F.out + (size_t)r * DM + col) = x[j]; }
        if (NEXT) { prenorm_mod(x, npre, mod_vec(F, nlayer, b, scchunk), mod_vec(F, nlayer, b, shchunk), F.lane);
            if (H8OUT) {
#pragma unroll
                for (int j = 0; j < 4; ++j) *(unsigned*)((unsigned char*)H + (size_t)r * DM + 4 * F.lane + 256 * j) = pk4_fp8(x[j][0], x[j][1], x[j][2], x[j][3]); }
            else store_row_bf16(H + (size_t)r * DM, F.lane, x); }
    }
}

__device__ __forceinline__ int ssd_sidx(int b, int cs, int g) { return (b * 34 + cs) * 8 + g; }
__device__ __forceinline__ void dt_scan(const float* DTR, int r0, int dcol, float bias, float A, int lane, float (&dt)[2], float (&dA)[2], float (&inc)[2], float& total) {
#pragma unroll
    for (int h = 0; h < 2; ++h) { const float x = DTR[(size_t)(r0 + lane + 64 * h) * 64 + dcol] + bias; dt[h] = x > 20.f ? x : log1pf(__expf(x)); dA[h] = dt[h] * A; }
    float s0 = dA[0], s1 = dA[1];
#pragma unroll
    for (int o = 1; o < 64; o <<= 1) { const float t0 = __shfl_up(s0, o), t1 = __shfl_up(s1, o); if (lane >= o) { s0 += t0; s1 += t1; } }
    const float tot0 = __shfl(s0, 63); s1 += tot0; inc[0] = s0; inc[1] = s1; total = __shfl(s1, 63);
}
__device__ __forceinline__ void ssd_phase_a(Frame& F, const int dry) {
    LAS unsigned char* XI = F.lds; LAS unsigned char* BI = F.lds + XI_BYTES; LAS float* WS = (LAS float*)(F.lds + SCAL_OFF);
    const int lane = F.lane, w = F.wave, gq = lane >> 4, q4 = (lane & 15) >> 2, p4 = lane & 3, l15 = lane & 15;
    const LAS unsigned char* trX = XI + (8 * gq + q4) * PXB + 8 * p4; const LAS unsigned char* trB = BI + (8 * gq + q4) * PBB + 8 * p4;
    bf16* XBC = (bf16*)(F.ws + WS_XBC); const float* DTR = (const float*)(F.ws + WS_DT); bf16* S = (bf16*)(F.ws + WS_S); float* CD = (float*)(F.ws + WS_CD);
    for (int u = blockIdx.x; u < NUNIT; u += F.G) {
        int b, cs, g; bool isctx;
        if (u < NUNIT_LAT) { b = u >> 8; cs = (u >> 3) & 31; g = u & 7; isctx = false; } else { const int v = u - NUNIT_LAT; b = v >> 4; cs = 32 + ((v >> 3) & 1); g = v & 7; isctx = true; }
        const int r0 = isctx ? MLAT + b * CTXL + (cs - 32) * 128 : b * SEQ + cs * 128, sidx = ssd_sidx(b, cs, g);
        const int col = lane < 32 ? g * 256 + 8 * lane : (lane < 48 ? 2048 + g * 128 + 8 * (lane - 32) : 3072 + g * 128 + 8 * (lane - 48));
        const int l0 = 16 * w; int lo, hi; if (isctx) { lo = -(cs - 32) * 128; hi = lo + 255; } else { lo = l0 & ~63; hi = lo + 63; }
        v4u raw[20];
#pragma unroll
        for (int i = 0; i < 20; ++i) { const int lp = l0 - 2 + i; raw[i] = (lp >= lo && lp <= hi) ? *(const v4u*)(XBC + (long)(r0 + lp) * CONVD + col) : (v4u){0u, 0u, 0u, 0u}; }
        f32x2n wt[5][4], bs[4];
#pragma unroll
        for (int t = 0; t < 5; ++t) { const f32x4 a = *(const f32x4*)(F.in[I_SCONVW] + t * CONVD + col), c4 = *(const f32x4*)(F.in[I_SCONVW] + t * CONVD + col + 4);
            wt[t][0] = (f32x2n){a[0], a[1]}; wt[t][1] = (f32x2n){a[2], a[3]}; wt[t][2] = (f32x2n){c4[0], c4[1]}; wt[t][3] = (f32x2n){c4[2], c4[3]}; }
        { const f32x4 a = *(const f32x4*)(F.in[I_SCONVB] + col), c4 = *(const f32x4*)(F.in[I_SCONVB] + col + 4);
          bs[0] = (f32x2n){a[0], a[1]}; bs[1] = (f32x2n){a[2], a[3]}; bs[2] = (f32x2n){c4[0], c4[1]}; bs[3] = (f32x2n){c4[2], c4[3]}; }
        VM_WAIT(); LDS_BARRIER();
        f32x2n f[5][4];
#define UNPK_ROW(dst, rw) do { dst[0] = (f32x2n){bflo(rw.x), bfhi(rw.x)}; dst[1] = (f32x2n){bflo(rw.y), bfhi(rw.y)}; dst[2] = (f32x2n){bflo(rw.z), bfhi(rw.z)}; dst[3] = (f32x2n){bflo(rw.w), bfhi(rw.w)}; } while (0)
#pragma unroll
        for (int i = 0; i < 4; ++i) UNPK_ROW(f[i], raw[i]);
#pragma unroll
        for (int i = 0; i < 16; ++i) {
            UNPK_ROW(f[(i + 4) % 5], raw[i + 4]);
            unsigned ow[4];
#pragma unroll
            for (int e = 0; e < 4; ++e) { f32x2n a = bs[e];
#pragma unroll
                for (int t = 0; t < 5; ++t) a = wt[t][e] * f[(i + t) % 5][e] + a;
                ow[e] = pk2(silu_f(a.x), silu_f(a.y)); }
            const v4u ov = {ow[0], ow[1], ow[2], ow[3]};
            const int l = l0 + i;
            if (lane < 32) *(LAS v4u*)(XI + l * PXB + 16 * lane) = ov; else if (lane < 48) *(LAS v4u*)(BI + l * PBB + 16 * (lane - 32)) = ov;
            if (!isctx && !dry) *(v4u*)(XBC + (size_t)(r0 + l) * CONVD + col) = ov;
        }
#undef UNPK_ROW
        { const int d = w >> 2, hh = g * 4 + (w & 3); float dt[2], dA[2], inc[2], total;
          dt_scan(DTR, r0, d * 32 + hh, F.in[I_SDTB][d * 32 + hh], -__expf(F.in[I_SALOG][d * 32 + hh]), lane, dt, dA, inc, total);
#pragma unroll
          for (int h = 0; h < 2; ++h) WS[w * 128 + lane + 64 * h] = dt[h] * (d == 0 ? __expf(total - inc[h]) : __expf(inc[h] - dA[h]));
          if (lane == 0) CD[sidx * 8 + w] = __expf(total); }
        LDS_BARRIER();
        bf16x8 bt[4];
#pragma unroll
        for (int ks = 0; ks < 4; ++ks) bt[ks] = tr_pair(trB + (32 * ks) * PBB + 32 * w, trB + (32 * ks + 4) * PBB + 32 * w);
#pragma unroll 1
        for (int j = 0; j < (dry == 2 ? 0 : 4); ++j) {
            bf16x8 as_[2][4];
#pragma unroll
            for (int d = 0; d < 2; ++d) {
                const int combo = d * 4 + j;
#pragma unroll
                for (int ks = 0; ks < 4; ++ks) { const f32x4 w0 = *(const LAS f32x4*)(WS + combo * 128 + 32 * ks + 8 * gq), w1 = *(const LAS f32x4*)(WS + combo * 128 + 32 * ks + 8 * gq + 4);
                    const bf16x8 r8 = bt[ks]; bf16x8 o8;
                    const unsigned u0 = pk2(bf1((bf16)r8[0]) * w0[0], bf1((bf16)r8[1]) * w0[1]), u1 = pk2(bf1((bf16)r8[2]) * w0[2], bf1((bf16)r8[3]) * w0[3]);
                    const unsigned u2 = pk2(bf1((bf16)r8[4]) * w1[0], bf1((bf16)r8[5]) * w1[1]), u3 = pk2(bf1((bf16)r8[6]) * w1[2], bf1((bf16)r8[7]) * w1[3]);
                    o8[0] = (short)(u0 & 0xffff); o8[1] = (short)(u0 >> 16); o8[2] = (short)(u1 & 0xffff); o8[3] = (short)(u1 >> 16); o8[4] = (short)(u2 & 0xffff); o8[5] = (short)(u2 >> 16); o8[6] = (short)(u3 & 0xffff); o8[7] = (short)(u3 >> 16);
                    as_[d][ks] = o8; }
            }
#pragma unroll
            for (int pt = 0; pt < 4; ++pt) {
                bf16x8 xf[4];
#pragma unroll
                for (int ks = 0; ks < 4; ++ks) xf[ks] = tr_pair(trX + (32 * ks) * PXB + (j * 64 + pt * 16) * 2, trX + (32 * ks + 4) * PXB + (j * 64 + pt * 16) * 2);
#pragma unroll
                for (int d = 0; d < 2; ++d) { const int combo = d * 4 + j; f32x4 acc = {0.f, 0.f, 0.f, 0.f};
#pragma unroll
                    for (int ks = 0; ks < 4; ++ks) acc = MFMA16(as_[d][ks], xf[ks], acc);
                    *(v2u*)(S + ((size_t)(sidx * 8 + combo) * 64 + pt * 16 + l15) * 128 + 16 * w + 4 * gq) = pack4(acc); }
            }
        }
        LDS_BARRIER();
    }
}
__device__ __forceinline__ void ssd_phase_b(Frame& F) {
    bf16* S = (bf16*)(F.ws + WS_S); const float* CD = (const float*)(F.ws + WS_CD);
    const int NT = F.G * NWAVES * 64;
    for (int q = blockIdx.x * (NWAVES * 64) + F.tid; q < 512 * 1024; q += NT) {
        const int e8 = q & 1023, seq = q >> 10, combo = seq & 7, g = (seq >> 3) & 7, b = seq >> 6, d = combo >> 2;
        float h[8];
#pragma unroll
        for (int e = 0; e < 8; ++e) h[e] = 0.f;
#pragma unroll
        for (int k = 0; k < 2; ++k) { const int cs = d == 0 ? 32 + k : 33 - k, si = ssd_sidx(b, cs, g) * 8 + combo; const float dec = CD[si]; const v4u t = *(const v4u*)(S + (size_t)si * 8192 + e8 * 8);
            h[0] = dec * h[0] + bflo(t.x); h[1] = dec * h[1] + bfhi(t.x); h[2] = dec * h[2] + bflo(t.y); h[3] = dec * h[3] + bfhi(t.y); h[4] = dec * h[4] + bflo(t.z); h[5] = dec * h[5] + bfhi(t.z); h[6] = dec * h[6] + bflo(t.w); h[7] = dec * h[7] + bfhi(t.w); }
        for (int c0 = 0; c0 < 32; c0 += 8) {
            v4u t[8]; float dc[8];
#pragma unroll
            for (int k = 0; k < 8; ++k) { const int cs = d == 0 ? c0 + k : 31 - (c0 + k), si = ssd_sidx(b, cs, g) * 8 + combo; dc[k] = CD[si]; t[k] = *(const v4u*)(S + (size_t)si * 8192 + e8 * 8); }
#pragma unroll
            for (int k = 0; k < 8; ++k) { const int cs = d == 0 ? c0 + k : 31 - (c0 + k), si = ssd_sidx(b, cs, g) * 8 + combo;
                v4u o; o.x = pk2(h[0], h[1]); o.y = pk2(h[2], h[3]); o.z = pk2(h[4], h[5]); o.w = pk2(h[6], h[7]);
                *(v4u*)(S + (size_t)si * 8192 + e8 * 8) = o;
                const float dec = dc[k]; const v4u tt = t[k];
                h[0] = dec * h[0] + bflo(tt.x); h[1] = dec * h[1] + bfhi(tt.x); h[2] = dec * h[2] + bflo(tt.y); h[3] = dec * h[3] + bfhi(tt.y); h[4] = dec * h[4] + bflo(tt.z); h[5] = dec * h[5] + bfhi(tt.z); h[6] = dec * h[6] + bflo(tt.w); h[7] = dec * h[7] + bfhi(tt.w); }
        }
    }
}
__device__ __forceinline__ void ssd_phase_c(Frame& F, const int dry) {
    LAS unsigned char* XI = F.lds; LAS unsigned char* BI = F.lds + XI_BYTES; LAS unsigned char* MWw = F.lds + XI_BYTES + BI_BYTES + F.wave * (16 * PMB);
    LAS float* DTS = (LAS float*)(F.lds + SCAL_OFF); LAS float* INC = DTS + 1024; LAS float* EXC = DTS + 2048; LAS float* BPw = (LAS float*)(F.lds + BPW_OFF) + F.wave * 128;
    const int tid = F.tid, lane = F.lane, w = F.wave, gq = lane >> 4, q4 = (lane & 15) >> 2, p4 = lane & 3, l15 = lane & 15, lme = 16 * w + l15;
    const LAS unsigned char* trX = XI + (8 * gq + q4) * PXB + 8 * p4;
    const bf16* XBC = (const bf16*)(F.ws + WS_XBC); const float* DTR = (const float*)(F.ws + WS_DT); const bf16* HIN = (const bf16*)(F.ws + WS_S); bf16* Z = (bf16*)(F.ws + WS_Z);
    for (int u = blockIdx.x; u < NUNIT_LAT; u += F.G) {
        const int b = u >> 8, c = (u >> 3) & 31, g = u & 7, r0 = b * SEQ + c * 128, sidx = ssd_sidx(b, c, g);
#pragma unroll
        for (int k = 0; k < 8; ++k) { const int id = tid + 512 * k, row = id >> 5, ch = id & 31; *(LAS v4u*)(XI + row * PXB + 16 * ch) = *(const v4u*)(XBC + (size_t)(r0 + row) * CONVD + g * 256 + 8 * ch); }
#pragma unroll
        for (int k = 0; k < 4; ++k) { const int id = tid + 512 * k, row = id >> 4, ch = id & 15; *(LAS v4u*)(BI + row * PBB + 16 * ch) = *(const v4u*)(XBC + (size_t)(r0 + row) * CONVD + 2048 + g * 128 + 8 * ch); }
        bf16x8 cf[4];
#pragma unroll
        for (int ks = 0; ks < 4; ++ks) cf[ks] = *(const bf16x8*)(XBC + (size_t)(r0 + lme) * CONVD + 3072 + g * 128 + 32 * ks + 8 * gq);
        v4u hp[2];
        const bf16* hbase = HIN + (size_t)sidx * 8 * 8192;
#pragma unroll
        for (int k = 0; k < 2; ++k) { const int id = tid + 512 * k; hp[k] = *(const v4u*)(hbase + (size_t)(id >> 4) * 128 + 8 * (id & 15)); }
        { const int d = w >> 2, hh = g * 4 + (w & 3); float dt[2], dA[2], inc[2], total;
          dt_scan(DTR, r0, d * 32 + hh, F.in[I_SDTB][d * 32 + hh], -__expf(F.in[I_SALOG][d * 32 + hh]), lane, dt, dA, inc, total);
#pragma unroll
          for (int h = 0; h < 2; ++h) { DTS[w * 128 + lane + 64 * h] = dt[h]; INC[w * 128 + lane + 64 * h] = inc[h]; EXC[w * 128 + lane + 64 * h] = inc[h] - dA[h]; } }
        LDS_BARRIER();
        f32x4 Gt[8];
#pragma unroll
        for (int st = 0; st < 8; ++st) { f32x4 a = {0.f, 0.f, 0.f, 0.f};
#pragma unroll
            for (int ks = 0; ks < 4; ++ks) a = MFMA16(*(const LAS bf16x8*)(BI + (16 * st + l15) * PBB + (32 * ks + 8 * gq) * 2), cf[ks], a);
            Gt[st] = a; }
        LDS_BARRIER();
        LAS unsigned char* HB0 = BI; LAS unsigned char* HB1 = BI + 64 * PBB;
#pragma unroll
        for (int k = 0; k < 2; ++k) { const int id = tid + 512 * k; *(LAS v4u*)(HB0 + (id >> 4) * PBB + 16 * (id & 15)) = hp[k]; }
        v4u hq[2];
#pragma unroll
        for (int k = 0; k < 2; ++k) { const int id = tid + 512 * k; hp[k] = *(const v4u*)(hbase + 4 * 8192 + (size_t)(id >> 4) * 128 + 8 * (id & 15));
                                      hq[k] = *(const v4u*)(hbase + 1 * 8192 + (size_t)(id >> 4) * 128 + 8 * (id & 15)); }
        LDS_BARRIER();
#pragma unroll 1
        for (int j = 0; j < 4; ++j) {
            f32x4 Y[4];
#pragma unroll
            for (int pt = 0; pt < 4; ++pt) Y[pt] = (f32x4){0.f, 0.f, 0.f, 0.f};
#pragma unroll 1
            for (int d = 0; d < (dry == 2 ? 0 : 2); ++d) {
                const int combo = d * 4 + j, ci = 2 * j + d;
                LAS unsigned char* HBc = (ci & 1) ? HB1 : HB0; LAS unsigned char* HBn = (ci & 1) ? HB0 : HB1;
                if (ci < 7) {
#pragma unroll
                    for (int k = 0; k < 2; ++k) { const int id = tid + 512 * k; *(LAS v4u*)(HBn + (id >> 4) * PBB + 16 * (id & 15)) = hp[k]; }
#pragma unroll
                    for (int k = 0; k < 2; ++k) hp[k] = hq[k];
                    if (ci < 5) { const int cn = ci + 3, combn = (cn & 1) * 4 + (cn >> 1);
#pragma unroll
                        for (int k = 0; k < 2; ++k) { const int id = tid + 512 * k; hq[k] = *(const v4u*)(hbase + (size_t)combn * 8192 + (size_t)(id >> 4) * 128 + 8 * (id & 15)); } }
                }
                const LAS float* U = (d ? EXC : INC) + combo * 128; const LAS float* DTc = DTS + combo * 128;
                const float tot = INC[combo * 128 + 127], u_l = U[lme]; const int kd = w >> 1;
                const float u_ref = d ? (kd == 3 ? tot : U[32 * kd + 32]) : (kd == 0 ? 0.f : U[32 * kd - 1]);
                const float a_l = __expf(d ? (u_ref - u_l) : (u_l - u_ref)), e_ref = __expf(d ? (tot - u_ref) : u_ref);
#pragma unroll
                for (int h = 0; h < 2; ++h) { const int s = lane + 64 * h; const float ar = d ? (U[s] - u_ref) : (u_ref - U[s]); BPw[s] = __expf(fminf(ar, 0.f)) * DTc[s]; }
                f32x4 Yp[4];
#pragma unroll
                for (int pt = 0; pt < 4; ++pt) { f32x4 a = {0.f, 0.f, 0.f, 0.f};
#pragma unroll
                    for (int ks = 0; ks < 4; ++ks) a = MFMA16(*(const LAS bf16x8*)(HBc + (16 * pt + l15) * PBB + (32 * ks + 8 * gq) * 2), cf[ks], a);
                    Yp[pt] = a * e_ref; }
#pragma unroll
                for (int ks = 0; ks < 4; ++ks) {
                    const bool offd = d ? (ks > kd) : (ks < kd);
                    if (offd) {
#pragma unroll
                        for (int t2 = 0; t2 < 2; ++t2) { const int st = 2 * ks + t2, s0 = 16 * st + 4 * gq; const f32x4 bp = *(const LAS f32x4*)(BPw + s0);
                            *(LAS v2u*)(MWw + l15 * PMB + s0 * 2) = pack4(Gt[st] * bp); }
                        const bf16x8 mb = *(const LAS bf16x8*)(MWw + l15 * PMB + (32 * ks + 8 * gq) * 2);
#pragma unroll
                        for (int pt = 0; pt < 4; ++pt) { const bf16x8 xa = tr_pair(trX + (32 * ks) * PXB + (j * 64 + pt * 16) * 2, trX + (32 * ks + 4) * PXB + (j * 64 + pt * 16) * 2);
                            Yp[pt] = MFMA16(xa, mb, Yp[pt]); }
                    }
                }
#pragma unroll
                for (int pt = 0; pt < 4; ++pt) Y[pt] = Y[pt] + Yp[pt] * a_l;
#pragma unroll
                for (int ks = 0; ks < 4; ++ks) if (ks == kd) {
#pragma unroll
                    for (int t2 = 0; t2 < 2; ++t2) { const int st = 2 * ks + t2, s0 = 16 * st + 4 * gq; const f32x4 u_s = *(const LAS f32x4*)(U + s0), dt_s = *(const LAS f32x4*)(DTc + s0);
                        f32x4 val;
#pragma unroll
                        for (int e = 0; e < 4; ++e) { const int s = s0 + e; const bool valid = d ? (s >= lme) : (s <= lme); const float arg = d ? (u_s[e] - u_l) : (u_l - u_s[e]);
                            val[e] = valid ? Gt[st][e] * __expf(arg) * dt_s[e] : 0.f; }
                        *(LAS v2u*)(MWw + l15 * PMB + s0 * 2) = pack4(val); }
                    const bf16x8 mb = *(const LAS bf16x8*)(MWw + l15 * PMB + (32 * ks + 8 * gq) * 2);
#pragma unroll
                    for (int pt = 0; pt < 4; ++pt) { const bf16x8 xa = tr_pair(trX + (32 * ks) * PXB + (j * 64 + pt * 16) * 2, trX + (32 * ks + 4) * PXB + (j * 64 + pt * 16) * 2);
                        Y[pt] = MFMA16(xa, mb, Y[pt]); }
                }
                LDS_BARRIER();
            }
            const float dsk = F.in[I_SD][g * 4 + j];
#pragma unroll
            for (int pt = 0; pt < 4; ++pt) { const int ch = j * 64 + pt * 16 + 4 * gq;
                const f32x4 xv = unpack4(*(const LAS v2u*)(XI + lme * PXB + ch * 2));
                *(LAS v2u*)(XI + lme * PXB + ch * 2) = pack4(Y[pt] + xv * dsk); }
        }
        LDS_BARRIER();
        { const int chunk = tid & 31; const f32x4 nw0 = *(const f32x4*)(F.in[I_SNORM] + g * 256 + 8 * chunk), nw1 = *(const f32x4*)(F.in[I_SNORM] + g * 256 + 8 * chunk + 4);
          v4u zq[8];
#pragma unroll
          for (int k = 0; k < 8; ++k) zq[k] = *(const v4u*)(Z + (size_t)(r0 + (tid >> 5) + 16 * k) * DIN + g * 256 + 8 * chunk);
#pragma unroll
          for (int k = 0; k < 8; ++k) { const int row = (tid >> 5) + 16 * k; const v4u yv = *(const LAS v4u*)(XI + row * PXB + 16 * chunk), zv = zq[k];
              float y[8] = {bflo(yv.x), bfhi(yv.x), bflo(yv.y), bfhi(yv.y), bflo(yv.z), bfhi(yv.z), bflo(yv.w), bfhi(yv.w)};
              const float z[8] = {bflo(zv.x), bfhi(zv.x), bflo(zv.y), bfhi(zv.y), bflo(zv.z), bfhi(zv.z), bflo(zv.w), bfhi(zv.w)};
              float ss = 0.f;
#pragma unroll
              for (int e = 0; e < 8; ++e) { y[e] = y[e] * silu_f(z[e]); ss += y[e] * y[e]; }
#pragma unroll
              for (int o = 1; o < 32; o <<= 1) ss += __shfl_xor(ss, o);
              const float rr = rsqrtf(ss * (1.0f / 256.0f) + EPS);
              v4u ov; ov.x = pk2(y[0] * rr * nw0[0], y[1] * rr * nw0[1]); ov.y = pk2(y[2] * rr * nw0[2], y[3] * rr * nw0[3]); ov.z = pk2(y[4] * rr * nw1[0], y[5] * rr * nw1[1]); ov.w = pk2(y[6] * rr * nw1[2], y[7] * rr * nw1[3]);
              if (!dry) *(v4u*)(Z + (size_t)(r0 + row) * DIN + g * 256 + 8 * chunk) = ov; } }
        LDS_BARRIER();
    }
}

__device__ __forceinline__ void p12_shortconv(Frame& F) {
    const bf16* P = (const bf16*)(F.ws + WS_SCP); bf16* U = (bf16*)(F.ws + WS_H); const float* cw = F.in[I_SCCONV];
    const int NT = F.G * NWAVES * 64;
    for (int id = blockIdx.x * (NWAVES * 64) + F.tid; id < MLAT * 128; id += NT) {
        const int r = id >> 7, col = 8 * (id & 127), xpos = r & 63;
        float acc[8];
#pragma unroll
        for (int e = 0; e < 8; ++e) acc[e] = 0.f;
#pragma unroll
        for (int t = 0; t < 3; ++t) { const int xp = xpos + t - 1; if (xp >= 0 && xp < 64) {
            const v4u gc = *(const v4u*)(P + (size_t)(r + t - 1) * 3072 + 1024 + col), vv = *(const v4u*)(P + (size_t)(r + t - 1) * 3072 + 2048 + col);
            const f32x4 w0 = *(const f32x4*)(cw + t * 1024 + col), w1 = *(const f32x4*)(cw + t * 1024 + col + 4);
            acc[0] += w0[0] * (bflo(gc.x) * bflo(vv.x)); acc[1] += w0[1] * (bfhi(gc.x) * bfhi(vv.x)); acc[2] += w0[2] * (bflo(gc.y) * bflo(vv.y)); acc[3] += w0[3] * (bfhi(gc.y) * bfhi(vv.y));
            acc[4] += w1[0] * (bflo(gc.z) * bflo(vv.z)); acc[5] += w1[1] * (bfhi(gc.z) * bfhi(vv.z)); acc[6] += w1[2] * (bflo(gc.w) * bflo(vv.w)); acc[7] += w1[3] * (bfhi(gc.w) * bfhi(vv.w)); } }
        const v4u gb = *(const v4u*)(P + (size_t)r * 3072 + col);
        v4u o; o.x = pk2(bflo(gb.x) * acc[0], bfhi(gb.x) * acc[1]); o.y = pk2(bflo(gb.y) * acc[2], bfhi(gb.y) * acc[3]); o.z = pk2(bflo(gb.z) * acc[4], bfhi(gb.z) * acc[5]); o.w = pk2(bflo(gb.w) * acc[6], bfhi(gb.w) * acc[7]);
        *(v4u*)(U + (size_t)r * DM + col) = o;
    }
}

__device__ __forceinline__ void p14_resnorm_route(Frame& F) {
    LAS float* RW = (LAS float*)F.lds;
    LAS int* SEL = (LAS int*)(F.lds + 32768);
    const bf16* Y = (const bf16*)(F.ws + WS_Y); unsigned char* H8 = (unsigned char*)(F.ws + WS_H);
    int* SELR = (int*)(F.ws + WS_ROUTE + RT_SELR); float* GATE = (float*)(F.ws + WS_ROUTE + RT_GATE); int* CNT = (int*)(F.ws + WS_ROUTE + RT_CNT);
    for (int i = F.tid; i < 8192; i += NWAVES * 64) RW[i] = F.in[I_ROUTER][i];
    __syncthreads();
    const float* npost = F.in[I_NPOST] + 2 * 1024; const float* npre = F.in[I_NPRE] + 3 * 1024;
    for (int vb = blockIdx.x; vb < 256; vb += F.G) {
        for (int i = 0; i < 16; ++i) {
            const int tl = 16 * F.wave + i, r = 128 * vb + tl, b = r >> 12;
            f32x4 y[4], x[4]; load_row_bf16(Y + (size_t)r * DM, F.lane, y); load_row_f32(F.out + (size_t)r * DM, F.lane, x);
            const float rr = rsqrtf(row_ss(y) * (1.0f / DM) + EPS); const float* gt = mod_vec(F, 1, b, 2);
#pragma unroll
            for (int j = 0; j < 4; ++j) { const int col = 4 * F.lane + 256 * j; x[j] = x[j] + *(const f32x4*)(gt + col) * ((y[j] * rr) * *(const f32x4*)(npost + col)); *(f32x4*)(F.out + (size_t)r * DM + col) = x[j]; }
            prenorm_mod(x, npre, mod_vec(F, 1, b, 4), mod_vec(F, 1, b, 3), F.lane);
#pragma unroll
            for (int j = 0; j < 4; ++j) *(unsigned*)(H8 + (size_t)r * DM + 4 * F.lane + 256 * j) = pk4_fp8(x[j][0], x[j][1], x[j][2], x[j][3]);
            float lg[8];
#pragma unroll
            for (int e = 0; e < 8; ++e) lg[e] = 0.f;
#pragma unroll
            for (int j = 0; j < 4; ++j)
#pragma unroll
                for (int q = 0; q < 4; ++q) { const int col = 4 * F.lane + 256 * j + q; const f32x4 r0 = *(const LAS f32x4*)(RW + col * 8), r1 = *(const LAS f32x4*)(RW + col * 8 + 4); const float hv = x[j][q];
                    lg[0] += hv * r0[0]; lg[1] += hv * r0[1]; lg[2] += hv * r0[2]; lg[3] += hv * r0[3]; lg[4] += hv * r1[0]; lg[5] += hv * r1[1]; lg[6] += hv * r1[2]; lg[7] += hv * r1[3]; }
#pragma unroll
            for (int e = 0; e < 8; ++e) lg[e] = wave_sum(lg[e]);
            int e0 = 0; float v0 = lg[0];
#pragma unroll
            for (int e = 1; e < 8; ++e) if (lg[e] > v0) { v0 = lg[e]; e0 = e; }
            int e1 = -1; float v1 = 0.f;
#pragma unroll
            for (int e = 0; e < 8; ++e) if (e != e0 && (e1 < 0 || lg[e] > v1)) { v1 = lg[e]; e1 = e; }
            if (F.lane == 0) { const float g0 = 1.0f / (1.0f + __expf(v1 - v0)); GATE[2 * r] = g0; GATE[2 * r + 1] = 1.0f - g0; SEL[2 * tl] = e0; SEL[2 * tl + 1] = e1; }
        }
        __syncthreads();
        if (F.tid < 8) { int cnt = 0;
            for (int t = 0; t < 256; ++t) if (SEL[t] == F.tid) { SELR[256 * vb + t] = F.tid | (cnt << 8); ++cnt; }
            CNT[vb * 8 + F.tid] = cnt; }
        __syncthreads();
    }
}
__device__ __forceinline__ void p15_permute(Frame& F) {
    LAS int* CNTL = (LAS int*)(F.lds + 69632);
    LAS int* PRE = CNTL + 2048;
    LAS int* TOT = PRE + 2048;
    LAS int* SEG = TOT + 8;
    const int* CNT = (const int*)(F.ws + WS_ROUTE + RT_CNT); const int* SELR = (const int*)(F.ws + WS_ROUTE + RT_SELR);
    int* POS = (int*)(F.ws + WS_ROUTE + RT_POS); int* TEXP = (int*)(F.ws + WS_ROUTE + RT_TEXP);
    const unsigned char* H8 = (const unsigned char*)(F.ws + WS_H); unsigned char* HP = (unsigned char*)(F.ws + WS_HP8);
    for (int i = F.tid; i < 2048; i += NWAVES * 64) CNTL[i] = CNT[i];
    __syncthreads();
    if (F.tid < 8) { int run = 0; for (int v = 0; v < 256; ++v) { PRE[v * 8 + F.tid] = run; run += CNTL[v * 8 + F.tid]; } TOT[F.tid] = run; }
    __syncthreads();
    if (F.tid == 0) { int ss = 0; for (int e = 0; e < 8; ++e) { SEG[e] = ss; ss += (TOT[e] + 255) & ~255; } SEG[8] = ss;
        if (blockIdx.x == 0) { for (int e = 0; e < 8; ++e) for (int t = SEG[e] >> 8; t < (SEG[e + 1] >> 8); ++t) TEXP[t] = e; TEXP[300] = ss >> 8; } }
    __syncthreads();
    for (int vb = blockIdx.x; vb < 256; vb += F.G) {
        for (int i = 0; i < 16; ++i) { const int tl = 16 * F.wave + i, r = 128 * vb + tl;
            const v4u a = *(const v4u*)(H8 + (size_t)r * DM + 16 * F.lane);
#pragma unroll
            for (int k = 0; k < 2; ++k) { const int sr = SELR[2 * r + k], e = sr & 255, pos = SEG[e] + PRE[vb * 8 + e] + (sr >> 8);
                *(v4u*)(HP + (size_t)pos * DM + 16 * F.lane) = a;
                if (F.lane == 0) POS[2 * r + k] = pos; } }
    }
    if ((int)blockIdx.x < 8) { const int e = blockIdx.x;
        for (int row = SEG[e] + TOT[e] + F.wave; row < SEG[e + 1]; row += NWAVES) *(v4u*)(HP + (size_t)row * DM + 16 * F.lane) = (v4u){0u, 0u, 0u, 0u}; }
    LAS float* scr = (LAS float*)(F.lds + F.wave * 8448);
    const int gw = blockIdx.x * NWAVES + F.wave, NGW = F.G * NWAVES;
    constexpr int IG = 16 * 224, ID = 56 * 32;
    { const float* mg = F.in[I_MGU]; const float* md = F.in[I_MDN]; unsigned char* ws = F.ws;
      auto dec = [mg, md, ws](int it, bool load, LAS float* scr_, int lane_, float (&v)[32]) { CvtDesc d; d.fp8 = 1; const int e = it / (IG + ID), r = it % (IG + ID);
          if (r < IG) { d.W = mg + (size_t)e * 1024 * 2 * DFFE; d.WT = ws + WS_WMGU + (size_t)e * 2 * DFFE * 1024; d.K = 1024; d.N = 2 * DFFE; d.item = r; d.mode = 1; d.dffx = DFFE; d.sc = WGU_SCALE; cvt_do(d, load, scr_, lane_, v); }
          else { d.W = md + (size_t)e * DFFE * 1024; d.WT = ws + WS_WMDN + (size_t)e * 1024 * DFFE; d.K = DFFE; d.N = 1024; d.item = r - IG; d.mode = 0; d.dffx = 0; d.sc = WDN_SCALE; cvt_do(d, load, scr_, lane_, v); } };
      cvt_stream(dec, 8 * (IG + ID), gw, NGW, scr, F.lane); }
}
__device__ __forceinline__ void p18_final(Frame& F) {
    const int gw = blockIdx.x * NWAVES + F.wave, NGW = F.G * NWAVES;
    const bf16* YP = (const bf16*)(F.ws + WS_YP); const int* POS = (const int*)(F.ws + WS_ROUTE + RT_POS); const float* GATE = (const float*)(F.ws + WS_ROUTE + RT_GATE);
    const float* npost = F.in[I_NPOST] + 3 * 1024;
    for (int r = gw; r < MLAT; r += NGW) {
        const int b = r >> 12, p0 = POS[2 * r], p1 = POS[2 * r + 1]; const float g0 = GATE[2 * r], g1 = GATE[2 * r + 1];
        f32x4 a[4], c[4], x[4]; load_row_bf16(YP + (size_t)p0 * DM, F.lane, a); load_row_bf16(YP + (size_t)p1 * DM, F.lane, c); load_row_f32(F.out + (size_t)r * DM, F.lane, x);
#pragma unroll
        for (int j = 0; j < 4; ++j) a[j] = a[j] * g0 + c[j] * g1;
        const float rr = rsqrtf(row_ss(a) * (1.0f / DM) + EPS); const float* gt = mod_vec(F, 1, b, 5);
#pragma unroll
        for (int j = 0; j < 4; ++j) { const int col = 4 * F.lane + 256 * j; *(f32x4*)(F.out + (size_t)r * DM + col) = x[j] + *(const f32x4*)(gt + col) * ((a[j] * rr) * *(const f32x4*)(npost + col)); }
    }
}

#define XB_TMO      128
#define XB_XCNT(j)  (256  + 64 * (j))
#define XB_XSUB(j)  (1280 + 64 * (j))
#define XB_XGEN(j)  (2304 + 64 * (j))
#define XB_TOP      3328
#define XB_TOPGEN   3392
#define XCD_BAR_WORDS 3456
#define XB_SPIN_CAP (1u << 18)

__device__ __forceinline__ unsigned xb_ld(unsigned* p)              { return __hip_atomic_load(p, __ATOMIC_RELAXED, __HIP_MEMORY_SCOPE_AGENT); }
__device__ __forceinline__ unsigned xb_add(unsigned* p, unsigned v) { return __hip_atomic_fetch_add(p, v, __ATOMIC_RELAXED, __HIP_MEMORY_SCOPE_AGENT); }
__device__ __forceinline__ unsigned xb_xcc_id() { return (unsigned)__builtin_amdgcn_s_getreg((3 << 11) | 20) & 0xFu; }
#define XB_SPIN(cond, bar) do { unsigned _sp = 0; while (cond) { __builtin_amdgcn_s_sleep(1); \
    if ((++_sp & 255u) == 0u) { if (xb_ld(&(bar)[XB_TMO])) break; if (_sp > XB_SPIN_CAP) { atomicAdd(&(bar)[XB_TMO], 1u); break; } } } } while (0)

struct XcdBarrier {
    unsigned* bar; unsigned x;
    volatile LAS unsigned* st;
};

__device__ __forceinline__ XcdBarrier xcd_barrier_post(unsigned* bar, volatile LAS unsigned* st) {
    XcdBarrier b; b.bar = bar; b.x = xb_xcc_id(); b.st = st;
    if (threadIdx.x == 0) (void)xb_add(&bar[XB_XCNT(b.x)], 1u);
    return b;
}
__device__ __forceinline__ void xcd_barrier_complete(unsigned* bar, unsigned x, unsigned& nloc, unsigned& nx) {
    const unsigned G = gridDim.x * gridDim.y * gridDim.z;
    unsigned sum, cnt, mine, sp = 0u;
    for (;;) {
        sum = 0u; cnt = 0u; mine = 0u;
#pragma unroll
        for (unsigned j = 0; j < 16; ++j) { const unsigned c = xb_ld(&bar[XB_XCNT(j)]); sum += c; cnt += (c > 0u) ? 1u : 0u; mine = (j == x) ? c : mine; }
        if (sum == G) break;
        __builtin_amdgcn_s_sleep(1);
        if ((++sp & 255u) == 0u) { if (xb_ld(&bar[XB_TMO])) break; if (sp > XB_SPIN_CAP) { atomicAdd(&bar[XB_TMO], 1u); break; } }
    }
    nloc = mine > 0u ? mine : 1u; nx = cnt > 0u ? cnt : 1u;
}

__device__ __forceinline__ void xcd_barrier(const XcdBarrier& b) {
    asm volatile("s_waitcnt vmcnt(0)" ::: "memory");
    __syncthreads();
    if (threadIdx.x == 0) {
        unsigned* bar = b.bar;
        __builtin_amdgcn_s_waitcnt(0);
        unsigned nloc = b.st[0], nx = b.st[1];
        if (nloc == 0u) { xcd_barrier_complete(bar, b.x, nloc, nx); b.st[0] = nloc; b.st[1] = nx; }
        const unsigned old = xb_add(&bar[XB_XSUB(b.x)], 1u);
        const unsigned gen = old / nloc;
        if (old + 1u == (gen + 1u) * nloc) {
            __builtin_amdgcn_fence(__ATOMIC_RELEASE, "agent");
            asm volatile("s_waitcnt vmcnt(0)" ::: "memory");
            const unsigned og = xb_add(&bar[XB_TOP], 1u);
            const unsigned tg = og / nx;
            if (og + 1u == (tg + 1u) * nx) xb_add(&bar[XB_TOPGEN], 1u);
            else XB_SPIN(xb_ld(&bar[XB_TOPGEN]) == tg, bar);
            __builtin_amdgcn_fence(__ATOMIC_ACQUIRE, "agent");
            xb_add(&bar[XB_XGEN(b.x)], 1u);
            asm volatile("s_waitcnt vmcnt(0)" ::: "memory");
        } else {
            XB_SPIN(xb_ld(&bar[XB_XGEN(b.x)]) == gen, bar);
            __builtin_amdgcn_fence(__ATOMIC_ACQUIRE, "agent");
            asm volatile("s_waitcnt vmcnt(0)" ::: "memory");
        }
    }
    __syncthreads();
}

#ifndef MK_DUMP
#define MK_DUMP 0
#endif
__device__ __forceinline__ void dump_phase(Frame& F) {
    const size_t NT = (size_t)F.G * NWAVES * 64, n = (size_t)MLAT * DM;
    for (size_t i = (size_t)blockIdx.x * (NWAVES * 64) + F.tid; i < n; i += NT) {
        float v = 0.f;
        if (MK_DUMP == 1) { v = bf1(((const bf16*)(F.ws + WS_H))[i]) + (i < (size_t)MCTX * DM ? bf1(((const bf16*)(F.ws + WS_H))[n + i]) : 0.f); }
        if (MK_DUMP == 2) { for (int k = 0; k < 4; ++k) v += bf1(((const bf16*)(F.ws + WS_XBC))[i + k * n]); for (int k = 0; k < 2; ++k) v += bf1(((const bf16*)(F.ws + WS_Z))[i + k * n]); if (i < (size_t)MALL * 64) v += ((const float*)(F.ws + WS_DT))[i]; }
        if (MK_DUMP == 3) { const size_t ns = (size_t)NUNIT * 8 * 8192; for (int k = 0; k < 5; ++k) if (i + k * n < ns) v += bf1(((const bf16*)(F.ws + WS_S))[i + k * n]); for (int k = 0; k < 4; ++k) v += bf1(((const bf16*)(F.ws + WS_XBC))[i + k * n]); if (i < (size_t)NUNIT * 8) v += ((const float*)(F.ws + WS_CD))[i]; }
        if (MK_DUMP == 4) { for (int k = 0; k < 2; ++k) v += bf1(((const bf16*)(F.ws + WS_Z))[i + k * n]); }
        if (MK_DUMP == 5) { v = bf1(((const bf16*)(F.ws + WS_Y))[i]); }
        F.out[i] = v;
    }
}

struct Args { const float* in[24]; float* out; unsigned char* ws; int ph_lo, ph_hi; };
__global__ void __launch_bounds__(NWAVES * 64, 2) fwd_kernel(Args args) {
    extern __shared__ __attribute__((aligned(16))) unsigned char lds[];
    Frame F;
    F.lds = (LAS unsigned char*)lds;
    F.MISC = (volatile LAS unsigned*)(F.lds + MISC_OFF);
    F.tid = threadIdx.x; F.lane = F.tid & 63; F.wave = __builtin_amdgcn_readfirstlane(F.tid >> 6);
    F.G = gridDim.x;
#pragma unroll
    for (int i = 0; i < 24; ++i) F.in[i] = args.in[i];
    F.out = args.out; F.ws = args.ws; F.ctl = (gu32*)(args.ws + WS_CTL);
    for (int u = F.tid; u < (LDS_BYTES - MISC_OFF) / 4; u += NWAVES * 64) ((LAS unsigned*)(F.lds + MISC_OFF))[u] = 0u;
    __syncthreads();
    XcdBarrier bar; bar.bar = (unsigned*)(F.ctl + CW_BAR); bar.x = 0; bar.st = nullptr;
    if (!MK_PER_PHASE) bar = xcd_barrier_post((unsigned*)(F.ctl + CW_BAR), F.MISC + 8);
    const int lo = args.ph_lo, hi = args.ph_hi & 0xff; const int dry = (args.ph_hi >> 8) & 3;
#ifndef MK_PHASE_MASK
#define MK_PHASE_MASK 0x7ffff
#endif
#define IN(k) (((MK_PHASE_MASK >> (k)) & 1) && lo <= (k) && (k) < hi)
#define SEAM(k) do { if (!MK_PER_PHASE && IN((k) + 1)) xcd_barrier(bar); } while (0)
    bf16* const WS_bH = (bf16*)(F.ws + WS_H); bf16* const WS_bY = (bf16*)(F.ws + WS_Y); bf16* const WS_bZ = (bf16*)(F.ws + WS_Z);

    if (IN(0)) { p0_prologue(F); SEAM(0); }
    if (IN(1)) { p1_prenorm(F); SEAM(1); }
    if (IN(2)) {
        pg8::Gemm g{WS_bH, (const bf16*)(F.ws + WS_WIN), MALL, DINP_PAD, DM}; pg8::InProjOrder S; S.init(MLAT, DINP_PAD, F.G, (int)blockIdx.x);
        pg8::EpiInProj E{WS_bZ, (bf16*)(F.ws + WS_XBC), (float*)(F.ws + WS_DT)};
        pg8::gemm_phase<pg8::EpiInProj, pg8::InProjOrder, true, true>(F.lds, g, S, E);
        SEAM(2);
    }
    if (IN(3)) { ssd_phase_a(F, dry); SEAM(3); }
    if (IN(4)) { ssd_phase_b(F); SEAM(4); }
    if (IN(5)) { ssd_phase_c(F, dry); SEAM(5); }
    if (IN(6)) {
        pg8::Gemm g{WS_bZ, (const bf16*)(F.ws + WS_WOUT), MLAT, DM, DIN}; pg8::StaticOrder S; S.init(MLAT, DM, F.G, (int)blockIdx.x);
        pg8::EpiBf16<0> E{WS_bY, DM, nullptr, 0, 0, 1.f};
        pg8::gemm_phase<pg8::EpiBf16<0>, pg8::StaticOrder, true, true>(F.lds, g, S, E);
        SEAM(6);
    }
    if (IN(7)) { resnorm_phase<true, FFN_FP8 != 0>(F, F.in[I_X], 0, 2, F.in[I_NPOST], F.in[I_NPRE] + 1024, 0, 4, 3); SEAM(7); }
    if (IN(8)) {
        if constexpr (FFN_FP8) {
            pg8::Gemm g{WS_bH, (const bf16*)(F.ws + WS_WGU), MLAT, 2 * DFF, DM / 2}; pg8::StaticOrder S; S.init(MLAT, 2 * DFF, F.G, (int)blockIdx.x);
            pg8::EpiSwiGLU8 E{(unsigned char*)(F.ws + WS_ACT0), DFF, 1.0f / WGU_SCALE};
            pg8::gemm_phase<pg8::EpiSwiGLU8, pg8::StaticOrder, true, true, true>(F.lds, g, S, E);
        } else {
            pg8::Gemm g{WS_bH, (const bf16*)(F.ws + WS_WGU), MLAT, 2 * DFF, DM}; pg8::StaticOrder S; S.init(MLAT, 2 * DFF, F.G, (int)blockIdx.x);
            pg8::EpiSwiGLU E{(bf16*)(F.ws + WS_ACT0), DFF};
            pg8::gemm_phase<pg8::EpiSwiGLU, pg8::StaticOrder, true, true>(F.lds, g, S, E);
        }
        SEAM(8);
    }
    if (IN(9)) {
        if constexpr (FFN_FP8) {
            pg8::Gemm g{(const bf16*)(F.ws + WS_ACT0), (const bf16*)(F.ws + WS_WDN), MLAT, DM, DFF / 2}; pg8::StaticOrder S; S.init(MLAT, DM, F.G, (int)blockIdx.x);
            pg8::EpiBf16S E{WS_bY, DM, 1.0f / WDN_SCALE};
            pg8::gemm_phase<pg8::EpiBf16S, pg8::StaticOrder, true, true, true>(F.lds, g, S, E);
        } else {
            pg8::Gemm g{(const bf16*)(F.ws + WS_ACT0), (const bf16*)(F.ws + WS_WDN), MLAT, DM, DFF}; pg8::StaticOrder S; S.init(MLAT, DM, F.G, (int)blockIdx.x);
            pg8::EpiBf16<0> E{WS_bY, DM, nullptr, 0, 0, 1.f};
            pg8::gemm_phase<pg8::EpiBf16<0>, pg8::StaticOrder, true, true>(F.lds, g, S, E);
        }
        SEAM(9);
    }
    if (IN(10)) { resnorm_phase<true>(F, F.out, 0, 5, F.in[I_NPOST] + 1024, F.in[I_NPRE] + 2048, 1, 1, 0); SEAM(10); }
    if (IN(11)) {
        pg8::Gemm g{WS_bH, (const bf16*)(F.ws + WS_WSCI), MLAT, 3072, DM}; pg8::StaticOrder S; S.init(MLAT, 3072, F.G, (int)blockIdx.x);
        pg8::EpiBf16<0> E{(bf16*)(F.ws + WS_SCP), 3072, nullptr, 0, 0, 1.f};
        pg8::gemm_phase<pg8::EpiBf16<0>, pg8::StaticOrder, true, true>(F.lds, g, S, E);
        SEAM(11);
    }
    if (IN(12)) { p12_shortconv(F); SEAM(12); }
    if (IN(13)) {
        pg8::Gemm g{WS_bH, (const bf16*)(F.ws + WS_WSCO), MLAT, DM, DM}; pg8::StaticOrder S; S.init(MLAT, DM, F.G, (int)blockIdx.x);
        pg8::EpiBf16<0> E{WS_bY, DM, nullptr, 0, 0, 1.f};
        pg8::gemm_phase<pg8::EpiBf16<0>, pg8::StaticOrder, true, true>(F.lds, g, S, E);
        SEAM(13);
    }
    if (IN(14)) { p14_resnorm_route(F); SEAM(14); }
    if (IN(15)) { p15_permute(F); SEAM(15); }
    if (MK_PER_PHASE && dry && lo == 16) {
        const int* texp = (const int*)(F.ws + WS_ROUTE + RT_TEXP); int nt = __builtin_amdgcn_readfirstlane(texp[300]); nt = nt < 0 ? 0 : (nt > MOE_ROWS / 256 ? MOE_ROWS / 256 : nt);
        pg8::Gemm g{(const bf16*)(F.ws + WS_HP8), (const bf16*)(F.ws + WS_WMGU), 256 * nt, 2 * DFFE, DM / 2};
        pg8::GroupedOrder S; S.init(256 * nt, 2 * DFFE, F.G, (int)blockIdx.x); S.texp = texp; S.estride = (size_t)2 * DFFE * DM;
        pg8::EpiNull E{(float*)(F.ws + WS_CD)};
        pg8::gemm_phase<pg8::EpiNull, pg8::GroupedOrder, true, true, true>(F.lds, g, S, E);
        return;
    }
    if (IN(16)) {
        const int* texp = (const int*)(F.ws + WS_ROUTE + RT_TEXP); int nt = __builtin_amdgcn_readfirstlane(texp[300]); nt = nt < 0 ? 0 : (nt > MOE_ROWS / 256 ? MOE_ROWS / 256 : nt);
        pg8::Gemm g{(const bf16*)(F.ws + WS_HP8), (const bf16*)(F.ws + WS_WMGU), 256 * nt, 2 * DFFE, DM / 2};
        pg8::GroupedOrder S; S.init(256 * nt, 2 * DFFE, F.G, (int)blockIdx.x); S.texp = texp; S.estride = (size_t)2 * DFFE * DM;
        pg8::EpiSwiGLU8 E{(unsigned char*)(F.ws + WS_ACT), DFFE, 1.0f / WGU_SCALE};
        pg8::gemm_phase<pg8::EpiSwiGLU8, pg8::GroupedOrder, true, true, true>(F.lds, g, S, E);
        SEAM(16);
    }
    if (IN(17)) {
        const int* texp = (const int*)(F.ws + WS_ROUTE + RT_TEXP); int nt = __builtin_amdgcn_readfirstlane(texp[300]); nt = nt < 0 ? 0 : (nt > MOE_ROWS / 256 ? MOE_ROWS / 256 : nt);
        pg8::Gemm g{(const bf16*)(F.ws + WS_ACT), (const bf16*)(F.ws + WS_WMDN), 256 * nt, DM, DFFE / 2};
        pg8::GroupedOrder S; S.init(256 * nt, DM, F.G, (int)blockIdx.x); S.texp = texp; S.estride = (size_t)DM * DFFE;
        pg8::EpiBf16S E{(bf16*)(F.ws + WS_YP), DM, 1.0f / WDN_SCALE};
        pg8::gemm_phase<pg8::EpiBf16S, pg8::GroupedOrder, true, true, true>(F.lds, g, S, E);
        SEAM(17);
    }
    if (IN(18)) { p18_final(F); }
    if (MK_DUMP && lo <= 19 && 19 < hi) dump_phase(F);
#undef IN
#undef SEAM
}

extern "C" void kernel_launch(void* const* d_in, const int* in_sizes, int n_in, void* d_out, int out_size, void* d_ws, size_t ws_size, hipStream_t stream) {
    static int grid = 0;
    if (grid == 0) {
        if (n_in != 24 || out_size != MLAT * DM || ws_size < WS_NEED) { fprintf(stderr, "kernel_launch: unexpected problem (n_in %d, out %d, ws %zu)\n", n_in, out_size, ws_size); grid = -1; return; }
        int dev = 0, cus = 0, per_cu = 0;
        if (hipGetDevice(&dev) != hipSuccess || hipDeviceGetAttribute(&cus, hipDeviceAttributeMultiprocessorCount, dev) != hipSuccess) { grid = -1; return; }
        if (hipFuncSetAttribute((const void*)fwd_kernel, hipFuncAttributeMaxDynamicSharedMemorySize, LDS_BYTES) != hipSuccess) { fprintf(stderr, "kernel_launch: hipFuncSetAttribute failed\n"); grid = -1; return; }
        if (hipOccupancyMaxActiveBlocksPerMultiprocessor(&per_cu, (const void*)fwd_kernel, NWAVES * 64, LDS_BYTES) != hipSuccess || per_cu < 1) { fprintf(stderr, "kernel_launch: occupancy query reports %d\n", per_cu); }
        (void)hipGetLastError();
        grid = cus;
    }
    if (grid < 0) return;
    if (hipMemsetAsync((char*)d_ws + WS_CTL, 0, CTL_ZERO_BYTES, stream) != hipSuccess) return;
    Args a{};
    for (int i = 0; i < 24; ++i) a.in[i] = (const float*)d_in[i];
    a.out = (float*)d_out; a.ws = (unsigned char*)d_ws;
#if MK_PER_PHASE
#ifndef MK_TWICE_MASK
#define MK_TWICE_MASK 0
#endif
#ifndef MK_DRY_MASK
#define MK_DRY_MASK 0
#endif
#ifndef MK_DRY_LEVEL
#define MK_DRY_LEVEL 1
#endif
    for (int p = 0; p <= MK_LAST_PHASE; ++p) { a.ph_lo = p;
        if ((MK_DRY_MASK >> p) & 1) { a.ph_hi = (p + 1) | (MK_DRY_LEVEL << 8); hipLaunchKernelGGL(fwd_kernel, dim3(grid), dim3(NWAVES * 64), LDS_BYTES, stream, a); }
        a.ph_hi = p + 1; hipLaunchKernelGGL(fwd_kernel, dim3(grid), dim3(NWAVES * 64), LDS_BYTES, stream, a);
        if ((MK_TWICE_MASK >> p) & 1) hipLaunchKernelGGL(fwd_kernel, dim3(grid), dim3(NWAVES * 64), LDS_BYTES, stream, a); }
    if (MK_DUMP) { a.ph_lo = 19; a.ph_hi = 20; hipLaunchKernelGGL(fwd_kernel, dim3(grid), dim3(NWAVES * 64), LDS_BYTES, stream, a); }
#else
    a.ph_lo = 0; a.ph_hi = MK_LAST_PHASE + 1;
    hipLaunchKernelGGL(fwd_kernel, dim3(grid), dim3(NWAVES * 64), LDS_BYTES, stream, a);
#endif
}
```

```cpp
#include <hip/hip_runtime.h>
#include <cstdio>
#include <cstdint>
#define MK_PER_PHASE 0
#define MK_LAST_PHASE 18
#define MK_DUMP 0
#define MK_TWICE_MASK 0
#define MK_DRY_MASK 0
#define MK_DRY_LEVEL 1
#define MK_SPIN_PHASE -1
#define MK_SPIN_K 3
#define MK_SUB 0
#define MK_BENCH 0
#define MK_BENCH_N 300
namespace pg8 {
#define PG8_LAS __attribute__((address_space(3)))
typedef unsigned short bf16_t;
typedef short bf16x8 __attribute__((ext_vector_type(8)));
typedef float f32x4 __attribute__((ext_vector_type(4)));
typedef unsigned u32x4 __attribute__((ext_vector_type(4)));
constexpr int BM = 256, BK = 64, HALF = 128, HTB = HALF * BK * 2  , STAGE_BYTES = 8 * HTB, NXCD = 8, WGM = 4;

__host__ __device__ __forceinline__ int lds_byte(int r, int c) { const int st = (r >> 4) * 2 + (c >> 5), rr = r & 15, cc = c & 31, ob = rr * 64 + cc * 2; return st * 1024 + (ob ^ (((ob >> 9) & 1) << 5)); }
__host__ __device__ __forceinline__ void stage_rc(int b, int& R, int& C) { const int st = b / 1024, sb = b % 1024, swz = sb ^ (((sb >> 9) & 1) << 5); R = (st >> 1) * 16 + swz / 64; C = (st & 1) * 32 + (swz % 64) / 2; }
__host__ __device__ __forceinline__ int perm32(int rho) { const int n = rho >> 4, i = rho & 15; return 8 * (i >> 2) + 4 * n + (i & 3); }

struct Unit { int pm, pn; };
struct Gemm { const bf16_t* A; const bf16_t* Bt; int M, N, K; };

struct StaticOrder {
    int nM, nN, nwg, G, c;
    __host__ __device__ void init(int M, int N, int G_, int c_) { nM = M / BM; nN = N / BM; nwg = nM * nN; G = G_; c = c_; }
    __host__ __device__ bool next(int i, Unit& u) const {
        const long L = (long)i * G + c; if (L >= nwg) return false;
        int wgid = (int)L; { const int q = nwg / NXCD, r = nwg % NXCD, xcd = wgid % NXCD, off = wgid / NXCD; wgid = (xcd < r ? xcd * (q + 1) : r * (q + 1) + (xcd - r) * q) + off; }
        const int nig = WGM * nN, gid = wgid / nig, fm = gid * WGM, gsz = (nM - fm) < WGM ? (nM - fm) : WGM;
        u.pm = fm + ((wgid % nig) % gsz); u.pn = (wgid % nig) / gsz; return true;
    }
    __device__ __forceinline__ void a_ready(const Unit&) const {}
    __device__ __forceinline__ void done(const Unit&) const {}
    __device__ __forceinline__ size_t boff(const Unit&) const { return 0; }
};

typedef float f32x2c __attribute__((ext_vector_type(2)));
typedef __bf16 bf16x2c __attribute__((ext_vector_type(2)));
__device__ __forceinline__ unsigned cvt_pk_bf16(float lo, float hi) { const f32x2c v = {lo, hi}; return __builtin_bit_cast(unsigned, __builtin_convertvector(v, bf16x2c)); }
typedef float f32x2 __attribute__((ext_vector_type(2)));
__device__ __forceinline__ f32x2 gelu_pk(f32x2 v) {
    const f32x2 av = __builtin_elementwise_abs(v), d = av * 0.2316418882f + 1.0f;
    f32x2 t; t.x = __builtin_amdgcn_rcpf(d.x); t.y = __builtin_amdgcn_rcpf(d.y);
    f32x2 q = t * 0.5307027145f + (-0.7265760135f); q = q * t + 0.7107068705f; q = q * t + (-0.142248368f); q = q * t + 0.127414796f; q = q * t;
    const f32x2 s = (v * v) * (-0.72134752044f);
    f32x2 e; e.x = __builtin_amdgcn_exp2f(s.x); e.y = __builtin_amdgcn_exp2f(s.y);
    const f32x2 m = v * (q * e), r = v - m;
    f32x2 o; o.x = v.x < 0.f ? m.x : r.x; o.y = v.y < 0.f ? m.y : r.y; return o;
}

template <int ACT  > struct EpiBf16 {
    static constexpr bool PERM = true, AFTER_DRAIN = false; static_assert(ACT == 0 || ACT == 1, "EpiBf16: ACT is 0 (none) or 1 (gelu_pk)");
    bf16_t* O; int ldc; const float* bias; int split_cols; size_t split_stride; float scale0;
    __device__ __forceinline__ void operator()(const f32x4 (&acc)[2][2][4][2], const Unit& u, int wr, int wc, int fr, int fq) const {
        const int row0 = u.pm * BM + wr * 64 + fr; int colt = u.pn * BM; bf16_t* base = O;
        float sc = 1.f; if (split_cols) { const int t = colt / split_cols; base += (size_t)t * split_stride; colt -= t * split_cols; if (t == 0) sc = scale0; }
        const int col0 = colt + wc * 32 + 8 * fq, bcol0 = u.pn * BM + wc * 32 + 8 * fq;
        f32x4 bv[2][2];
#pragma unroll
        for (int bj = 0; bj < 2; ++bj)
#pragma unroll
            for (int n = 0; n < 2; ++n) bv[bj][n] = bias ? *(const f32x4*)(bias + bcol0 + bj * HALF + 4 * n) : (f32x4){0.f, 0.f, 0.f, 0.f};
#pragma unroll
        for (int ai = 0; ai < 2; ++ai)
#pragma unroll
            for (int m = 0; m < 4; ++m) { bf16_t* rowp = base + (size_t)(row0 + ai * HALF + m * 16) * ldc + col0;
#pragma unroll
                for (int bj = 0; bj < 2; ++bj) { f32x4 v0 = acc[ai][bj][m][0] + bv[bj][0], v1 = acc[ai][bj][m][1] + bv[bj][1];
                    if (ACT == 1) { f32x2 a = gelu_pk((f32x2){v0[0], v0[1]}), b = gelu_pk((f32x2){v0[2], v0[3]}), c = gelu_pk((f32x2){v1[0], v1[1]}), d = gelu_pk((f32x2){v1[2], v1[3]});
                        v0 = (f32x4){a.x, a.y, b.x, b.y}; v1 = (f32x4){c.x, c.y, d.x, d.y}; }
                    v0 = v0 * sc; v1 = v1 * sc; u32x4 w; w.x = cvt_pk_bf16(v0[0], v0[1]); w.y = cvt_pk_bf16(v0[2], v0[3]); w.z = cvt_pk_bf16(v1[0], v1[1]); w.w = cvt_pk_bf16(v1[2], v1[3]);
                    *(u32x4*)(rowp + bj * HALF) = w; } }
    }
};

typedef int i32x4f __attribute__((ext_vector_type(4)));
typedef int i32x8f __attribute__((ext_vector_type(8)));
__device__ __forceinline__ i32x8f cat8(bf16x8 a, bf16x8 b) { const i32x4f lo = __builtin_bit_cast(i32x4f, a), hi = __builtin_bit_cast(i32x4f, b); return __builtin_shufflevector(lo, hi, 0, 1, 2, 3, 4, 5, 6, 7); }
template <class Epi, class Sched, bool ALIGN_EPI = false, bool SP2 = false, bool FP8 = false>
__device__ __forceinline__ void gemm_phase(PG8_LAS unsigned char* lds, const Gemm g, const Sched& S, const Epi& E) {
    const int tid = threadIdx.x, wid = __builtin_amdgcn_readfirstlane(tid >> 6), lane = tid & 63, wr = wid >> 2, wc = wid & 3, fr = lane & 15, fq = lane >> 4;
    const int K = g.K, nt = K / BK;
    unsigned voffA[2], voffB[2];
#pragma unroll
    for (int i = 0; i < 2; ++i) { int R, C; stage_rc(tid * 16 + i * 8192, R, C); const int Rb = Epi::PERM ? ((R & ~31) + perm32(R & 31)) : R;
        voffA[i] = (unsigned)(R * K + C) * 2u; voffB[i] = (unsigned)(Rb * K + C) * 2u; }
    const size_t kstep = (size_t)(BK * 2);
    const size_t hstep = (size_t)HALF * K * 2;
    const size_t tstep = 2 * hstep;
    const unsigned ldsw = (unsigned)wid * 1024u;
    const int aoff = lds_byte(wr * 64 + fr, fq * 8), boff = lds_byte(wc * 32 + fr, fq * 8);
#define PG8_SA(b, h) (((b) * 2 + (h)) * HTB)
#define PG8_SB(b, h) ((4 + (b) * 2 + (h)) * HTB)
#define PG8_STAGE(bufoff, gbase, voff) do { _Pragma("unroll") for (int _i = 0; _i < 2; ++_i) \
        __builtin_amdgcn_global_load_lds((const unsigned*)((const char*)(gbase) + (voff)[_i]), (PG8_LAS unsigned*)(lds + (bufoff) + ldsw + _i * 8192), 16, 0, 0); } while (0)
#define PG8_LDA(dst, b, h) do { _Pragma("unroll") for (int m = 0; m < 4; ++m) { const bf16x8 x0_ = *(const PG8_LAS bf16x8*)(lds + PG8_SA(b, h) + aoff + m * 2048), x1_ = *(const PG8_LAS bf16x8*)(lds + PG8_SA(b, h) + aoff + m * 2048 + 1024); \
        if constexpr (FP8) dst##8[m] = cat8(x0_, x1_); else { dst[m][0] = x0_; dst[m][1] = x1_; } } } while (0)
#define PG8_LDB(dst, b, h) do { _Pragma("unroll") for (int n = 0; n < 2; ++n) { const bf16x8 x0_ = *(const PG8_LAS bf16x8*)(lds + PG8_SB(b, h) + boff + n * 2048), x1_ = *(const PG8_LAS bf16x8*)(lds + PG8_SB(b, h) + boff + n * 2048 + 1024); \
        if constexpr (FP8) dst##8[n] = cat8(x0_, x1_); else { dst[n][0] = x0_; dst[n][1] = x1_; } } } while (0)
#define PG8_MMA(ai, bj, At, Bt) do { __builtin_amdgcn_s_setprio(1); _Pragma("unroll") for (int m = 0; m < 4; ++m) _Pragma("unroll") for (int n = 0; n < 2; ++n) { \
        if constexpr (FP8) asm volatile("v_mfma_f32_16x16x128_f8f6f4 %0, %1, %2, %0" : "+v"(acc[ai][bj][m][n]) : "v"(Bt##8[n]), "v"(At##8[m])); \
        else { _Pragma("unroll") for (int k = 0; k < 2; ++k) acc[ai][bj][m][n] = __builtin_amdgcn_mfma_f32_16x16x32_bf16(Bt[n][k], At[m][k], acc[ai][bj][m][n], 0, 0, 0); } } __builtin_amdgcn_s_setprio(0); } while (0)
#define PG8_WAIT_V(n) asm volatile("s_waitcnt vmcnt(" #n ")" ::: "memory")
#define PG8_WAIT_L(n) asm volatile("s_waitcnt lgkmcnt(" #n ")" ::: "memory")
#define PG8_BAR __builtin_amdgcn_s_barrier()
#define PG8_SCHED __builtin_amdgcn_sched_barrier(0)
    Unit cur, nxt; int ui = 0;
    if (!S.next(0, cur)) return;
    f32x4 acc[2][2][4][2];
#pragma unroll
    for (int a = 0; a < 2; ++a)
#pragma unroll
        for (int b = 0; b < 2; ++b)
#pragma unroll
            for (int m = 0; m < 4; ++m)
#pragma unroll
                for (int n = 0; n < 2; ++n) acc[a][b][m][n] = (f32x4){0.f, 0.f, 0.f, 0.f};
    bf16x8 At[4][2], B0[2][2], B1[2][2]; i32x8f At8[4], B08[2], B18[2];
    const char* cA = (const char*)g.A + (size_t)cur.pm * tstep; const char* cB = (const char*)g.Bt + S.boff(cur) + (size_t)cur.pn * tstep;
    S.a_ready(cur);
    if constexpr (SP2) {
        PG8_STAGE(PG8_SB(0, 0), cB, voffB); PG8_STAGE(PG8_SB(0, 1), cB + hstep, voffB); PG8_STAGE(PG8_SA(0, 0), cA, voffA); PG8_STAGE(PG8_SA(0, 1), cA + hstep, voffA);
        if (wr == 1) PG8_BAR;
        PG8_WAIT_V(2); PG8_BAR;
        PG8_STAGE(PG8_SB(1, 0), cB + kstep, voffB); PG8_STAGE(PG8_SA(1, 0), cA + kstep, voffA); PG8_STAGE(PG8_SB(1, 1), cB + hstep + kstep, voffB);
        PG8_WAIT_V(6); PG8_BAR;
    } else {
        PG8_STAGE(PG8_SB(0, 0), cB, voffB); PG8_STAGE(PG8_SA(0, 0), cA, voffA); PG8_STAGE(PG8_SB(0, 1), cB + hstep, voffB); PG8_STAGE(PG8_SA(0, 1), cA + hstep, voffA);
        if (wr == 1) PG8_BAR;
        PG8_WAIT_V(4); PG8_BAR;
        PG8_STAGE(PG8_SB(1, 0), cB + kstep, voffB); PG8_STAGE(PG8_SA(1, 0), cA + kstep, voffA); PG8_STAGE(PG8_SB(1, 1), cB + hstep + kstep, voffB);
        PG8_WAIT_V(6); PG8_BAR;
    }
    for (;;) {
        const bool has_next = S.next(ui + 1, nxt);
        const char* nA = has_next ? (const char*)g.A + (size_t)nxt.pm * tstep : cA; const char* nB = has_next ? (const char*)g.Bt + S.boff(nxt) + (size_t)nxt.pn * tstep : cB;
        for (int t = 0; t < nt; t += 2) {
            const bool last = (t == nt - 2);
            const char* a1 = cA + (size_t)(t + 1) * kstep;
            const char* a2 = last ? nA : cA + (size_t)(t + 2) * kstep; const char* b2 = last ? nB : cB + (size_t)(t + 2) * kstep;
            const char* a3 = a2 + kstep; const char* b3 = b2 + kstep;
            if (last && has_next) S.a_ready(nxt);
            if constexpr (SP2) {
            PG8_LDB(B0, 0, 0); PG8_LDB(B1, 0, 1); PG8_SCHED; PG8_LDA(At, 0, 0); PG8_STAGE(PG8_SA(1, 1), a1 + hstep, voffA);
            PG8_WAIT_V(8); PG8_WAIT_L(0); PG8_BAR; PG8_MMA(0, 0, At, B0); PG8_MMA(0, 1, At, B1); PG8_BAR; PG8_SCHED;
            PG8_LDA(At, 0, 1); PG8_STAGE(PG8_SB(0, 0), b2, voffB); PG8_STAGE(PG8_SB(0, 1), b2 + hstep, voffB); PG8_STAGE(PG8_SA(0, 0), a2, voffA);
            PG8_WAIT_V(8); PG8_WAIT_L(0); PG8_BAR; PG8_MMA(1, 0, At, B0); PG8_MMA(1, 1, At, B1); PG8_BAR; PG8_SCHED;
            PG8_LDB(B0, 1, 0); PG8_LDB(B1, 1, 1); PG8_SCHED; PG8_LDA(At, 1, 0); PG8_STAGE(PG8_SA(0, 1), a2 + hstep, voffA);
            PG8_WAIT_V(8); PG8_WAIT_L(0); PG8_BAR; PG8_MMA(0, 0, At, B0); PG8_MMA(0, 1, At, B1); PG8_BAR; PG8_SCHED;
            PG8_LDA(At, 1, 1); PG8_STAGE(PG8_SB(1, 0), b3, voffB); PG8_STAGE(PG8_SB(1, 1), b3 + hstep, voffB); PG8_STAGE(PG8_SA(1, 0), a3, voffA);
            PG8_WAIT_V(8); PG8_WAIT_L(0); PG8_BAR; PG8_MMA(1, 0, At, B0); PG8_MMA(1, 1, At, B1); PG8_BAR; PG8_SCHED;
            } else {
            PG8_LDB(B0, 0, 0); PG8_SCHED; PG8_LDA(At, 0, 0); PG8_STAGE(PG8_SA(1, 1), a1 + hstep, voffA);
            PG8_WAIT_L(8); PG8_BAR; PG8_WAIT_L(0); PG8_MMA(0, 0, At, B0); PG8_BAR; PG8_SCHED;
            PG8_LDB(B1, 0, 1); PG8_STAGE(PG8_SB(0, 0), b2, voffB);
            PG8_BAR; PG8_WAIT_L(0); PG8_MMA(0, 1, At, B1); PG8_BAR;
            PG8_LDA(At, 0, 1); PG8_STAGE(PG8_SA(0, 0), a2, voffA);
            PG8_BAR; PG8_WAIT_L(0); PG8_MMA(1, 0, At, B0); PG8_BAR; PG8_SCHED;
            PG8_STAGE(PG8_SB(0, 1), b2 + hstep, voffB);
            PG8_WAIT_V(6); PG8_BAR; PG8_MMA(1, 1, At, B1); PG8_BAR;
            PG8_LDB(B0, 1, 0); PG8_SCHED; PG8_LDA(At, 1, 0); PG8_STAGE(PG8_SA(0, 1), a2 + hstep, voffA);
            PG8_WAIT_L(8); PG8_BAR; PG8_WAIT_L(0); PG8_MMA(0, 0, At, B0); PG8_BAR; PG8_SCHED;
            PG8_LDB(B1, 1, 1); PG8_STAGE(PG8_SB(1, 0), b3, voffB);
            PG8_BAR; PG8_WAIT_L(0); PG8_MMA(0, 1, At, B1); PG8_BAR;
            PG8_LDA(At, 1, 1); PG8_STAGE(PG8_SA(1, 0), a3, voffA);
            PG8_BAR; PG8_WAIT_L(0); PG8_MMA(1, 0, At, B0); PG8_BAR; PG8_SCHED;
            PG8_STAGE(PG8_SB(1, 1), b3 + hstep, voffB);
            PG8_WAIT_V(6); PG8_BAR; PG8_MMA(1, 1, At, B1); PG8_BAR;
            }
        }
        if constexpr (FP8) asm volatile("s_nop 7\n\ts_nop 7\n\ts_nop 7" ::: "memory");
        if constexpr (ALIGN_EPI) { if (wr == 0) PG8_BAR; }
        if constexpr (!Epi::AFTER_DRAIN) { E(acc, cur, wr, wc, fr, fq); S.done(cur); }
        if (!has_next) break;
#pragma unroll
        for (int a = 0; a < 2; ++a)
#pragma unroll
            for (int b = 0; b < 2; ++b)
#pragma unroll
                for (int m = 0; m < 4; ++m)
#pragma unroll
                    for (int n = 0; n < 2; ++n) acc[a][b][m][n] = (f32x4){0.f, 0.f, 0.f, 0.f};
        cur = nxt; cA = nA; cB = nB; ++ui;
        if constexpr (ALIGN_EPI) { if (wr == 1) PG8_BAR; }
    }
    PG8_WAIT_V(0);
    if constexpr (!ALIGN_EPI) { if (wr == 0) PG8_BAR; }
    PG8_BAR;
    if constexpr (Epi::AFTER_DRAIN) { E.fused(acc, cur, wr, wc, fr, fq, lds, wid, lane); S.done(cur); }
#undef PG8_SA
#undef PG8_SB
#undef PG8_STAGE
#undef PG8_LDA
#undef PG8_LDB
#undef PG8_MMA
#undef PG8_WAIT_V
#undef PG8_WAIT_L
#undef PG8_BAR
#undef PG8_SCHED
}
}

constexpr int NWAVES = 8;
constexpr int DM = 1024, NB = 8, SEQ = 4096, CTXL = 256;
constexpr int MLAT = NB * SEQ, MCTX = NB * CTXL, MALL = MLAT + MCTX;
constexpr int DIN = 2048, CONVD = 4096, DINP = 6208, DINP_PAD = 6400;
constexpr int DFF = 2816, NE = 8, DFFE = 3584;
constexpr int NUNIT_LAT = NB * 32 * 8, NUNIT = NUNIT_LAT + NB * 2 * 8;
constexpr int MOE_ROWS = 67584;
constexpr float EPS = 1e-6f;
#ifndef MK_PER_PHASE
#define MK_PER_PHASE 0
#endif
#ifndef MK_LAST_PHASE
#define MK_LAST_PHASE 18
#endif
constexpr int N_PHASES = 19;

constexpr size_t MiB = 1u << 20;
constexpr size_t WS_CTL = 0, CTL_ZERO_BYTES = 32 * 1024;
constexpr size_t WS_MOD = 1 * MiB;
constexpr size_t WS_ROUTE = 2 * MiB;
constexpr size_t WS_CD = 4 * MiB;
constexpr size_t WS_WIN = 8 * MiB, WS_WOUT = 21 * MiB, WS_WGU = 25 * MiB, WS_WDN = 36 * MiB, WS_WSCI = 42 * MiB, WS_WSCO = 48 * MiB;
constexpr size_t WS_H = 56 * MiB;
constexpr size_t WS_Y = 124 * MiB;
constexpr size_t WS_Z = 188 * MiB;
constexpr size_t WS_XBC = 324 * MiB;
constexpr size_t WS_DT = 596 * MiB;
constexpr size_t WS_S = 606 * MiB;
constexpr size_t WS_ACT0 = 324 * MiB;
constexpr size_t WS_SCP = 324 * MiB;
constexpr size_t WS_HP8 = 124 * MiB;
constexpr size_t WS_YP = 190 * MiB;
constexpr size_t WS_WMGU = 322 * MiB, WS_WMDN = 378 * MiB;
constexpr size_t WS_ACT = 406 * MiB;
constexpr size_t WS_END = 640 * MiB;
constexpr float WGU_SCALE = 64.f, WDN_SCALE = 128.f;
#ifndef MK_FFN_FP8
#define MK_FFN_FP8 0
#endif
constexpr int FFN_FP8 = MK_FFN_FP8;
static_assert(WS_S + (size_t)NUNIT * 8 * 8192 * 2 <= 878 * MiB && WS_HP8 + (size_t)MOE_ROWS * DM <= WS_YP && WS_YP + (size_t)MOE_ROWS * DM * 2 <= WS_WMGU && WS_WMGU + (size_t)8 * 2 * DFFE * DM <= WS_WMDN && WS_WMDN + (size_t)8 * DM * DFFE <= WS_ACT && WS_ACT + (size_t)MOE_ROWS * DFFE <= WS_END, "d_ws map");
constexpr size_t WS_NEED = 878 * MiB;
constexpr size_t RT_SELR = 0, RT_GATE = 256 * 1024, RT_POS = 512 * 1024, RT_CNT = 768 * 1024, RT_TEXP = 800 * 1024;
constexpr int CW_TMO = 0, CW_CODE = 1, CW_BAR = 4096;

constexpr int PXB = 544, PBB = 272, PMB = 272;
#define XOFF(R, cb) ((R) * PXB + ((((cb)) + (((R) & 8) << 4)) & 511))
constexpr int XI_BYTES = 128 * PXB, BI_BYTES = 128 * PBB, MW_BYTES = 8 * 16 * PMB;
constexpr int SCAL_OFF = XI_BYTES + BI_BYTES + MW_BYTES;
constexpr int BPW_OFF = SCAL_OFF + 3 * 4096;
constexpr int MISC_OFF = BPW_OFF + 8192;
constexpr int LDS_BYTES = MISC_OFF + 512;
static_assert(LDS_BYTES <= 160 * 1024 && pg8::STAGE_BYTES <= MISC_OFF, "LDS map");

#define GAS __attribute__((address_space(1)))
#define LAS __attribute__((address_space(3)))
typedef unsigned short bf16;
typedef unsigned v4u __attribute__((ext_vector_type(4)));
typedef unsigned v2u __attribute__((ext_vector_type(2)));
typedef float f32x4 __attribute__((ext_vector_type(4)));
typedef short bf16x8 __attribute__((ext_vector_type(8)));
typedef short s16x4 __attribute__((ext_vector_type(4)));
typedef GAS unsigned gu32;
#define RLX_AGENT __ATOMIC_RELAXED, __HIP_MEMORY_SCOPE_AGENT
#define LDS_WAIT() asm volatile("s_waitcnt lgkmcnt(0)" ::: "memory")
#define VM_WAIT() asm volatile("s_waitcnt vmcnt(0)" ::: "memory")
#define LDS_BARRIER() do { asm volatile("s_waitcnt lgkmcnt(0)" ::: "memory"); __builtin_amdgcn_s_barrier(); asm volatile("" ::: "memory"); } while (0)
typedef float f32x2n __attribute__((ext_vector_type(2)));
typedef __bf16 bf16x2n __attribute__((ext_vector_type(2)));
__device__ __forceinline__ unsigned pk2(float lo, float hi) { const f32x2n v = {lo, hi}; return __builtin_bit_cast(unsigned, __builtin_convertvector(v, bf16x2n)); }
__device__ __forceinline__ float bflo(unsigned u) { return __uint_as_float(u << 16); }
__device__ __forceinline__ float bfhi(unsigned u) { return __uint_as_float(u & 0xffff0000u); }
__device__ __forceinline__ float bf1(bf16 b) { return __uint_as_float(((unsigned)b) << 16); }
__device__ __forceinline__ f32x4 unpack4(v2u u) { return (f32x4){bflo(u.x), bfhi(u.x), bflo(u.y), bfhi(u.y)}; }
__device__ __forceinline__ v2u pack4(f32x4 v) { v2u r; r.x = pk2(v[0], v[1]); r.y = pk2(v[2], v[3]); return r; }
__device__ __forceinline__ unsigned pk4_fp8(float a, float b, float c, float d) {
    a = fminf(fmaxf(a, -448.f), 448.f); b = fminf(fmaxf(b, -448.f), 448.f); c = fminf(fmaxf(c, -448.f), 448.f); d = fminf(fmaxf(d, -448.f), 448.f);
    int v = __builtin_amdgcn_cvt_pk_fp8_f32(a, b, 0, false); v = __builtin_amdgcn_cvt_pk_fp8_f32(c, d, v, true); return (unsigned)v; }
__device__ __forceinline__ float silu_f(float v) { return v * __builtin_amdgcn_rcpf(1.0f + __builtin_amdgcn_exp2f(-1.44269504f * v)); }
__device__ __forceinline__ float wave_sum(float v) {
#pragma unroll
    for (int o = 1; o < 64; o <<= 1) v += __shfl_xor(v, o);
    return v;
}
__device__ __forceinline__ void wave_sum2(float& a, float& b) {
#pragma unroll
    for (int o = 1; o < 64; o <<= 1) { const float ta = __shfl_xor(a, o), tb = __shfl_xor(b, o); a += ta; b += tb; }
}
__device__ __forceinline__ unsigned lds_addr(LAS unsigned char* p) { return (unsigned)(size_t)p; }
__device__ __forceinline__ bf16x8 tr_pair(const LAS unsigned char* p0, const LAS unsigned char* p1) {
    const s16x4 x = __builtin_amdgcn_ds_read_tr16_b64_v4i16((LAS s16x4*)p0), y = __builtin_amdgcn_ds_read_tr16_b64_v4i16((LAS s16x4*)p1);
    return (bf16x8){x[0], x[1], x[2], x[3], y[0], y[1], y[2], y[3]};
}
#define MFMA16(a, b, c) __builtin_amdgcn_mfma_f32_16x16x32_bf16((a), (b), (c), 0, 0, 0)

namespace pg8 {
struct EpiInProj {
    static constexpr bool PERM = true, AFTER_DRAIN = false; static constexpr int MALL_ROWS = 34816;
    bf16_t* Z; bf16_t* XBC; float* DT;
    __device__ __forceinline__ void operator()(const f32x4 (&acc)[2][2][4][2], const Unit& u, int wr, int wc, int fr, int fq) const {
        const int row0 = u.pm * BM + wr * 64 + fr;
        if (u.pn < 24) {
            bf16_t* base; int ldc, colt;
            if (u.pn < 8) { base = Z; ldc = 2048; colt = u.pn * BM; } else { base = XBC; ldc = 4096; colt = (u.pn - 8) * BM; }
            const int col0 = colt + wc * 32 + 8 * fq;
#pragma unroll
            for (int ai = 0; ai < 2; ++ai)
#pragma unroll
                for (int m = 0; m < 4; ++m) { bf16_t* rowp = base + (size_t)(row0 + ai * HALF + m * 16) * ldc + col0;
#pragma unroll
                    for (int bj = 0; bj < 2; ++bj) { const f32x4 v0 = acc[ai][bj][m][0], v1 = acc[ai][bj][m][1];
                        u32x4 w; w.x = cvt_pk_bf16(v0[0], v0[1]); w.y = cvt_pk_bf16(v0[2], v0[3]); w.z = cvt_pk_bf16(v1[0], v1[1]); w.w = cvt_pk_bf16(v1[2], v1[3]);
                        *(u32x4*)(rowp + bj * HALF) = w; } }
        } else if (wc < 2) {
            const int col0 = wc * 32 + 8 * fq;
#pragma unroll
            for (int ai = 0; ai < 2; ++ai)
#pragma unroll
                for (int m = 0; m < 4; ++m) { const int row = row0 + ai * HALF + m * 16;
#pragma unroll
                    for (int n = 0; n < 2; ++n)
#pragma unroll
                        for (int j = 0; j < 4; ++j) DT[(size_t)(col0 + 4 * n + j) * MALL_ROWS + row] = acc[ai][0][m][n][j]; }
        }
    }
};
struct EpiSwiGLU {
    static constexpr bool PERM = true, AFTER_DRAIN = false;
    bf16_t* O; int ldc;
    __device__ __forceinline__ void operator()(const f32x4 (&acc)[2][2][4][2], const Unit& u, int wr, int wc, int fr, int fq) const {
        const int row0 = u.pm * BM + wr * 64 + fr, col0 = u.pn * HALF + wc * 32 + 8 * fq;
#pragma unroll
        for (int ai = 0; ai < 2; ++ai)
#pragma unroll
            for (int m = 0; m < 4; ++m) { bf16_t* rowp = O + (size_t)(row0 + ai * HALF + m * 16) * ldc + col0;
                float o[8];
#pragma unroll
                for (int n = 0; n < 2; ++n)
#pragma unroll
                    for (int j = 0; j < 4; ++j) { const float gt = acc[ai][0][m][n][j], up = acc[ai][1][m][n][j]; o[4 * n + j] = gt * __builtin_amdgcn_rcpf(1.0f + __expf(-gt)) * up; }
                u32x4 w; w.x = cvt_pk_bf16(o[0], o[1]); w.y = cvt_pk_bf16(o[2], o[3]); w.z = cvt_pk_bf16(o[4], o[5]); w.w = cvt_pk_bf16(o[6], o[7]);
                *(u32x4*)(rowp) = w; }
    }
};
struct EpiSwiGLU8 {
    static constexpr bool PERM = true, AFTER_DRAIN = false;
    unsigned char* O; int ldc; float sc;
    __device__ __forceinline__ void operator()(const f32x4 (&acc)[2][2][4][2], const Unit& u, int wr, int wc, int fr, int fq) const {
        const int row0 = u.pm * BM + wr * 64 + fr, col0 = u.pn * HALF + wc * 32 + 8 * fq;
#pragma unroll
        for (int ai = 0; ai < 2; ++ai)
#pragma unroll
            for (int m = 0; m < 4; ++m) { unsigned char* rowp = O + (size_t)(row0 + ai * HALF + m * 16) * ldc + col0;
                float o[8];
#pragma unroll
                for (int n = 0; n < 2; ++n)
#pragma unroll
                    for (int j = 0; j < 4; ++j) { const float gt = acc[ai][0][m][n][j] * sc, up = acc[ai][1][m][n][j] * sc; o[4 * n + j] = gt * __builtin_amdgcn_rcpf(1.0f + __builtin_amdgcn_exp2f(-1.44269504f * gt)) * up; }
                typedef unsigned u32x2e __attribute__((ext_vector_type(2)));
                u32x2e w; w.x = pk4_fp8(o[0], o[1], o[2], o[3]); w.y = pk4_fp8(o[4], o[5], o[6], o[7]);
                *(u32x2e*)(rowp) = w; }
    }
};
struct EpiBf16S {
    static constexpr bool PERM = true, AFTER_DRAIN = false;
    bf16_t* O; int ldc; float sc;
    __device__ __forceinline__ void operator()(const f32x4 (&acc)[2][2][4][2], const Unit& u, int wr, int wc, int fr, int fq) const {
        const int row0 = u.pm * BM + wr * 64 + fr, col0 = u.pn * BM + wc * 32 + 8 * fq;
#pragma unroll
        for (int ai = 0; ai < 2; ++ai)
#pragma unroll
            for (int m = 0; m < 4; ++m) { bf16_t* rowp = O + (size_t)(row0 + ai * HALF + m * 16) * ldc + col0;
#pragma unroll
                for (int bj = 0; bj < 2; ++bj) { const f32x4 v0 = acc[ai][bj][m][0] * sc, v1 = acc[ai][bj][m][1] * sc;
                    u32x4 w; w.x = cvt_pk_bf16(v0[0], v0[1]); w.y = cvt_pk_bf16(v0[2], v0[3]); w.z = cvt_pk_bf16(v1[0], v1[1]); w.w = cvt_pk_bf16(v1[2], v1[3]);
                    *(u32x4*)(rowp + bj * HALF) = w; } }
    }
};
struct EpiScIn {
    static constexpr bool PERM = true, AFTER_DRAIN = false;
    bf16_t* P; bf16_t* GB;
    __device__ __forceinline__ void operator()(const f32x4 (&acc)[2][2][4][2], const Unit& u, int wr, int wc, int fr, int fq) const {
        const int row0 = u.pm * BM + wr * 64 + fr;
        if (u.pn < 8) {
            const int col0 = u.pn * HALF + wc * 32 + 8 * fq;
#pragma unroll
            for (int ai = 0; ai < 2; ++ai)
#pragma unroll
                for (int m = 0; m < 4; ++m) { bf16_t* rowp = P + (size_t)(row0 + ai * HALF + m * 16) * 1024 + col0;
                    const f32x4 v0 = acc[ai][0][m][0] * acc[ai][1][m][0], v1 = acc[ai][0][m][1] * acc[ai][1][m][1];
                    u32x4 w; w.x = cvt_pk_bf16(v0[0], v0[1]); w.y = cvt_pk_bf16(v0[2], v0[3]); w.z = cvt_pk_bf16(v1[0], v1[1]); w.w = cvt_pk_bf16(v1[2], v1[3]);
                    *(u32x4*)(rowp) = w; }
        } else {
            const int col0 = (u.pn - 8) * BM + wc * 32 + 8 * fq;
#pragma unroll
            for (int ai = 0; ai < 2; ++ai)
#pragma unroll
                for (int m = 0; m < 4; ++m) { bf16_t* rowp = GB + (size_t)(row0 + ai * HALF + m * 16) * 1024 + col0;
#pragma unroll
                    for (int bj = 0; bj < 2; ++bj) { const f32x4 v0 = acc[ai][bj][m][0], v1 = acc[ai][bj][m][1];
                        u32x4 w; w.x = cvt_pk_bf16(v0[0], v0[1]); w.y = cvt_pk_bf16(v0[2], v0[3]); w.z = cvt_pk_bf16(v1[0], v1[1]); w.w = cvt_pk_bf16(v1[2], v1[3]);
                        *(u32x4*)(rowp + bj * HALF) = w; } }
        }
    }
};
struct InProjOrder : StaticOrder {
    __device__ __forceinline__ bool next(int i, Unit& u) const {
        const long L = (long)i * G + c; if (L >= nwg + 104) return false;
        if (L < nwg) return StaticOrder::next(i, u);
        const int idx = (int)(L - nwg), px = idx % 13; u.pm = nM + idx / 13; u.pn = px < 12 ? 8 + px : 24; return true;
    }
};
struct EpiNull {
    static constexpr bool PERM = true, AFTER_DRAIN = false;
    float* sink;
    __device__ __forceinline__ void operator()(const f32x4 (&acc)[2][2][4][2], const Unit& u, int wr, int wc, int fr, int fq) const {
        float s = 0.f;
#pragma unroll
        for (int ai = 0; ai < 2; ++ai)
#pragma unroll
            for (int bj = 0; bj < 2; ++bj)
#pragma unroll
                for (int m = 0; m < 4; ++m)
#pragma unroll
                    for (int n = 0; n < 2; ++n) s += acc[ai][bj][m][n][0];
        if (s == 12345.678f) sink[0] = s;
    }
};
struct GroupedOrder : StaticOrder {
    const int* texp; size_t estride;
    __device__ __forceinline__ size_t boff(const Unit& u) const { return (size_t)texp[u.pm] * estride; }
};
}

struct Frame {
    LAS unsigned char* lds;
    volatile LAS unsigned* MISC;
    gu32* ctl;
    int tid, lane, wave, G;
    const float* in[24]; float* out; unsigned char* ws;
};
enum { I_X = 0, I_C, I_CTX, I_CCTX, I_ADAW, I_ADAB, I_NPRE, I_NPOST, I_SWIN, I_SCONVW, I_SCONVB, I_SALOG, I_SDTB, I_SD, I_SNORM, I_SWOUT, I_SCWIN, I_SCCONV, I_SCWOUT, I_FGU, I_FDN, I_ROUTER, I_MGU, I_MDN };

__device__ __forceinline__ void cvt_item(const float* W, int K, int N, bf16* WT, LAS float* scr, int item, int lane, int mode, int dffx) {
    const int nblk = N / 32, kb = item / nblk, nb = item % nblk, k0 = 64 * kb, n0 = 32 * nb;
#pragma unroll 8
    for (int i = 0; i < 32; ++i) { const int kk = 2 * i + (lane >> 5); scr[kk * 33 + (lane & 31)] = W[(size_t)(k0 + kk) * N + n0 + (lane & 31)]; }
    LDS_WAIT(); asm volatile("" ::: "memory");
    const int c = lane & 7;
#pragma unroll
    for (int j = 0; j < 4; ++j) { const int n = (lane >> 3) + 8 * j; const LAS float* s = scr + (8 * c) * 33 + n;
        v4u o; o.x = pk2(s[0 * 33], s[1 * 33]); o.y = pk2(s[2 * 33], s[3 * 33]); o.z = pk2(s[4 * 33], s[5 * 33]); o.w = pk2(s[6 * 33], s[7 * 33]);
        int nd = n0 + n; if (mode) { const int half = nd >= dffx ? 1 : 0, i2 = nd - half * dffx; nd = 256 * (i2 >> 7) + 128 * half + (i2 & 127); }
        *(v4u*)(WT + (size_t)nd * K + k0 + 8 * c) = o; }
    LDS_WAIT(); asm volatile("" ::: "memory");
}
__device__ __forceinline__ void cvt_item8(const float* W, int K, int N, unsigned char* WT, LAS float* scr, int item, int lane, int mode, int dffx, float sc) {
    const int nblk = N / 32, kb = item / nblk, nb = item % nblk, k0 = 64 * kb, n0 = 32 * nb;
#pragma unroll 8
    for (int i = 0; i < 32; ++i) { const int kk = 2 * i + (lane >> 5); scr[kk * 33 + (lane & 31)] = W[(size_t)(k0 + kk) * N + n0 + (lane & 31)]; }
    LDS_WAIT(); asm volatile("" ::: "memory");
    const int c = lane & 7;
#pragma unroll
    for (int j = 0; j < 4; ++j) { const int n = (lane >> 3) + 8 * j; const LAS float* s = scr + (8 * c) * 33 + n;
        v2u o; o.x = pk4_fp8(s[0 * 33] * sc, s[1 * 33] * sc, s[2 * 33] * sc, s[3 * 33] * sc); o.y = pk4_fp8(s[4 * 33] * sc, s[5 * 33] * sc, s[6 * 33] * sc, s[7 * 33] * sc);
        int nd = n0 + n; if (mode) { const int half = nd >= dffx ? 1 : 0, i2 = nd - half * dffx; nd = 256 * (i2 >> 7) + 128 * half + (i2 & 127); }
        *(v2u*)(WT + (size_t)nd * K + k0 + 8 * c) = o; }
    LDS_WAIT(); asm volatile("" ::: "memory");
}
__device__ __forceinline__ void load_row_f32(const float* p, int lane, f32x4 (&v)[4]) {
#pragma unroll
    for (int j = 0; j < 4; ++j) v[j] = *(const f32x4*)(p + 4 * lane + 256 * j);
}
__device__ __forceinline__ void load_row_bf16(const bf16* p, int lane, f32x4 (&v)[4]) {
#pragma unroll
    for (int j = 0; j < 4; ++j) v[j] = unpack4(*(const v2u*)(p + 4 * lane + 256 * j));
}
__device__ __forceinline__ float row_ss(const f32x4 (&v)[4]) {
    float s = 0.f;
#pragma unroll
    for (int j = 0; j < 4; ++j) s += (v[j][0] * v[j][0] + v[j][1] * v[j][1]) + (v[j][2] * v[j][2] + v[j][3] * v[j][3]);
    return wave_sum(s);
}
__device__ __forceinline__ float ss_part(const f32x4 (&v)[4]) {
    float s = 0.f;
#pragma unroll
    for (int j = 0; j < 4; ++j) s += (v[j][0] * v[j][0] + v[j][1] * v[j][1]) + (v[j][2] * v[j][2] + v[j][3] * v[j][3]);
    return s;
}
__device__ __forceinline__ void prenorm_mod(f32x4 (&v)[4], const float* npre, const float* sc, const float* sh, int lane) {
    const float rr = rsqrtf(row_ss(v) * (1.0f / DM) + EPS);
#pragma unroll
    for (int j = 0; j < 4; ++j) { const int col = 4 * lane + 256 * j; const f32x4 w4 = *(const f32x4*)(npre + col), s4 = *(const f32x4*)(sc + col), h4 = *(const f32x4*)(sh + col);
        v[j] = (v[j] * rr * w4) * (s4 + 1.0f) + h4; }
}
__device__ __forceinline__ void store_row_bf16(bf16* p, int lane, const f32x4 (&v)[4]) {
#pragma unroll
    for (int j = 0; j < 4; ++j) *(v2u*)(p + 4 * lane + 256 * j) = pack4(v[j]);
}
__device__ __forceinline__ const float* mod_vec(Frame& F, int layer, int row, int chunk) { return (const float*)(F.ws + WS_MOD) + ((size_t)(layer * 9 + row) * 6144 + chunk * 1024); }


struct CvtDesc { const float* W; void* WT; int K, N, item, mode, dffx, fp8; float sc; };
__device__ __forceinline__ void cvt_load(const CvtDesc& d, int lane, float (&v)[32]) {
    const int nblk = d.N / 32, kb = d.item / nblk, nb = d.item % nblk; const float* p = d.W + (size_t)(64 * kb + (lane >> 5)) * d.N + 32 * nb + (lane & 31);
#pragma unroll
    for (int i = 0; i < 32; ++i) v[i] = __builtin_nontemporal_load(p + (size_t)(2 * i) * d.N);
}
__device__ __forceinline__ void cvt_finish(const CvtDesc& d, LAS float* scr, int lane, const float (&v)[32]) {
    const int nblk = d.N / 32, kb = d.item / nblk, nb = d.item % nblk, k0 = 64 * kb, n0 = 32 * nb;
#pragma unroll
    for (int i = 0; i < 32; ++i) scr[(2 * i + (lane >> 5)) * 33 + (lane & 31)] = v[i];
    LDS_WAIT(); asm volatile("" ::: "memory");
    const int c = lane & 7;
#pragma unroll
    for (int j = 0; j < 4; ++j) { const int n = (lane >> 3) + 8 * j; const LAS float* s = scr + (8 * c) * 33 + n;
        int nd = n0 + n; if (d.mode == 1) { const int half = nd >= d.dffx ? 1 : 0, i2 = nd - half * d.dffx; nd = 256 * (i2 >> 7) + 128 * half + (i2 & 127); }
        else if (d.mode == 2) { if (nd < 1024) nd += 2048; else { const int q = nd - 1024, half = q >> 10, i2 = q & 1023; nd = 256 * (i2 >> 7) + 128 * half + (i2 & 127); } }
        if (d.fp8) { const float sc = d.sc; v2u o; o.x = pk4_fp8(s[0 * 33] * sc, s[1 * 33] * sc, s[2 * 33] * sc, s[3 * 33] * sc); o.y = pk4_fp8(s[4 * 33] * sc, s[5 * 33] * sc, s[6 * 33] * sc, s[7 * 33] * sc);
            *(v2u*)((unsigned char*)d.WT + (size_t)nd * d.K + k0 + 8 * c) = o; }
        else { v4u o; o.x = pk2(s[0 * 33], s[1 * 33]); o.y = pk2(s[2 * 33], s[3 * 33]); o.z = pk2(s[4 * 33], s[5 * 33]); o.w = pk2(s[6 * 33], s[7 * 33]);
            *(v4u*)((bf16*)d.WT + (size_t)nd * d.K + k0 + 8 * c) = o; } }
    LDS_WAIT(); asm volatile("" ::: "memory");
}
template <class Dec> __device__ __forceinline__ void cvt_stream(const Dec& dec, int total, int first, int stride, LAS float* scr, int lane) {
    int it = first; if (it >= total) return;
    float v[32]; dec(it, true, scr, lane, v);
    for (;;) {
        const int itn = it + stride; const bool hn = itn < total; float vn[32];
        if (hn) dec(itn, true, scr, lane, vn);
        dec(it, false, scr, lane, v);
        if (!hn) break;
        it = itn;
#pragma unroll
        for (int i = 0; i < 32; ++i) v[i] = vn[i];
    }
}
__device__ __forceinline__ void cvt_do(const CvtDesc& d, bool load, LAS float* scr, int lane, float (&v)[32]) { if (load) cvt_load(d, lane, v); else cvt_finish(d, scr, lane, v); }
__device__ __forceinline__ void p0_prologue(Frame& F) {
    LAS float* scr = (LAS float*)(F.lds + F.wave * 8448);
    LAS float* SIL = (LAS float*)(F.lds + 69632);
    LAS float* RED = (LAS float*)(F.lds + 69632 + 36864);
    if ((int)blockIdx.x < 192) {
        for (int idx = F.tid; idx < 9 * 1024; idx += NWAVES * 64) { const int r = idx >> 10, k = idx & 1023; const float cv = r < 8 ? F.in[I_C][r * 1024 + k] : F.in[I_CCTX][k]; SIL[idx] = silu_f(cv); }
        __syncthreads();
        for (int t = blockIdx.x; t < 192; t += F.G) {
            const int i = t / 96, col0 = 64 * (t % 96);
            const float* wp = F.in[I_ADAW] + ((size_t)i * 1024 + F.wave * 128) * 6144 + col0 + F.lane;
            float acc[9];
#pragma unroll
            for (int r = 0; r < 9; ++r) acc[r] = 0.f;
            for (int k8 = 0; k8 < 128; k8 += 32) {
                float wv[32];
#pragma unroll
                for (int q = 0; q < 32; ++q) wv[q] = __builtin_nontemporal_load(wp + (size_t)(k8 + q) * 6144);
#pragma unroll
                for (int q = 0; q < 32; ++q)
#pragma unroll
                    for (int r = 0; r < 9; ++r) acc[r] += SIL[r * 1024 + F.wave * 128 + k8 + q] * wv[q];
            }
#pragma unroll
            for (int r = 0; r < 9; ++r) RED[(F.wave * 9 + r) * 64 + F.lane] = acc[r];
            __syncthreads();
            for (int idx = F.tid; idx < 576; idx += NWAVES * 64) { const int r = idx >> 6, ln = idx & 63; float s = 0.f;
#pragma unroll
                for (int w = 0; w < 8; ++w) s += RED[(w * 9 + r) * 64 + ln];
                ((float*)(F.ws + WS_MOD))[(size_t)(i * 9 + r) * 6144 + col0 + ln] = s + F.in[I_ADAB][i * 6144 + col0 + ln]; }
            __syncthreads();
        }
    }
    const int gw = blockIdx.x * NWAVES + F.wave, NGW = F.G * NWAVES;
    constexpr int I0 = 16 * 194, I1 = 32 * 32, I2 = 16 * 176, I3 = 44 * 32, I4 = 16 * 96, I5 = 16 * 32;
    { const float* w0 = F.in[I_SWIN]; const float* w1 = F.in[I_SWOUT]; const float* w2 = F.in[I_FGU]; const float* w3 = F.in[I_FDN]; const float* w4 = F.in[I_SCWIN]; const float* w5 = F.in[I_SCWOUT]; unsigned char* ws = F.ws;
      auto dec = [w0, w1, w2, w3, w4, w5, ws](int it, bool load, LAS float* scr_, int lane_, float (&v)[32]) { CvtDesc d; d.mode = 0; d.dffx = 0; d.fp8 = 0; d.sc = 1.f; int r = it;
          if (r < I0) { d.W = w0; d.WT = ws + WS_WIN; d.K = 1024; d.N = DINP; d.item = r; cvt_do(d, load, scr_, lane_, v); return; } r -= I0;
          if (r < I1) { d.W = w1; d.WT = ws + WS_WOUT; d.K = 2048; d.N = 1024; d.item = r; cvt_do(d, load, scr_, lane_, v); return; } r -= I1;
          if (r < I2) { d.W = w2; d.WT = ws + WS_WGU; d.K = 1024; d.N = 2 * DFF; d.item = r; d.mode = 1; d.dffx = DFF; d.fp8 = FFN_FP8; d.sc = FFN_FP8 ? WGU_SCALE : 1.f; cvt_do(d, load, scr_, lane_, v); return; } r -= I2;
          if (r < I3) { d.W = w3; d.WT = ws + WS_WDN; d.K = DFF; d.N = 1024; d.item = r; d.fp8 = FFN_FP8; d.sc = FFN_FP8 ? WDN_SCALE : 1.f; cvt_do(d, load, scr_, lane_, v); return; } r -= I3;
          if (r < I4) { d.W = w4; d.WT = ws + WS_WSCI; d.K = 1024; d.N = 3072; d.item = r; d.mode = 2; cvt_do(d, load, scr_, lane_, v); return; } r -= I4;
          d.W = w5; d.WT = ws + WS_WSCO; d.K = 1024; d.N = 1024; d.item = r; cvt_do(d, load, scr_, lane_, v); };
      cvt_stream(dec, I0 + I1 + I2 + I3 + I4 + I5, gw, NGW, scr, F.lane); }
    { v4u* zp = (v4u*)((bf16*)(F.ws + WS_WIN) + (size_t)DINP * 1024); const int n16 = (DINP_PAD - DINP) * 1024 / 8;
      for (int i = blockIdx.x * (NWAVES * 64) + F.tid; i < n16; i += F.G * NWAVES * 64) zp[i] = (v4u){0u, 0u, 0u, 0u}; }
}
__device__ __forceinline__ void p1_prenorm(Frame& F) {
    const int gw = blockIdx.x * NWAVES + F.wave, NGW = F.G * NWAVES;
    bf16* H = (bf16*)(F.ws + WS_H);
    for (int r = gw; r < MALL; r += NGW) {
        const float* src = r < MLAT ? F.in[I_X] + (size_t)r * DM : F.in[I_CTX] + (size_t)(r - MLAT) * DM; const int mr = r < MLAT ? (r >> 12) : 8;
        f32x4 v[4]; load_row_f32(src, F.lane, v);
        prenorm_mod(v, F.in[I_NPRE], mod_vec(F, 0, mr, 1), mod_vec(F, 0, mr, 0), F.lane);
        store_row_bf16(H + (size_t)r * DM, F.lane, v);
    }
}
template <bool NEXT, bool H8OUT = false>
__device__ __forceinline__ void resnorm_phase(Frame& F, const float* xin, int layer, int gchunk, const float* npost, const float* npre, int nlayer, int scchunk, int shchunk) {
    const int gw = blockIdx.x * NWAVES + F.wave, NGW = F.G * NWAVES, rstep = 2 * NGW;
    const int r_beg = 2 * gw, r_end = MLAT;
    if (r_beg >= r_end) return;
    const bf16* Y = (const bf16*)(F.ws + WS_Y); bf16* H = (bf16*)(F.ws + WS_H);
    const int c0 = 4 * F.lane;
    v2u yq[2][4]; f32x4 xq[2][4];
#define RN_LOAD(rr_, s_) do { if ((rr_) < r_end) { _Pragma("unroll") for (int j = 0; j < 4; ++j) { yq[s_][j] = *(const v2u*)(Y + (size_t)(rr_) * DM + c0 + 256 * j); xq[s_][j] = *(const f32x4*)(xin + (size_t)(rr_) * DM + c0 + 256 * j); } } } while (0)
    RN_LOAD(r_beg, 0); RN_LOAD(r_beg + 1, 1);
    for (int r = r_beg; r < r_end; r += rstep) {
        const bool two = (r + 1) < r_end;
        f32x4 y0[4], y1[4], x0[4], x1[4];
#pragma unroll
        for (int j = 0; j < 4; ++j) { y0[j] = unpack4(yq[0][j]); y1[j] = unpack4(yq[1][j]); x0[j] = xq[0][j]; x1[j] = xq[1][j]; }
        RN_LOAD(r + rstep, 0); RN_LOAD(r + rstep + 1, 1);
        const int b = r >> 12; const float* g_ = mod_vec(F, layer, b, gchunk);
        float s0 = ss_part(y0), s1 = ss_part(y1); wave_sum2(s0, s1);
        const float q0 = rsqrtf(s0 * (1.0f / DM) + EPS), q1 = rsqrtf(s1 * (1.0f / DM) + EPS);
#pragma unroll
        for (int j = 0; j < 4; ++j) { const f32x4 gt = *(const f32x4*)(g_ + c0 + 256 * j), np = *(const f32x4*)(npost + c0 + 256 * j);
            x0[j] = x0[j] + gt * ((y0[j] * q0) * np); x1[j] = x1[j] + gt * ((y1[j] * q1) * np);
            *(f32x4*)(F.out + (size_t)r * DM + c0 + 256 * j) = x0[j]; if (two) *(f32x4*)(F.out + (size_t)(r + 1) * DM + c0 + 256 * j) = x1[j]; }
        if (NEXT) {
            const float* s_ = mod_vec(F, nlayer, b, scchunk); const float* h_ = mod_vec(F, nlayer, b, shchunk);
            float t0 = ss_part(x0), t1 = ss_part(x1); wave_sum2(t0, t1);
            const float p0 = rsqrtf(t0 * (1.0f / DM) + EPS), p1 = rsqrtf(t1 * (1.0f / DM) + EPS);
#pragma unroll
            for (int j = 0; j < 4; ++j) { const f32x4 npr = *(const f32x4*)(npre + c0 + 256 * j), sc = *(const f32x4*)(s_ + c0 + 256 * j) + 1.0f, sh = *(const f32x4*)(h_ + c0 + 256 * j);
                x0[j] = (x0[j] * p0 * npr) * sc + sh; x1[j] = (x1[j] * p1 * npr) * sc + sh; }
            if (H8OUT) {
#pragma unroll
                for (int j = 0; j < 4; ++j) { *(unsigned*)((unsigned char*)H + (size_t)r * DM + c0 + 256 * j) = pk4_fp8(x0[j][0], x0[j][1], x0[j][2], x0[j][3]);
                    if (two) *(unsigned*)((unsigned char*)H + (size_t)(r + 1) * DM + c0 + 256 * j) = pk4_fp8(x1[j][0], x1[j][1], x1[j][2], x1[j][3]); } }
            else { store_row_bf16(H + (size_t)r * DM, F.lane, x0); if (two) store_row_bf16(H + (size_t)(r + 1) * DM, F.lane, x1); }
        }
    }
#undef RN_LOAD
}

__device__ __forceinline__ int ssd_sidx(int b, int cs, int g) { return (b * 34 + cs) * 8 + g; }
__device__ __forceinline__ void dt_scan(const float* DTR, int r0, int dcol, float bias, float A, int lane, float (&dt)[2], float (&dA)[2], float (&inc)[2], float& total) {
#pragma unroll
    for (int h = 0; h < 2; ++h) { const float x = DTR[(size_t)dcol * MALL + (r0 + lane + 64 * h)] + bias; dt[h] = x > 20.f ? x : log1pf(__expf(x)); dA[h] = dt[h] * A; }
    float s0 = dA[0], s1 = dA[1];
#pragma unroll
    for (int o = 1; o < 64; o <<= 1) { const float t0 = __shfl_up(s0, o), t1 = __shfl_up(s1, o); if (lane >= o) { s0 += t0; s1 += t1; } }
    const float tot0 = __shfl(s0, 63); s1 += tot0; inc[0] = s0; inc[1] = s1; total = __shfl(s1, 63);
}
__device__ __forceinline__ void ssd_phase_a(Frame& F, const int dry) {
    LAS unsigned char* XI = F.lds; LAS unsigned char* BI = F.lds + XI_BYTES; LAS float* WS = (LAS float*)(F.lds + SCAL_OFF);
    const int lane = F.lane, w = F.wave, gq = lane >> 4, q4 = (lane & 15) >> 2, p4 = lane & 3, l15 = lane & 15;
    const LAS unsigned char* trXr = XI + (8 * gq + q4) * PXB; const int trXc = 8 * p4 + 128 * (gq & 1); const LAS unsigned char* trB = BI + (8 * gq + q4) * PBB + 8 * p4;
    bf16* XBC = (bf16*)(F.ws + WS_XBC); const float* DTR = (const float*)(F.ws + WS_DT); bf16* S = (bf16*)(F.ws + WS_S); float* CD = (float*)(F.ws + WS_CD);
    for (int u = blockIdx.x; u < NUNIT; u += F.G) {
        int b, cs, g; bool isctx;
        if (u < NUNIT_LAT) { b = u >> 8; cs = (u >> 3) & 31; g = u & 7; isctx = false; } else { const int v = u - NUNIT_LAT; b = v >> 4; cs = 32 + ((v >> 3) & 1); g = v & 7; isctx = true; }
        const int r0 = isctx ? MLAT + b * CTXL + (cs - 32) * 128 : b * SEQ + cs * 128, sidx = ssd_sidx(b, cs, g);
        const int col = lane < 32 ? g * 256 + 8 * lane : (lane < 48 ? 2048 + g * 128 + 8 * (lane - 32) : 3072 + g * 128 + 8 * (lane - 48));
        const int l0 = 16 * w; int lo, hi; if (isctx) { lo = -(cs - 32) * 128; hi = lo + 255; } else { lo = l0 & ~63; hi = lo + 63; }
        v4u raw[20];
#pragma unroll
        for (int i = 0; i < 20; ++i) { const int lp = l0 - 2 + i; raw[i] = (lp >= lo && lp <= hi) ? *(const v4u*)(XBC + (long)(r0 + lp) * CONVD + col) : (v4u){0u, 0u, 0u, 0u}; }
        f32x2n wt[5][4], bs[4];
#pragma unroll
        for (int t = 0; t < 5; ++t) { const f32x4 a = *(const f32x4*)(F.in[I_SCONVW] + t * CONVD + col), c4 = *(const f32x4*)(F.in[I_SCONVW] + t * CONVD + col + 4);
            wt[t][0] = (f32x2n){a[0], a[1]}; wt[t][1] = (f32x2n){a[2], a[3]}; wt[t][2] = (f32x2n){c4[0], c4[1]}; wt[t][3] = (f32x2n){c4[2], c4[3]}; }
        { const f32x4 a = *(const f32x4*)(F.in[I_SCONVB] + col), c4 = *(const f32x4*)(F.in[I_SCONVB] + col + 4);
          bs[0] = (f32x2n){a[0], a[1]}; bs[1] = (f32x2n){a[2], a[3]}; bs[2] = (f32x2n){c4[0], c4[1]}; bs[3] = (f32x2n){c4[2], c4[3]}; }
        float ws_v[2], cd_v;
        { const int d = w >> 2, hh = g * 4 + (w & 3); float dt[2], dA[2], inc[2], total;
          dt_scan(DTR, r0, d * 32 + hh, F.in[I_SDTB][d * 32 + hh], -__expf(F.in[I_SALOG][d * 32 + hh]), lane, dt, dA, inc, total);
#pragma unroll
          for (int h = 0; h < 2; ++h) ws_v[h] = dt[h] * (d == 0 ? __expf(total - inc[h]) : __expf(inc[h] - dA[h]));
          cd_v = __expf(total); }
        VM_WAIT(); LDS_BARRIER();
        f32x2n f[5][4];
#define UNPK_ROW(dst, rw) do { dst[0] = (f32x2n){bflo(rw.x), bfhi(rw.x)}; dst[1] = (f32x2n){bflo(rw.y), bfhi(rw.y)}; dst[2] = (f32x2n){bflo(rw.z), bfhi(rw.z)}; dst[3] = (f32x2n){bflo(rw.w), bfhi(rw.w)}; } while (0)
#pragma unroll
        for (int i = 0; i < 4; ++i) UNPK_ROW(f[i], raw[i]);
#pragma unroll
        for (int i = 0; i < 16; ++i) {
            UNPK_ROW(f[(i + 4) % 5], raw[i + 4]);
            unsigned ow[4];
#pragma unroll
            for (int e = 0; e < 4; ++e) { f32x2n a = bs[e];
#pragma unroll
                for (int t = 0; t < 5; ++t) a = wt[t][e] * f[(i + t) % 5][e] + a;
                ow[e] = pk2(silu_f(a.x), silu_f(a.y)); }
            const v4u ov = {ow[0], ow[1], ow[2], ow[3]};
            const int l = l0 + i;
            if (lane < 32) *(LAS v4u*)(XI + XOFF(l, 16 * lane)) = ov; else if (lane < 48) *(LAS v4u*)(BI + l * PBB + 16 * (lane - 32)) = ov;
            if (!isctx && !dry) *(v4u*)(XBC + (size_t)(r0 + l) * CONVD + col) = ov;
        }
#undef UNPK_ROW
#pragma unroll
        for (int h = 0; h < 2; ++h) WS[w * 128 + lane + 64 * h] = ws_v[h];
        if (lane == 0) CD[sidx * 8 + w] = cd_v;
        LDS_BARRIER();
        float btf[4][8];
#pragma unroll
        for (int ks = 0; ks < 4; ++ks) { const bf16x8 r8 = tr_pair(trB + (32 * ks) * PBB + 32 * w, trB + (32 * ks + 4) * PBB + 32 * w);
#pragma unroll
            for (int i = 0; i < 8; ++i) btf[ks][i] = bf1((bf16)r8[i]); }
#pragma unroll 1
        for (int j = 0; j < (dry == 2 ? 0 : 4); ++j) {
            bf16x8 as_[2][4];
#pragma unroll
            for (int d = 0; d < 2; ++d) {
                const int combo = d * 4 + j;
#pragma unroll
                for (int ks = 0; ks < 4; ++ks) { const f32x4 w0 = *(const LAS f32x4*)(WS + combo * 128 + 32 * ks + 8 * gq), w1 = *(const LAS f32x4*)(WS + combo * 128 + 32 * ks + 8 * gq + 4);
                    bf16x8 o8;
                    const unsigned u0 = pk2(btf[ks][0] * w0[0], btf[ks][1] * w0[1]), u1 = pk2(btf[ks][2] * w0[2], btf[ks][3] * w0[3]);
                    const unsigned u2 = pk2(btf[ks][4] * w1[0], btf[ks][5] * w1[1]), u3 = pk2(btf[ks][6] * w1[2], btf[ks][7] * w1[3]);
                    o8[0] = (short)(u0 & 0xffff); o8[1] = (short)(u0 >> 16); o8[2] = (short)(u1 & 0xffff); o8[3] = (short)(u1 >> 16); o8[4] = (short)(u2 & 0xffff); o8[5] = (short)(u2 >> 16); o8[6] = (short)(u3 & 0xffff); o8[7] = (short)(u3 >> 16);
                    as_[d][ks] = o8; }
            }
            const LAS unsigned char* xb[4];
#pragma unroll
            for (int pt = 0; pt < 4; ++pt) xb[pt] = trXr + (((j * 64 + pt * 16) * 2 + trXc) & 511);
#pragma unroll
            for (int pt = 0; pt < 4; ++pt) {
                bf16x8 xf[4];
#pragma unroll
                for (int ks = 0; ks < 4; ++ks) xf[ks] = tr_pair(xb[pt] + (32 * ks) * PXB, xb[pt] + (32 * ks + 4) * PXB);
#pragma unroll
                for (int d = 0; d < 2; ++d) { const int combo = d * 4 + j; f32x4 acc = {0.f, 0.f, 0.f, 0.f};
#pragma unroll
                    for (int ks = 0; ks < 4; ++ks) acc = MFMA16(as_[d][ks], xf[ks], acc);
                    *(v2u*)(S + ((size_t)(sidx * 8 + combo) * 64 + pt * 16 + l15) * 128 + 16 * w + 4 * gq) = pack4(acc); }
            }
        }
        LDS_BARRIER();
    }
}
__device__ __forceinline__ void ssd_phase_b(Frame& F) {
    bf16* S = (bf16*)(F.ws + WS_S); const float* CD = (const float*)(F.ws + WS_CD);
    const int NT = F.G * NWAVES * 64;
    for (int q = blockIdx.x * (NWAVES * 64) + F.tid; q < 512 * 1024; q += NT) {
        const int e8 = q & 1023, seq = q >> 10, combo = seq & 7, g = (seq >> 3) & 7, b = seq >> 6, d = combo >> 2;
        float h[8];
#pragma unroll
        for (int e = 0; e < 8; ++e) h[e] = 0.f;
#pragma unroll
        for (int k = 0; k < 2; ++k) { const int cs = d == 0 ? 32 + k : 33 - k, si = ssd_sidx(b, cs, g) * 8 + combo; const float dec = CD[si]; const v4u t = *(const v4u*)(S + (size_t)si * 8192 + e8 * 8);
            h[0] = dec * h[0] + bflo(t.x); h[1] = dec * h[1] + bfhi(t.x); h[2] = dec * h[2] + bflo(t.y); h[3] = dec * h[3] + bfhi(t.y); h[4] = dec * h[4] + bflo(t.z); h[5] = dec * h[5] + bfhi(t.z); h[6] = dec * h[6] + bflo(t.w); h[7] = dec * h[7] + bfhi(t.w); }
        for (int c0 = 0; c0 < 32; c0 += 8) {
            v4u t[8]; float dc[8];
#pragma unroll
            for (int k = 0; k < 8; ++k) { const int cs = d == 0 ? c0 + k : 31 - (c0 + k), si = ssd_sidx(b, cs, g) * 8 + combo; dc[k] = CD[si]; t[k] = *(const v4u*)(S + (size_t)si * 8192 + e8 * 8); }
#pragma unroll
            for (int k = 0; k < 8; ++k) { const int cs = d == 0 ? c0 + k : 31 - (c0 + k), si = ssd_sidx(b, cs, g) * 8 + combo;
                v4u o; o.x = pk2(h[0], h[1]); o.y = pk2(h[2], h[3]); o.z = pk2(h[4], h[5]); o.w = pk2(h[6], h[7]);
                *(v4u*)(S + (size_t)si * 8192 + e8 * 8) = o;
                const float dec = dc[k]; const v4u tt = t[k];
                h[0] = dec * h[0] + bflo(tt.x); h[1] = dec * h[1] + bfhi(tt.x); h[2] = dec * h[2] + bflo(tt.y); h[3] = dec * h[3] + bfhi(tt.y); h[4] = dec * h[4] + bflo(tt.z); h[5] = dec * h[5] + bfhi(tt.z); h[6] = dec * h[6] + bflo(tt.w); h[7] = dec * h[7] + bfhi(tt.w); }
        }
    }
}
__device__ __forceinline__ void ssd_phase_c(Frame& F, const int dry) {
    LAS unsigned char* XI = F.lds; LAS unsigned char* BI = F.lds + XI_BYTES; LAS unsigned char* MWw = F.lds + XI_BYTES + BI_BYTES + F.wave * (16 * PMB);
    LAS float* DTS = (LAS float*)(F.lds + SCAL_OFF); LAS float* INC = DTS + 1024; LAS float* EXC = DTS + 2048; LAS float* BPw = (LAS float*)(F.lds + BPW_OFF) + F.wave * 256;
    const int tid = F.tid, lane = F.lane, w = F.wave, gq = lane >> 4, q4 = (lane & 15) >> 2, p4 = lane & 3, l15 = lane & 15, lme = 16 * w + l15;
    const LAS unsigned char* trXr = XI + (8 * gq + q4) * PXB; const int trXc = 8 * p4 + 128 * (gq & 1);
    const bf16* XBC = (const bf16*)(F.ws + WS_XBC); const float* DTR = (const float*)(F.ws + WS_DT); const bf16* HIN = (const bf16*)(F.ws + WS_S); bf16* Z = (bf16*)(F.ws + WS_Z);
#ifndef MK_SUB
#define MK_SUB 0
#endif
#ifndef MK_SUBK
#define MK_SUBK 3
#endif
    unsigned long long sub_acc = 0, sub_t0 = 0;
#define SUB_BEG(k_) do { if (MK_SUB == (k_)) sub_t0 = __builtin_amdgcn_s_memrealtime(); } while (0)
#define SUB_END(k_) do { if (MK_SUB == (k_)) sub_acc += __builtin_amdgcn_s_memrealtime() - sub_t0; } while (0)
    for (int u = blockIdx.x; u < NUNIT_LAT; u += F.G) {
        const int b = u >> 8, c = (u >> 3) & 31, g = u & 7, r0 = b * SEQ + c * 128, sidx = ssd_sidx(b, c, g);
        SUB_BEG(1);
        v4u sx[8], sb[4];
#pragma unroll
        for (int k = 0; k < 8; ++k) { const int id = tid + 512 * k, row = id >> 5, ch = id & 31; sx[k] = *(const v4u*)(XBC + (size_t)(r0 + row) * CONVD + g * 256 + 8 * ch); }
#pragma unroll
        for (int k = 0; k < 4; ++k) { const int id = tid + 512 * k, row = id >> 4, ch = id & 15; sb[k] = *(const v4u*)(XBC + (size_t)(r0 + row) * CONVD + 2048 + g * 128 + 8 * ch); }
        bf16x8 cf[4];
#pragma unroll
        for (int ks = 0; ks < 4; ++ks) cf[ks] = *(const bf16x8*)(XBC + (size_t)(r0 + lme) * CONVD + 3072 + g * 128 + 32 * ks + 8 * gq);
        v4u hp[2], hq[2];
        const bf16* hbase = HIN + (size_t)sidx * 8 * 8192;
#pragma unroll
        for (int k = 0; k < 2; ++k) { const int id = tid + 512 * k; hp[k] = *(const v4u*)(hbase + (size_t)(id >> 4) * 128 + 8 * (id & 15)); hq[k] = *(const v4u*)(hbase + 4 * 8192 + (size_t)(id >> 4) * 128 + 8 * (id & 15)); }
        { const int d = w >> 2, hh = g * 4 + (w & 3); float dt[2], dA[2], inc[2], total;
          dt_scan(DTR, r0, d * 32 + hh, F.in[I_SDTB][d * 32 + hh], -__expf(F.in[I_SALOG][d * 32 + hh]), lane, dt, dA, inc, total);
#pragma unroll
          for (int h = 0; h < 2; ++h) { DTS[w * 128 + lane + 64 * h] = dt[h]; INC[w * 128 + lane + 64 * h] = inc[h]; EXC[w * 128 + lane + 64 * h] = inc[h] - dA[h]; } }
#pragma unroll
        for (int k = 0; k < 8; ++k) { const int id = tid + 512 * k, row = id >> 5, ch = id & 31; *(LAS v4u*)(XI + XOFF(row, 16 * ch)) = sx[k]; }
#pragma unroll
        for (int k = 0; k < 4; ++k) { const int id = tid + 512 * k, row = id >> 4, ch = id & 15; *(LAS v4u*)(BI + row * PBB + 16 * ch) = sb[k]; }
        LDS_BARRIER();
        SUB_END(1); SUB_BEG(2);
        f32x4 Gt[8];
#pragma unroll
        for (int st = 0; st < 8; ++st) { f32x4 a = {0.f, 0.f, 0.f, 0.f};
#pragma unroll
            for (int ks = 0; ks < 4; ++ks) a = MFMA16(*(const LAS bf16x8*)(BI + (16 * st + l15) * PBB + (32 * ks + 8 * gq) * 2), cf[ks], a);
            Gt[st] = a; }
        LDS_BARRIER();
        LAS unsigned char* HB0 = BI; LAS unsigned char* HB1 = BI + 64 * PBB;
#pragma unroll
        for (int k = 0; k < 2; ++k) { const int id = tid + 512 * k; *(LAS v4u*)(HB0 + (id >> 4) * PBB + 16 * (id & 15)) = hp[k]; *(LAS v4u*)(HB1 + (id >> 4) * PBB + 16 * (id & 15)) = hq[k]; }
#pragma unroll
        for (int k = 0; k < 2; ++k) { const int id = tid + 512 * k; hp[k] = *(const v4u*)(hbase + 1 * 8192 + (size_t)(id >> 4) * 128 + 8 * (id & 15));
                                      hq[k] = *(const v4u*)(hbase + 5 * 8192 + (size_t)(id >> 4) * 128 + 8 * (id & 15)); }
        LDS_BARRIER();
        SUB_END(2); SUB_BEG(3);
#pragma unroll 1
        for (int j = 0; j < 4; ++j) {
            f32x4 Y[4]; const LAS unsigned char* xb[4];
#pragma unroll
            for (int pt = 0; pt < 4; ++pt) { Y[pt] = (f32x4){0.f, 0.f, 0.f, 0.f}; xb[pt] = trXr + (((j * 64 + pt * 16) * 2 + trXc) & 511); }
            const int kd = w >> 1; float ul2[2], al2[2], er2[2];
#pragma unroll
            for (int d = 0; d < 2; ++d) { const int combo = d * 4 + j; const LAS float* U = (d ? EXC : INC) + combo * 128; const LAS float* DTc = DTS + combo * 128;
                const float tot = INC[combo * 128 + 127], u_l = U[lme];
                const float u_ref = d ? (kd == 3 ? tot : U[32 * kd + 32]) : (kd == 0 ? 0.f : U[32 * kd - 1]);
                ul2[d] = u_l; al2[d] = __expf(d ? (u_ref - u_l) : (u_l - u_ref)); er2[d] = __expf(d ? (tot - u_ref) : u_ref);
#pragma unroll
                for (int h = 0; h < 2; ++h) { const int s = lane + 64 * h; const float ar = d ? (U[s] - u_ref) : (u_ref - U[s]); BPw[d * 128 + s] = __expf(fminf(ar, 0.f)) * DTc[s]; } }
#pragma unroll
            for (int d = 0; d < 2; ++d) {
                const int combo = d * 4 + j;
                LAS unsigned char* HBc = d ? HB1 : HB0;
                const LAS float* U = (d ? EXC : INC) + combo * 128; const LAS float* DTc = DTS + combo * 128;
                const float u_l = ul2[d], a_l = al2[d], e_ref = er2[d];
#pragma unroll
                for (int ks = 0; ks < 4; ++ks) {
                    if (ks == kd) {
#pragma unroll
                        for (int t2 = 0; t2 < 2; ++t2) { const int st = 2 * ks + t2, s0 = 16 * st + 4 * gq; const f32x4 u_s = *(const LAS f32x4*)(U + s0), dt_s = *(const LAS f32x4*)(DTc + s0);
                            f32x4 val;
#pragma unroll
                            for (int e = 0; e < 4; ++e) { const int s = s0 + e; const bool valid = d ? (s >= lme) : (s <= lme); const float arg = d ? (u_s[e] - u_l) : (u_l - u_s[e]);
                                val[e] = valid ? Gt[st][e] * __expf(arg) * dt_s[e] : 0.f; }
                            *(LAS v2u*)(MWw + l15 * PMB + s0 * 2) = pack4(val); }
                    } else if (d ? (ks > kd) : (ks < kd)) {
#pragma unroll
                        for (int t2 = 0; t2 < 2; ++t2) { const int st = 2 * ks + t2, s0 = 16 * st + 4 * gq; const f32x4 bp = *(const LAS f32x4*)(BPw + d * 128 + s0);
                            *(LAS v2u*)(MWw + l15 * PMB + s0 * 2) = pack4(Gt[st] * bp); }
                    }
                }
                f32x4 Yp[4];
#pragma unroll
                for (int pt = 0; pt < 4; ++pt) { f32x4 a = {0.f, 0.f, 0.f, 0.f};
#pragma unroll
                    for (int ks = 0; ks < 4; ++ks) a = MFMA16(*(const LAS bf16x8*)(HBc + (16 * pt + l15) * PBB + (32 * ks + 8 * gq) * 2), cf[ks], a);
                    Yp[pt] = a * e_ref; }
#pragma unroll
                for (int ks = 0; ks < 4; ++ks) if (d ? (ks > kd) : (ks < kd)) {
                    const bf16x8 mb = *(const LAS bf16x8*)(MWw + l15 * PMB + (32 * ks + 8 * gq) * 2);
#pragma unroll
                    for (int pt = 0; pt < 4; ++pt) { const bf16x8 xa = tr_pair(xb[pt] + (32 * ks) * PXB, xb[pt] + (32 * ks + 4) * PXB);
                        Yp[pt] = MFMA16(xa, mb, Yp[pt]); }
                }
#pragma unroll
                for (int pt = 0; pt < 4; ++pt) Y[pt] = Y[pt] + Yp[pt] * a_l;
#pragma unroll
                for (int ks = 0; ks < 4; ++ks) if (ks == kd) {
                    const bf16x8 mb = *(const LAS bf16x8*)(MWw + l15 * PMB + (32 * ks + 8 * gq) * 2);
#pragma unroll
                    for (int pt = 0; pt < 4; ++pt) { const bf16x8 xa = tr_pair(xb[pt] + (32 * ks) * PXB, xb[pt] + (32 * ks + 4) * PXB);
                        Y[pt] = MFMA16(xa, mb, Y[pt]); }
                }
            }
            LDS_BARRIER();
            const float dsk = F.in[I_SD][g * 4 + j];
#pragma unroll
            for (int pt = 0; pt < 4; ++pt) { const int ch = j * 64 + pt * 16 + 4 * gq;
                const f32x4 xv = unpack4(*(const LAS v2u*)(XI + XOFF(lme, ch * 2)));
                *(LAS v2u*)(XI + XOFF(lme, ch * 2)) = pack4(Y[pt] + xv * dsk); }
            if (j < 3) {
#pragma unroll
                for (int k = 0; k < 2; ++k) { const int id = tid + 512 * k; *(LAS v4u*)(HB0 + (id >> 4) * PBB + 16 * (id & 15)) = hp[k]; *(LAS v4u*)(HB1 + (id >> 4) * PBB + 16 * (id & 15)) = hq[k]; }
                if (j < 2) {
#pragma unroll
                    for (int k = 0; k < 2; ++k) { const int id = tid + 512 * k; hp[k] = *(const v4u*)(hbase + (size_t)(j + 2) * 8192 + (size_t)(id >> 4) * 128 + 8 * (id & 15));
                                                  hq[k] = *(const v4u*)(hbase + (size_t)(6 + j) * 8192 + (size_t)(id >> 4) * 128 + 8 * (id & 15)); } }
                LDS_BARRIER();
            }
        }
        SUB_END(3); SUB_BEG(4);
        { const int chunk = tid & 31; const f32x4 nw0 = *(const f32x4*)(F.in[I_SNORM] + g * 256 + 8 * chunk), nw1 = *(const f32x4*)(F.in[I_SNORM] + g * 256 + 8 * chunk + 4);
          v4u zq[8];
#pragma unroll
          for (int k = 0; k < 8; ++k) zq[k] = *(const v4u*)(Z + (size_t)(r0 + (tid >> 5) + 16 * k) * DIN + g * 256 + 8 * chunk);
          LDS_BARRIER();
#pragma unroll
          for (int k = 0; k < 8; ++k) { const int row = (tid >> 5) + 16 * k; const v4u yv = *(const LAS v4u*)(XI + XOFF(row, 16 * chunk)), zv = zq[k];
              float y[8] = {bflo(yv.x), bfhi(yv.x), bflo(yv.y), bfhi(yv.y), bflo(yv.z), bfhi(yv.z), bflo(yv.w), bfhi(yv.w)};
              const float z[8] = {bflo(zv.x), bfhi(zv.x), bflo(zv.y), bfhi(zv.y), bflo(zv.z), bfhi(zv.z), bflo(zv.w), bfhi(zv.w)};
              float ss = 0.f;
#pragma unroll
              for (int e = 0; e < 8; ++e) { y[e] = y[e] * silu_f(z[e]); ss += y[e] * y[e]; }
#pragma unroll
              for (int o = 1; o < 32; o <<= 1) ss += __shfl_xor(ss, o);
              const float rr = rsqrtf(ss * (1.0f / 256.0f) + EPS);
              v4u ov; ov.x = pk2(y[0] * rr * nw0[0], y[1] * rr * nw0[1]); ov.y = pk2(y[2] * rr * nw0[2], y[3] * rr * nw0[3]); ov.z = pk2(y[4] * rr * nw1[0], y[5] * rr * nw1[1]); ov.w = pk2(y[6] * rr * nw1[2], y[7] * rr * nw1[3]);
              if (!dry) *(v4u*)(Z + (size_t)(r0 + row) * DIN + g * 256 + 8 * chunk) = ov; } }
        LDS_BARRIER();
        SUB_END(4);
    }
    if (MK_SUB) { const unsigned long long t1_ = __builtin_amdgcn_s_memrealtime(), d_ = sub_acc * MK_SUBK; while (__builtin_amdgcn_s_memrealtime() - t1_ < d_) __builtin_amdgcn_s_sleep(8); }
#undef SUB_BEG
#undef SUB_END
}

__device__ __forceinline__ void p12_shortconv(Frame& F) {
    const bf16* P = (const bf16*)(F.ws + WS_SCP); const bf16* GB = P + (size_t)MLAT * 1024; bf16* U = (bf16*)(F.ws + WS_H); const float* cw = F.in[I_SCCONV];
    const int NT = F.G * NWAVES * 64;
    const int id0 = blockIdx.x * (NWAVES * 64) + F.tid, col = 8 * (id0 & 127), rstep = NT >> 7;
    f32x4 w0[3], w1[3];
#pragma unroll
    for (int t = 0; t < 3; ++t) { w0[t] = *(const f32x4*)(cw + t * 1024 + col); w1[t] = *(const f32x4*)(cw + t * 1024 + col + 4); }
    for (int r = id0 >> 7; r < MLAT; r += 2 * rstep) {
        v4u pp[2][3], gb[2];
#pragma unroll
        for (int u = 0; u < 2; ++u) { const int rr = r + u * rstep; const int xpos = rr & 63;
#pragma unroll
            for (int t = 0; t < 3; ++t) { const int xp = xpos + t - 1; const bool ok = (rr < MLAT) && xp >= 0 && xp < 64;
                pp[u][t] = ok ? *(const v4u*)(P + (size_t)(rr + t - 1) * 1024 + col) : (v4u){0u, 0u, 0u, 0u}; }
            gb[u] = (rr < MLAT) ? *(const v4u*)(GB + (size_t)rr * 1024 + col) : (v4u){0u, 0u, 0u, 0u}; }
#pragma unroll
        for (int u = 0; u < 2; ++u) { const int rr = r + u * rstep; if (rr >= MLAT) break;
            float acc[8];
#pragma unroll
            for (int e = 0; e < 8; ++e) acc[e] = 0.f;
#pragma unroll
            for (int t = 0; t < 3; ++t) { const v4u p_ = pp[u][t];
                acc[0] += w0[t][0] * bflo(p_.x); acc[1] += w0[t][1] * bfhi(p_.x); acc[2] += w0[t][2] * bflo(p_.y); acc[3] += w0[t][3] * bfhi(p_.y);
                acc[4] += w1[t][0] * bflo(p_.z); acc[5] += w1[t][1] * bfhi(p_.z); acc[6] += w1[t][2] * bflo(p_.w); acc[7] += w1[t][3] * bfhi(p_.w); }
            const v4u b_ = gb[u];
            v4u o; o.x = pk2(bflo(b_.x) * acc[0], bfhi(b_.x) * acc[1]); o.y = pk2(bflo(b_.y) * acc[2], bfhi(b_.y) * acc[3]); o.z = pk2(bflo(b_.z) * acc[4], bfhi(b_.z) * acc[5]); o.w = pk2(bflo(b_.w) * acc[6], bfhi(b_.w) * acc[7]);
            *(v4u*)(U + (size_t)rr * DM + col) = o; }
    }
}

__device__ __forceinline__ void reduce8(const float (&v)[8], float (&out)[8], int lane) {
    const bool u5 = (lane & 32) != 0, u4 = (lane & 16) != 0, u3 = (lane & 8) != 0;
    float a[4];
#pragma unroll
    for (int k = 0; k < 4; ++k) { const float snd = u5 ? v[k] : v[4 + k], kp = u5 ? v[4 + k] : v[k]; a[k] = kp + __shfl_xor(snd, 32); }
    float c[2];
#pragma unroll
    for (int k = 0; k < 2; ++k) { const float snd = u4 ? a[k] : a[2 + k], kp = u4 ? a[2 + k] : a[k]; c[k] = kp + __shfl_xor(snd, 16); }
    float d; { const float snd = u3 ? c[0] : c[1], kp = u3 ? c[1] : c[0]; d = kp + __shfl_xor(snd, 8); }
    d += __shfl_xor(d, 4); d += __shfl_xor(d, 2); d += __shfl_xor(d, 1);
#pragma unroll
    for (int e = 0; e < 8; ++e) out[e] = __builtin_bit_cast(float, __builtin_amdgcn_readlane(__builtin_bit_cast(int, d), 8 * e));
}
__device__ __forceinline__ void top2_gates(const float (&lg)[8], int& e0, int& e1, float& g0) {
    e0 = 0; float v0 = lg[0];
#pragma unroll
    for (int e = 1; e < 8; ++e) if (lg[e] > v0) { v0 = lg[e]; e0 = e; }
    e1 = -1; float v1 = 0.f;
#pragma unroll
    for (int e = 0; e < 8; ++e) if (e != e0 && (e1 < 0 || lg[e] > v1)) { v1 = lg[e]; e1 = e; }
    g0 = 1.0f / (1.0f + __expf(v1 - v0));
}
__device__ __forceinline__ void p14_resnorm_route(Frame& F) {
    LAS float* RW = (LAS float*)F.lds;
    LAS int* SEL = (LAS int*)(F.lds + 32768);
    const bf16* Y = (const bf16*)(F.ws + WS_Y); unsigned char* H8 = (unsigned char*)(F.ws + WS_H);
    int* SELR = (int*)(F.ws + WS_ROUTE + RT_SELR); float* GATE = (float*)(F.ws + WS_ROUTE + RT_GATE); int* CNT = (int*)(F.ws + WS_ROUTE + RT_CNT);
    for (int i = F.tid; i < 8192; i += NWAVES * 64) RW[(i & 7) * 1024 + (i >> 3)] = F.in[I_ROUTER][i];
    __syncthreads();
    const float* npost = F.in[I_NPOST] + 2 * 1024; const float* npre = F.in[I_NPRE] + 3 * 1024;
    const int c0 = 4 * F.lane;
    for (int vb = blockIdx.x; vb < 256; vb += F.G) {
        f32x4 xq[2][4];
#pragma unroll
        for (int j = 0; j < 4; ++j) { xq[0][j] = *(const f32x4*)(F.out + (size_t)(512 * F.wave + 2 * vb) * DM + c0 + 256 * j); xq[1][j] = *(const f32x4*)(F.out + (size_t)(512 * F.wave + 2 * vb + 1) * DM + c0 + 256 * j); }
        for (int i = 0; i < 8; ++i) {
            const int pr = F.wave + 8 * i, r = 512 * pr + 2 * vb, tl = 2 * pr, b = r >> 12;
            f32x4 y0[4], y1[4], x0[4], x1[4];
#pragma unroll
            for (int j = 0; j < 4; ++j) { y0[j] = unpack4(*(const v2u*)(Y + (size_t)r * DM + c0 + 256 * j)); y1[j] = unpack4(*(const v2u*)(Y + (size_t)(r + 1) * DM + c0 + 256 * j)); x0[j] = xq[0][j]; x1[j] = xq[1][j]; }
            if (i + 1 < 8) {
#pragma unroll
                for (int j = 0; j < 4; ++j) { xq[0][j] = *(const f32x4*)(F.out + (size_t)(r + 4096) * DM + c0 + 256 * j); xq[1][j] = *(const f32x4*)(F.out + (size_t)(r + 4097) * DM + c0 + 256 * j); } }
            const float* g_ = mod_vec(F, 1, b, 2); const float* s_ = mod_vec(F, 1, b, 4); const float* h_ = mod_vec(F, 1, b, 3);
            float s0 = ss_part(y0), s1 = ss_part(y1); wave_sum2(s0, s1);
            const float q0 = rsqrtf(s0 * (1.0f / DM) + EPS), q1 = rsqrtf(s1 * (1.0f / DM) + EPS);
#pragma unroll
            for (int j = 0; j < 4; ++j) { const f32x4 np_ = *(const f32x4*)(npost + c0 + 256 * j), gt_ = *(const f32x4*)(g_ + c0 + 256 * j); x0[j] = x0[j] + gt_ * ((y0[j] * q0) * np_); x1[j] = x1[j] + gt_ * ((y1[j] * q1) * np_);
                *(f32x4*)(F.out + (size_t)r * DM + c0 + 256 * j) = x0[j]; *(f32x4*)(F.out + (size_t)(r + 1) * DM + c0 + 256 * j) = x1[j]; }
            float t0 = ss_part(x0), t1 = ss_part(x1); wave_sum2(t0, t1);
            const float p0 = rsqrtf(t0 * (1.0f / DM) + EPS), p1 = rsqrtf(t1 * (1.0f / DM) + EPS);
#pragma unroll
            for (int j = 0; j < 4; ++j) { const f32x4 npr_ = *(const f32x4*)(npre + c0 + 256 * j), sc_ = *(const f32x4*)(s_ + c0 + 256 * j) + 1.0f, sh_ = *(const f32x4*)(h_ + c0 + 256 * j); x0[j] = (x0[j] * p0 * npr_) * sc_ + sh_; x1[j] = (x1[j] * p1 * npr_) * sc_ + sh_;
                *(unsigned*)(H8 + (size_t)r * DM + c0 + 256 * j) = pk4_fp8(x0[j][0], x0[j][1], x0[j][2], x0[j][3]); *(unsigned*)(H8 + (size_t)(r + 1) * DM + c0 + 256 * j) = pk4_fp8(x1[j][0], x1[j][1], x1[j][2], x1[j][3]); }
            float la[8], lb[8];
#pragma unroll
            for (int e = 0; e < 8; ++e) { la[e] = 0.f; lb[e] = 0.f; }
#pragma unroll
            for (int j = 0; j < 4; ++j)
#pragma unroll
                for (int e = 0; e < 8; ++e) { const f32x4 rw = *(const LAS f32x4*)(RW + e * 1024 + c0 + 256 * j);
                    la[e] += (x0[j][0] * rw[0] + x0[j][1] * rw[1]) + (x0[j][2] * rw[2] + x0[j][3] * rw[3]);
                    lb[e] += (x1[j][0] * rw[0] + x1[j][1] * rw[1]) + (x1[j][2] * rw[2] + x1[j][3] * rw[3]); }
            float ta[8], tb[8]; reduce8(la, ta, F.lane); reduce8(lb, tb, F.lane);
            int ea0, ea1, eb0, eb1; float ga, gb; top2_gates(ta, ea0, ea1, ga); top2_gates(tb, eb0, eb1, gb);
            if (F.lane == 0) { GATE[2 * r] = ga; GATE[2 * r + 1] = 1.0f - ga; SEL[2 * tl] = ea0; SEL[2 * tl + 1] = ea1;
                               GATE[2 * r + 2] = gb; GATE[2 * r + 3] = 1.0f - gb; SEL[2 * tl + 2] = eb0; SEL[2 * tl + 3] = eb1; }
        }
        __syncthreads();
        { const int e = F.wave; const v4u s4 = *(const LAS v4u*)(SEL + 4 * F.lane);
          const int f0 = (int)s4.x == e, f1 = (int)s4.y == e, f2 = (int)s4.z == e, f3 = (int)s4.w == e, cl = f0 + f1 + f2 + f3;
          int inc = cl;
#pragma unroll
          for (int o = 1; o < 64; o <<= 1) { const int t = __shfl_up(inc, o); if (F.lane >= o) inc += t; }
          int rk = inc - cl;
          const int tot = __shfl(inc, 63);
#define P14_PUT(k_, f_) do { if (f_) { const int t_ = 4 * F.lane + (k_), tl_ = t_ >> 1, r_ = 512 * (tl_ >> 1) + 2 * vb + (tl_ & 1); SELR[2 * r_ + (t_ & 1)] = e | (rk << 8); ++rk; } } while (0)
          P14_PUT(0, f0); P14_PUT(1, f1); P14_PUT(2, f2); P14_PUT(3, f3);
#undef P14_PUT
          if (F.lane == 0) CNT[vb * 8 + e] = tot; }
        __syncthreads();
    }
}
__device__ __forceinline__ void p15_permute(Frame& F) {
    LAS int* CNTL = (LAS int*)(F.lds + 69632);
    LAS int* PRE = CNTL + 2048;
    LAS int* TOT = PRE + 2048;
    LAS int* SEG = TOT + 8;
    const int* CNT = (const int*)(F.ws + WS_ROUTE + RT_CNT); const int* SELR = (const int*)(F.ws + WS_ROUTE + RT_SELR);
    int* POS = (int*)(F.ws + WS_ROUTE + RT_POS); int* TEXP = (int*)(F.ws + WS_ROUTE + RT_TEXP);
    const unsigned char* H8 = (const unsigned char*)(F.ws + WS_H); unsigned char* HP = (unsigned char*)(F.ws + WS_HP8);
    for (int i = F.tid; i < 2048; i += NWAVES * 64) CNTL[i] = CNT[i];
    __syncthreads();
    if (F.tid < 8) { int run = 0; for (int v = 0; v < 256; ++v) { PRE[v * 8 + F.tid] = run; run += CNTL[v * 8 + F.tid]; } TOT[F.tid] = run; }
    __syncthreads();
    if (F.tid == 0) { int ss = 0; for (int e = 0; e < 8; ++e) { SEG[e] = ss; ss += (TOT[e] + 255) & ~255; } SEG[8] = ss;
        if (blockIdx.x == 0) { for (int e = 0; e < 8; ++e) for (int t = SEG[e] >> 8; t < (SEG[e + 1] >> 8); ++t) TEXP[t] = e; TEXP[300] = ss >> 8; } }
    __syncthreads();
    for (int vb = blockIdx.x; vb < 256; vb += F.G) {
        for (int i = 0; i < 16; ++i) { const int tl = 16 * F.wave + i, r = 512 * (tl >> 1) + 2 * vb + (tl & 1);
            const v4u a = *(const v4u*)(H8 + (size_t)r * DM + 16 * F.lane);
#pragma unroll
            for (int k = 0; k < 2; ++k) { const int sr = SELR[2 * r + k], e = sr & 255, pos = SEG[e] + PRE[vb * 8 + e] + (sr >> 8);
                *(v4u*)(HP + (size_t)pos * DM + 16 * F.lane) = a;
                if (F.lane == 0) POS[2 * r + k] = pos; } }
    }
    if ((int)blockIdx.x < 8) { const int e = blockIdx.x;
        for (int row = SEG[e] + TOT[e] + F.wave; row < SEG[e + 1]; row += NWAVES) *(v4u*)(HP + (size_t)row * DM + 16 * F.lane) = (v4u){0u, 0u, 0u, 0u}; }
    LAS float* scr = (LAS float*)(F.lds + F.wave * 8448);
    const int gw = blockIdx.x * NWAVES + F.wave, NGW = F.G * NWAVES;
    constexpr int IG = 16 * 224, ID = 56 * 32;
    { const float* mg = F.in[I_MGU]; const float* md = F.in[I_MDN]; unsigned char* ws = F.ws;
      auto dec = [mg, md, ws](int it, bool load, LAS float* scr_, int lane_, float (&v)[32]) { CvtDesc d; d.fp8 = 1; const int e = it / (IG + ID), r = it % (IG + ID);
          if (r < IG) { d.W = mg + (size_t)e * 1024 * 2 * DFFE; d.WT = ws + WS_WMGU + (size_t)e * 2 * DFFE * 1024; d.K = 1024; d.N = 2 * DFFE; d.item = r; d.mode = 1; d.dffx = DFFE; d.sc = WGU_SCALE; cvt_do(d, load, scr_, lane_, v); }
          else { d.W = md + (size_t)e * DFFE * 1024; d.WT = ws + WS_WMDN + (size_t)e * 1024 * DFFE; d.K = DFFE; d.N = 1024; d.item = r - IG; d.mode = 0; d.dffx = 0; d.sc = WDN_SCALE; cvt_do(d, load, scr_, lane_, v); } };
      cvt_stream(dec, 8 * (IG + ID), gw, NGW, scr, F.lane); }
}
__device__ __forceinline__ void p18_final(Frame& F) {
    const int gw = blockIdx.x * NWAVES + F.wave, NGW = F.G * NWAVES;
    const bf16* YP = (const bf16*)(F.ws + WS_YP); const int* POS = (const int*)(F.ws + WS_ROUTE + RT_POS); const float* GATE = (const float*)(F.ws + WS_ROUTE + RT_GATE);
    const float* npost = F.in[I_NPOST] + 3 * 1024;
    for (int r = gw; r < MLAT; r += NGW) {
        const int b = r >> 12, p0 = POS[2 * r], p1 = POS[2 * r + 1]; const float g0 = GATE[2 * r], g1 = GATE[2 * r + 1];
        f32x4 a[4], c[4], x[4]; load_row_bf16(YP + (size_t)p0 * DM, F.lane, a); load_row_bf16(YP + (size_t)p1 * DM, F.lane, c); load_row_f32(F.out + (size_t)r * DM, F.lane, x);
#pragma unroll
        for (int j = 0; j < 4; ++j) a[j] = a[j] * g0 + c[j] * g1;
        const float rr = rsqrtf(row_ss(a) * (1.0f / DM) + EPS); const float* gt = mod_vec(F, 1, b, 5);
#pragma unroll
        for (int j = 0; j < 4; ++j) { const int col = 4 * F.lane + 256 * j; *(f32x4*)(F.out + (size_t)r * DM + col) = x[j] + *(const f32x4*)(gt + col) * ((a[j] * rr) * *(const f32x4*)(npost + col)); }
    }
}

#define XB_TMO      128
#define XB_XCNT(j)  (256  + 64 * (j))
#define XB_XSUB(j)  (1280 + 64 * (j))
#define XB_XGEN(j)  (2304 + 64 * (j))
#define XB_TOP      3328
#define XB_TOPGEN   3392
#define XCD_BAR_WORDS 3456
#define XB_SPIN_CAP (1u << 18)

__device__ __forceinline__ unsigned xb_ld(unsigned* p)              { return __hip_atomic_load(p, __ATOMIC_RELAXED, __HIP_MEMORY_SCOPE_AGENT); }
__device__ __forceinline__ unsigned xb_add(unsigned* p, unsigned v) { return __hip_atomic_fetch_add(p, v, __ATOMIC_RELAXED, __HIP_MEMORY_SCOPE_AGENT); }
__device__ __forceinline__ unsigned xb_xcc_id() { return (unsigned)__builtin_amdgcn_s_getreg((3 << 11) | 20) & 0xFu; }
#define XB_SPIN(cond, bar) do { unsigned _sp = 0; while (cond) { __builtin_amdgcn_s_sleep(1); \
    if ((++_sp & 255u) == 0u) { if (xb_ld(&(bar)[XB_TMO])) break; if (_sp > XB_SPIN_CAP) { atomicAdd(&(bar)[XB_TMO], 1u); break; } } } } while (0)

struct XcdBarrier {
    unsigned* bar; unsigned x;
    volatile LAS unsigned* st;
};

__device__ __forceinline__ XcdBarrier xcd_barrier_post(unsigned* bar, volatile LAS unsigned* st) {
    XcdBarrier b; b.bar = bar; b.x = xb_xcc_id(); b.st = st;
    if (threadIdx.x == 0) (void)xb_add(&bar[XB_XCNT(b.x)], 1u);
    return b;
}
__device__ __forceinline__ void xcd_barrier_complete(unsigned* bar, unsigned x, unsigned& nloc, unsigned& nx) {
    const unsigned G = gridDim.x * gridDim.y * gridDim.z;
    unsigned sum, cnt, mine, sp = 0u;
    for (;;) {
        sum = 0u; cnt = 0u; mine = 0u;
#pragma unroll
        for (unsigned j = 0; j < 16; ++j) { const unsigned c = xb_ld(&bar[XB_XCNT(j)]); sum += c; cnt += (c > 0u) ? 1u : 0u; mine = (j == x) ? c : mine; }
        if (sum == G) break;
        __builtin_amdgcn_s_sleep(1);
        if ((++sp & 255u) == 0u) { if (xb_ld(&bar[XB_TMO])) break; if (sp > XB_SPIN_CAP) { atomicAdd(&bar[XB_TMO], 1u); break; } }
    }
    nloc = mine > 0u ? mine : 1u; nx = cnt > 0u ? cnt : 1u;
}

__device__ __forceinline__ void xcd_barrier(const XcdBarrier& b) {
    asm volatile("s_waitcnt vmcnt(0)" ::: "memory");
    __syncthreads();
    if (threadIdx.x == 0) {
        unsigned* bar = b.bar;
        __builtin_amdgcn_s_waitcnt(0);
        unsigned nloc = b.st[0], nx = b.st[1];
        if (nloc == 0u) { xcd_barrier_complete(bar, b.x, nloc, nx); b.st[0] = nloc; b.st[1] = nx; }
        const unsigned old = xb_add(&bar[XB_XSUB(b.x)], 1u);
        const unsigned gen = old / nloc;
        if (old + 1u == (gen + 1u) * nloc) {
            __builtin_amdgcn_fence(__ATOMIC_RELEASE, "agent");
            asm volatile("s_waitcnt vmcnt(0)" ::: "memory");
            const unsigned og = xb_add(&bar[XB_TOP], 1u);
            const unsigned tg = og / nx;
            if (og + 1u == (tg + 1u) * nx) xb_add(&bar[XB_TOPGEN], 1u);
            else XB_SPIN(xb_ld(&bar[XB_TOPGEN]) == tg, bar);
            __builtin_amdgcn_fence(__ATOMIC_ACQUIRE, "agent");
            xb_add(&bar[XB_XGEN(b.x)], 1u);
            asm volatile("s_waitcnt vmcnt(0)" ::: "memory");
        } else {
            XB_SPIN(xb_ld(&bar[XB_XGEN(b.x)]) == gen, bar);
            __builtin_amdgcn_fence(__ATOMIC_ACQUIRE, "agent");
            asm volatile("s_waitcnt vmcnt(0)" ::: "memory");
        }
    }
    __syncthreads();
}

#ifndef MK_DUMP
#define MK_DUMP 0
#endif
__device__ __forceinline__ void dump_phase(Frame& F) {
    const size_t NT = (size_t)F.G * NWAVES * 64, n = (size_t)MLAT * DM;
    for (size_t i = (size_t)blockIdx.x * (NWAVES * 64) + F.tid; i < n; i += NT) {
        float v = 0.f;
        if (MK_DUMP == 1) { v = bf1(((const bf16*)(F.ws + WS_H))[i]) + (i < (size_t)MCTX * DM ? bf1(((const bf16*)(F.ws + WS_H))[n + i]) : 0.f); }
        if (MK_DUMP == 2) { for (int k = 0; k < 4; ++k) v += bf1(((const bf16*)(F.ws + WS_XBC))[i + k * n]); for (int k = 0; k < 2; ++k) v += bf1(((const bf16*)(F.ws + WS_Z))[i + k * n]); if (i < (size_t)MALL * 64) v += ((const float*)(F.ws + WS_DT))[i]; }
        if (MK_DUMP == 3) { const size_t ns = (size_t)NUNIT * 8 * 8192; for (int k = 0; k < 5; ++k) if (i + k * n < ns) v += bf1(((const bf16*)(F.ws + WS_S))[i + k * n]); for (int k = 0; k < 4; ++k) v += bf1(((const bf16*)(F.ws + WS_XBC))[i + k * n]); if (i < (size_t)NUNIT * 8) v += ((const float*)(F.ws + WS_CD))[i]; }
        if (MK_DUMP == 4) { for (int k = 0; k < 2; ++k) v += bf1(((const bf16*)(F.ws + WS_Z))[i + k * n]); }
        if (MK_DUMP == 5) { v = bf1(((const bf16*)(F.ws + WS_Y))[i]); }
        F.out[i] = v;
    }
}

struct Args { const float* in[24]; float* out; unsigned char* ws; int ph_lo, ph_hi; };
__global__ void __launch_bounds__(NWAVES * 64, 2) fwd_kernel(Args args) {
    extern __shared__ __attribute__((aligned(16))) unsigned char lds[];
    Frame F;
    F.lds = (LAS unsigned char*)lds;
    F.MISC = (volatile LAS unsigned*)(F.lds + MISC_OFF);
    F.tid = threadIdx.x; F.lane = F.tid & 63; F.wave = __builtin_amdgcn_readfirstlane(F.tid >> 6);
    F.G = gridDim.x;
#pragma unroll
    for (int i = 0; i < 24; ++i) F.in[i] = args.in[i];
    F.out = args.out; F.ws = args.ws; F.ctl = (gu32*)(args.ws + WS_CTL);
    for (int u = F.tid; u < (LDS_BYTES - MISC_OFF) / 4; u += NWAVES * 64) ((LAS unsigned*)(F.lds + MISC_OFF))[u] = 0u;
    __syncthreads();
    XcdBarrier bar; bar.bar = (unsigned*)(F.ctl + CW_BAR); bar.x = 0; bar.st = nullptr;
    if (!MK_PER_PHASE) bar = xcd_barrier_post((unsigned*)(F.ctl + CW_BAR), F.MISC + 8);
    const int lo = args.ph_lo, hi = args.ph_hi & 0xff; const int dry = (args.ph_hi >> 8) & 3;
#ifndef MK_PHASE_MASK
#define MK_PHASE_MASK 0x7ffff
#endif
#define IN(k) (((MK_PHASE_MASK >> (k)) & 1) && lo <= (k) && (k) < hi)
#ifndef MK_SPIN_PHASE
#define MK_SPIN_PHASE -1
#endif
#ifndef MK_SPIN_K
#define MK_SPIN_K 3
#endif
    unsigned long long spin_t0 = 0, spin_c0 = 0;
#define SPIN_BEGIN(k) do { if (MK_SPIN_PHASE == (k)) { spin_t0 = __builtin_amdgcn_s_memrealtime(); spin_c0 = __builtin_amdgcn_s_memtime(); } } while (0)
#define SEAM(k) do { if (MK_SPIN_PHASE == (k)) { const unsigned long long c1_ = __builtin_amdgcn_s_memtime(), t1_ = __builtin_amdgcn_s_memrealtime(), d_ = MK_SPIN_K ? (t1_ - spin_t0) * MK_SPIN_K : ((c1_ - spin_c0) >> 4); while (__builtin_amdgcn_s_memrealtime() - t1_ < d_) __builtin_amdgcn_s_sleep(8); } \
        if (!MK_PER_PHASE && IN((k) + 1)) { xcd_barrier(bar); if (MK_SPIN_PHASE == 99) { xcd_barrier(bar); xcd_barrier(bar); } } } while (0)
    bf16* const WS_bH = (bf16*)(F.ws + WS_H); bf16* const WS_bY = (bf16*)(F.ws + WS_Y); bf16* const WS_bZ = (bf16*)(F.ws + WS_Z);

    if (IN(0)) { SPIN_BEGIN(0); p0_prologue(F); SEAM(0); }
    if (IN(1)) { SPIN_BEGIN(1); p1_prenorm(F); SEAM(1); }
    if (IN(2)) { SPIN_BEGIN(2);
        pg8::Gemm g{WS_bH, (const bf16*)(F.ws + WS_WIN), MALL, DINP_PAD, DM}; pg8::InProjOrder S; S.init(MLAT, DINP_PAD, F.G, (int)blockIdx.x);
        pg8::EpiInProj E{WS_bZ, (bf16*)(F.ws + WS_XBC), (float*)(F.ws + WS_DT)};
        pg8::gemm_phase<pg8::EpiInProj, pg8::InProjOrder, true, true>(F.lds, g, S, E);
        SEAM(2);
    }
    if (IN(3)) { SPIN_BEGIN(3); ssd_phase_a(F, dry); SEAM(3); }
    if (IN(4)) { SPIN_BEGIN(4); ssd_phase_b(F); SEAM(4); }
    if (IN(5)) { SPIN_BEGIN(5); ssd_phase_c(F, dry); SEAM(5); }
    if (IN(6)) { SPIN_BEGIN(6);
        pg8::Gemm g{WS_bZ, (const bf16*)(F.ws + WS_WOUT), MLAT, DM, DIN}; pg8::StaticOrder S; S.init(MLAT, DM, F.G, (int)blockIdx.x);
        pg8::EpiBf16<0> E{WS_bY, DM, nullptr, 0, 0, 1.f};
        pg8::gemm_phase<pg8::EpiBf16<0>, pg8::StaticOrder, true, true>(F.lds, g, S, E);
        SEAM(6);
    }
    if (IN(7)) { SPIN_BEGIN(7); resnorm_phase<true, FFN_FP8 != 0>(F, F.in[I_X], 0, 2, F.in[I_NPOST], F.in[I_NPRE] + 1024, 0, 4, 3); SEAM(7); }
    if (IN(8)) { SPIN_BEGIN(8);
        if constexpr (FFN_FP8) {
            pg8::Gemm g{WS_bH, (const bf16*)(F.ws + WS_WGU), MLAT, 2 * DFF, DM / 2}; pg8::StaticOrder S; S.init(MLAT, 2 * DFF, F.G, (int)blockIdx.x);
            pg8::EpiSwiGLU8 E{(unsigned char*)(F.ws + WS_ACT0), DFF, 1.0f / WGU_SCALE};
            pg8::gemm_phase<pg8::EpiSwiGLU8, pg8::StaticOrder, true, true, true>(F.lds, g, S, E);
        } else {
            pg8::Gemm g{WS_bH, (const bf16*)(F.ws + WS_WGU), MLAT, 2 * DFF, DM}; pg8::StaticOrder S; S.init(MLAT, 2 * DFF, F.G, (int)blockIdx.x);
            pg8::EpiSwiGLU E{(bf16*)(F.ws + WS_ACT0), DFF};
            pg8::gemm_phase<pg8::EpiSwiGLU, pg8::StaticOrder, true, true>(F.lds, g, S, E);
        }
        SEAM(8);
    }
    if (IN(9)) { SPIN_BEGIN(9);
        if constexpr (FFN_FP8) {
            pg8::Gemm g{(const bf16*)(F.ws + WS_ACT0), (const bf16*)(F.ws + WS_WDN), MLAT, DM, DFF / 2}; pg8::StaticOrder S; S.init(MLAT, DM, F.G, (int)blockIdx.x);
            pg8::EpiBf16S E{WS_bY, DM, 1.0f / WDN_SCALE};
            pg8::gemm_phase<pg8::EpiBf16S, pg8::StaticOrder, true, true, true>(F.lds, g, S, E);
        } else {
            pg8::Gemm g{(const bf16*)(F.ws + WS_ACT0), (const bf16*)(F.ws + WS_WDN), MLAT, DM, DFF}; pg8::StaticOrder S; S.init(MLAT, DM, F.G, (int)blockIdx.x);
            pg8::EpiBf16<0> E{WS_bY, DM, nullptr, 0, 0, 1.f};
            pg8::gemm_phase<pg8::EpiBf16<0>, pg8::StaticOrder, true, true>(F.lds, g, S, E);
        }
        SEAM(9);
    }
    if (IN(10)) { SPIN_BEGIN(10); resnorm_phase<true>(F, F.out, 0, 5, F.in[I_NPOST] + 1024, F.in[I_NPRE] + 2048, 1, 1, 0); SEAM(10); }
    if (IN(11)) { SPIN_BEGIN(11);
        pg8::Gemm g{WS_bH, (const bf16*)(F.ws + WS_WSCI), MLAT, 3072, DM}; pg8::StaticOrder S; S.init(MLAT, 3072, F.G, (int)blockIdx.x);
        pg8::EpiScIn E{(bf16*)(F.ws + WS_SCP), (bf16*)(F.ws + WS_SCP) + (size_t)MLAT * 1024};
        pg8::gemm_phase<pg8::EpiScIn, pg8::StaticOrder, true, true>(F.lds, g, S, E);
        SEAM(11);
    }
    if (IN(12)) { SPIN_BEGIN(12); p12_shortconv(F); SEAM(12); }
    if (IN(13)) { SPIN_BEGIN(13);
        pg8::Gemm g{WS_bH, (const bf16*)(F.ws + WS_WSCO), MLAT, DM, DM}; pg8::StaticOrder S; S.init(MLAT, DM, F.G, (int)blockIdx.x);
        pg8::EpiBf16<0> E{WS_bY, DM, nullptr, 0, 0, 1.f};
        pg8::gemm_phase<pg8::EpiBf16<0>, pg8::StaticOrder, true, true>(F.lds, g, S, E);
        SEAM(13);
    }
    if (IN(14)) { SPIN_BEGIN(14); p14_resnorm_route(F); SEAM(14); }
    if (IN(15)) { SPIN_BEGIN(15); p15_permute(F); SEAM(15); }
    if (MK_PER_PHASE && dry && lo == 16) {
        const int* texp = (const int*)(F.ws + WS_ROUTE + RT_TEXP); int nt = __builtin_amdgcn_readfirstlane(texp[300]); nt = nt < 0 ? 0 : (nt > MOE_ROWS / 256 ? MOE_ROWS / 256 : nt);
        pg8::Gemm g{(const bf16*)(F.ws + WS_HP8), (const bf16*)(F.ws + WS_WMGU), 256 * nt, 2 * DFFE, DM / 2};
        pg8::GroupedOrder S; S.init(256 * nt, 2 * DFFE, F.G, (int)blockIdx.x); S.texp = texp; S.estride = (size_t)2 * DFFE * DM;
        pg8::EpiNull E{(float*)(F.ws + WS_CD)};
        pg8::gemm_phase<pg8::EpiNull, pg8::GroupedOrder, true, true, true>(F.lds, g, S, E);
        return;
    }
    if (IN(16)) { SPIN_BEGIN(16);
        const int* texp = (const int*)(F.ws + WS_ROUTE + RT_TEXP); int nt = __builtin_amdgcn_readfirstlane(texp[300]); nt = nt < 0 ? 0 : (nt > MOE_ROWS / 256 ? MOE_ROWS / 256 : nt);
        pg8::Gemm g{(const bf16*)(F.ws + WS_HP8), (const bf16*)(F.ws + WS_WMGU), 256 * nt, 2 * DFFE, DM / 2};
        pg8::GroupedOrder S; S.init(256 * nt, 2 * DFFE, F.G, (int)blockIdx.x); S.texp = texp; S.estride = (size_t)2 * DFFE * DM;
        pg8::EpiSwiGLU8 E{(unsigned char*)(F.ws + WS_ACT), DFFE, 1.0f / WGU_SCALE};
        pg8::gemm_phase<pg8::EpiSwiGLU8, pg8::GroupedOrder, true, true, true>(F.lds, g, S, E);
        SEAM(16);
    }
    if (IN(17)) { SPIN_BEGIN(17);
        const int* texp = (const int*)(F.ws + WS_ROUTE + RT_TEXP); int nt = __builtin_amdgcn_readfirstlane(texp[300]); nt = nt < 0 ? 0 : (nt > MOE_ROWS / 256 ? MOE_ROWS / 256 : nt);
        pg8::Gemm g{(const bf16*)(F.ws + WS_ACT), (const bf16*)(F.ws + WS_WMDN), 256 * nt, DM, DFFE / 2};
        pg8::GroupedOrder S; S.init(256 * nt, DM, F.G, (int)blockIdx.x); S.texp = texp; S.estride = (size_t)DM * DFFE;
        pg8::EpiBf16S E{(bf16*)(F.ws + WS_YP), DM, 1.0f / WDN_SCALE};
        pg8::gemm_phase<pg8::EpiBf16S, pg8::GroupedOrder, true, true, true>(F.lds, g, S, E);
        SEAM(17);
    }
    if (IN(18)) { SPIN_BEGIN(18); p18_final(F); SEAM(18); }
#ifndef MK_BENCH
#define MK_BENCH 0
#endif
#if MK_BENCH
    {
        typedef int i32x8b __attribute__((ext_vector_type(8))); typedef int i32x4b __attribute__((ext_vector_type(4)));
        unsigned h = (unsigned)(blockIdx.x * 512 + F.tid) * 2654435761u + 12345u;
        f32x4 bacc[16];
#pragma unroll
        for (int i = 0; i < 16; ++i) bacc[i] = (f32x4){0.f, 0.f, 0.f, 0.f};
#if MK_BENCH == 1
        i32x8b oa[4], ob[4];
#pragma unroll
        for (int i = 0; i < 4; ++i)
#pragma unroll
            for (int j = 0; j < 8; ++j) { h = h * 1664525u + 1013904223u; oa[i][j] = (int)(h & 0xBFBFBFBFu); h = h * 1664525u + 1013904223u; ob[i][j] = (int)(h & 0xBFBFBFBFu); }
#pragma unroll 1
        for (int it = 0; it < MK_BENCH_N; ++it) {
#pragma unroll
            for (int m = 0; m < 4; ++m)
#pragma unroll
                for (int n = 0; n < 4; ++n) asm volatile("v_mfma_f32_16x16x128_f8f6f4 %0, %1, %2, %0" : "+v"(bacc[m * 4 + n]) : "v"(oa[m]), "v"(ob[n]));
        }
#else
        i32x4b oa[8], ob[4];
#pragma unroll
        for (int i = 0; i < 8; ++i)
#pragma unroll
            for (int j = 0; j < 4; ++j) { h = h * 1664525u + 1013904223u; oa[i][j] = (int)(h & 0xBFFFBFFFu); }
#pragma unroll
        for (int i = 0; i < 4; ++i)
#pragma unroll
            for (int j = 0; j < 4; ++j) { h = h * 1664525u + 1013904223u; ob[i][j] = (int)(h & 0xBFFFBFFFu); }
#pragma unroll 1
        for (int it = 0; it < MK_BENCH_N; ++it) {
#pragma unroll
            for (int m = 0; m < 8; ++m)
#pragma unroll
                for (int n = 0; n < 4; ++n) asm volatile("v_mfma_f32_16x16x32_bf16 %0, %1, %2, %0" : "+v"(bacc[(m & 3) * 4 + n]) : "v"(oa[m]), "v"(ob[n]));
        }
#endif
        asm volatile("s_nop 7\n\ts_nop 7\n\ts_nop 7" ::: "memory");
        float bs = 0.f;
#pragma unroll
        for (int i = 0; i < 16; ++i) bs += bacc[i][0] + bacc[i][1] + bacc[i][2] + bacc[i][3];
        if (bs == 123456.789f) ((float*)(F.ws + WS_CD))[F.tid] = bs;
    }
#endif
    if (MK_DUMP && lo <= 19 && 19 < hi) dump_phase(F);
#undef IN
#undef SEAM
}

extern "C" void kernel_launch(void* const* d_in, const int* in_sizes, int n_in, void* d_out, int out_size, void* d_ws, size_t ws_size, hipStream_t stream) {
    static int grid = 0;
    if (grid == 0) {
        if (n_in != 24 || out_size != MLAT * DM || ws_size < WS_NEED) { fprintf(stderr, "kernel_launch: unexpected problem (n_in %d, out %d, ws %zu)\n", n_in, out_size, ws_size); grid = -1; return; }
        int dev = 0, cus = 0, per_cu = 0;
        if (hipGetDevice(&dev) != hipSuccess || hipDeviceGetAttribute(&cus, hipDeviceAttributeMultiprocessorCount, dev) != hipSuccess) { grid = -1; return; }
        if (hipFuncSetAttribute((const void*)fwd_kernel, hipFuncAttributeMaxDynamicSharedMemorySize, LDS_BYTES) != hipSuccess) { fprintf(stderr, "kernel_launch: hipFuncSetAttribute failed\n"); grid = -1; return; }
        if (hipOccupancyMaxActiveBlocksPerMultiprocessor(&per_cu, (const void*)fwd_kernel, NWAVES * 64, LDS_BYTES) != hipSuccess || per_cu < 1) { fprintf(stderr, "kernel_launch: occupancy query reports %d\n", per_cu); }
        (void)hipGetLastError();
        grid = cus;
    }
    if (grid < 0) return;
    if (hipMemsetAsync((char*)d_ws + WS_CTL, 0, CTL_ZERO_BYTES, stream) != hipSuccess) return;
    Args a{};
    for (int i = 0; i < 24; ++i) a.in[i] = (const float*)d_in[i];
    a.out = (float*)d_out; a.ws = (unsigned char*)d_ws;
#if MK_PER_PHASE
#ifndef MK_TWICE_MASK
#define MK_TWICE_MASK 0
#endif
#ifndef MK_DRY_MASK
#define MK_DRY_MASK 0
#endif
#ifndef MK_DRY_LEVEL
#define MK_DRY_LEVEL 1
#endif
    for (int p = 0; p <= MK_LAST_PHASE; ++p) { a.ph_lo = p;
        if ((MK_DRY_MASK >> p) & 1) { a.ph_hi = (p + 1) | (MK_DRY_LEVEL << 8); hipLaunchKernelGGL(fwd_kernel, dim3(grid), dim3(NWAVES * 64), LDS_BYTES, stream, a); }
        a.ph_hi = p + 1; hipLaunchKernelGGL(fwd_kernel, dim3(grid), dim3(NWAVES * 64), LDS_BYTES, stream, a);
        if ((MK_TWICE_MASK >> p) & 1) hipLaunchKernelGGL(fwd_kernel, dim3(grid), dim3(NWAVES * 64), LDS_BYTES, stream, a); }
    if (MK_DUMP) { a.ph_lo = 19; a.ph_hi = 20; hipLaunchKernelGGL(fwd_kernel, dim3(grid), dim3(NWAVES * 64), LDS_BYTES, stream, a); }
#else
    a.ph_lo = 0; a.ph_hi = MK_LAST_PHASE + 1;
    hipLaunchKernelGGL(fwd_kernel, dim3(grid), dim3(NWAVES * 64), LDS_BYTES, stream, a);
#endif
}
```

```cpp
#include <hip/hip_runtime.h>
#include <cstdio>
#include <cstdint>
#define MK_PER_PHASE 0
#define MK_LAST_PHASE 18
#define MK_DUMP 0
#define MK_TWICE_MASK 0
#define MK_DRY_MASK 0
#define MK_DRY_LEVEL 1
#define MK_SPIN_PHASE -1
#define MK_SPIN_K 3
#define MK_SUB 0
#define MK_BENCH 0
#define MK_BENCH_N 300
namespace pg8 {
#define PG8_LAS __attribute__((address_space(3)))
typedef unsigned short bf16_t;
typedef short bf16x8 __attribute__((ext_vector_type(8)));
typedef float f32x4 __attribute__((ext_vector_type(4)));
typedef unsigned u32x4 __attribute__((ext_vector_type(4)));
constexpr int BM = 256, BK = 64, HALF = 128, HTB = HALF * BK * 2  , STAGE_BYTES = 8 * HTB, NXCD = 8, WGM = 4;

__host__ __device__ __forceinline__ int lds_byte(int r, int c) { const int st = (r >> 4) * 2 + (c >> 5), rr = r & 15, cc = c & 31, ob = rr * 64 + cc * 2; return st * 1024 + (ob ^ (((ob >> 9) & 1) << 5)); }
__host__ __device__ __forceinline__ void stage_rc(int b, int& R, int& C) { const int st = b / 1024, sb = b % 1024, swz = sb ^ (((sb >> 9) & 1) << 5); R = (st >> 1) * 16 + swz / 64; C = (st & 1) * 32 + (swz % 64) / 2; }
__host__ __device__ __forceinline__ int perm32(int rho) { const int n = rho >> 4, i = rho & 15; return 8 * (i >> 2) + 4 * n + (i & 3); }

struct Unit { int pm, pn; };
struct Gemm { const bf16_t* A; const bf16_t* Bt; int M, N, K; };

struct StaticOrder {
    int nM, nN, nwg, G, c;
    __host__ __device__ void init(int M, int N, int G_, int c_) { nM = M / BM; nN = N / BM; nwg = nM * nN; G = G_; c = c_; }
    __host__ __device__ bool next(int i, Unit& u) const {
        const long L = (long)i * G + c; if (L >= nwg) return false;
        int wgid = (int)L; { const int q = nwg / NXCD, r = nwg % NXCD, xcd = wgid % NXCD, off = wgid / NXCD; wgid = (xcd < r ? xcd * (q + 1) : r * (q + 1) + (xcd - r) * q) + off; }
        const int nig = WGM * nN, gid = wgid / nig, fm = gid * WGM, gsz = (nM - fm) < WGM ? (nM - fm) : WGM;
        u.pm = fm + ((wgid % nig) % gsz); u.pn = (wgid % nig) / gsz; return true;
    }
    __device__ __forceinline__ void a_ready(const Unit&) const {}
    __device__ __forceinline__ void done(const Unit&) const {}
    __device__ __forceinline__ size_t boff(const Unit&) const { return 0; }
};

typedef float f32x2c __attribute__((ext_vector_type(2)));
typedef __bf16 bf16x2c __attribute__((ext_vector_type(2)));
__device__ __forceinline__ unsigned cvt_pk_bf16(float lo, float hi) { const f32x2c v = {lo, hi}; return __builtin_bit_cast(unsigned, __builtin_convertvector(v, bf16x2c)); }
typedef float f32x2 __attribute__((ext_vector_type(2)));
__device__ __forceinline__ f32x2 gelu_pk(f32x2 v) {
    const f32x2 av = __builtin_elementwise_abs(v), d = av * 0.2316418882f + 1.0f;
    f32x2 t; t.x = __builtin_amdgcn_rcpf(d.x); t.y = __builtin_amdgcn_rcpf(d.y);
    f32x2 q = t * 0.5307027145f + (-0.7265760135f); q = q * t + 0.7107068705f; q = q * t + (-0.142248368f); q = q * t + 0.127414796f; q = q * t;
    const f32x2 s = (v * v) * (-0.72134752044f);
    f32x2 e; e.x = __builtin_amdgcn_exp2f(s.x); e.y = __builtin_amdgcn_exp2f(s.y);
    const f32x2 m = v * (q * e), r = v - m;
    f32x2 o; o.x = v.x < 0.f ? m.x : r.x; o.y = v.y < 0.f ? m.y : r.y; return o;
}

template <int ACT  > struct EpiBf16 {
    static constexpr bool PERM = true, AFTER_DRAIN = false; static_assert(ACT == 0 || ACT == 1, "EpiBf16: ACT is 0 (none) or 1 (gelu_pk)");
    bf16_t* O; int ldc; const float* bias; int split_cols; size_t split_stride; float scale0;
    __device__ __forceinline__ void operator()(const f32x4 (&acc)[2][2][4][2], const Unit& u, int wr, int wc, int fr, int fq) const {
        const int row0 = u.pm * BM + wr * 64 + fr; int colt = u.pn * BM; bf16_t* base = O;
        float sc = 1.f; if (split_cols) { const int t = colt / split_cols; base += (size_t)t * split_stride; colt -= t * split_cols; if (t == 0) sc = scale0; }
        const int col0 = colt + wc * 32 + 8 * fq, bcol0 = u.pn * BM + wc * 32 + 8 * fq;
        f32x4 bv[2][2];
#pragma unroll
        for (int bj = 0; bj < 2; ++bj)
#pragma unroll
            for (int n = 0; n < 2; ++n) bv[bj][n] = bias ? *(const f32x4*)(bias + bcol0 + bj * HALF + 4 * n) : (f32x4){0.f, 0.f, 0.f, 0.f};
#pragma unroll
        for (int ai = 0; ai < 2; ++ai)
#pragma unroll
            for (int m = 0; m < 4; ++m) { bf16_t* rowp = base + (size_t)(row0 + ai * HALF + m * 16) * ldc + col0;
#pragma unroll
                for (int bj = 0; bj < 2; ++bj) { f32x4 v0 = acc[ai][bj][m][0] + bv[bj][0], v1 = acc[ai][bj][m][1] + bv[bj][1];
                    if (ACT == 1) { f32x2 a = gelu_pk((f32x2){v0[0], v0[1]}), b = gelu_pk((f32x2){v0[2], v0[3]}), c = gelu_pk((f32x2){v1[0], v1[1]}), d = gelu_pk((f32x2){v1[2], v1[3]});
                        v0 = (f32x4){a.x, a.y, b.x, b.y}; v1 = (f32x4){c.x, c.y, d.x, d.y}; }
                    v0 = v0 * sc; v1 = v1 * sc; u32x4 w; w.x = cvt_pk_bf16(v0[0], v0[1]); w.y = cvt_pk_bf16(v0[2], v0[3]); w.z = cvt_pk_bf16(v1[0], v1[1]); w.w = cvt_pk_bf16(v1[2], v1[3]);
                    *(u32x4*)(rowp + bj * HALF) = w; } }
    }
};

typedef int i32x4f __attribute__((ext_vector_type(4)));
typedef int i32x8f __attribute__((ext_vector_type(8)));
__device__ __forceinline__ i32x8f cat8(bf16x8 a, bf16x8 b) { const i32x4f lo = __builtin_bit_cast(i32x4f, a), hi = __builtin_bit_cast(i32x4f, b); return __builtin_shufflevector(lo, hi, 0, 1, 2, 3, 4, 5, 6, 7); }
template <class Epi, class Sched, bool ALIGN_EPI = false, bool SP2 = false, bool FP8 = false, bool BENCH = false  >
__device__ __forceinline__ void gemm_phase(PG8_LAS unsigned char* lds, const Gemm g, const Sched& S, const Epi& E) {
    const int tid = threadIdx.x, wid = __builtin_amdgcn_readfirstlane(tid >> 6), lane = tid & 63, wr = wid >> 2, wc = wid & 3, fr = lane & 15, fq = lane >> 4;
    const int K = g.K, nt = K / BK;
    unsigned voffA[2], voffB[2];
#pragma unroll
    for (int i = 0; i < 2; ++i) { int R, C; stage_rc(tid * 16 + i * 8192, R, C); const int Rb = Epi::PERM ? ((R & ~31) + perm32(R & 31)) : R;
        voffA[i] = (unsigned)(R * K + C) * 2u; voffB[i] = (unsigned)(Rb * K + C) * 2u; }
    const size_t kstep = (size_t)(BK * 2);
    const size_t hstep = (size_t)HALF * K * 2;
    const size_t tstep = 2 * hstep;
    const unsigned ldsw = (unsigned)wid * 1024u;
    const int aoff = lds_byte(wr * 64 + fr, fq * 8), boff = lds_byte(wc * 32 + fr, fq * 8);
#define PG8_SA(b, h) (((b) * 2 + (h)) * HTB)
#define PG8_SB(b, h) ((4 + (b) * 2 + (h)) * HTB)
#define PG8_STAGE(bufoff, gbase, voff) do { if constexpr (!BENCH) _Pragma("unroll") for (int _i = 0; _i < 2; ++_i) \
        __builtin_amdgcn_global_load_lds((const unsigned*)((const char*)(gbase) + (voff)[_i]), (PG8_LAS unsigned*)(lds + (bufoff) + ldsw + _i * 8192), 16, 0, 0); } while (0)
#define PG8_LDA(dst, b, h) do { _Pragma("unroll") for (int m = 0; m < 4; ++m) { const bf16x8 x0_ = *(const PG8_LAS bf16x8*)(lds + PG8_SA(b, h) + aoff + m * 2048), x1_ = *(const PG8_LAS bf16x8*)(lds + PG8_SA(b, h) + aoff + m * 2048 + 1024); \
        if constexpr (FP8) dst##8[m] = cat8(x0_, x1_); else { dst[m][0] = x0_; dst[m][1] = x1_; } } } while (0)
#define PG8_LDB(dst, b, h) do { _Pragma("unroll") for (int n = 0; n < 2; ++n) { const bf16x8 x0_ = *(const PG8_LAS bf16x8*)(lds + PG8_SB(b, h) + boff + n * 2048), x1_ = *(const PG8_LAS bf16x8*)(lds + PG8_SB(b, h) + boff + n * 2048 + 1024); \
        if constexpr (FP8) dst##8[n] = cat8(x0_, x1_); else { dst[n][0] = x0_; dst[n][1] = x1_; } } } while (0)
#define PG8_MMA(ai, bj, At, Bt) do { __builtin_amdgcn_s_setprio(1); _Pragma("unroll") for (int m = 0; m < 4; ++m) _Pragma("unroll") for (int n = 0; n < 2; ++n) { \
        if constexpr (FP8) asm volatile("v_mfma_f32_16x16x128_f8f6f4 %0, %1, %2, %0" : "+v"(acc[ai][bj][m][n]) : "v"(Bt##8[n]), "v"(At##8[m])); \
        else { _Pragma("unroll") for (int k = 0; k < 2; ++k) acc[ai][bj][m][n] = __builtin_amdgcn_mfma_f32_16x16x32_bf16(Bt[n][k], At[m][k], acc[ai][bj][m][n], 0, 0, 0); } } __builtin_amdgcn_s_setprio(0); } while (0)
#define PG8_WAIT_V(n) asm volatile("s_waitcnt vmcnt(" #n ")" ::: "memory")
#define PG8_WAIT_L(n) asm volatile("s_waitcnt lgkmcnt(" #n ")" ::: "memory")
#define PG8_BAR __builtin_amdgcn_s_barrier()
#define PG8_SCHED __builtin_amdgcn_sched_barrier(0)
    Unit cur, nxt; int ui = 0;
    if (!S.next(0, cur)) return;
    f32x4 acc[2][2][4][2];
#pragma unroll
    for (int a = 0; a < 2; ++a)
#pragma unroll
        for (int b = 0; b < 2; ++b)
#pragma unroll
            for (int m = 0; m < 4; ++m)
#pragma unroll
                for (int n = 0; n < 2; ++n) acc[a][b][m][n] = (f32x4){0.f, 0.f, 0.f, 0.f};
    bf16x8 At[4][2], B0[2][2], B1[2][2]; i32x8f At8[4], B08[2], B18[2];
    const char* cA = (const char*)g.A + (size_t)cur.pm * tstep; const char* cB = (const char*)g.Bt + S.boff(cur) + (size_t)cur.pn * tstep;
    S.a_ready(cur);
    if constexpr (SP2) {
        PG8_STAGE(PG8_SB(0, 0), cB, voffB); PG8_STAGE(PG8_SB(0, 1), cB + hstep, voffB); PG8_STAGE(PG8_SA(0, 0), cA, voffA); PG8_STAGE(PG8_SA(0, 1), cA + hstep, voffA);
        if (wr == 1) PG8_BAR;
        PG8_WAIT_V(2); PG8_BAR;
        PG8_STAGE(PG8_SB(1, 0), cB + kstep, voffB); PG8_STAGE(PG8_SA(1, 0), cA + kstep, voffA); PG8_STAGE(PG8_SB(1, 1), cB + hstep + kstep, voffB);
        PG8_WAIT_V(6); PG8_BAR;
    } else {
        PG8_STAGE(PG8_SB(0, 0), cB, voffB); PG8_STAGE(PG8_SA(0, 0), cA, voffA); PG8_STAGE(PG8_SB(0, 1), cB + hstep, voffB); PG8_STAGE(PG8_SA(0, 1), cA + hstep, voffA);
        if (wr == 1) PG8_BAR;
        PG8_WAIT_V(4); PG8_BAR;
        PG8_STAGE(PG8_SB(1, 0), cB + kstep, voffB); PG8_STAGE(PG8_SA(1, 0), cA + kstep, voffA); PG8_STAGE(PG8_SB(1, 1), cB + hstep + kstep, voffB);
        PG8_WAIT_V(6); PG8_BAR;
    }
    for (;;) {
        const bool has_next = S.next(ui + 1, nxt);
        const char* nA = has_next ? (const char*)g.A + (size_t)nxt.pm * tstep : cA; const char* nB = has_next ? (const char*)g.Bt + S.boff(nxt) + (size_t)nxt.pn * tstep : cB;
        for (int t = 0; t < nt; t += 2) {
            const bool last = (t == nt - 2);
            const char* a1 = cA + (size_t)(t + 1) * kstep;
            const char* a2 = last ? nA : cA + (size_t)(t + 2) * kstep; const char* b2 = last ? nB : cB + (size_t)(t + 2) * kstep;
            const char* a3 = a2 + kstep; const char* b3 = b2 + kstep;
            if (last && has_next) S.a_ready(nxt);
            if constexpr (SP2) {
            PG8_LDB(B0, 0, 0); PG8_LDB(B1, 0, 1); PG8_SCHED; PG8_LDA(At, 0, 0); PG8_STAGE(PG8_SA(1, 1), a1 + hstep, voffA);
            PG8_WAIT_V(8); PG8_WAIT_L(0); PG8_BAR; PG8_MMA(0, 0, At, B0); PG8_MMA(0, 1, At, B1); PG8_BAR; PG8_SCHED;
            PG8_LDA(At, 0, 1); PG8_STAGE(PG8_SB(0, 0), b2, voffB); PG8_STAGE(PG8_SB(0, 1), b2 + hstep, voffB); PG8_STAGE(PG8_SA(0, 0), a2, voffA);
            PG8_WAIT_V(8); PG8_WAIT_L(0); PG8_BAR; PG8_MMA(1, 0, At, B0); PG8_MMA(1, 1, At, B1); PG8_BAR; PG8_SCHED;
            PG8_LDB(B0, 1, 0); PG8_LDB(B1, 1, 1); PG8_SCHED; PG8_LDA(At, 1, 0); PG8_STAGE(PG8_SA(0, 1), a2 + hstep, voffA);
            PG8_WAIT_V(8); PG8_WAIT_L(0); PG8_BAR; PG8_MMA(0, 0, At, B0); PG8_MMA(0, 1, At, B1); PG8_BAR; PG8_SCHED;
            PG8_LDA(At, 1, 1); PG8_STAGE(PG8_SB(1, 0), b3, voffB); PG8_STAGE(PG8_SB(1, 1), b3 + hstep, voffB); PG8_STAGE(PG8_SA(1, 0), a3, voffA);
            PG8_WAIT_V(8); PG8_WAIT_L(0); PG8_BAR; PG8_MMA(1, 0, At, B0); PG8_MMA(1, 1, At, B1); PG8_BAR; PG8_SCHED;
            } else {
            PG8_LDB(B0, 0, 0); PG8_SCHED; PG8_LDA(At, 0, 0); PG8_STAGE(PG8_SA(1, 1), a1 + hstep, voffA);
            PG8_WAIT_L(8); PG8_BAR; PG8_WAIT_L(0); PG8_MMA(0, 0, At, B0); PG8_BAR; PG8_SCHED;
            PG8_LDB(B1, 0, 1); PG8_STAGE(PG8_SB(0, 0), b2, voffB);
            PG8_BAR; PG8_WAIT_L(0); PG8_MMA(0, 1, At, B1); PG8_BAR;
            PG8_LDA(At, 0, 1); PG8_STAGE(PG8_SA(0, 0), a2, voffA);
            PG8_BAR; PG8_WAIT_L(0); PG8_MMA(1, 0, At, B0); PG8_BAR; PG8_SCHED;
            PG8_STAGE(PG8_SB(0, 1), b2 + hstep, voffB);
            PG8_WAIT_V(6); PG8_BAR; PG8_MMA(1, 1, At, B1); PG8_BAR;
            PG8_LDB(B0, 1, 0); PG8_SCHED; PG8_LDA(At, 1, 0); PG8_STAGE(PG8_SA(0, 1), a2 + hstep, voffA);
            PG8_WAIT_L(8); PG8_BAR; PG8_WAIT_L(0); PG8_MMA(0, 0, At, B0); PG8_BAR; PG8_SCHED;
            PG8_LDB(B1, 1, 1); PG8_STAGE(PG8_SB(1, 0), b3, voffB);
            PG8_BAR; PG8_WAIT_L(0); PG8_MMA(0, 1, At, B1); PG8_BAR;
            PG8_LDA(At, 1, 1); PG8_STAGE(PG8_SA(1, 0), a3, voffA);
            PG8_BAR; PG8_WAIT_L(0); PG8_MMA(1, 0, At, B0); PG8_BAR; PG8_SCHED;
            PG8_STAGE(PG8_SB(1, 1), b3 + hstep, voffB);
            PG8_WAIT_V(6); PG8_BAR; PG8_MMA(1, 1, At, B1); PG8_BAR;
            }
        }
        if constexpr (FP8) asm volatile("s_nop 7\n\ts_nop 7\n\ts_nop 7" ::: "memory");
        if constexpr (ALIGN_EPI) { if (wr == 0) PG8_BAR; }
        if constexpr (!Epi::AFTER_DRAIN) { E(acc, cur, wr, wc, fr, fq); S.done(cur); }
        if (!has_next) break;
#pragma unroll
        for (int a = 0; a < 2; ++a)
#pragma unroll
            for (int b = 0; b < 2; ++b)
#pragma unroll
                for (int m = 0; m < 4; ++m)
#pragma unroll
                    for (int n = 0; n < 2; ++n) acc[a][b][m][n] = (f32x4){0.f, 0.f, 0.f, 0.f};
        cur = nxt; cA = nA; cB = nB; ++ui;
        if constexpr (ALIGN_EPI) { if (wr == 1) PG8_BAR; }
    }
    PG8_WAIT_V(0);
    if constexpr (!ALIGN_EPI) { if (wr == 0) PG8_BAR; }
    PG8_BAR;
    if constexpr (Epi::AFTER_DRAIN) { E.fused(acc, cur, wr, wc, fr, fq, lds, wid, lane); S.done(cur); }
#undef PG8_SA
#undef PG8_SB
#undef PG8_STAGE
#undef PG8_LDA
#undef PG8_LDB
#undef PG8_MMA
#undef PG8_WAIT_V
#undef PG8_WAIT_L
#undef PG8_BAR
#undef PG8_SCHED
}
}

constexpr int NWAVES = 8;
constexpr int DM = 1024, NB = 8, SEQ = 4096, CTXL = 256;
constexpr int MLAT = NB * SEQ, MCTX = NB * CTXL, MALL = MLAT + MCTX;
constexpr int DIN = 2048, CONVD = 4096, DINP = 6208, DINP_PAD = 6400;
constexpr int DFF = 2816, NE = 8, DFFE = 3584;
constexpr int NUNIT_LAT = NB * 32 * 8, NUNIT = NUNIT_LAT + NB * 2 * 8;
constexpr int MOE_ROWS = 67584;
constexpr float EPS = 1e-6f;
#ifndef MK_PER_PHASE
#define MK_PER_PHASE 0
#endif
#ifndef MK_LAST_PHASE
#define MK_LAST_PHASE 18
#endif
constexpr int N_PHASES = 19;

constexpr size_t MiB = 1u << 20;
constexpr size_t WS_CTL = 0, CTL_ZERO_BYTES = 32 * 1024;
constexpr size_t WS_MOD = 1 * MiB;
constexpr size_t WS_ROUTE = 2 * MiB;
constexpr size_t WS_CD = 4 * MiB;
constexpr size_t WS_WIN = 8 * MiB, WS_WOUT = 21 * MiB, WS_WGU = 25 * MiB, WS_WDN = 36 * MiB, WS_WSCI = 42 * MiB, WS_WSCO = 48 * MiB;
constexpr size_t WS_H = 56 * MiB;
constexpr size_t WS_Y = 124 * MiB;
constexpr size_t WS_Z = 188 * MiB;
constexpr size_t WS_XBC = 324 * MiB;
constexpr size_t WS_DT = 596 * MiB;
constexpr size_t WS_S = 606 * MiB;
constexpr size_t WS_ACT0 = 324 * MiB;
constexpr size_t WS_SCP = 324 * MiB;
constexpr size_t WS_HP8 = 124 * MiB;
constexpr size_t WS_YP = 190 * MiB;
constexpr size_t WS_WMGU = 764 * MiB, WS_WMDN = 824 * MiB;
constexpr size_t WS_ACT = 406 * MiB;
constexpr size_t WS_END = 640 * MiB;
constexpr size_t WS_Y3 = 700 * MiB;
constexpr size_t WS_RSTD = 3 * MiB;
constexpr float WGU_SCALE = 64.f, WDN_SCALE = 128.f;
#ifndef MK_FFN_FP8
#define MK_FFN_FP8 0
#endif
constexpr int FFN_FP8 = MK_FFN_FP8;
static_assert(WS_S + (size_t)NUNIT * 8 * 8192 * 2 <= 878 * MiB && WS_HP8 + (size_t)MOE_ROWS * DM <= WS_YP && WS_YP + (size_t)MOE_ROWS * DM * 2 <= WS_ACT && WS_WMGU >= 764 * MiB && WS_WMGU + (size_t)8 * 2 * DFFE * DM <= WS_WMDN && WS_WMDN + (size_t)8 * DM * DFFE <= 878 * MiB && WS_ACT + (size_t)MOE_ROWS * DFFE <= WS_END, "d_ws map");
constexpr size_t WS_NEED = 878 * MiB;
constexpr size_t RT_SELR = 0, RT_GATE = 256 * 1024, RT_POS = 512 * 1024, RT_CNT = 768 * 1024, RT_TEXP = 800 * 1024;
constexpr int CW_TMO = 0, CW_CODE = 1, CW_Q3 = 64, CW_Q5 = 128, CW_QC = 192  , CW_QL = 224  , CW_BAR = 4096;

constexpr int PXB = 544, PBB = 272, PMB = 272;
#define XOFF(R, cb) ((R) * PXB + ((((cb)) + (((R) & 8) << 4)) & 511))
constexpr int XI_BYTES = 128 * PXB, BI_BYTES = 128 * PBB, MW_BYTES = 8 * 16 * PMB;
constexpr int SCAL_OFF = XI_BYTES + BI_BYTES + MW_BYTES;
constexpr int BPW_OFF = SCAL_OFF + 3 * 4096;
constexpr int MISC_OFF = BPW_OFF + 8192;
constexpr int LDS_BYTES = MISC_OFF + 512;
static_assert(LDS_BYTES <= 160 * 1024 && pg8::STAGE_BYTES <= MISC_OFF, "LDS map");

#define GAS __attribute__((address_space(1)))
#define LAS __attribute__((address_space(3)))
typedef unsigned short bf16;
typedef unsigned v4u __attribute__((ext_vector_type(4)));
typedef unsigned v2u __attribute__((ext_vector_type(2)));
typedef float f32x4 __attribute__((ext_vector_type(4)));
typedef short bf16x8 __attribute__((ext_vector_type(8)));
typedef short s16x4 __attribute__((ext_vector_type(4)));
typedef GAS unsigned gu32;
#define RLX_AGENT __ATOMIC_RELAXED, __HIP_MEMORY_SCOPE_AGENT
#define LDS_WAIT() asm volatile("s_waitcnt lgkmcnt(0)" ::: "memory")
#define VM_WAIT() asm volatile("s_waitcnt vmcnt(0)" ::: "memory")
#define LDS_BARRIER() do { asm volatile("s_waitcnt lgkmcnt(0)" ::: "memory"); __builtin_amdgcn_s_barrier(); asm volatile("" ::: "memory"); } while (0)
typedef float f32x2n __attribute__((ext_vector_type(2)));
typedef __bf16 bf16x2n __attribute__((ext_vector_type(2)));
__device__ __forceinline__ unsigned pk2(float lo, float hi) { const f32x2n v = {lo, hi}; return __builtin_bit_cast(unsigned, __builtin_convertvector(v, bf16x2n)); }
__device__ __forceinline__ float bflo(unsigned u) { return __uint_as_float(u << 16); }
__device__ __forceinline__ float bfhi(unsigned u) { return __uint_as_float(u & 0xffff0000u); }
__device__ __forceinline__ float bf1(bf16 b) { return __uint_as_float(((unsigned)b) << 16); }
__device__ __forceinline__ f32x4 unpack4(v2u u) { return (f32x4){bflo(u.x), bfhi(u.x), bflo(u.y), bfhi(u.y)}; }
__device__ __forceinline__ v2u pack4(f32x4 v) { v2u r; r.x = pk2(v[0], v[1]); r.y = pk2(v[2], v[3]); return r; }
__device__ __forceinline__ unsigned pk4_fp8(float a, float b, float c, float d) {
    a = fminf(fmaxf(a, -448.f), 448.f); b = fminf(fmaxf(b, -448.f), 448.f); c = fminf(fmaxf(c, -448.f), 448.f); d = fminf(fmaxf(d, -448.f), 448.f);
    int v = __builtin_amdgcn_cvt_pk_fp8_f32(a, b, 0, false); v = __builtin_amdgcn_cvt_pk_fp8_f32(c, d, v, true); return (unsigned)v; }
__device__ __forceinline__ float silu_f(float v) { return v * __builtin_amdgcn_rcpf(1.0f + __builtin_amdgcn_exp2f(-1.44269504f * v)); }
__device__ __forceinline__ float wave_sum(float v) {
#pragma unroll
    for (int o = 1; o < 64; o <<= 1) v += __shfl_xor(v, o);
    return v;
}
__device__ __forceinline__ void wave_sum2(float& a, float& b) {
#pragma unroll
    for (int o = 1; o < 64; o <<= 1) { const float ta = __shfl_xor(a, o), tb = __shfl_xor(b, o); a += ta; b += tb; }
}
__device__ __forceinline__ unsigned lds_addr(LAS unsigned char* p) { return (unsigned)(size_t)p; }
__device__ __forceinline__ bf16x8 tr_pair(const LAS unsigned char* p0, const LAS unsigned char* p1) {
    const s16x4 x = __builtin_amdgcn_ds_read_tr16_b64_v4i16((LAS s16x4*)p0), y = __builtin_amdgcn_ds_read_tr16_b64_v4i16((LAS s16x4*)p1);
    return (bf16x8){x[0], x[1], x[2], x[3], y[0], y[1], y[2], y[3]};
}
#define MFMA16(a, b, c) __builtin_amdgcn_mfma_f32_16x16x32_bf16((a), (b), (c), 0, 0, 0)

namespace pg8 {
struct EpiInProj {
    static constexpr bool PERM = true, AFTER_DRAIN = false; static constexpr int MALL_ROWS = 34816;
    bf16_t* Z; bf16_t* XBC; float* DT;
    __device__ __forceinline__ void operator()(const f32x4 (&acc)[2][2][4][2], const Unit& u, int wr, int wc, int fr, int fq) const {
        const int row0 = u.pm * BM + wr * 64 + fr;
        if (u.pn < 24) {
            bf16_t* base; int ldc, colt;
            if (u.pn < 8) { base = Z; ldc = 2048; colt = u.pn * BM; } else { base = XBC; ldc = 4096; colt = (u.pn - 8) * BM; }
            const int col0 = colt + wc * 32 + 8 * fq;
#pragma unroll
            for (int ai = 0; ai < 2; ++ai)
#pragma unroll
                for (int m = 0; m < 4; ++m) { bf16_t* rowp = base + (size_t)(row0 + ai * HALF + m * 16) * ldc + col0;
#pragma unroll
                    for (int bj = 0; bj < 2; ++bj) { const f32x4 v0 = acc[ai][bj][m][0], v1 = acc[ai][bj][m][1];
                        u32x4 w; w.x = cvt_pk_bf16(v0[0], v0[1]); w.y = cvt_pk_bf16(v0[2], v0[3]); w.z = cvt_pk_bf16(v1[0], v1[1]); w.w = cvt_pk_bf16(v1[2], v1[3]);
                        *(u32x4*)(rowp + bj * HALF) = w; } }
        } else if (wc < 2) {
            const int col0 = wc * 32 + 8 * fq;
#pragma unroll
            for (int ai = 0; ai < 2; ++ai)
#pragma unroll
                for (int m = 0; m < 4; ++m) { const int row = row0 + ai * HALF + m * 16;
#pragma unroll
                    for (int n = 0; n < 2; ++n)
#pragma unroll
                        for (int j = 0; j < 4; ++j) DT[(size_t)(col0 + 4 * n + j) * MALL_ROWS + row] = acc[ai][0][m][n][j]; }
        }
    }
};
struct EpiSwiGLU {
    static constexpr bool PERM = true, AFTER_DRAIN = false;
    bf16_t* O; int ldc;
    __device__ __forceinline__ void operator()(const f32x4 (&acc)[2][2][4][2], const Unit& u, int wr, int wc, int fr, int fq) const {
        const int row0 = u.pm * BM + wr * 64 + fr, col0 = u.pn * HALF + wc * 32 + 8 * fq;
#pragma unroll
        for (int ai = 0; ai < 2; ++ai)
#pragma unroll
            for (int m = 0; m < 4; ++m) { bf16_t* rowp = O + (size_t)(row0 + ai * HALF + m * 16) * ldc + col0;
                float o[8];
#pragma unroll
                for (int n = 0; n < 2; ++n)
#pragma unroll
                    for (int j = 0; j < 4; ++j) { const float gt = acc[ai][0][m][n][j], up = acc[ai][1][m][n][j]; o[4 * n + j] = gt * __builtin_amdgcn_rcpf(1.0f + __expf(-gt)) * up; }
                u32x4 w; w.x = cvt_pk_bf16(o[0], o[1]); w.y = cvt_pk_bf16(o[2], o[3]); w.z = cvt_pk_bf16(o[4], o[5]); w.w = cvt_pk_bf16(o[6], o[7]);
                *(u32x4*)(rowp) = w; }
    }
};
struct EpiSwiGLU8 {
    static constexpr bool PERM = true, AFTER_DRAIN = false;
    unsigned char* O; int ldc; float sc;
    __device__ __forceinline__ void operator()(const f32x4 (&acc)[2][2][4][2], const Unit& u, int wr, int wc, int fr, int fq) const {
        const int row0 = u.pm * BM + wr * 64 + fr, col0 = u.pn * HALF + wc * 32 + 8 * fq;
#pragma unroll
        for (int ai = 0; ai < 2; ++ai)
#pragma unroll
            for (int m = 0; m < 4; ++m) { unsigned char* rowp = O + (size_t)(row0 + ai * HALF + m * 16) * ldc + col0;
                float o[8];
#pragma unroll
                for (int n = 0; n < 2; ++n)
#pragma unroll
                    for (int j = 0; j < 4; ++j) { const float gt = acc[ai][0][m][n][j] * sc, up = acc[ai][1][m][n][j] * sc; o[4 * n + j] = gt * __builtin_amdgcn_rcpf(1.0f + __builtin_amdgcn_exp2f(-1.44269504f * gt)) * up; }
                typedef unsigned u32x2e __attribute__((ext_vector_type(2)));
                u32x2e w; w.x = pk4_fp8(o[0], o[1], o[2], o[3]); w.y = pk4_fp8(o[4], o[5], o[6], o[7]);
                *(u32x2e*)(rowp) = w; }
    }
};
struct EpiBf16S {
    static constexpr bool PERM = true, AFTER_DRAIN = false;
    bf16_t* O; int ldc; float sc;
    __device__ __forceinline__ void operator()(const f32x4 (&acc)[2][2][4][2], const Unit& u, int wr, int wc, int fr, int fq) const {
        const int row0 = u.pm * BM + wr * 64 + fr, col0 = u.pn * BM + wc * 32 + 8 * fq;
#pragma unroll
        for (int ai = 0; ai < 2; ++ai)
#pragma unroll
            for (int m = 0; m < 4; ++m) { bf16_t* rowp = O + (size_t)(row0 + ai * HALF + m * 16) * ldc + col0;
#pragma unroll
                for (int bj = 0; bj < 2; ++bj) { const f32x4 v0 = acc[ai][bj][m][0] * sc, v1 = acc[ai][bj][m][1] * sc;
                    u32x4 w; w.x = cvt_pk_bf16(v0[0], v0[1]); w.y = cvt_pk_bf16(v0[2], v0[3]); w.z = cvt_pk_bf16(v1[0], v1[1]); w.w = cvt_pk_bf16(v1[2], v1[3]);
                    *(u32x4*)(rowp + bj * HALF) = w; } }
    }
};
struct EpiScIn {
    static constexpr bool PERM = true, AFTER_DRAIN = false;
    bf16_t* P; bf16_t* GB;
    __device__ __forceinline__ void operator()(const f32x4 (&acc)[2][2][4][2], const Unit& u, int wr, int wc, int fr, int fq) const {
        const int row0 = u.pm * BM + wr * 64 + fr;
        if (u.pn < 8) {
            const int col0 = u.pn * HALF + wc * 32 + 8 * fq;
#pragma unroll
            for (int ai = 0; ai < 2; ++ai)
#pragma unroll
                for (int m = 0; m < 4; ++m) { bf16_t* rowp = P + (size_t)(row0 + ai * HALF + m * 16) * 1024 + col0;
                    const f32x4 v0 = acc[ai][0][m][0] * acc[ai][1][m][0], v1 = acc[ai][0][m][1] * acc[ai][1][m][1];
                    u32x4 w; w.x = cvt_pk_bf16(v0[0], v0[1]); w.y = cvt_pk_bf16(v0[2], v0[3]); w.z = cvt_pk_bf16(v1[0], v1[1]); w.w = cvt_pk_bf16(v1[2], v1[3]);
                    *(u32x4*)(rowp) = w; }
        } else {
            const int col0 = (u.pn - 8) * BM + wc * 32 + 8 * fq;
#pragma unroll
            for (int ai = 0; ai < 2; ++ai)
#pragma unroll
                for (int m = 0; m < 4; ++m) { bf16_t* rowp = GB + (size_t)(row0 + ai * HALF + m * 16) * 1024 + col0;
#pragma unroll
                    for (int bj = 0; bj < 2; ++bj) { const f32x4 v0 = acc[ai][bj][m][0], v1 = acc[ai][bj][m][1];
                        u32x4 w; w.x = cvt_pk_bf16(v0[0], v0[1]); w.y = cvt_pk_bf16(v0[2], v0[3]); w.z = cvt_pk_bf16(v1[0], v1[1]); w.w = cvt_pk_bf16(v1[2], v1[3]);
                        *(u32x4*)(rowp + bj * HALF) = w; } }
        }
    }
};
struct InProjOrder : StaticOrder {
    __device__ __forceinline__ bool next(int i, Unit& u) const {
        const long L = (long)i * G + c; if (L >= nwg + 104) return false;
        if (L < nwg) return StaticOrder::next(i, u);
        const int idx = (int)(L - nwg), px = idx % 13; u.pm = nM + idx / 13; u.pn = px < 12 ? 8 + px : 24; return true;
    }
};
struct EpiNull {
    static constexpr bool PERM = true, AFTER_DRAIN = false;
    float* sink;
    __device__ __forceinline__ void operator()(const f32x4 (&acc)[2][2][4][2], const Unit& u, int wr, int wc, int fr, int fq) const {
        float s = 0.f;
#pragma unroll
        for (int ai = 0; ai < 2; ++ai)
#pragma unroll
            for (int bj = 0; bj < 2; ++bj)
#pragma unroll
                for (int m = 0; m < 4; ++m)
#pragma unroll
                    for (int n = 0; n < 2; ++n) s += acc[ai][bj][m][n][0];
        if (s == 12345.678f) sink[0] = s;
    }
};
struct GroupedOrder : StaticOrder {
    const int* texp; size_t estride;
    __device__ __forceinline__ size_t boff(const Unit& u) const { return (size_t)texp[u.pm] * estride; }
};
}

struct Frame {
    LAS unsigned char* lds;
    volatile LAS unsigned* MISC;
    gu32* ctl;
    int tid, lane, wave, G;
    const float* in[24]; float* out; unsigned char* ws;
};
enum { I_X = 0, I_C, I_CTX, I_CCTX, I_ADAW, I_ADAB, I_NPRE, I_NPOST, I_SWIN, I_SCONVW, I_SCONVB, I_SALOG, I_SDTB, I_SD, I_SNORM, I_SWOUT, I_SCWIN, I_SCCONV, I_SCWOUT, I_FGU, I_FDN, I_ROUTER, I_MGU, I_MDN };

__device__ __forceinline__ void cvt_item(const float* W, int K, int N, bf16* WT, LAS float* scr, int item, int lane, int mode, int dffx) {
    const int nblk = N / 32, kb = item / nblk, nb = item % nblk, k0 = 64 * kb, n0 = 32 * nb;
#pragma unroll 8
    for (int i = 0; i < 32; ++i) { const int kk = 2 * i + (lane >> 5); scr[kk * 33 + (lane & 31)] = W[(size_t)(k0 + kk) * N + n0 + (lane & 31)]; }
    LDS_WAIT(); asm volatile("" ::: "memory");
    const int c = lane & 7;
#pragma unroll
    for (int j = 0; j < 4; ++j) { const int n = (lane >> 3) + 8 * j; const LAS float* s = scr + (8 * c) * 33 + n;
        v4u o; o.x = pk2(s[0 * 33], s[1 * 33]); o.y = pk2(s[2 * 33], s[3 * 33]); o.z = pk2(s[4 * 33], s[5 * 33]); o.w = pk2(s[6 * 33], s[7 * 33]);
        int nd = n0 + n; if (mode) { const int half = nd >= dffx ? 1 : 0, i2 = nd - half * dffx; nd = 256 * (i2 >> 7) + 128 * half + (i2 & 127); }
        *(v4u*)(WT + (size_t)nd * K + k0 + 8 * c) = o; }
    LDS_WAIT(); asm volatile("" ::: "memory");
}
__device__ __forceinline__ void cvt_item8(const float* W, int K, int N, unsigned char* WT, LAS float* scr, int item, int lane, int mode, int dffx, float sc) {
    const int nblk = N / 32, kb = item / nblk, nb = item % nblk, k0 = 64 * kb, n0 = 32 * nb;
#pragma unroll 8
    for (int i = 0; i < 32; ++i) { const int kk = 2 * i + (lane >> 5); scr[kk * 33 + (lane & 31)] = W[(size_t)(k0 + kk) * N + n0 + (lane & 31)]; }
    LDS_WAIT(); asm volatile("" ::: "memory");
    const int c = lane & 7;
#pragma unroll
    for (int j = 0; j < 4; ++j) { const int n = (lane >> 3) + 8 * j; const LAS float* s = scr + (8 * c) * 33 + n;
        v2u o; o.x = pk4_fp8(s[0 * 33] * sc, s[1 * 33] * sc, s[2 * 33] * sc, s[3 * 33] * sc); o.y = pk4_fp8(s[4 * 33] * sc, s[5 * 33] * sc, s[6 * 33] * sc, s[7 * 33] * sc);
        int nd = n0 + n; if (mode) { const int half = nd >= dffx ? 1 : 0, i2 = nd - half * dffx; nd = 256 * (i2 >> 7) + 128 * half + (i2 & 127); }
        *(v2u*)(WT + (size_t)nd * K + k0 + 8 * c) = o; }
    LDS_WAIT(); asm volatile("" ::: "memory");
}
__device__ __forceinline__ void load_row_f32(const float* p, int lane, f32x4 (&v)[4]) {
#pragma unroll
    for (int j = 0; j < 4; ++j) v[j] = *(const f32x4*)(p + 4 * lane + 256 * j);
}
__device__ __forceinline__ void load_row_bf16(const bf16* p, int lane, f32x4 (&v)[4]) {
#pragma unroll
    for (int j = 0; j < 4; ++j) v[j] = unpack4(*(const v2u*)(p + 4 * lane + 256 * j));
}
__device__ __forceinline__ float row_ss(const f32x4 (&v)[4]) {
    float s = 0.f;
#pragma unroll
    for (int j = 0; j < 4; ++j) s += (v[j][0] * v[j][0] + v[j][1] * v[j][1]) + (v[j][2] * v[j][2] + v[j][3] * v[j][3]);
    return wave_sum(s);
}
__device__ __forceinline__ float ss_part(const f32x4 (&v)[4]) {
    float s = 0.f;
#pragma unroll
    for (int j = 0; j < 4; ++j) s += (v[j][0] * v[j][0] + v[j][1] * v[j][1]) + (v[j][2] * v[j][2] + v[j][3] * v[j][3]);
    return s;
}
__device__ __forceinline__ void prenorm_mod(f32x4 (&v)[4], const float* npre, const float* sc, const float* sh, int lane) {
    const float rr = rsqrtf(row_ss(v) * (1.0f / DM) + EPS);
#pragma unroll
    for (int j = 0; j < 4; ++j) { const int col = 4 * lane + 256 * j; const f32x4 w4 = *(const f32x4*)(npre + col), s4 = *(const f32x4*)(sc + col), h4 = *(const f32x4*)(sh + col);
        v[j] = (v[j] * rr * w4) * (s4 + 1.0f) + h4; }
}
__device__ __forceinline__ void store_row_bf16(bf16* p, int lane, const f32x4 (&v)[4]) {
#pragma unroll
    for (int j = 0; j < 4; ++j) *(v2u*)(p + 4 * lane + 256 * j) = pack4(v[j]);
}
__device__ __forceinline__ const float* mod_vec(Frame& F, int layer, int row, int chunk) { return (const float*)(F.ws + WS_MOD) + ((size_t)(layer * 9 + row) * 6144 + chunk * 1024); }


struct CvtDesc { const float* W; void* WT; int K, N, item, mode, dffx, fp8; float sc; };
__device__ __forceinline__ void cvt_load(const CvtDesc& d, int lane, float (&v)[32]) {
    const int nblk = d.N / 32, kb = d.item / nblk, nb = d.item % nblk; const float* p = d.W + (size_t)(64 * kb + (lane >> 5)) * d.N + 32 * nb + (lane & 31);
#pragma unroll
    for (int i = 0; i < 32; ++i) v[i] = __builtin_nontemporal_load(p + (size_t)(2 * i) * d.N);
}
__device__ __forceinline__ void cvt_finish(const CvtDesc& d, LAS float* scr, int lane, const float (&v)[32]) {
    const int nblk = d.N / 32, kb = d.item / nblk, nb = d.item % nblk, k0 = 64 * kb, n0 = 32 * nb;
#pragma unroll
    for (int i = 0; i < 32; ++i) scr[(2 * i + (lane >> 5)) * 33 + (lane & 31)] = v[i];
    LDS_WAIT(); asm volatile("" ::: "memory");
    const int c = lane & 7;
#pragma unroll
    for (int j = 0; j < 4; ++j) { const int n = (lane >> 3) + 8 * j; const LAS float* s = scr + (8 * c) * 33 + n;
        int nd = n0 + n; if (d.mode == 1) { const int half = nd >= d.dffx ? 1 : 0, i2 = nd - half * d.dffx; nd = 256 * (i2 >> 7) + 128 * half + (i2 & 127); }
        else if (d.mode == 2) { if (nd < 1024) nd += 2048; else { const int q = nd - 1024, half = q >> 10, i2 = q & 1023; nd = 256 * (i2 >> 7) + 128 * half + (i2 & 127); } }
        if (d.fp8) { const float sc = d.sc; v2u o; o.x = pk4_fp8(s[0 * 33] * sc, s[1 * 33] * sc, s[2 * 33] * sc, s[3 * 33] * sc); o.y = pk4_fp8(s[4 * 33] * sc, s[5 * 33] * sc, s[6 * 33] * sc, s[7 * 33] * sc);
            __builtin_nontemporal_store(o, (v2u*)((unsigned char*)d.WT + (size_t)nd * d.K + k0 + 8 * c)); }
        else { v4u o; o.x = pk2(s[0 * 33], s[1 * 33]); o.y = pk2(s[2 * 33], s[3 * 33]); o.z = pk2(s[4 * 33], s[5 * 33]); o.w = pk2(s[6 * 33], s[7 * 33]);
            *(v4u*)((bf16*)d.WT + (size_t)nd * d.K + k0 + 8 * c) = o; } }
    LDS_WAIT(); asm volatile("" ::: "memory");
}
template <class Dec> __device__ __forceinline__ void cvt_stream(const Dec& dec, int total, int first, int stride, LAS float* scr, int lane) {
    int it = first; if (it >= total) return;
    float v[32]; dec(it, true, scr, lane, v);
    for (;;) {
        const int itn = it + stride; const bool hn = itn < total; float vn[32];
        if (hn) dec(itn, true, scr, lane, vn);
        dec(it, false, scr, lane, v);
        if (!hn) break;
        it = itn;
#pragma unroll
        for (int i = 0; i < 32; ++i) v[i] = vn[i];
    }
}
__device__ __forceinline__ void cvt_do(const CvtDesc& d, bool load, LAS float* scr, int lane, float (&v)[32]) { if (load) cvt_load(d, lane, v); else cvt_finish(d, scr, lane, v); }
constexpr int LW_I0 = 16 * 194, LW_I1 = 32 * 32, LW_I2 = 16 * 176, LW_I3 = 44 * 32, LW_I4 = 16 * 96, LW_I5 = 16 * 32, LW_ITEMS = LW_I1 + LW_I2 + LW_I3 + LW_I4 + LW_I5, LW_BATCHES = LW_ITEMS / 8;
static_assert(LW_ITEMS % 8 == 0, "layer-weight batches");
__device__ __forceinline__ CvtDesc lw_cvt_desc(const float* w1, const float* w2, const float* w3, const float* w4, const float* w5, unsigned char* ws, int r) {
    CvtDesc d; d.mode = 0; d.dffx = 0; d.fp8 = 0; d.sc = 1.f;
    if (r < LW_I1) { d.W = w1; d.WT = ws + WS_WOUT; d.K = 2048; d.N = 1024; d.item = r; return d; } r -= LW_I1;
    if (r < LW_I2) { d.W = w2; d.WT = ws + WS_WGU; d.K = 1024; d.N = 2 * DFF; d.item = r; d.mode = 1; d.dffx = DFF; d.fp8 = FFN_FP8; d.sc = FFN_FP8 ? WGU_SCALE : 1.f; return d; } r -= LW_I2;
    if (r < LW_I3) { d.W = w3; d.WT = ws + WS_WDN; d.K = DFF; d.N = 1024; d.item = r; d.fp8 = FFN_FP8; d.sc = FFN_FP8 ? WDN_SCALE : 1.f; return d; } r -= LW_I3;
    if (r < LW_I4) { d.W = w4; d.WT = ws + WS_WSCI; d.K = 1024; d.N = 3072; d.item = r; d.mode = 2; return d; } r -= LW_I4;
    d.W = w5; d.WT = ws + WS_WSCO; d.K = 1024; d.N = 1024; d.item = r; return d;
}
__device__ __forceinline__ void lw_cvt_batch(Frame& F, int bt) {
    LAS float* scr = (LAS float*)(F.lds + F.wave * 8448);
    const CvtDesc d = lw_cvt_desc(F.in[I_SWOUT], F.in[I_FGU], F.in[I_FDN], F.in[I_SCWIN], F.in[I_SCWOUT], F.ws, bt * 8 + F.wave);
    float v[32]; cvt_load(d, F.lane, v); cvt_finish(d, scr, F.lane, v);
}
__device__ __forceinline__ void p0_prologue(Frame& F) {
    LAS float* scr = (LAS float*)(F.lds + F.wave * 8448);
    LAS float* SIL = (LAS float*)(F.lds + 69632);
    LAS float* RED = (LAS float*)(F.lds + 69632 + 36864);
    if ((int)blockIdx.x < 192) {
        for (int idx = F.tid; idx < 9 * 1024; idx += NWAVES * 64) { const int r = idx >> 10, k = idx & 1023; const float cv = r < 8 ? F.in[I_C][r * 1024 + k] : F.in[I_CCTX][k]; SIL[idx] = silu_f(cv); }
        __syncthreads();
        for (int t = blockIdx.x; t < 192; t += F.G) {
            const int i = t / 96, col0 = 64 * (t % 96);
            const float* wp = F.in[I_ADAW] + ((size_t)i * 1024 + F.wave * 128) * 6144 + col0 + F.lane;
            float acc[9];
#pragma unroll
            for (int r = 0; r < 9; ++r) acc[r] = 0.f;
            for (int k8 = 0; k8 < 128; k8 += 32) {
                float wv[32];
#pragma unroll
                for (int q = 0; q < 32; ++q) wv[q] = __builtin_nontemporal_load(wp + (size_t)(k8 + q) * 6144);
#pragma unroll
                for (int q = 0; q < 32; ++q)
#pragma unroll
                    for (int r = 0; r < 9; ++r) acc[r] += SIL[r * 1024 + F.wave * 128 + k8 + q] * wv[q];
            }
#pragma unroll
            for (int r = 0; r < 9; ++r) RED[(F.wave * 9 + r) * 64 + F.lane] = acc[r];
            __syncthreads();
            for (int idx = F.tid; idx < 576; idx += NWAVES * 64) { const int r = idx >> 6, ln = idx & 63; float s = 0.f;
#pragma unroll
                for (int w = 0; w < 8; ++w) s += RED[(w * 9 + r) * 64 + ln];
                ((float*)(F.ws + WS_MOD))[(size_t)(i * 9 + r) * 6144 + col0 + ln] = s + F.in[I_ADAB][i * 6144 + col0 + ln]; }
            __syncthreads();
        }
    }
    const int gw = blockIdx.x * NWAVES + F.wave, NGW = F.G * NWAVES;
    constexpr int I0 = 16 * 194, I1 = 32 * 32, I2 = 16 * 176, I3 = 44 * 32, I4 = 16 * 96, I5 = 16 * 32;
    { const float* w0 = F.in[I_SWIN]; const float* w1 = F.in[I_SWOUT]; const float* w2 = F.in[I_FGU]; const float* w3 = F.in[I_FDN]; const float* w4 = F.in[I_SCWIN]; const float* w5 = F.in[I_SCWOUT]; unsigned char* ws = F.ws;
      auto dec = [w0, w1, w2, w3, w4, w5, ws](int it, bool load, LAS float* scr_, int lane_, float (&v)[32]) { CvtDesc d; d.mode = 0; d.dffx = 0; d.fp8 = 0; d.sc = 1.f; int r = it;
          if (r < I0) { d.W = w0; d.WT = ws + WS_WIN; d.K = 1024; d.N = DINP; d.item = r; cvt_do(d, load, scr_, lane_, v); return; } r -= I0;
          if (r < I1) { d.W = w1; d.WT = ws + WS_WOUT; d.K = 2048; d.N = 1024; d.item = r; cvt_do(d, load, scr_, lane_, v); return; } r -= I1;
          if (r < I2) { d.W = w2; d.WT = ws + WS_WGU; d.K = 1024; d.N = 2 * DFF; d.item = r; d.mode = 1; d.dffx = DFF; d.fp8 = FFN_FP8; d.sc = FFN_FP8 ? WGU_SCALE : 1.f; cvt_do(d, load, scr_, lane_, v); return; } r -= I2;
          if (r < I3) { d.W = w3; d.WT = ws + WS_WDN; d.K = DFF; d.N = 1024; d.item = r; d.fp8 = FFN_FP8; d.sc = FFN_FP8 ? WDN_SCALE : 1.f; cvt_do(d, load, scr_, lane_, v); return; } r -= I3;
          if (r < I4) { d.W = w4; d.WT = ws + WS_WSCI; d.K = 1024; d.N = 3072; d.item = r; d.mode = 2; cvt_do(d, load, scr_, lane_, v); return; } r -= I4;
          d.W = w5; d.WT = ws + WS_WSCO; d.K = 1024; d.N = 1024; d.item = r; cvt_do(d, load, scr_, lane_, v); };
      cvt_stream(dec, I0, gw, NGW, scr, F.lane); }
    { v4u* zp = (v4u*)((bf16*)(F.ws + WS_WIN) + (size_t)DINP * 1024); const int n16 = (DINP_PAD - DINP) * 1024 / 8;
      for (int i = blockIdx.x * (NWAVES * 64) + F.tid; i < n16; i += F.G * NWAVES * 64) zp[i] = (v4u){0u, 0u, 0u, 0u}; }
}
__device__ __forceinline__ void p1_prenorm(Frame& F) {
    const int gw = blockIdx.x * NWAVES + F.wave, NGW = F.G * NWAVES;
    bf16* H = (bf16*)(F.ws + WS_H);
    const float* xl = F.in[I_X]; const float* xc = F.in[I_CTX];
    f32x4 vn[4];
    if (gw < MALL) load_row_f32(gw < MLAT ? xl + (size_t)gw * DM : xc + (size_t)(gw - MLAT) * DM, F.lane, vn);
    for (int r = gw; r < MALL; r += NGW) {
        const int mr = r < MLAT ? (r >> 12) : 8, rn = r + NGW;
        f32x4 v[4];
#pragma unroll
        for (int j = 0; j < 4; ++j) v[j] = vn[j];
        if (rn < MALL) load_row_f32(rn < MLAT ? xl + (size_t)rn * DM : xc + (size_t)(rn - MLAT) * DM, F.lane, vn);
        prenorm_mod(v, F.in[I_NPRE], mod_vec(F, 0, mr, 1), mod_vec(F, 0, mr, 0), F.lane);
        store_row_bf16(H + (size_t)r * DM, F.lane, v);
    }
}
template <bool NEXT, bool H8OUT = false>
__device__ __forceinline__ void resnorm_phase(Frame& F, const float* xin, int layer, int gchunk, const float* npost, const float* npre, int nlayer, int scchunk, int shchunk) {
    const int gw = blockIdx.x * NWAVES + F.wave, NGW = F.G * NWAVES, rstep = 2 * NGW;
    const int r_beg = 2 * gw, r_end = MLAT;
    if (r_beg >= r_end) return;
    const bf16* Y = (const bf16*)(F.ws + WS_Y); bf16* H = (bf16*)(F.ws + WS_H);
    const int c0 = 4 * F.lane;
    v2u yq[2][4]; f32x4 xq[2][4];
#define RN_LOAD(rr_, s_) do { if ((rr_) < r_end) { _Pragma("unroll") for (int j = 0; j < 4; ++j) { yq[s_][j] = *(const v2u*)(Y + (size_t)(rr_) * DM + c0 + 256 * j); xq[s_][j] = *(const f32x4*)(xin + (size_t)(rr_) * DM + c0 + 256 * j); } } } while (0)
    RN_LOAD(r_beg, 0); RN_LOAD(r_beg + 1, 1);
    for (int r = r_beg; r < r_end; r += rstep) {
        const bool two = (r + 1) < r_end;
        f32x4 y0[4], y1[4], x0[4], x1[4];
#pragma unroll
        for (int j = 0; j < 4; ++j) { y0[j] = unpack4(yq[0][j]); y1[j] = unpack4(yq[1][j]); x0[j] = xq[0][j]; x1[j] = xq[1][j]; }
        RN_LOAD(r + rstep, 0); RN_LOAD(r + rstep + 1, 1);
        const int b = r >> 12; const float* g_ = mod_vec(F, layer, b, gchunk);
        float s0 = ss_part(y0), s1 = ss_part(y1); wave_sum2(s0, s1);
        const float q0 = rsqrtf(s0 * (1.0f / DM) + EPS), q1 = rsqrtf(s1 * (1.0f / DM) + EPS);
#pragma unroll
        for (int j = 0; j < 4; ++j) { const f32x4 gt = *(const f32x4*)(g_ + c0 + 256 * j), np = *(const f32x4*)(npost + c0 + 256 * j);
            x0[j] = x0[j] + gt * ((y0[j] * q0) * np); x1[j] = x1[j] + gt * ((y1[j] * q1) * np);
            *(f32x4*)(F.out + (size_t)r * DM + c0 + 256 * j) = x0[j]; if (two) *(f32x4*)(F.out + (size_t)(r + 1) * DM + c0 + 256 * j) = x1[j]; }
        if (NEXT) {
            const float* s_ = mod_vec(F, nlayer, b, scchunk); const float* h_ = mod_vec(F, nlayer, b, shchunk);
            float t0 = ss_part(x0), t1 = ss_part(x1); wave_sum2(t0, t1);
            const float p0 = rsqrtf(t0 * (1.0f / DM) + EPS), p1 = rsqrtf(t1 * (1.0f / DM) + EPS);
#pragma unroll
            for (int j = 0; j < 4; ++j) { const f32x4 npr = *(const f32x4*)(npre + c0 + 256 * j), sc = *(const f32x4*)(s_ + c0 + 256 * j) + 1.0f, sh = *(const f32x4*)(h_ + c0 + 256 * j);
                x0[j] = (x0[j] * p0 * npr) * sc + sh; x1[j] = (x1[j] * p1 * npr) * sc + sh; }
            if (H8OUT) {
#pragma unroll
                for (int j = 0; j < 4; ++j) { *(unsigned*)((unsigned char*)H + (size_t)r * DM + c0 + 256 * j) = pk4_fp8(x0[j][0], x0[j][1], x0[j][2], x0[j][3]);
                    if (two) *(unsigned*)((unsigned char*)H + (size_t)(r + 1) * DM + c0 + 256 * j) = pk4_fp8(x1[j][0], x1[j][1], x1[j][2], x1[j][3]); } }
            else { store_row_bf16(H + (size_t)r * DM, F.lane, x0); if (two) store_row_bf16(H + (size_t)(r + 1) * DM, F.lane, x1); }
        }
    }
#undef RN_LOAD
}

__device__ __forceinline__ int ssd_sidx(int b, int cs, int g) { return (b * 34 + cs) * 8 + g; }
__device__ __forceinline__ void dt_scan(const float* DTR, int r0, int dcol, float bias, float A, int lane, float (&dt)[2], float (&dA)[2], float (&inc)[2], float& total) {
#pragma unroll
    for (int h = 0; h < 2; ++h) { const float x = DTR[(size_t)dcol * MALL + (r0 + lane + 64 * h)] + bias; dt[h] = x > 20.f ? x : log1pf(__expf(x)); dA[h] = dt[h] * A; }
    float s0 = dA[0], s1 = dA[1];
#pragma unroll
    for (int o = 1; o < 64; o <<= 1) { const float t0 = __shfl_up(s0, o), t1 = __shfl_up(s1, o); if (lane >= o) { s0 += t0; s1 += t1; } }
    const float tot0 = __shfl(s0, 63); s1 += tot0; inc[0] = s0; inc[1] = s1; total = __shfl(s1, 63);
}
__device__ __forceinline__ void ssd_phase_a(Frame& F, const int dry) {
    LAS unsigned char* XI = F.lds; LAS unsigned char* BI = F.lds + XI_BYTES; LAS float* WS = (LAS float*)(F.lds + SCAL_OFF);
    const int lane = F.lane, w = F.wave, gq = lane >> 4, q4 = (lane & 15) >> 2, p4 = lane & 3, l15 = lane & 15;
    const LAS unsigned char* trXr = XI + (8 * gq + q4) * PXB; const int trXc = 8 * p4 + 128 * (gq & 1); const LAS unsigned char* trB = BI + (8 * gq + q4) * PBB + 8 * p4;
    bf16* XBC = (bf16*)(F.ws + WS_XBC); const float* DTR = (const float*)(F.ws + WS_DT); bf16* S = (bf16*)(F.ws + WS_S); float* CD = (float*)(F.ws + WS_CD);
    LAS int* QS = (LAS int*)(F.lds + MISC_OFF + 128); unsigned* qhead = (unsigned*)(F.ctl + CW_Q3);
    for (int u = blockIdx.x; u < NUNIT_LAT + 2 * (NUNIT - NUNIT_LAT);) {
        unsigned qtk = 0u; if (F.tid == 0) qtk = __hip_atomic_fetch_add(qhead, 1u, __ATOMIC_RELAXED, __HIP_MEMORY_SCOPE_AGENT);
        int b, cs, g, jlo = 0, jhi = 4; bool isctx;
        if (u < NUNIT_LAT) { b = u >> 8; cs = (u >> 3) & 31; g = u & 7; isctx = false; } else { const int v = (u - NUNIT_LAT) >> 1; jlo = 2 * ((u - NUNIT_LAT) & 1); jhi = jlo + 2; b = v >> 4; cs = 32 + ((v >> 3) & 1); g = v & 7; isctx = true; }
        const int r0 = isctx ? MLAT + b * CTXL + (cs - 32) * 128 : b * SEQ + cs * 128, sidx = ssd_sidx(b, cs, g);
        const int col = lane < 32 ? g * 256 + 8 * lane : (lane < 48 ? 2048 + g * 128 + 8 * (lane - 32) : 3072 + g * 128 + 8 * (lane - 48));
        const int l0 = 16 * w; int lo, hi; if (isctx) { lo = -(cs - 32) * 128; hi = lo + 255; } else { lo = l0 & ~63; hi = lo + 63; }
        v4u raw[20];
#pragma unroll
        for (int i = 0; i < 20; ++i) { const int lp = l0 - 2 + i; raw[i] = (lp >= lo && lp <= hi) ? *(const v4u*)(XBC + (long)(r0 + lp) * CONVD + col) : (v4u){0u, 0u, 0u, 0u}; }
        f32x2n wt[5][4], bs[4];
#pragma unroll
        for (int t = 0; t < 5; ++t) { const f32x4 a = *(const f32x4*)(F.in[I_SCONVW] + t * CONVD + col), c4 = *(const f32x4*)(F.in[I_SCONVW] + t * CONVD + col + 4);
            wt[t][0] = (f32x2n){a[0], a[1]}; wt[t][1] = (f32x2n){a[2], a[3]}; wt[t][2] = (f32x2n){c4[0], c4[1]}; wt[t][3] = (f32x2n){c4[2], c4[3]}; }
        { const f32x4 a = *(const f32x4*)(F.in[I_SCONVB] + col), c4 = *(const f32x4*)(F.in[I_SCONVB] + col + 4);
          bs[0] = (f32x2n){a[0], a[1]}; bs[1] = (f32x2n){a[2], a[3]}; bs[2] = (f32x2n){c4[0], c4[1]}; bs[3] = (f32x2n){c4[2], c4[3]}; }
        float ws_v[2], cd_v;
        { const int d = w >> 2, hh = g * 4 + (w & 3); float dt[2], dA[2], inc[2], total;
          dt_scan(DTR, r0, d * 32 + hh, F.in[I_SDTB][d * 32 + hh], -__expf(F.in[I_SALOG][d * 32 + hh]), lane, dt, dA, inc, total);
#pragma unroll
          for (int h = 0; h < 2; ++h) ws_v[h] = dt[h] * (d == 0 ? __expf(total - inc[h]) : __expf(inc[h] - dA[h]));
          cd_v = __expf(total); }
        VM_WAIT(); LDS_BARRIER();
        f32x2n f[5][4];
#define UNPK_ROW(dst, rw) do { dst[0] = (f32x2n){bflo(rw.x), bfhi(rw.x)}; dst[1] = (f32x2n){bflo(rw.y), bfhi(rw.y)}; dst[2] = (f32x2n){bflo(rw.z), bfhi(rw.z)}; dst[3] = (f32x2n){bflo(rw.w), bfhi(rw.w)}; } while (0)
#pragma unroll
        for (int i = 0; i < 4; ++i) UNPK_ROW(f[i], raw[i]);
#pragma unroll
        for (int i = 0; i < 16; ++i) {
            UNPK_ROW(f[(i + 4) % 5], raw[i + 4]);
            unsigned ow[4];
#pragma unroll
            for (int e = 0; e < 4; ++e) { f32x2n a = bs[e];
#pragma unroll
                for (int t = 0; t < 5; ++t) a = wt[t][e] * f[(i + t) % 5][e] + a;
                ow[e] = pk2(silu_f(a.x), silu_f(a.y)); }
            const v4u ov = {ow[0], ow[1], ow[2], ow[3]};
            const int l = l0 + i;
            if (lane < 32) *(LAS v4u*)(XI + XOFF(l, 16 * lane)) = ov; else if (lane < 48) *(LAS v4u*)(BI + l * PBB + 16 * (lane - 32)) = ov;
            if (!isctx && !dry) *(v4u*)(XBC + (size_t)(r0 + l) * CONVD + col) = ov;
        }
#undef UNPK_ROW
#pragma unroll
        for (int h = 0; h < 2; ++h) WS[w * 128 + lane + 64 * h] = ws_v[h];
        if (lane == 0) CD[sidx * 8 + w] = cd_v;
        LDS_BARRIER();
        float btf[4][8];
#pragma unroll
        for (int ks = 0; ks < 4; ++ks) { const bf16x8 r8 = tr_pair(trB + (32 * ks) * PBB + 32 * w, trB + (32 * ks + 4) * PBB + 32 * w);
#pragma unroll
            for (int i = 0; i < 8; ++i) btf[ks][i] = bf1((bf16)r8[i]); }
#pragma unroll 1
        for (int j = jlo; j < (dry == 2 ? 0 : jhi); ++j) {
            bf16x8 as_[2][4];
#pragma unroll
            for (int d = 0; d < 2; ++d) {
                const int combo = d * 4 + j;
#pragma unroll
                for (int ks = 0; ks < 4; ++ks) { const f32x4 w0 = *(const LAS f32x4*)(WS + combo * 128 + 32 * ks + 8 * gq), w1 = *(const LAS f32x4*)(WS + combo * 128 + 32 * ks + 8 * gq + 4);
                    bf16x8 o8;
                    const unsigned u0 = pk2(btf[ks][0] * w0[0], btf[ks][1] * w0[1]), u1 = pk2(btf[ks][2] * w0[2], btf[ks][3] * w0[3]);
                    const unsigned u2 = pk2(btf[ks][4] * w1[0], btf[ks][5] * w1[1]), u3 = pk2(btf[ks][6] * w1[2], btf[ks][7] * w1[3]);
                    o8[0] = (short)(u0 & 0xffff); o8[1] = (short)(u0 >> 16); o8[2] = (short)(u1 & 0xffff); o8[3] = (short)(u1 >> 16); o8[4] = (short)(u2 & 0xffff); o8[5] = (short)(u2 >> 16); o8[6] = (short)(u3 & 0xffff); o8[7] = (short)(u3 >> 16);
                    as_[d][ks] = o8; }
            }
            const LAS unsigned char* xb[4];
#pragma unroll
            for (int pt = 0; pt < 4; ++pt) xb[pt] = trXr + (((j * 64 + pt * 16) * 2 + trXc) & 511);
#pragma unroll
            for (int pt = 0; pt < 4; ++pt) {
                bf16x8 xf[4];
#pragma unroll
                for (int ks = 0; ks < 4; ++ks) xf[ks] = tr_pair(xb[pt] + (32 * ks) * PXB, xb[pt] + (32 * ks + 4) * PXB);
#pragma unroll
                for (int d = 0; d < 2; ++d) { const int combo = d * 4 + j; f32x4 acc = {0.f, 0.f, 0.f, 0.f};
#pragma unroll
                    for (int ks = 0; ks < 4; ++ks) acc = MFMA16(as_[d][ks], xf[ks], acc);
                    *(v2u*)(S + ((size_t)(sidx * 8 + combo) * 64 + pt * 16 + l15) * 128 + 16 * w + 4 * gq) = pack4(acc); }
            }
        }
        if (F.tid == 0) QS[0] = (int)qtk;
        LDS_BARRIER();
        u = F.G + QS[0];
    }
}
__device__ __forceinline__ void ssd_phase_b(Frame& F) {
    bf16* S = (bf16*)(F.ws + WS_S); const float* CD = (const float*)(F.ws + WS_CD);
    const int NT = F.G * NWAVES * 64;
    for (int q = blockIdx.x * (NWAVES * 64) + F.tid; q < 512 * 1024; q += NT) {
        const int e8 = q & 1023, seq = q >> 10, combo = seq & 7, g = (seq >> 3) & 7, b = seq >> 6, d = combo >> 2;
        float h[8];
#pragma unroll
        for (int e = 0; e < 8; ++e) h[e] = 0.f;
#pragma unroll
        for (int k = 0; k < 2; ++k) { const int cs = d == 0 ? 32 + k : 33 - k, si = ssd_sidx(b, cs, g) * 8 + combo; const float dec = CD[si]; const v4u t = *(const v4u*)(S + (size_t)si * 8192 + e8 * 8);
            h[0] = dec * h[0] + bflo(t.x); h[1] = dec * h[1] + bfhi(t.x); h[2] = dec * h[2] + bflo(t.y); h[3] = dec * h[3] + bfhi(t.y); h[4] = dec * h[4] + bflo(t.z); h[5] = dec * h[5] + bfhi(t.z); h[6] = dec * h[6] + bflo(t.w); h[7] = dec * h[7] + bfhi(t.w); }
        for (int c0 = 0; c0 < 32; c0 += 8) {
            v4u t[8]; float dc[8];
#pragma unroll
            for (int k = 0; k < 8; ++k) { const int cs = d == 0 ? c0 + k : 31 - (c0 + k), si = ssd_sidx(b, cs, g) * 8 + combo; dc[k] = CD[si]; t[k] = *(const v4u*)(S + (size_t)si * 8192 + e8 * 8); }
#pragma unroll
            for (int k = 0; k < 8; ++k) { const int cs = d == 0 ? c0 + k : 31 - (c0 + k), si = ssd_sidx(b, cs, g) * 8 + combo;
                v4u o; o.x = pk2(h[0], h[1]); o.y = pk2(h[2], h[3]); o.z = pk2(h[4], h[5]); o.w = pk2(h[6], h[7]);
                *(v4u*)(S + (size_t)si * 8192 + e8 * 8) = o;
                const float dec = dc[k]; const v4u tt = t[k];
                h[0] = dec * h[0] + bflo(tt.x); h[1] = dec * h[1] + bfhi(tt.x); h[2] = dec * h[2] + bflo(tt.y); h[3] = dec * h[3] + bfhi(tt.y); h[4] = dec * h[4] + bflo(tt.z); h[5] = dec * h[5] + bfhi(tt.z); h[6] = dec * h[6] + bflo(tt.w); h[7] = dec * h[7] + bfhi(tt.w); }
        }
    }
}
__device__ __forceinline__ void ssd_phase_c(Frame& F, const int dry) {
    LAS unsigned char* XI = F.lds; LAS unsigned char* BI = F.lds + XI_BYTES; LAS unsigned char* MWw = F.lds + XI_BYTES + BI_BYTES + F.wave * (16 * PMB);
    LAS float* DTS = (LAS float*)(F.lds + SCAL_OFF); LAS float* INC = DTS + 1024; LAS float* EXC = DTS + 2048; LAS float* BPw = (LAS float*)(F.lds + BPW_OFF) + F.wave * 256;
    const int tid = F.tid, lane = F.lane, w = F.wave, gq = lane >> 4, q4 = (lane & 15) >> 2, p4 = lane & 3, l15 = lane & 15, lme = 16 * w + l15;
    const LAS unsigned char* trXr = XI + (8 * gq + q4) * PXB; const int trXc = 8 * p4 + 128 * (gq & 1);
    const bf16* XBC = (const bf16*)(F.ws + WS_XBC); const float* DTR = (const float*)(F.ws + WS_DT); const bf16* HIN = (const bf16*)(F.ws + WS_S); bf16* Z = (bf16*)(F.ws + WS_Z);
#ifndef MK_SUB
#define MK_SUB 0
#endif
#ifndef MK_SUBK
#define MK_SUBK 3
#endif
    unsigned long long sub_acc = 0, sub_t0 = 0;
#define SUB_BEG(k_) do { if (MK_SUB == (k_)) sub_t0 = __builtin_amdgcn_s_memrealtime(); } while (0)
#define SUB_END(k_) do { if (MK_SUB == (k_)) sub_acc += __builtin_amdgcn_s_memrealtime() - sub_t0; } while (0)
    {
        unsigned cq = __hip_atomic_load((unsigned*)(F.ctl + CW_QL), __ATOMIC_RELAXED, __HIP_MEMORY_SCOPE_AGENT); cq = cq > (unsigned)LW_BATCHES ? (unsigned)LW_BATCHES : cq; const int c8 = __builtin_amdgcn_readfirstlane((int)cq) * 8;
        const float* w1 = F.in[I_SWOUT]; const float* w2 = F.in[I_FGU]; const float* w3 = F.in[I_FDN]; const float* w4 = F.in[I_SCWIN]; const float* w5 = F.in[I_SCWOUT]; unsigned char* ws = F.ws;
        auto dec = [w1, w2, w3, w4, w5, ws](int it, bool load, LAS float* scr_, int lane_, float (&v)[32]) { const CvtDesc d = lw_cvt_desc(w1, w2, w3, w4, w5, ws, it); cvt_do(d, load, scr_, lane_, v); };
        cvt_stream(dec, LW_ITEMS, c8 + blockIdx.x * NWAVES + F.wave, F.G * NWAVES, (LAS float*)(F.lds + F.wave * 8448), F.lane);
        LDS_BARRIER(); }
    LAS int* QS = (LAS int*)(F.lds + MISC_OFF + 128); unsigned* qhead = (unsigned*)(F.ctl + CW_Q5);
    for (int u = blockIdx.x; u < NUNIT_LAT;) {
        unsigned qtk = 0u; if (tid == 0) qtk = __hip_atomic_fetch_add(qhead, 1u, __ATOMIC_RELAXED, __HIP_MEMORY_SCOPE_AGENT);
        const int b = u >> 8, c = (u >> 3) & 31, g = u & 7, r0 = b * SEQ + c * 128, sidx = ssd_sidx(b, c, g);
        SUB_BEG(1);
        v4u sx[8], sb[4];
#pragma unroll
        for (int k = 0; k < 8; ++k) { const int id = tid + 512 * k, row = id >> 5, ch = id & 31; sx[k] = *(const v4u*)(XBC + (size_t)(r0 + row) * CONVD + g * 256 + 8 * ch); }
#pragma unroll
        for (int k = 0; k < 4; ++k) { const int id = tid + 512 * k, row = id >> 4, ch = id & 15; sb[k] = *(const v4u*)(XBC + (size_t)(r0 + row) * CONVD + 2048 + g * 128 + 8 * ch); }
        bf16x8 cf[4];
#pragma unroll
        for (int ks = 0; ks < 4; ++ks) cf[ks] = *(const bf16x8*)(XBC + (size_t)(r0 + lme) * CONVD + 3072 + g * 128 + 32 * ks + 8 * gq);
        v4u hp[2], hq[2];
        const bf16* hbase = HIN + (size_t)sidx * 8 * 8192;
#pragma unroll
        for (int k = 0; k < 2; ++k) { const int id = tid + 512 * k; hp[k] = *(const v4u*)(hbase + (size_t)(id >> 4) * 128 + 8 * (id & 15)); hq[k] = *(const v4u*)(hbase + 4 * 8192 + (size_t)(id >> 4) * 128 + 8 * (id & 15)); }
        { const int d = w >> 2, hh = g * 4 + (w & 3); float dt[2], dA[2], inc[2], total;
          dt_scan(DTR, r0, d * 32 + hh, F.in[I_SDTB][d * 32 + hh], -__expf(F.in[I_SALOG][d * 32 + hh]), lane, dt, dA, inc, total);
#pragma unroll
          for (int h = 0; h < 2; ++h) { DTS[w * 128 + lane + 64 * h] = dt[h]; INC[w * 128 + lane + 64 * h] = inc[h]; EXC[w * 128 + lane + 64 * h] = inc[h] - dA[h]; } }
#pragma unroll
        for (int k = 0; k < 8; ++k) { const int id = tid + 512 * k, row = id >> 5, ch = id & 31; *(LAS v4u*)(XI + XOFF(row, 16 * ch)) = sx[k]; }
#pragma unroll
        for (int k = 0; k < 4; ++k) { const int id = tid + 512 * k, row = id >> 4, ch = id & 15; *(LAS v4u*)(BI + row * PBB + 16 * ch) = sb[k]; }
        LDS_BARRIER();
        SUB_END(1); SUB_BEG(2);
        f32x4 Gt[8];
#pragma unroll
        for (int st = 0; st < 8; ++st) { f32x4 a = {0.f, 0.f, 0.f, 0.f};
#pragma unroll
            for (int ks = 0; ks < 4; ++ks) a = MFMA16(*(const LAS bf16x8*)(BI + (16 * st + l15) * PBB + (32 * ks + 8 * gq) * 2), cf[ks], a);
            Gt[st] = a; }
        LDS_BARRIER();
        LAS unsigned char* HB0 = BI; LAS unsigned char* HB1 = BI + 64 * PBB;
#pragma unroll
        for (int k = 0; k < 2; ++k) { const int id = tid + 512 * k; *(LAS v4u*)(HB0 + (id >> 4) * PBB + 16 * (id & 15)) = hp[k]; *(LAS v4u*)(HB1 + (id >> 4) * PBB + 16 * (id & 15)) = hq[k]; }
#pragma unroll
        for (int k = 0; k < 2; ++k) { const int id = tid + 512 * k; hp[k] = *(const v4u*)(hbase + 1 * 8192 + (size_t)(id >> 4) * 128 + 8 * (id & 15));
                                      hq[k] = *(const v4u*)(hbase + 5 * 8192 + (size_t)(id >> 4) * 128 + 8 * (id & 15)); }
        LDS_BARRIER();
        SUB_END(2); SUB_BEG(3);
#pragma unroll 1
        for (int j = 0; j < 4; ++j) {
            f32x4 Y[4]; const LAS unsigned char* xb[4];
#pragma unroll
            for (int pt = 0; pt < 4; ++pt) { Y[pt] = (f32x4){0.f, 0.f, 0.f, 0.f}; xb[pt] = trXr + (((j * 64 + pt * 16) * 2 + trXc) & 511); }
            const int kd = w >> 1; float ul2[2], al2[2], er2[2];
#pragma unroll
            for (int d = 0; d < 2; ++d) { const int combo = d * 4 + j; const LAS float* U = (d ? EXC : INC) + combo * 128; const LAS float* DTc = DTS + combo * 128;
                const float tot = INC[combo * 128 + 127], u_l = U[lme];
                const float u_ref = d ? (kd == 3 ? tot : U[32 * kd + 32]) : (kd == 0 ? 0.f : U[32 * kd - 1]);
                ul2[d] = u_l; al2[d] = __expf(d ? (u_ref - u_l) : (u_l - u_ref)); er2[d] = __expf(d ? (tot - u_ref) : u_ref);
#pragma unroll
                for (int h = 0; h < 2; ++h) { const int s = lane + 64 * h; const float ar = d ? (U[s] - u_ref) : (u_ref - U[s]); BPw[d * 128 + s] = __expf(fminf(ar, 0.f)) * DTc[s]; } }
#pragma unroll
            for (int d = 0; d < 2; ++d) {
                const int combo = d * 4 + j;
                LAS unsigned char* HBc = d ? HB1 : HB0;
                const LAS float* U = (d ? EXC : INC) + combo * 128; const LAS float* DTc = DTS + combo * 128;
                const float u_l = ul2[d], a_l = al2[d], e_ref = er2[d];
#pragma unroll
                for (int ks = 0; ks < 4; ++ks) {
                    if (ks == kd) {
#pragma unroll
                        for (int t2 = 0; t2 < 2; ++t2) { const int st = 2 * ks + t2, s0 = 16 * st + 4 * gq; const f32x4 u_s = *(const LAS f32x4*)(U + s0), dt_s = *(const LAS f32x4*)(DTc + s0);
                            f32x4 val;
#pragma unroll
                            for (int e = 0; e < 4; ++e) { const int s = s0 + e; const bool valid = d ? (s >= lme) : (s <= lme); const float arg = d ? (u_s[e] - u_l) : (u_l - u_s[e]);
                                val[e] = valid ? Gt[st][e] * __expf(arg) * dt_s[e] : 0.f; }
                            *(LAS v2u*)(MWw + l15 * PMB + s0 * 2) = pack4(val); }
                    } else if (d ? (ks > kd) : (ks < kd)) {
#pragma unroll
                        for (int t2 = 0; t2 < 2; ++t2) { const int st = 2 * ks + t2, s0 = 16 * st + 4 * gq; const f32x4 bp = *(const LAS f32x4*)(BPw + d * 128 + s0);
                            *(LAS v2u*)(MWw + l15 * PMB + s0 * 2) = pack4(Gt[st] * bp); }
                    }
                }
                f32x4 Yp[4];
#pragma unroll
                for (int pt = 0; pt < 4; ++pt) { f32x4 a = {0.f, 0.f, 0.f, 0.f};
#pragma unroll
                    for (int ks = 0; ks < 4; ++ks) a = MFMA16(*(const LAS bf16x8*)(HBc + (16 * pt + l15) * PBB + (32 * ks + 8 * gq) * 2), cf[ks], a);
                    Yp[pt] = a * e_ref; }
#pragma unroll
                for (int ks = 0; ks < 4; ++ks) if (d ? (ks > kd) : (ks < kd)) {
                    const bf16x8 mb = *(const LAS bf16x8*)(MWw + l15 * PMB + (32 * ks + 8 * gq) * 2);
#pragma unroll
                    for (int pt = 0; pt < 4; ++pt) { const bf16x8 xa = tr_pair(xb[pt] + (32 * ks) * PXB, xb[pt] + (32 * ks + 4) * PXB);
                        Yp[pt] = MFMA16(xa, mb, Yp[pt]); }
                }
#pragma unroll
                for (int pt = 0; pt < 4; ++pt) Y[pt] = Y[pt] + Yp[pt] * a_l;
#pragma unroll
                for (int ks = 0; ks < 4; ++ks) if (ks == kd) {
                    const bf16x8 mb = *(const LAS bf16x8*)(MWw + l15 * PMB + (32 * ks + 8 * gq) * 2);
#pragma unroll
                    for (int pt = 0; pt < 4; ++pt) { const bf16x8 xa = tr_pair(xb[pt] + (32 * ks) * PXB, xb[pt] + (32 * ks + 4) * PXB);
                        Y[pt] = MFMA16(xa, mb, Y[pt]); }
                }
            }
            LDS_BARRIER();
            const float dsk = F.in[I_SD][g * 4 + j];
#pragma unroll
            for (int pt = 0; pt < 4; ++pt) { const int ch = j * 64 + pt * 16 + 4 * gq;
                const f32x4 xv = unpack4(*(const LAS v2u*)(XI + XOFF(lme, ch * 2)));
                *(LAS v2u*)(XI + XOFF(lme, ch * 2)) = pack4(Y[pt] + xv * dsk); }
            if (j < 3) {
#pragma unroll
                for (int k = 0; k < 2; ++k) { const int id = tid + 512 * k; *(LAS v4u*)(HB0 + (id >> 4) * PBB + 16 * (id & 15)) = hp[k]; *(LAS v4u*)(HB1 + (id >> 4) * PBB + 16 * (id & 15)) = hq[k]; }
                if (j < 2) {
#pragma unroll
                    for (int k = 0; k < 2; ++k) { const int id = tid + 512 * k; hp[k] = *(const v4u*)(hbase + (size_t)(j + 2) * 8192 + (size_t)(id >> 4) * 128 + 8 * (id & 15));
                                                  hq[k] = *(const v4u*)(hbase + (size_t)(6 + j) * 8192 + (size_t)(id >> 4) * 128 + 8 * (id & 15)); } }
                LDS_BARRIER();
            }
        }
        SUB_END(3); SUB_BEG(4);
        { const int chunk = tid & 31; const f32x4 nw0 = *(const f32x4*)(F.in[I_SNORM] + g * 256 + 8 * chunk), nw1 = *(const f32x4*)(F.in[I_SNORM] + g * 256 + 8 * chunk + 4);
          v4u zq[8];
#pragma unroll
          for (int k = 0; k < 8; ++k) zq[k] = *(const v4u*)(Z + (size_t)(r0 + (tid >> 5) + 16 * k) * DIN + g * 256 + 8 * chunk);
          LDS_BARRIER();
#pragma unroll
          for (int k = 0; k < 8; ++k) { const int row = (tid >> 5) + 16 * k; const v4u yv = *(const LAS v4u*)(XI + XOFF(row, 16 * chunk)), zv = zq[k];
              float y[8] = {bflo(yv.x), bfhi(yv.x), bflo(yv.y), bfhi(yv.y), bflo(yv.z), bfhi(yv.z), bflo(yv.w), bfhi(yv.w)};
              const float z[8] = {bflo(zv.x), bfhi(zv.x), bflo(zv.y), bfhi(zv.y), bflo(zv.z), bfhi(zv.z), bflo(zv.w), bfhi(zv.w)};
              float ss = 0.f;
#pragma unroll
              for (int e = 0; e < 8; ++e) { y[e] = y[e] * silu_f(z[e]); ss += y[e] * y[e]; }
#pragma unroll
              for (int o = 1; o < 32; o <<= 1) ss += __shfl_xor(ss, o);
              const float rr = rsqrtf(ss * (1.0f / 256.0f) + EPS);
              v4u ov; ov.x = pk2(y[0] * rr * nw0[0], y[1] * rr * nw0[1]); ov.y = pk2(y[2] * rr * nw0[2], y[3] * rr * nw0[3]); ov.z = pk2(y[4] * rr * nw1[0], y[5] * rr * nw1[1]); ov.w = pk2(y[6] * rr * nw1[2], y[7] * rr * nw1[3]);
              if (!dry) *(v4u*)(Z + (size_t)(r0 + row) * DIN + g * 256 + 8 * chunk) = ov; } }
        if (tid == 0) QS[0] = (int)qtk;
        LDS_BARRIER();
        SUB_END(4);
        u = F.G + QS[0];
    }
    if (MK_SUB) { const unsigned long long t1_ = __builtin_amdgcn_s_memrealtime(), d_ = sub_acc * MK_SUBK; while (__builtin_amdgcn_s_memrealtime() - t1_ < d_) __builtin_amdgcn_s_sleep(8); }
#undef SUB_BEG
#undef SUB_END
}

__device__ __forceinline__ void p12_shortconv(Frame& F) {
    const bf16* P = (const bf16*)(F.ws + WS_SCP); const bf16* GB = P + (size_t)MLAT * 1024; bf16* U = (bf16*)(F.ws + WS_H); const float* cw = F.in[I_SCCONV];
    const int NT = F.G * NWAVES * 64;
    const int id0 = blockIdx.x * (NWAVES * 64) + F.tid, col = 8 * (id0 & 127), rstep = NT >> 7;
    f32x4 w0[3], w1[3];
#pragma unroll
    for (int t = 0; t < 3; ++t) { w0[t] = *(const f32x4*)(cw + t * 1024 + col); w1[t] = *(const f32x4*)(cw + t * 1024 + col + 4); }
    for (int r = id0 >> 7; r < MLAT; r += 2 * rstep) {
        v4u pp[2][3], gb[2];
#pragma unroll
        for (int u = 0; u < 2; ++u) { const int rr = r + u * rstep; const int xpos = rr & 63;
#pragma unroll
            for (int t = 0; t < 3; ++t) { const int xp = xpos + t - 1; const bool ok = (rr < MLAT) && xp >= 0 && xp < 64;
                pp[u][t] = ok ? *(const v4u*)(P + (size_t)(rr + t - 1) * 1024 + col) : (v4u){0u, 0u, 0u, 0u}; }
            gb[u] = (rr < MLAT) ? *(const v4u*)(GB + (size_t)rr * 1024 + col) : (v4u){0u, 0u, 0u, 0u}; }
#pragma unroll
        for (int u = 0; u < 2; ++u) { const int rr = r + u * rstep; if (rr >= MLAT) break;
            float acc[8];
#pragma unroll
            for (int e = 0; e < 8; ++e) acc[e] = 0.f;
#pragma unroll
            for (int t = 0; t < 3; ++t) { const v4u p_ = pp[u][t];
                acc[0] += w0[t][0] * bflo(p_.x); acc[1] += w0[t][1] * bfhi(p_.x); acc[2] += w0[t][2] * bflo(p_.y); acc[3] += w0[t][3] * bfhi(p_.y);
                acc[4] += w1[t][0] * bflo(p_.z); acc[5] += w1[t][1] * bfhi(p_.z); acc[6] += w1[t][2] * bflo(p_.w); acc[7] += w1[t][3] * bfhi(p_.w); }
            const v4u b_ = gb[u];
            v4u o; o.x = pk2(bflo(b_.x) * acc[0], bfhi(b_.x) * acc[1]); o.y = pk2(bflo(b_.y) * acc[2], bfhi(b_.y) * acc[3]); o.z = pk2(bflo(b_.z) * acc[4], bfhi(b_.z) * acc[5]); o.w = pk2(bflo(b_.w) * acc[6], bfhi(b_.w) * acc[7]);
            *(v4u*)(U + (size_t)rr * DM + col) = o; }
    }
}

__device__ __forceinline__ void reduce8(const float (&v)[8], float (&out)[8], int lane) {
    const bool u5 = (lane & 32) != 0, u4 = (lane & 16) != 0, u3 = (lane & 8) != 0;
    float a[4];
#pragma unroll
    for (int k = 0; k < 4; ++k) { const float snd = u5 ? v[k] : v[4 + k], kp = u5 ? v[4 + k] : v[k]; a[k] = kp + __shfl_xor(snd, 32); }
    float c[2];
#pragma unroll
    for (int k = 0; k < 2; ++k) { const float snd = u4 ? a[k] : a[2 + k], kp = u4 ? a[2 + k] : a[k]; c[k] = kp + __shfl_xor(snd, 16); }
    float d; { const float snd = u3 ? c[0] : c[1], kp = u3 ? c[1] : c[0]; d = kp + __shfl_xor(snd, 8); }
    d += __shfl_xor(d, 4); d += __shfl_xor(d, 2); d += __shfl_xor(d, 1);
#pragma unroll
    for (int e = 0; e < 8; ++e) out[e] = __builtin_bit_cast(float, __builtin_amdgcn_readlane(__builtin_bit_cast(int, d), 8 * e));
}
__device__ __forceinline__ void top2_gates(const float (&lg)[8], int& e0, int& e1, float& g0) {
    e0 = 0; float v0 = lg[0];
#pragma unroll
    for (int e = 1; e < 8; ++e) if (lg[e] > v0) { v0 = lg[e]; e0 = e; }
    e1 = -1; float v1 = 0.f;
#pragma unroll
    for (int e = 0; e < 8; ++e) if (e != e0 && (e1 < 0 || lg[e] > v1)) { v1 = lg[e]; e1 = e; }
    g0 = 1.0f / (1.0f + __expf(v1 - v0));
}
__device__ __forceinline__ void p14_resnorm_route(Frame& F) {
    LAS float* RW = (LAS float*)F.lds;
    LAS int* SEL = (LAS int*)(F.lds + 32768);
    const bf16* Y = (const bf16*)(F.ws + WS_Y3); unsigned char* H8 = (unsigned char*)(F.ws + WS_H); float* RSTD = (float*)(F.ws + WS_RSTD);
    int* SELR = (int*)(F.ws + WS_ROUTE + RT_SELR); float* GATE = (float*)(F.ws + WS_ROUTE + RT_GATE); int* CNT = (int*)(F.ws + WS_ROUTE + RT_CNT);
    for (int i = F.tid; i < 8192; i += NWAVES * 64) RW[(i & 7) * 1024 + (i >> 3)] = F.in[I_ROUTER][i];
    __syncthreads();
    const float* npost = F.in[I_NPOST] + 2 * 1024; const float* npre = F.in[I_NPRE] + 3 * 1024;
    const int c0 = 4 * F.lane;
    for (int vb = blockIdx.x; vb < 256; vb += F.G) {
        f32x4 xq[2][4];
#pragma unroll
        for (int j = 0; j < 4; ++j) { xq[0][j] = *(const f32x4*)(F.out + (size_t)(512 * F.wave + 2 * vb) * DM + c0 + 256 * j); xq[1][j] = *(const f32x4*)(F.out + (size_t)(512 * F.wave + 2 * vb + 1) * DM + c0 + 256 * j); }
        for (int i = 0; i < 8; ++i) {
            const int pr = F.wave + 8 * i, r = 512 * pr + 2 * vb, tl = 2 * pr, b = r >> 12;
            f32x4 y0[4], y1[4], x0[4], x1[4];
#pragma unroll
            for (int j = 0; j < 4; ++j) { y0[j] = unpack4(*(const v2u*)(Y + (size_t)r * DM + c0 + 256 * j)); y1[j] = unpack4(*(const v2u*)(Y + (size_t)(r + 1) * DM + c0 + 256 * j)); x0[j] = xq[0][j]; x1[j] = xq[1][j]; }
            if (i + 1 < 8) {
#pragma unroll
                for (int j = 0; j < 4; ++j) { xq[0][j] = *(const f32x4*)(F.out + (size_t)(r + 4096) * DM + c0 + 256 * j); xq[1][j] = *(const f32x4*)(F.out + (size_t)(r + 4097) * DM + c0 + 256 * j); } }
            const float* g_ = mod_vec(F, 1, b, 2); const float* s_ = mod_vec(F, 1, b, 4); const float* h_ = mod_vec(F, 1, b, 3);
            float s0 = ss_part(y0), s1 = ss_part(y1); wave_sum2(s0, s1);
            const float q0 = rsqrtf(s0 * (1.0f / DM) + EPS), q1 = rsqrtf(s1 * (1.0f / DM) + EPS);
#pragma unroll
            for (int j = 0; j < 4; ++j) { const f32x4 np_ = *(const f32x4*)(npost + c0 + 256 * j), gt_ = *(const f32x4*)(g_ + c0 + 256 * j); x0[j] = x0[j] + gt_ * ((y0[j] * q0) * np_); x1[j] = x1[j] + gt_ * ((y1[j] * q1) * np_); }
            float t0 = ss_part(x0), t1 = ss_part(x1); wave_sum2(t0, t1);
            const float p0 = rsqrtf(t0 * (1.0f / DM) + EPS), p1 = rsqrtf(t1 * (1.0f / DM) + EPS);
#pragma unroll
            for (int j = 0; j < 4; ++j) { const f32x4 npr_ = *(const f32x4*)(npre + c0 + 256 * j), sc_ = *(const f32x4*)(s_ + c0 + 256 * j) + 1.0f, sh_ = *(const f32x4*)(h_ + c0 + 256 * j); x0[j] = (x0[j] * p0 * npr_) * sc_ + sh_; x1[j] = (x1[j] * p1 * npr_) * sc_ + sh_;
                *(unsigned*)(H8 + (size_t)r * DM + c0 + 256 * j) = pk4_fp8(x0[j][0], x0[j][1], x0[j][2], x0[j][3]); *(unsigned*)(H8 + (size_t)(r + 1) * DM + c0 + 256 * j) = pk4_fp8(x1[j][0], x1[j][1], x1[j][2], x1[j][3]); }
            float la[8], lb[8];
#pragma unroll
            for (int e = 0; e < 8; ++e) { la[e] = 0.f; lb[e] = 0.f; }
#pragma unroll
            for (int j = 0; j < 4; ++j)
#pragma unroll
                for (int e = 0; e < 8; ++e) { const f32x4 rw = *(const LAS f32x4*)(RW + e * 1024 + c0 + 256 * j);
                    la[e] += (x0[j][0] * rw[0] + x0[j][1] * rw[1]) + (x0[j][2] * rw[2] + x0[j][3] * rw[3]);
                    lb[e] += (x1[j][0] * rw[0] + x1[j][1] * rw[1]) + (x1[j][2] * rw[2] + x1[j][3] * rw[3]); }
            float ta[8], tb[8]; reduce8(la, ta, F.lane); reduce8(lb, tb, F.lane);
            int ea0, ea1, eb0, eb1; float ga, gb; top2_gates(ta, ea0, ea1, ga); top2_gates(tb, eb0, eb1, gb);
            if (F.lane == 0) { RSTD[r] = q0; RSTD[r + 1] = q1; GATE[2 * r] = ga; GATE[2 * r + 1] = 1.0f - ga; SEL[2 * tl] = ea0; SEL[2 * tl + 1] = ea1;
                               GATE[2 * r + 2] = gb; GATE[2 * r + 3] = 1.0f - gb; SEL[2 * tl + 2] = eb0; SEL[2 * tl + 3] = eb1; }
        }
        __syncthreads();
        { const int e = F.wave; const v4u s4 = *(const LAS v4u*)(SEL + 4 * F.lane);
          const int f0 = (int)s4.x == e, f1 = (int)s4.y == e, f2 = (int)s4.z == e, f3 = (int)s4.w == e, cl = f0 + f1 + f2 + f3;
          int inc = cl;
#pragma unroll
          for (int o = 1; o < 64; o <<= 1) { const int t = __shfl_up(inc, o); if (F.lane >= o) inc += t; }
          int rk = inc - cl;
          const int tot = __shfl(inc, 63);
#define P14_PUT(k_, f_) do { if (f_) { const int t_ = 4 * F.lane + (k_), tl_ = t_ >> 1, r_ = 512 * (tl_ >> 1) + 2 * vb + (tl_ & 1); SELR[2 * r_ + (t_ & 1)] = e | (rk << 8); ++rk; } } while (0)
          P14_PUT(0, f0); P14_PUT(1, f1); P14_PUT(2, f2); P14_PUT(3, f3);
#undef P14_PUT
          if (F.lane == 0) CNT[vb * 8 + e] = tot; }
        __syncthreads();
    }
}
constexpr int MOE_IG = 16 * 224, MOE_ID = 56 * 32, MOE_ITEMS = 8 * (MOE_IG + MOE_ID), MOE_BATCHES = MOE_ITEMS / 8;
__device__ __forceinline__ CvtDesc moe_cvt_desc(const float* mg, const float* md, unsigned char* ws, int it) {
    CvtDesc d; d.fp8 = 1; const int e = it / (MOE_IG + MOE_ID), r = it % (MOE_IG + MOE_ID);
    if (r < MOE_IG) { d.W = mg + (size_t)e * 1024 * 2 * DFFE; d.WT = ws + WS_WMGU + (size_t)e * 2 * DFFE * 1024; d.K = 1024; d.N = 2 * DFFE; d.item = r; d.mode = 1; d.dffx = DFFE; d.sc = WGU_SCALE; }
    else { d.W = md + (size_t)e * DFFE * 1024; d.WT = ws + WS_WMDN + (size_t)e * 1024 * DFFE; d.K = DFFE; d.N = 1024; d.item = r - MOE_IG; d.mode = 0; d.dffx = 0; d.sc = WDN_SCALE; }
    return d;
}
__device__ __forceinline__ void moe_cvt_batch(Frame& F, int bt) {
    LAS float* scr = (LAS float*)(F.lds + F.wave * 8448);
    const CvtDesc d = moe_cvt_desc(F.in[I_MGU], F.in[I_MDN], F.ws, bt * 8 + F.wave);
    float v[32]; cvt_load(d, F.lane, v); cvt_finish(d, scr, F.lane, v);
}
__device__ __forceinline__ void p15_permute(Frame& F) {
    LAS int* CNTL = (LAS int*)(F.lds + 69632);
    LAS int* PRE = CNTL + 2048;
    LAS int* TOT = PRE + 2048;
    LAS int* SEG = TOT + 8;
    const int* CNT = (const int*)(F.ws + WS_ROUTE + RT_CNT); const int* SELR = (const int*)(F.ws + WS_ROUTE + RT_SELR);
    int* POS = (int*)(F.ws + WS_ROUTE + RT_POS); int* TEXP = (int*)(F.ws + WS_ROUTE + RT_TEXP);
    const unsigned char* H8 = (const unsigned char*)(F.ws + WS_H); unsigned char* HP = (unsigned char*)(F.ws + WS_HP8);
    for (int i = F.tid; i < 2048; i += NWAVES * 64) CNTL[i] = CNT[i];
    __syncthreads();
    { const int e = F.wave; int c[4], sum = 0;
#pragma unroll
      for (int k = 0; k < 4; ++k) { c[k] = CNTL[(4 * F.lane + k) * 8 + e]; sum += c[k]; }
      int inc = sum;
#pragma unroll
      for (int o = 1; o < 64; o <<= 1) { const int t = __shfl_up(inc, o); if (F.lane >= o) inc += t; }
      int run = inc - sum;
#pragma unroll
      for (int k = 0; k < 4; ++k) { PRE[(4 * F.lane + k) * 8 + e] = run; run += c[k]; }
      if (F.lane == 63) TOT[e] = inc; }
    __syncthreads();
    if (F.tid == 0) { int ss = 0; for (int e = 0; e < 8; ++e) { SEG[e] = ss; ss += (TOT[e] + 255) & ~255; } SEG[8] = ss;
        if (blockIdx.x == 0) { for (int e = 0; e < 8; ++e) for (int t = SEG[e] >> 8; t < (SEG[e + 1] >> 8); ++t) TEXP[t] = e; TEXP[300] = ss >> 8; } }
    __syncthreads();
    for (int vb = blockIdx.x; vb < 256; vb += F.G) {
        int my_pos = 0;
        { const int tl = 16 * F.wave + ((F.lane & 31) >> 1), r = 512 * (tl >> 1) + 2 * vb + (tl & 1), k = F.lane & 1;
          const int sr = SELR[2 * r + k], e = sr & 255; my_pos = SEG[e] + PRE[vb * 8 + e] + (sr >> 8);
          if (F.lane < 32) POS[2 * r + k] = my_pos; }
        v4u a[16];
#pragma unroll
        for (int i = 0; i < 16; ++i) { const int tl = 16 * F.wave + i, r = 512 * (tl >> 1) + 2 * vb + (tl & 1); a[i] = *(const v4u*)(H8 + (size_t)r * DM + 16 * F.lane); }
#pragma unroll
        for (int i = 0; i < 16; ++i)
#pragma unroll
            for (int k = 0; k < 2; ++k) { const int pos = __builtin_amdgcn_readlane(my_pos, 2 * i + k); *(v4u*)(HP + (size_t)pos * DM + 16 * F.lane) = a[i]; }
    }
    if ((int)blockIdx.x < 8) { const int e = blockIdx.x;
        for (int row = SEG[e] + TOT[e] + F.wave; row < SEG[e + 1]; row += NWAVES) *(v4u*)(HP + (size_t)row * DM + 16 * F.lane) = (v4u){0u, 0u, 0u, 0u}; }
    LAS float* scr = (LAS float*)(F.lds + F.wave * 8448);
    const int gw = blockIdx.x * NWAVES + F.wave, NGW = F.G * NWAVES;
    { unsigned cq = __hip_atomic_load((unsigned*)(F.ctl + CW_QC), __ATOMIC_RELAXED, __HIP_MEMORY_SCOPE_AGENT); cq = cq > (unsigned)MOE_BATCHES ? (unsigned)MOE_BATCHES : cq; const int c8 = __builtin_amdgcn_readfirstlane((int)cq) * 8;
      const float* mg = F.in[I_MGU]; const float* md = F.in[I_MDN]; unsigned char* ws = F.ws;
      auto dec = [mg, md, ws](int it, bool load, LAS float* scr_, int lane_, float (&v)[32]) { const CvtDesc d = moe_cvt_desc(mg, md, ws, it); cvt_do(d, load, scr_, lane_, v); };
      cvt_stream(dec, MOE_ITEMS, c8 + gw, NGW, scr, F.lane); }
}
__device__ __forceinline__ void p18_final(Frame& F) {
    const int gw = blockIdx.x * NWAVES + F.wave, NGW = F.G * NWAVES;
    const bf16* YP = (const bf16*)(F.ws + WS_YP); const int* POS = (const int*)(F.ws + WS_ROUTE + RT_POS); const float* GATE = (const float*)(F.ws + WS_ROUTE + RT_GATE);
    const float* npost = F.in[I_NPOST] + 3 * 1024; const float* npost2 = F.in[I_NPOST] + 2 * 1024;
    const bf16* Y3 = (const bf16*)(F.ws + WS_Y3); const float* RSTD = (const float*)(F.ws + WS_RSTD);
    for (int r = gw; r < MLAT; r += NGW) {
        const int b = r >> 12, p0 = POS[2 * r], p1 = POS[2 * r + 1]; const float g0 = GATE[2 * r], g1 = GATE[2 * r + 1], q = RSTD[r];
        f32x4 a[4], c[4], x[4], y[4]; load_row_bf16(YP + (size_t)p0 * DM, F.lane, a); load_row_bf16(YP + (size_t)p1 * DM, F.lane, c); load_row_f32(F.out + (size_t)r * DM, F.lane, x); load_row_bf16(Y3 + (size_t)r * DM, F.lane, y);
#pragma unroll
        for (int j = 0; j < 4; ++j) a[j] = a[j] * g0 + c[j] * g1;
        const float rr = rsqrtf(row_ss(a) * (1.0f / DM) + EPS); const float* gt = mod_vec(F, 1, b, 5); const float* gt2 = mod_vec(F, 1, b, 2);
#pragma unroll
        for (int j = 0; j < 4; ++j) { const int col = 4 * F.lane + 256 * j;
            const f32x4 x3 = x[j] + *(const f32x4*)(gt2 + col) * ((y[j] * q) * *(const f32x4*)(npost2 + col));
            *(f32x4*)(F.out + (size_t)r * DM + col) = x3 + *(const f32x4*)(gt + col) * ((a[j] * rr) * *(const f32x4*)(npost + col)); }
    }
}

#define XB_TMO      128
#define XB_XCNT(j)  (256  + 64 * (j))
#define XB_XSUB(j)  (1280 + 64 * (j))
#define XB_XGEN(j)  (2304 + 64 * (j))
#define XB_TOP      3328
#define XB_TOPGEN   3392
#define XCD_BAR_WORDS 3456
#define XB_SPIN_CAP (1u << 18)
#ifndef MK_HARVEST_CAP
#define MK_HARVEST_CAP 64
#endif

__device__ __forceinline__ unsigned xb_ld(unsigned* p)              { return __hip_atomic_load(p, __ATOMIC_RELAXED, __HIP_MEMORY_SCOPE_AGENT); }
__device__ __forceinline__ unsigned xb_add(unsigned* p, unsigned v) { return __hip_atomic_fetch_add(p, v, __ATOMIC_RELAXED, __HIP_MEMORY_SCOPE_AGENT); }
__device__ __forceinline__ unsigned xb_xcc_id() { return (unsigned)__builtin_amdgcn_s_getreg((3 << 11) | 20) & 0xFu; }
#define XB_SPIN(cond, bar) do { unsigned _sp = 0; while (cond) { __builtin_amdgcn_s_sleep(1); \
    if ((++_sp & 255u) == 0u) { if (xb_ld(&(bar)[XB_TMO])) break; if (_sp > XB_SPIN_CAP) { atomicAdd(&(bar)[XB_TMO], 1u); break; } } } } while (0)

struct XcdBarrier {
    unsigned* bar; unsigned x;
    volatile LAS unsigned* st;
};

__device__ __forceinline__ XcdBarrier xcd_barrier_post(unsigned* bar, volatile LAS unsigned* st) {
    XcdBarrier b; b.bar = bar; b.x = xb_xcc_id(); b.st = st;
    if (threadIdx.x == 0) (void)xb_add(&bar[XB_XCNT(b.x)], 1u);
    return b;
}
__device__ __forceinline__ void xcd_barrier_complete(unsigned* bar, unsigned x, unsigned& nloc, unsigned& nx) {
    const unsigned G = gridDim.x * gridDim.y * gridDim.z;
    unsigned sum, cnt, mine, sp = 0u;
    for (;;) {
        sum = 0u; cnt = 0u; mine = 0u;
#pragma unroll
        for (unsigned j = 0; j < 16; ++j) { const unsigned c = xb_ld(&bar[XB_XCNT(j)]); sum += c; cnt += (c > 0u) ? 1u : 0u; mine = (j == x) ? c : mine; }
        if (sum == G) break;
        __builtin_amdgcn_s_sleep(1);
        if ((++sp & 255u) == 0u) { if (xb_ld(&bar[XB_TMO])) break; if (sp > XB_SPIN_CAP) { atomicAdd(&bar[XB_TMO], 1u); break; } }
    }
    nloc = mine > 0u ? mine : 1u; nx = cnt > 0u ? cnt : 1u;
}

__device__ __forceinline__ void xcd_barrier(const XcdBarrier& b) {
    asm volatile("s_waitcnt vmcnt(0)" ::: "memory");
    __syncthreads();
    if (threadIdx.x == 0) {
        unsigned* bar = b.bar;
        __builtin_amdgcn_s_waitcnt(0);
        unsigned nloc = b.st[0], nx = b.st[1];
        if (nloc == 0u) { xcd_barrier_complete(bar, b.x, nloc, nx); b.st[0] = nloc; b.st[1] = nx; }
        const unsigned old = xb_add(&bar[XB_XSUB(b.x)], 1u);
        const unsigned gen = old / nloc;
        if (old + 1u == (gen + 1u) * nloc) {
            __builtin_amdgcn_fence(__ATOMIC_RELEASE, "agent");
            asm volatile("s_waitcnt vmcnt(0)" ::: "memory");
            const unsigned og = xb_add(&bar[XB_TOP], 1u);
            const unsigned tg = og / nx;
            if (og + 1u == (tg + 1u) * nx) xb_add(&bar[XB_TOPGEN], 1u);
            else XB_SPIN(xb_ld(&bar[XB_TOPGEN]) == tg, bar);
            __builtin_amdgcn_fence(__ATOMIC_ACQUIRE, "agent");
            xb_add(&bar[XB_XGEN(b.x)], 1u);
            asm volatile("s_waitcnt vmcnt(0)" ::: "memory");
        } else {
            XB_SPIN(xb_ld(&bar[XB_XGEN(b.x)]) == gen, bar);
            __builtin_amdgcn_fence(__ATOMIC_ACQUIRE, "agent");
            asm volatile("s_waitcnt vmcnt(0)" ::: "memory");
        }
    }
    __syncthreads();
}
template <int WHICH  > __device__ __forceinline__ void xcd_barrier_harvest(const XcdBarrier& b, Frame& F) {
    asm volatile("s_waitcnt vmcnt(0)" ::: "memory");
    __syncthreads();
    volatile LAS unsigned* hv = F.MISC + 16;
    unsigned* bar = b.bar;
    if (threadIdx.x == 0) {
        __builtin_amdgcn_s_waitcnt(0);
        unsigned nloc = b.st[0], nx = b.st[1];
        if (nloc == 0u) { xcd_barrier_complete(bar, b.x, nloc, nx); b.st[0] = nloc; b.st[1] = nx; }
        const unsigned old = xb_add(&bar[XB_XSUB(b.x)], 1u);
        const unsigned gen = old / nloc;
        if (old + 1u == (gen + 1u) * nloc) {
            __builtin_amdgcn_fence(__ATOMIC_RELEASE, "agent");
            asm volatile("s_waitcnt vmcnt(0)" ::: "memory");
            const unsigned og = xb_add(&bar[XB_TOP], 1u);
            const unsigned tg = og / nx;
            if (og + 1u == (tg + 1u) * nx) xb_add(&bar[XB_TOPGEN], 1u);
            else XB_SPIN(xb_ld(&bar[XB_TOPGEN]) == tg, bar);
            __builtin_amdgcn_fence(__ATOMIC_ACQUIRE, "agent");
            xb_add(&bar[XB_XGEN(b.x)], 1u);
            asm volatile("s_waitcnt vmcnt(0)" ::: "memory");
            hv[0] = 0u;
        } else { hv[0] = 1u; hv[1] = gen; }
    }
    __syncthreads();
    if (hv[0] == 1u) {
        const unsigned gen = hv[1];
#pragma unroll 1
        for (int n = 0; ; ++n) {
            if (threadIdx.x == 0) {
                int bt = -1;
                if (n < MK_HARVEST_CAP && xb_ld(&bar[XB_XGEN(b.x)]) == gen) { const unsigned t = xb_add((unsigned*)(F.ctl + (WHICH ? CW_QL : CW_QC)), 1u); bt = t < (unsigned)(WHICH ? LW_BATCHES : MOE_BATCHES) ? (int)t : -1; }
                hv[2 + (n & 1)] = (unsigned)bt;
            }
            __syncthreads();
            const int bt = (int)hv[2 + (n & 1)];
            if (bt < 0) break;
            if (WHICH) lw_cvt_batch(F, bt); else moe_cvt_batch(F, bt);
        }
        if (threadIdx.x == 0) {
            XB_SPIN(xb_ld(&bar[XB_XGEN(b.x)]) == gen, bar);
            __builtin_amdgcn_fence(__ATOMIC_ACQUIRE, "agent");
            asm volatile("s_waitcnt vmcnt(0)" ::: "memory");
        }
    }
    __syncthreads();
}


#ifndef MK_DUMP
#define MK_DUMP 0
#endif
__device__ __forceinline__ void dump_phase(Frame& F) {
    const size_t NT = (size_t)F.G * NWAVES * 64, n = (size_t)MLAT * DM;
    for (size_t i = (size_t)blockIdx.x * (NWAVES * 64) + F.tid; i < n; i += NT) {
        float v = 0.f;
        if (MK_DUMP == 1) { v = bf1(((const bf16*)(F.ws + WS_H))[i]) + (i < (size_t)MCTX * DM ? bf1(((const bf16*)(F.ws + WS_H))[n + i]) : 0.f); }
        if (MK_DUMP == 2) { for (int k = 0; k < 4; ++k) v += bf1(((const bf16*)(F.ws + WS_XBC))[i + k * n]); for (int k = 0; k < 2; ++k) v += bf1(((const bf16*)(F.ws + WS_Z))[i + k * n]); if (i < (size_t)MALL * 64) v += ((const float*)(F.ws + WS_DT))[i]; }
        if (MK_DUMP == 3) { const size_t ns = (size_t)NUNIT * 8 * 8192; for (int k = 0; k < 5; ++k) if (i + k * n < ns) v += bf1(((const bf16*)(F.ws + WS_S))[i + k * n]); for (int k = 0; k < 4; ++k) v += bf1(((const bf16*)(F.ws + WS_XBC))[i + k * n]); if (i < (size_t)NUNIT * 8) v += ((const float*)(F.ws + WS_CD))[i]; }
        if (MK_DUMP == 4) { for (int k = 0; k < 2; ++k) v += bf1(((const bf16*)(F.ws + WS_Z))[i + k * n]); }
        if (MK_DUMP == 5) { v = bf1(((const bf16*)(F.ws + WS_Y))[i]); }
        F.out[i] = v;
    }
}

struct Args { const float* in[24]; float* out; unsigned char* ws; int ph_lo, ph_hi; };
__global__ void __launch_bounds__(NWAVES * 64, 2) fwd_kernel(Args args) {
    extern __shared__ __attribute__((aligned(16))) unsigned char lds[];
    Frame F;
    F.lds = (LAS unsigned char*)lds;
    F.MISC = (volatile LAS unsigned*)(F.lds + MISC_OFF);
    F.tid = threadIdx.x; F.lane = F.tid & 63; F.wave = __builtin_amdgcn_readfirstlane(F.tid >> 6);
    F.G = gridDim.x;
#pragma unroll
    for (int i = 0; i < 24; ++i) F.in[i] = args.in[i];
    F.out = args.out; F.ws = args.ws; F.ctl = (gu32*)(args.ws + WS_CTL);
    for (int u = F.tid; u < (LDS_BYTES - MISC_OFF) / 4; u += NWAVES * 64) ((LAS unsigned*)(F.lds + MISC_OFF))[u] = 0u;
    __syncthreads();
    XcdBarrier bar; bar.bar = (unsigned*)(F.ctl + CW_BAR); bar.x = 0; bar.st = nullptr;
    if (!MK_PER_PHASE) bar = xcd_barrier_post((unsigned*)(F.ctl + CW_BAR), F.MISC + 8);
    const int lo = args.ph_lo, hi = args.ph_hi & 0xff; const int dry = (args.ph_hi >> 8) & 3;
#ifndef MK_PHASE_MASK
#define MK_PHASE_MASK 0x7ffff
#endif
#define IN(k) (((MK_PHASE_MASK >> (k)) & 1) && lo <= (k) && (k) < hi)
#ifndef MK_SPIN_PHASE
#define MK_SPIN_PHASE -1
#endif
#ifndef MK_SPIN_K
#define MK_SPIN_K 3
#endif
    unsigned long long spin_t0 = 0, spin_c0 = 0;
#define SPIN_BEGIN(k) do { if (MK_SPIN_PHASE == (k)) { spin_t0 = __builtin_amdgcn_s_memrealtime(); spin_c0 = __builtin_amdgcn_s_memtime(); } } while (0)
#define SEAM(k) do { if (MK_SPIN_PHASE == (k)) { const unsigned long long c1_ = __builtin_amdgcn_s_memtime(), t1_ = __builtin_amdgcn_s_memrealtime(), d_ = MK_SPIN_K ? (t1_ - spin_t0) * MK_SPIN_K : ((c1_ - spin_c0) >> 4); while (__builtin_amdgcn_s_memrealtime() - t1_ < d_) __builtin_amdgcn_s_sleep(8); } \
        if (!MK_PER_PHASE && IN((k) + 1)) { if ((k) >= 6 && (k) <= 13) xcd_barrier_harvest<0>(bar, F); else if ((k) >= 1 && (k) <= 3) xcd_barrier_harvest<1>(bar, F); else xcd_barrier(bar); if (MK_SPIN_PHASE == 99) { xcd_barrier(bar); xcd_barrier(bar); } } } while (0)
    bf16* const WS_bH = (bf16*)(F.ws + WS_H); bf16* const WS_bY = (bf16*)(F.ws + WS_Y); bf16* const WS_bZ = (bf16*)(F.ws + WS_Z);

    if (IN(0)) { SPIN_BEGIN(0); p0_prologue(F); SEAM(0); }
    if (IN(1)) { SPIN_BEGIN(1); p1_prenorm(F); SEAM(1); }
    if (IN(2)) { SPIN_BEGIN(2);
        pg8::Gemm g{WS_bH, (const bf16*)(F.ws + WS_WIN), MALL, DINP_PAD, DM}; pg8::InProjOrder S; S.init(MLAT, DINP_PAD, F.G, (int)blockIdx.x);
        pg8::EpiInProj E{WS_bZ, (bf16*)(F.ws + WS_XBC), (float*)(F.ws + WS_DT)};
        pg8::gemm_phase<pg8::EpiInProj, pg8::InProjOrder, true, true>(F.lds, g, S, E);
        SEAM(2);
    }
    if (IN(3)) { SPIN_BEGIN(3); ssd_phase_a(F, dry); SEAM(3); }
    if (IN(4)) { SPIN_BEGIN(4); ssd_phase_b(F); SEAM(4); }
    if (IN(5)) { SPIN_BEGIN(5); ssd_phase_c(F, dry); SEAM(5); }
    if (IN(6)) { SPIN_BEGIN(6);
        pg8::Gemm g{WS_bZ, (const bf16*)(F.ws + WS_WOUT), MLAT, DM, DIN}; pg8::StaticOrder S; S.init(MLAT, DM, F.G, (int)blockIdx.x);
        pg8::EpiBf16<0> E{WS_bY, DM, nullptr, 0, 0, 1.f};
        pg8::gemm_phase<pg8::EpiBf16<0>, pg8::StaticOrder, true, true>(F.lds, g, S, E);
        SEAM(6);
    }
    if (IN(7)) { SPIN_BEGIN(7); resnorm_phase<true, FFN_FP8 != 0>(F, F.in[I_X], 0, 2, F.in[I_NPOST], F.in[I_NPRE] + 1024, 0, 4, 3); SEAM(7); }
    if (IN(8)) { SPIN_BEGIN(8);
        if constexpr (FFN_FP8) {
            pg8::Gemm g{WS_bH, (const bf16*)(F.ws + WS_WGU), MLAT, 2 * DFF, DM / 2}; pg8::StaticOrder S; S.init(MLAT, 2 * DFF, F.G, (int)blockIdx.x);
            pg8::EpiSwiGLU8 E{(unsigned char*)(F.ws + WS_ACT0), DFF, 1.0f / WGU_SCALE};
            pg8::gemm_phase<pg8::EpiSwiGLU8, pg8::StaticOrder, true, true, true>(F.lds, g, S, E);
        } else {
            pg8::Gemm g{WS_bH, (const bf16*)(F.ws + WS_WGU), MLAT, 2 * DFF, DM}; pg8::StaticOrder S; S.init(MLAT, 2 * DFF, F.G, (int)blockIdx.x);
            pg8::EpiSwiGLU E{(bf16*)(F.ws + WS_ACT0), DFF};
            pg8::gemm_phase<pg8::EpiSwiGLU, pg8::StaticOrder, true, true>(F.lds, g, S, E);
        }
        SEAM(8);
    }
    if (IN(9)) { SPIN_BEGIN(9);
        if constexpr (FFN_FP8) {
            pg8::Gemm g{(const bf16*)(F.ws + WS_ACT0), (const bf16*)(F.ws + WS_WDN), MLAT, DM, DFF / 2}; pg8::StaticOrder S; S.init(MLAT, DM, F.G, (int)blockIdx.x);
            pg8::EpiBf16S E{WS_bY, DM, 1.0f / WDN_SCALE};
            pg8::gemm_phase<pg8::EpiBf16S, pg8::StaticOrder, true, true, true>(F.lds, g, S, E);
        } else {
            pg8::Gemm g{(const bf16*)(F.ws + WS_ACT0), (const bf16*)(F.ws + WS_WDN), MLAT, DM, DFF}; pg8::StaticOrder S; S.init(MLAT, DM, F.G, (int)blockIdx.x);
            pg8::EpiBf16<0> E{WS_bY, DM, nullptr, 0, 0, 1.f};
            pg8::gemm_phase<pg8::EpiBf16<0>, pg8::StaticOrder, true, true>(F.lds, g, S, E);
        }
        SEAM(9);
    }
    if (IN(10)) { SPIN_BEGIN(10); resnorm_phase<true>(F, F.out, 0, 5, F.in[I_NPOST] + 1024, F.in[I_NPRE] + 2048, 1, 1, 0); SEAM(10); }
    if (IN(11)) { SPIN_BEGIN(11);
        pg8::Gemm g{WS_bH, (const bf16*)(F.ws + WS_WSCI), MLAT, 3072, DM}; pg8::StaticOrder S; S.init(MLAT, 3072, F.G, (int)blockIdx.x);
        pg8::EpiScIn E{(bf16*)(F.ws + WS_SCP), (bf16*)(F.ws + WS_SCP) + (size_t)MLAT * 1024};
        pg8::gemm_phase<pg8::EpiScIn, pg8::StaticOrder, true, true>(F.lds, g, S, E);
        SEAM(11);
    }
    if (IN(12)) { SPIN_BEGIN(12); p12_shortconv(F); SEAM(12); }
    if (IN(13)) { SPIN_BEGIN(13);
        pg8::Gemm g{WS_bH, (const bf16*)(F.ws + WS_WSCO), MLAT, DM, DM}; pg8::StaticOrder S; S.init(MLAT, DM, F.G, (int)blockIdx.x);
        pg8::EpiBf16<0> E{(bf16*)(F.ws + WS_Y3), DM, nullptr, 0, 0, 1.f};
        pg8::gemm_phase<pg8::EpiBf16<0>, pg8::StaticOrder, true, true>(F.lds, g, S, E);
        SEAM(13);
    }
    if (IN(14)) { SPIN_BEGIN(14); p14_resnorm_route(F); SEAM(14); }
    if (IN(15)) { SPIN_BEGIN(15); p15_permute(F); SEAM(15); }
    if (MK_PER_PHASE && dry && lo == 16) {
        const int* texp = (const int*)(F.ws + WS_ROUTE + RT_TEXP); int nt = __builtin_amdgcn_readfirstlane(texp[300]); nt = nt < 0 ? 0 : (nt > MOE_ROWS / 256 ? MOE_ROWS / 256 : nt);
        pg8::Gemm g{(const bf16*)(F.ws + WS_HP8), (const bf16*)(F.ws + WS_WMGU), 256 * nt, 2 * DFFE, DM / 2};
        pg8::GroupedOrder S; S.init(256 * nt, 2 * DFFE, F.G, (int)blockIdx.x); S.texp = texp; S.estride = (size_t)2 * DFFE * DM;
        pg8::EpiNull E{(float*)(F.ws + WS_CD)};
        pg8::gemm_phase<pg8::EpiNull, pg8::GroupedOrder, true, true, true>(F.lds, g, S, E);
        return;
    }
    if (IN(16)) { SPIN_BEGIN(16);
        const int* texp = (const int*)(F.ws + WS_ROUTE + RT_TEXP); int nt = __builtin_amdgcn_readfirstlane(texp[300]); nt = nt < 0 ? 0 : (nt > MOE_ROWS / 256 ? MOE_ROWS / 256 : nt);
        pg8::Gemm g{(const bf16*)(F.ws + WS_HP8), (const bf16*)(F.ws + WS_WMGU), 256 * nt, 2 * DFFE, DM / 2};
        pg8::GroupedOrder S; S.init(256 * nt, 2 * DFFE, F.G, (int)blockIdx.x); S.texp = texp; S.estride = (size_t)2 * DFFE * DM;
        pg8::EpiSwiGLU8 E{(unsigned char*)(F.ws + WS_ACT), DFFE, 1.0f / WGU_SCALE};
        pg8::gemm_phase<pg8::EpiSwiGLU8, pg8::GroupedOrder, true, true, true>(F.lds, g, S, E);
        SEAM(16);
    }
    if (IN(17)) { SPIN_BEGIN(17);
        const int* texp = (const int*)(F.ws + WS_ROUTE + RT_TEXP); int nt = __builtin_amdgcn_readfirstlane(texp[300]); nt = nt < 0 ? 0 : (nt > MOE_ROWS / 256 ? MOE_ROWS / 256 : nt);
        pg8::Gemm g{(const bf16*)(F.ws + WS_ACT), (const bf16*)(F.ws + WS_WMDN), 256 * nt, DM, DFFE / 2};
        pg8::GroupedOrder S; S.init(256 * nt, DM, F.G, (int)blockIdx.x); S.texp = texp; S.estride = (size_t)DM * DFFE;
        pg8::EpiBf16S E{(bf16*)(F.ws + WS_YP), DM, 1.0f / WDN_SCALE};
        pg8::gemm_phase<pg8::EpiBf16S, pg8::GroupedOrder, true, true, true>(F.lds, g, S, E);
        SEAM(17);
    }
    if (IN(18)) { SPIN_BEGIN(18); p18_final(F); SEAM(18); }
#ifndef MK_BENCH
#define MK_BENCH 0
#endif
#ifndef MK_BENCH_DMA
#define MK_BENCH_DMA 0
#endif
#if MK_BENCH >= 3
    {
        pg8::Gemm g{WS_bH, (const bf16*)(F.ws + WS_WIN), 256, 256 * F.G * MK_BENCH_N, 512}; pg8::StaticOrder S; S.init(256, 256 * F.G * MK_BENCH_N, F.G, (int)blockIdx.x);
        pg8::EpiNull E{(float*)(F.ws + WS_CD)};
        pg8::gemm_phase<pg8::EpiNull, pg8::StaticOrder, true, true, MK_BENCH == 3, MK_BENCH_DMA == 0>(F.lds, g, S, E);
    }
#elif MK_BENCH
    {
        typedef int i32x8b __attribute__((ext_vector_type(8))); typedef int i32x4b __attribute__((ext_vector_type(4)));
        unsigned h = (unsigned)(blockIdx.x * 512 + F.tid) * 2654435761u + 12345u;
        f32x4 bacc[16];
#pragma unroll
        for (int i = 0; i < 16; ++i) bacc[i] = (f32x4){0.f, 0.f, 0.f, 0.f};
#if MK_BENCH == 1
        i32x8b oa[4], ob[4];
#pragma unroll
        for (int i = 0; i < 4; ++i)
#pragma unroll
            for (int j = 0; j < 8; ++j) { h = h * 1664525u + 1013904223u; oa[i][j] = (int)(h & 0xBFBFBFBFu); h = h * 1664525u + 1013904223u; ob[i][j] = (int)(h & 0xBFBFBFBFu); }
#pragma unroll 1
        for (int it = 0; it < MK_BENCH_N; ++it) {
#pragma unroll
            for (int m = 0; m < 4; ++m)
#pragma unroll
                for (int n = 0; n < 4; ++n) asm volatile("v_mfma_f32_16x16x128_f8f6f4 %0, %1, %2, %0" : "+v"(bacc[m * 4 + n]) : "v"(oa[m]), "v"(ob[n]));
        }
#else
        i32x4b oa[8], ob[4];
#pragma unroll
        for (int i = 0; i < 8; ++i)
#pragma unroll
            for (int j = 0; j < 4; ++j) { h = h * 1664525u + 1013904223u; oa[i][j] = (int)(h & 0xBFFFBFFFu); }
#pragma unroll
        for (int i = 0; i < 4; ++i)
#pragma unroll
            for (int j = 0; j < 4; ++j) { h = h * 1664525u + 1013904223u; ob[i][j] = (int)(h & 0xBFFFBFFFu); }
#pragma unroll 1
        for (int it = 0; it < MK_BENCH_N; ++it) {
#pragma unroll
            for (int m = 0; m < 8; ++m)
#pragma unroll
                for (int n = 0; n < 4; ++n) asm volatile("v_mfma_f32_16x16x32_bf16 %0, %1, %2, %0" : "+v"(bacc[(m & 3) * 4 + n]) : "v"(oa[m]), "v"(ob[n]));
        }
#endif
        asm volatile("s_nop 7\n\ts_nop 7\n\ts_nop 7" ::: "memory");
        float bs = 0.f;
#pragma unroll
        for (int i = 0; i < 16; ++i) bs += bacc[i][0] + bacc[i][1] + bacc[i][2] + bacc[i][3];
        if (bs == 123456.789f) ((float*)(F.ws + WS_CD))[F.tid] = bs;
    }
#endif
    if (MK_DUMP && lo <= 19 && 19 < hi) dump_phase(F);
#undef IN
#undef SEAM
}

extern "C" void kernel_launch(void* const* d_in, const int* in_sizes, int n_in, void* d_out, int out_size, void* d_ws, size_t ws_size, hipStream_t stream) {
    static int grid = 0;
    if (grid == 0) {
        if (n_in != 24 || out_size != MLAT * DM || ws_size < WS_NEED) { fprintf(stderr, "kernel_launch: unexpected problem (n_in %d, out %d, ws %zu)\n", n_in, out_size, ws_size); grid = -1; return; }
        int dev = 0, cus = 0, per_cu = 0;
        if (hipGetDevice(&dev) != hipSuccess || hipDeviceGetAttribute(&cus, hipDeviceAttributeMultiprocessorCount, dev) != hipSuccess) { grid = -1; return; }
        if (hipFuncSetAttribute((const void*)fwd_kernel, hipFuncAttributeMaxDynamicSharedMemorySize, LDS_BYTES) != hipSuccess) { fprintf(stderr, "kernel_launch: hipFuncSetAttribute failed\n"); grid = -1; return; }
        if (hipOccupancyMaxActiveBlocksPerMultiprocessor(&per_cu, (const void*)fwd_kernel, NWAVES * 64, LDS_BYTES) != hipSuccess || per_cu < 1) { fprintf(stderr, "kernel_launch: occupancy query reports %d\n", per_cu); }
        (void)hipGetLastError();
        grid = cus;
    }
    if (grid < 0) return;
    if (hipMemsetAsync((char*)d_ws + WS_CTL, 0, CTL_ZERO_BYTES, stream) != hipSuccess) return;
    Args a{};
    for (int i = 0; i < 24; ++i) a.in[i] = (const float*)d_in[i];
    a.out = (float*)d_out; a.ws = (unsigned char*)d_ws;
#if MK_PER_PHASE
#ifndef MK_TWICE_MASK
#define MK_TWICE_MASK 0
#endif
#ifndef MK_DRY_MASK
#define MK_DRY_MASK 0
#endif
#ifndef MK_DRY_LEVEL
#define MK_DRY_LEVEL 1
#endif
    for (int p = 0; p <= MK_LAST_PHASE; ++p) { a.ph_lo = p;
        if ((MK_DRY_MASK >> p) & 1) { a.ph_hi = (p + 1) | (MK_DRY_LEVEL << 8); hipLaunchKernelGGL(fwd_kernel, dim3(grid), dim3(NWAVES * 64), LDS_BYTES, stream, a); }
        a.ph_hi = p + 1; hipLaunchKernelGGL(fwd_kernel, dim3(grid), dim3(NWAVES * 64), LDS_BYTES, stream, a);
        if ((MK_TWICE_MASK >> p) & 1) hipLaunchKernelGGL(fwd_kernel, dim3(grid), dim3(NWAVES * 64), LDS_BYTES, stream, a); }
    if (MK_DUMP) { a.ph_lo = 19; a.ph_hi = 20; hipLaunchKernelGGL(fwd_kernel, dim3(grid), dim3(NWAVES * 64), LDS_BYTES, stream, a); }
#else
    a.ph_lo = 0; a.ph_hi = MK_LAST_PHASE + 1;
    hipLaunchKernelGGL(fwd_kernel, dim3(grid), dim3(NWAVES * 64), LDS_BYTES, stream, a);
#endif
}
```
